# Optimizing an MI355X kernel written in HIP

```python
import jax, jax.numpy as jnp
from jax import lax
import numpy as np

D_MODEL = 1024
BATCH = 2
SEQ = 8192
DEPTH = 1

D_MIX = D_MODEL
D_HGRN = D_MIX // 2
HGRN_HEAD_DIM = 128
HGRN_HEADS = D_HGRN // HGRN_HEAD_DIM
HGRN_CHUNK = 64
D_RG = D_MIX - D_HGRN
RG_BLOCKS = 8
RG_BLOCK_DIM = D_RG // RG_BLOCKS
CONV_WIDTH = 4
RG_C = 8.0
D_IN = 4 * D_HGRN + 2 * D_RG
N_GROUPS = 4
EXPERTS_PER_GROUP = 8
N_EXPERTS = N_GROUPS * EXPERTS_PER_GROUP
TOP_K = 2
D_EXPERT = D_MODEL // 2
MOE_BLOCK = 256
EPS = 1e-6

kernel_name = "hybrid_hgrn2_rglru_hmoe_block"


def rmsnorm(x, g):
    xf = x.astype(jnp.float32)
    y = xf * lax.rsqrt(jnp.mean(xf * xf, axis=-1, keepdims=True) + EPS)
    return (y * g.astype(jnp.float32)).astype(x.dtype)


def hgrn2_chunkwise(q, k, v, log_f):
    B, S, H, K = q.shape
    V = v.shape[-1]
    N = S // HGRN_CHUNK

    def to_chunks(t):
        return t.reshape(B, N, HGRN_CHUNK, H, t.shape[-1]).transpose(1, 0, 3, 2, 4)

    mask = jnp.tril(jnp.ones((HGRN_CHUNK, HGRN_CHUNK), dtype=bool))[:, :, None]

    def step(state, inp):
        qc, kc, vc, gc = inp
        b = jnp.cumsum(gc, axis=-2)
        diff = b[:, :, :, None, :] - b[:, :, None, :, :]
        decay = jnp.exp(jnp.where(mask, diff, -jnp.inf))
        scores = jnp.einsum('bhtk,bhtsk,bhsk->bhts', qc, decay, kc)
        o = jnp.einsum('bhts,bhsv->bhtv', scores, vc) + jnp.einsum('bhtk,bhkv->bhtv', qc * jnp.exp(b), state)
        b_last = b[:, :, -1:, :]
        new_state = jnp.exp(b_last[:, :, 0, :, None]) * state + jnp.einsum('bhsk,bhsv->bhkv', kc * jnp.exp(b_last - b), vc)
        return new_state, o

    s0 = jnp.zeros((B, H, K, V), jnp.float32)
    _, o = lax.scan(step, s0, (to_chunks(q), to_chunks(k), to_chunks(v), to_chunks(log_f)))
    return o.transpose(1, 0, 3, 2, 4).reshape(B, S, H, V)


def causal_dwconv(x, w, b):
    y = lax.conv_general_dilated(x, w[:, None, :].astype(x.dtype), window_strides=(1,),
                                 padding=[(CONV_WIDTH - 1, 0)],
                                 dimension_numbers=('NWC', 'WIO', 'NWC'),
                                 feature_group_count=x.shape[-1])
    return y + b.astype(x.dtype)


def rg_lru(xc, w_r, b_r, w_i, b_i, lam):
    B, S, R = xc.shape
    xh = xc.reshape(B, S, RG_BLOCKS, RG_BLOCK_DIM)
    r = jax.nn.sigmoid(jnp.einsum('bshi,hij->bshj', xh, w_r.astype(jnp.float32)).reshape(B, S, R) + b_r.astype(jnp.float32))
    i = jax.nn.sigmoid(jnp.einsum('bshi,hij->bshj', xh, w_i.astype(jnp.float32)).reshape(B, S, R) + b_i.astype(jnp.float32))
    log_a = RG_C * r * jax.nn.log_sigmoid(lam.astype(jnp.float32))
    a = jnp.exp(log_a)
    u = jnp.sqrt(-jnp.expm1(2.0 * log_a)) * (i * xc)

    def combine(lhs, rhs):
        a1, b1 = lhs
        a2, b2 = rhs
        return a1 * a2, a2 * b1 + b2

    _, h = lax.associative_scan(combine, (a, u), axis=1)
    return h


def hier_moe(h, w_rg, b_rg, w_re, b_re, w1, w3, w2):
    T, D = h.shape
    logits_g = (h @ w_rg + b_rg).astype(jnp.float32)
    p_g = jax.nn.softmax(logits_g, axis=-1)
    g_star = jnp.argmax(p_g, axis=-1)
    gate_g = jnp.max(p_g, axis=-1)
    logits_e = (h @ w_re + b_re).astype(jnp.float32).reshape(T, N_GROUPS, EXPERTS_PER_GROUP)
    sel = jnp.take_along_axis(logits_e, g_star[:, None, None], axis=1)[:, 0]
    p_e = jax.nn.softmax(sel, axis=-1)
    top_v, top_i = lax.top_k(p_e, TOP_K)
    w_tok = top_v / jnp.sum(top_v, axis=-1, keepdims=True) * gate_g[:, None]

    eid = (g_star[:, None] * EXPERTS_PER_GROUP + top_i).reshape(-1).astype(jnp.int32)
    tok = jnp.repeat(jnp.arange(T, dtype=jnp.int32), TOP_K)
    wflat = w_tok.reshape(-1)
    A = T * TOP_K
    n_blocks = -(-A // MOE_BLOCK) + N_EXPERTS
    P = n_blocks * MOE_BLOCK

    order = jnp.argsort(eid)
    s_eid = eid[order]
    counts = jnp.zeros((N_EXPERTS,), jnp.int32).at[eid].add(1)
    starts = jnp.cumsum(counts) - counts
    pcounts = (counts + MOE_BLOCK - 1) // MOE_BLOCK * MOE_BLOCK
    pends = jnp.cumsum(pcounts)
    pstarts = pends - pcounts
    dest = pstarts[s_eid] + (jnp.arange(A, dtype=jnp.int32) - starts[s_eid])
    buf_tok = jnp.full((P,), T, jnp.int32).at[dest].set(tok[order])
    buf_w = jnp.zeros((P,), jnp.float32).at[dest].set(wflat[order])
    blk_e = jnp.minimum(jnp.searchsorted(pends, jnp.arange(n_blocks, dtype=jnp.int32) * MOE_BLOCK, side='right'),
                        N_EXPERTS - 1).astype(jnp.int32)

    h_pad = jnp.concatenate([h, jnp.zeros((1, D), h.dtype)], axis=0)
    xb = h_pad[buf_tok].reshape(n_blocks, MOE_BLOCK, D)

    def expert_block(args):
        xblk, e = args
        return (jax.nn.silu(xblk @ w1[e]) * (xblk @ w3[e])) @ w2[e]

    yb = lax.map(expert_block, (xb, blk_e)).reshape(P, D)
    out = jnp.zeros((T + 1, D), yb.dtype).at[buf_tok].add(yb * buf_w[:, None].astype(yb.dtype))
    return out[:T]


def setup_inputs(seed: int = 0) -> dict:
    key = jax.random.key(seed)
    ks = jax.random.split(key, 28)
    f32 = jnp.float32

    def nrm(k, shape, fan_in):
        return jax.random.normal(k, shape, f32) * (fan_in ** -0.5)

    def gain(k, n):
        return 1.0 + 0.05 * jax.random.normal(k, (DEPTH, n), f32)

    def small(k, shape):
        return 0.01 * jax.random.normal(k, shape, f32)

    u = jax.random.uniform(ks[17], (DEPTH, D_RG), f32, minval=0.9, maxval=0.999)
    s = u ** (1.0 / RG_C)
    rg_lambda = jnp.log(s) - jnp.log1p(-s)
    return {
        "x": jax.random.normal(ks[0], (BATCH, SEQ, D_MODEL), f32),
        "c": jax.random.normal(ks[1], (BATCH, D_MODEL), f32),
        "w_ada": 0.5 * nrm(ks[2], (DEPTH, D_MODEL, 6 * D_MODEL), D_MODEL),
        "b_ada": small(ks[3], (DEPTH, 6 * D_MODEL)),
        "g_pre_mix": gain(ks[4], D_MODEL),
        "g_post_mix": gain(ks[5], D_MODEL),
        "g_pre_ffn": gain(ks[6], D_MODEL),
        "g_post_ffn": gain(ks[7], D_MODEL),
        "w_in": nrm(ks[8], (DEPTH, D_MODEL, D_IN), D_MODEL),
        "hgrn_gamma": jax.random.normal(ks[9], (DEPTH + 1, D_HGRN), f32),
        "hgrn_norm_g": gain(ks[10], D_HGRN),
        "conv_w": nrm(ks[11], (DEPTH, CONV_WIDTH, D_RG), CONV_WIDTH),
        "conv_b": small(ks[12], (DEPTH, D_RG)),
        "rg_w_r": nrm(ks[13], (DEPTH, RG_BLOCKS, RG_BLOCK_DIM, RG_BLOCK_DIM), RG_BLOCK_DIM),
        "rg_b_r": small(ks[14], (DEPTH, D_RG)),
        "rg_w_i": nrm(ks[15], (DEPTH, RG_BLOCKS, RG_BLOCK_DIM, RG_BLOCK_DIM), RG_BLOCK_DIM),
        "rg_b_i": small(ks[16], (DEPTH, D_RG)),
        "rg_lambda": rg_lambda,
        "rg_norm_g": gain(ks[18], D_RG),
        "w_out": nrm(ks[19], (DEPTH, D_MIX, D_MODEL), D_MIX),
        "w_router_group": nrm(ks[20], (DEPTH, D_MODEL, N_GROUPS), D_MODEL),
        "b_router_group": small(ks[21], (DEPTH, N_GROUPS)),
        "w_router_expert": nrm(ks[22], (DEPTH, D_MODEL, N_EXPERTS), D_MODEL),
        "b_router_expert": small(ks[23], (DEPTH, N_EXPERTS)),
        "w1": nrm(ks[24], (DEPTH, N_EXPERTS, D_MODEL, D_EXPERT), D_MODEL),
        "w3": nrm(ks[25], (DEPTH, N_EXPERTS, D_MODEL, D_EXPERT), D_MODEL),
        "w2": nrm(ks[26], (DEPTH, N_EXPERTS, D_EXPERT, D_MODEL), D_EXPERT),
    }


def reference(x, c, w_ada, b_ada, g_pre_mix, g_post_mix, g_pre_ffn, g_post_ffn, w_in, hgrn_gamma,
              hgrn_norm_g, conv_w, conv_b, rg_w_r, rg_b_r, rg_w_i, rg_b_i, rg_lambda, rg_norm_g, w_out,
              w_router_group, b_router_group, w_router_expert, b_router_expert, w1, w3, w2):
    B, S, D = x.shape
    lb_table = jnp.cumsum(jax.nn.softmax(hgrn_gamma.astype(jnp.float32), axis=0), axis=0)
    for l in range(DEPTH):
        mod = jax.nn.silu(c) @ w_ada[l] + b_ada[l]
        sh1, sc1, gt1, sh2, sc2, gt2 = [m[:, None, :] for m in jnp.split(mod, 6, axis=-1)]

        h = rmsnorm(x, g_pre_mix[l]) * (1.0 + sc1) + sh1
        proj = h @ w_in[l]
        q, fz, iv, gz, xr, yr = jnp.split(proj, [D_HGRN, 2 * D_HGRN, 3 * D_HGRN, 4 * D_HGRN, 4 * D_HGRN + D_RG], axis=-1)

        lb = lb_table[l]
        fz32 = fz.astype(jnp.float32)
        f = lb + (1.0 - lb) * jax.nn.sigmoid(fz32)
        k_in = (1.0 - lb) * jax.nn.sigmoid(-fz32)
        hs = (B, S, HGRN_HEADS, HGRN_HEAD_DIM)
        o_a = hgrn2_chunkwise(jax.nn.silu(q.astype(jnp.float32)).reshape(hs), k_in.reshape(hs),
                              iv.astype(jnp.float32).reshape(hs), jnp.log(f).reshape(hs))
        o_a = rmsnorm(o_a, hgrn_norm_g[l].reshape(HGRN_HEADS, HGRN_HEAD_DIM)).reshape(B, S, D_HGRN)
        o_a = (o_a * jax.nn.silu(gz.astype(jnp.float32))).astype(x.dtype)

        xc = causal_dwconv(xr, conv_w[l], conv_b[l]).astype(jnp.float32)
        hr = rg_lru(xc, rg_w_r[l], rg_b_r[l], rg_w_i[l], rg_b_i[l], rg_lambda[l])
        o_b = rmsnorm(hr * jax.nn.gelu(yr.astype(jnp.float32)), rg_norm_g[l]).astype(x.dtype)

        mix = jnp.concatenate([o_a, o_b], axis=-1) @ w_out[l]
        x = x + gt1 * rmsnorm(mix, g_post_mix[l])

        h = rmsnorm(x, g_pre_ffn[l]) * (1.0 + sc2) + sh2
        y = hier_moe(h.reshape(B * S, D), w_router_group[l], b_router_group[l], w_router_expert[l],
                     b_router_expert[l], w1[l], w3[l], w2[l]).reshape(B, S, D)
        x = x + gt2 * rmsnorm(y, g_post_ffn[l])
    return x
```

```cpp
#include <hip/hip_runtime.h>
#include <cstdio>
#include <cstdint>

#ifndef MK_N_LAUNCHES
#define MK_N_LAUNCHES 1
#endif

constexpr int BATCH = 2, SEQ = 8192, D = 1024, T = BATCH * SEQ;
constexpr int DH = 512, HD = 128, NH = 4, CHK = 64, NCH = SEQ / CHK;
constexpr int DR = 512, RBD = 64;
constexpr int DIN = 3072;
constexpr int NG = 4, EPG = 8, NE = 32, DE = 512;
constexpr int MAXMB = 160;
constexpr float EPS = 1e-6f;
constexpr int NWAVES = 8, NTHR = 512;

#define GAS __attribute__((address_space(1)))
#define LAS __attribute__((address_space(3)))
typedef unsigned short bf16;
typedef unsigned v4u __attribute__((ext_vector_type(4)));
typedef unsigned v2u __attribute__((ext_vector_type(2)));
typedef float f32x4 __attribute__((ext_vector_type(4)));
typedef short bf16x8 __attribute__((ext_vector_type(8)));
typedef GAS unsigned gu32;
#define RLX_AGENT __ATOMIC_RELAXED, __HIP_MEMORY_SCOPE_AGENT
#define LDS_WAIT() asm volatile("s_waitcnt lgkmcnt(0)" ::: "memory")
#define VM_WAIT() asm volatile("s_waitcnt vmcnt(0)" ::: "memory")

__device__ __forceinline__ unsigned f2bf(float f) { unsigned u = __builtin_bit_cast(unsigned, f); return (u + 0x7fffu + ((u >> 16) & 1u)) >> 16; }
__device__ __forceinline__ float bf2f(unsigned h) { return __builtin_bit_cast(float, h << 16); }
typedef float f32x2_t __attribute__((ext_vector_type(2))); typedef __bf16 bf16x2_t __attribute__((ext_vector_type(2)));
__device__ __forceinline__ unsigned pk2m(float lo, float hi) { f32x2_t v = {lo, hi}; bf16x2_t b = __builtin_convertvector(v, bf16x2_t); return __builtin_bit_cast(unsigned, b); }
__device__ __forceinline__ unsigned pk2(float lo, float hi) { unsigned r; asm volatile("v_cvt_pk_bf16_f32 %0, %1, %2" : "=v"(r) : "v"(lo), "v"(hi)); return r; }
__device__ __forceinline__ float frcp(float v) { return __builtin_amdgcn_rcpf(v); }
__device__ __forceinline__ float sigmoidf_(float v) { return frcp(1.f + __expf(-v)); }
__device__ __forceinline__ float siluf_(float v) { return v * frcp(1.f + __expf(-v)); }
__device__ __forceinline__ float gelu_tanh_(float v) { const float u = 1.5957691216057308f * (v + 0.044715f * v * v * v); return v * frcp(1.f + __expf(-u)); }
__device__ __forceinline__ float wave_sum(float v) {
#pragma unroll
    for (int o = 1; o < 64; o <<= 1) v += __shfl_xor(v, o);
    return v;
}

constexpr size_t MiB = 1u << 20, KiB = 1u << 10;
constexpr size_t WS_CTL = 0, CTL_ZERO_BYTES = 1 * MiB;
constexpr size_t WS_MOD = 1 * MiB;
constexpr size_t WS_LB = WS_MOD + 64 * KiB;
constexpr size_t WS_WRT = WS_MOD + 128 * KiB;
constexpr size_t WS_WIT = WS_WRT + 64 * KiB;
constexpr size_t WS_RGA = 2 * MiB;
constexpr size_t WS_RGH = WS_RGA + 512 * KiB;
constexpr size_t WS_CARRY = WS_RGH + 512 * KiB;
constexpr size_t WS_DD = WS_CARRY + 512 * KiB;
constexpr size_t WS_WGT = 4 * MiB;
constexpr size_t WS_LIST = 5 * MiB;
constexpr size_t WS_WIN = 10 * MiB;
constexpr size_t WS_WOUT = 16 * MiB;
constexpr size_t WS_W13 = 18 * MiB;
constexpr size_t WS_W2 = 82 * MiB;
constexpr size_t WS_H = 114 * MiB;
constexpr size_t WS_PROJ = 146 * MiB;
constexpr size_t WS_MIX = WS_PROJ;
constexpr size_t WS_YA = WS_PROJ;
constexpr size_t WS_ACT = WS_PROJ + 64 * MiB;
constexpr size_t WS_END = 258 * MiB;
constexpr size_t PROJ_S = (size_t)T * DH;
constexpr int CW_CNT = 64;
constexpr int CW_BAR = 4096;

constexpr int RING_BYTES = 131072;
constexpr int RTAB_BYTES = 1024 * 36 * 4;
constexpr int X_OFF = RTAB_BYTES;
constexpr int X_GTAB = X_OFF;
constexpr int X_MBE = X_OFF + 4096;
constexpr int X_MISC = X_OFF + 6144;
constexpr int LDS_BYTES = X_OFF + 8192;

namespace pg8 {
constexpr int BM = 256, BK = 64, HALF = 128, HTB = HALF * BK * 2, NXCD = 8, WGM = 8;
__host__ __device__ __forceinline__ int lds_byte(int r, int c) { const int st = (r >> 4) * 2 + (c >> 5), rr = r & 15, cc = c & 31, ob = rr * 64 + cc * 2; return st * 1024 + (ob ^ (((ob >> 9) & 1) << 5)); }
__host__ __device__ __forceinline__ void stage_rc(int b, int& R, int& C) { const int st = b / 1024, sb = b % 1024, swz = sb ^ (((sb >> 9) & 1) << 5); R = (st >> 1) * 16 + swz / 64; C = (st & 1) * 32 + (swz % 64) / 2; }
__host__ __device__ __forceinline__ int perm32(int rho) { const int n = rho >> 4, i = rho & 15; return 8 * (i >> 2) + 4 * n + (i & 3); }

struct Unit { int pm, pn, slot; };
struct Gemm { const bf16* A; const bf16* Bt; int K; };

struct StaticOrder {
    int nM, nN, nwg, G, c, K;
    __device__ void init(int M, int N, int K_, int G_, int c_) { nM = M / BM; nN = N / BM; nwg = nM * nN; G = G_; c = c_; K = K_; }
    __device__ bool next(int i, Unit& u) const {
        const long L = (long)i * G + c; if (L >= nwg) return false;
        int wgid = (int)L; { const int q = nwg / NXCD, r = nwg % NXCD, xcd = wgid % NXCD, off = wgid / NXCD; wgid = (xcd < r ? xcd * (q + 1) : r * (q + 1) + (xcd - r) * q) + off; }
        const int nig = WGM * nN, gid = wgid / nig, fm = gid * WGM, gsz = (nM - fm) < WGM ? (nM - fm) : WGM;
        u.pm = fm + ((wgid % nig) % gsz); u.pn = (wgid % nig) / gsz; u.slot = i; return true;
    }
    __device__ size_t aoff(const Unit& u) const { return (size_t)u.pm * BM * K * 2; }
    __device__ size_t boff(const Unit& u) const { return (size_t)u.pn * BM * K * 2; }
};
struct MoeOrder {
    int nunits, G, c, K; const LAS int* mbe; size_t estride;
    __device__ bool next(int i, Unit& u) const {
        long L;
        if (G == 256) { const int x = c & 7, ci = c >> 3; const int lo = (int)(((long)nunits * x) >> 3), hi = (int)(((long)nunits * (x + 1)) >> 3); L = lo + ci + 32 * i; if (L >= hi) return false; }
        else { L = (long)i * G + c; if (L >= nunits) return false; }
        u.pm = (int)(L >> 2); u.pn = (int)(L & 3); u.slot = i; return true;
    }
    __device__ size_t aoff(const Unit& u) const { return (size_t)u.pm * BM * K * 2; }
    __device__ size_t boff(const Unit& u) const { return (size_t)mbe[u.pm] * estride + (size_t)u.pn * BM * K * 2; }
};

struct EpiProj {
    static constexpr bool PERM = true;
    bf16* base; const float* lb;
    __device__ __forceinline__ void operator()(const f32x4 (&acc)[2][2][4][2], const Unit& u, int wr, int wc, int fr, int fq) const {
        const int grp = u.pn >> 1, c0 = (u.pn & 1) * 256 + wc * 32 + 8 * fq, row0 = u.pm * BM + wr * 64 + fr;
        bf16* ob = base + (grp == 0 ? 0 : grp == 1 ? PROJ_S : (size_t)(grp + 1) * PROJ_S);
        float lbv[2][8];
        if (grp == 1) {
#pragma unroll
            for (int bj = 0; bj < 2; ++bj) { const f32x4 a = *(const f32x4*)(lb + c0 + bj * HALF), b = *(const f32x4*)(lb + c0 + bj * HALF + 4);
                lbv[bj][0] = a[0]; lbv[bj][1] = a[1]; lbv[bj][2] = a[2]; lbv[bj][3] = a[3]; lbv[bj][4] = b[0]; lbv[bj][5] = b[1]; lbv[bj][6] = b[2]; lbv[bj][7] = b[3]; }
        }
#pragma unroll
        for (int ai = 0; ai < 2; ++ai)
#pragma unroll
            for (int m = 0; m < 4; ++m) { bf16* rowp = ob + (size_t)(row0 + ai * HALF + m * 16) * DH + c0;
#pragma unroll
                for (int bj = 0; bj < 2; ++bj) {
                    float v[8];
#pragma unroll
                    for (int j = 0; j < 4; ++j) { v[j] = acc[ai][bj][m][0][j]; v[4 + j] = acc[ai][bj][m][1][j]; }
                    if (grp == 1) {
                        float kv[8];
#pragma unroll
                        for (int j = 0; j < 8; ++j) { const float l = lbv[bj][j], sg = sigmoidf_(v[j]); kv[j] = (1.f - l) * (1.f - sg); v[j] = __logf(l + (1.f - l) * sg); }
                        v4u w; w.x = pk2(kv[0], kv[1]); w.y = pk2(kv[2], kv[3]); w.z = pk2(kv[4], kv[5]); w.w = pk2(kv[6], kv[7]);
                        *(v4u*)(rowp + PROJ_S + bj * HALF) = w;
                    } else if (grp == 0 || grp == 3) {
#pragma unroll
                        for (int j = 0; j < 8; ++j) v[j] = siluf_(v[j]);
                    } else if (grp == 5) {
#pragma unroll
                        for (int j = 0; j < 8; ++j) v[j] = gelu_tanh_(v[j]);
                    }
                    v4u w; w.x = pk2m(v[0], v[1]); w.y = pk2m(v[2], v[3]); w.z = pk2m(v[4], v[5]); w.w = pk2m(v[6], v[7]);
                    *(v4u*)(rowp + bj * HALF) = w;
                } }
    }
};
struct EpiF32 {
    static constexpr bool PERM = false;
    float* C; int ldc;
    __device__ __forceinline__ void operator()(const f32x4 (&acc)[2][2][4][2], const Unit& u, int wr, int wc, int fr, int fq) const {
        const int row0 = u.pm * BM + wr * 64 + fr, col0 = u.pn * BM + wc * 32 + 4 * fq;
#pragma unroll
        for (int ai = 0; ai < 2; ++ai)
#pragma unroll
            for (int m = 0; m < 4; ++m) { float* rowp = C + (size_t)(row0 + ai * HALF + m * 16) * ldc + col0;
#pragma unroll
                for (int bj = 0; bj < 2; ++bj)
#pragma unroll
                    for (int n = 0; n < 2; ++n) *(f32x4*)(rowp + bj * HALF + n * 16) = acc[ai][bj][m][n]; }
    }
};
struct EpiAct {
    static constexpr bool PERM = true;
    bf16* act;
    __device__ __forceinline__ void operator()(const f32x4 (&acc)[2][2][4][2], const Unit& u, int wr, int wc, int fr, int fq) const {
        const int row0 = u.pm * BM + wr * 64 + fr, col0 = u.pn * HALF + wc * 32 + 8 * fq;
#pragma unroll
        for (int ai = 0; ai < 2; ++ai)
#pragma unroll
            for (int m = 0; m < 4; ++m) {
                float v[8];
#pragma unroll
                for (int j = 0; j < 4; ++j) { v[j] = siluf_(acc[ai][0][m][0][j]) * acc[ai][1][m][0][j]; v[4 + j] = siluf_(acc[ai][0][m][1][j]) * acc[ai][1][m][1][j]; }
                v4u w; w.x = pk2(v[0], v[1]); w.y = pk2(v[2], v[3]); w.z = pk2(v[4], v[5]); w.w = pk2(v[6], v[7]);
                *(v4u*)(act + (size_t)(row0 + ai * HALF + m * 16) * DE + col0) = w; }
    }
};
struct EpiYa {
    static constexpr bool PERM = true;
    bf16* ya; const float* wgt; const LAS int* tab;
    __device__ __forceinline__ void operator()(const f32x4 (&acc)[2][2][4][2], const Unit& u, int wr, int wc, int fr, int fq) const {
        const int col0 = u.pn * BM + wc * 32 + 8 * fq;
#pragma unroll
        for (int ai = 0; ai < 2; ++ai)
#pragma unroll
            for (int m = 0; m < 4; ++m) { const int aid = tab[u.slot * 256 + ai * HALF + wr * 64 + m * 16 + fr];
                if (aid >= 0) { const float w8 = wgt[aid]; bf16* rowp = ya + (size_t)aid * D + col0;
#pragma unroll
                    for (int bj = 0; bj < 2; ++bj) { const f32x4 a = acc[ai][bj][m][0] * w8, b = acc[ai][bj][m][1] * w8;
                        v4u w; w.x = pk2(a[0], a[1]); w.y = pk2(a[2], a[3]); w.z = pk2(b[0], b[1]); w.w = pk2(b[2], b[3]);
                        *(v4u*)(rowp + bj * HALF) = w; } } }
    }
};

template <class Epi, class Sched, bool GATHER>
__device__ __forceinline__ void gemm_phase(LAS unsigned char* lds, const Gemm g, const Sched& S, const Epi& E, const LAS unsigned* gtab) {
    const int tid = threadIdx.x, wid = __builtin_amdgcn_readfirstlane(tid >> 6), lane = tid & 63, wr = wid >> 2, wc = wid & 3, fr = lane & 15, fq = lane >> 4;
    const int K = g.K, nt = K / BK;
    unsigned voffA[2], voffB[2]; int rowA[2];
#pragma unroll
    for (int i = 0; i < 2; ++i) { int R, C; stage_rc(tid * 16 + i * 8192, R, C); const int Rb = Epi::PERM ? ((R & ~31) + perm32(R & 31)) : R;
        voffA[i] = GATHER ? (unsigned)(C * 2) : (unsigned)(R * K + C) * 2u; voffB[i] = (unsigned)(Rb * K + C) * 2u; rowA[i] = R; }
    const size_t kstep = (size_t)(BK * 2);
    const size_t hstep = (size_t)HALF * K * 2;
    const unsigned ldsw = (unsigned)wid * 1024u;
    const int aoff = lds_byte(wr * 64 + fr, fq * 8), boff = lds_byte(wc * 32 + fr, fq * 8);
#define PG8_SA(b, h) (((b) * 2 + (h)) * HTB)
#define PG8_SB(b, h) ((4 + (b) * 2 + (h)) * HTB)
#define PG8_STAGE(bufoff, gbase, voff) do { _Pragma("unroll") for (int _i = 0; _i < 2; ++_i) \
        __builtin_amdgcn_global_load_lds((const unsigned*)((const char*)(gbase) + (voff)[_i]), (LAS unsigned*)(lds + (bufoff) + ldsw + _i * 8192), 16, 0, 0); } while (0)
#define PG8_STAGE_A(bufoff, gbase, slot, h) do { if constexpr (GATHER) { _Pragma("unroll") for (int _i = 0; _i < 2; ++_i) { const unsigned _ro = gtab[(slot) * 256 + (h) * HALF + rowA[_i]]; \
        __builtin_amdgcn_global_load_lds((const unsigned*)((const char*)(gbase) + _ro + voffA[_i]), (LAS unsigned*)(lds + (bufoff) + ldsw + _i * 8192), 16, 0, 0); } } \
        else { PG8_STAGE(bufoff, (const char*)(gbase) + (h) * hstep, voffA); } } while (0)
#define PG8_LDA(dst, b, h) do { _Pragma("unroll") for (int m = 0; m < 4; ++m) _Pragma("unroll") for (int k = 0; k < 2; ++k) dst[m][k] = *(const LAS bf16x8*)(lds + PG8_SA(b, h) + aoff + m * 2048 + k * 1024); } while (0)
#define PG8_LDB(dst, b, h) do { _Pragma("unroll") for (int n = 0; n < 2; ++n) _Pragma("unroll") for (int k = 0; k < 2; ++k) dst[n][k] = *(const LAS bf16x8*)(lds + PG8_SB(b, h) + boff + n * 2048 + k * 1024); } while (0)
#define PG8_MMA(ai, bj, At, Bt) do { __builtin_amdgcn_s_setprio(1); _Pragma("unroll") for (int m = 0; m < 4; ++m) _Pragma("unroll") for (int n = 0; n < 2; ++n) _Pragma("unroll") for (int k = 0; k < 2; ++k) \
        acc[ai][bj][m][n] = __builtin_amdgcn_mfma_f32_16x16x32_bf16(Bt[n][k], At[m][k], acc[ai][bj][m][n], 0, 0, 0); __builtin_amdgcn_s_setprio(0); } while (0)
#define PG8_WAIT_V(n) asm volatile("s_waitcnt vmcnt(" #n ")" ::: "memory")
#define PG8_WAIT_L(n) asm volatile("s_waitcnt lgkmcnt(" #n ")" ::: "memory")
#define PG8_BAR __builtin_amdgcn_s_barrier()
#define PG8_SCHED __builtin_amdgcn_sched_barrier(0)
    Unit cur, nxt; int ui = 0;
    if (!S.next(0, cur)) return;
    f32x4 acc[2][2][4][2];
#pragma unroll
    for (int a = 0; a < 2; ++a)
#pragma unroll
        for (int b = 0; b < 2; ++b)
#pragma unroll
            for (int m = 0; m < 4; ++m)
#pragma unroll
                for (int n = 0; n < 2; ++n) acc[a][b][m][n] = (f32x4){0.f, 0.f, 0.f, 0.f};
    bf16x8 At[4][2], B0[2][2], B1[2][2];
    const char* cA = (const char*)g.A + (GATHER ? (size_t)0 : S.aoff(cur)); const char* cB = (const char*)g.Bt + S.boff(cur);
    PG8_STAGE(PG8_SB(0, 0), cB, voffB); PG8_STAGE(PG8_SB(0, 1), cB + hstep, voffB); PG8_STAGE_A(PG8_SA(0, 0), cA, 0, 0); PG8_STAGE_A(PG8_SA(0, 1), cA, 0, 1);
    if (wr == 1) PG8_BAR;
    PG8_WAIT_V(2); PG8_BAR;
    PG8_STAGE(PG8_SB(1, 0), cB + kstep, voffB); PG8_STAGE_A(PG8_SA(1, 0), cA + kstep, 0, 0); PG8_STAGE(PG8_SB(1, 1), cB + hstep + kstep, voffB);
    PG8_WAIT_V(6); PG8_BAR;
    for (;;) {
        const bool has_next = S.next(ui + 1, nxt);
        const char* nA = has_next ? (const char*)g.A + (GATHER ? (size_t)0 : S.aoff(nxt)) : cA; const char* nB = has_next ? (const char*)g.Bt + S.boff(nxt) : cB;
        const int nslot = has_next ? ui + 1 : ui;
        for (int t = 0; t < nt; t += 2) {
            const bool last = (t == nt - 2);
            const char* a1 = cA + (size_t)(t + 1) * kstep;
            const char* a2 = last ? nA : cA + (size_t)(t + 2) * kstep; const char* b2 = last ? nB : cB + (size_t)(t + 2) * kstep;
            const char* a3 = a2 + kstep; const char* b3 = b2 + kstep;
            const int s2 = last ? nslot : ui;
            PG8_LDB(B0, 0, 0); PG8_LDB(B1, 0, 1); PG8_SCHED; PG8_LDA(At, 0, 0); PG8_STAGE_A(PG8_SA(1, 1), a1, ui, 1);
            PG8_WAIT_V(8); PG8_WAIT_L(0); PG8_BAR; PG8_MMA(0, 0, At, B0); PG8_MMA(0, 1, At, B1); PG8_BAR; PG8_SCHED;
            PG8_LDA(At, 0, 1); PG8_STAGE(PG8_SB(0, 0), b2, voffB); PG8_STAGE(PG8_SB(0, 1), b2 + hstep, voffB); PG8_STAGE_A(PG8_SA(0, 0), a2, s2, 0);
            PG8_WAIT_V(8); PG8_WAIT_L(0); PG8_BAR; PG8_MMA(1, 0, At, B0); PG8_MMA(1, 1, At, B1); PG8_BAR; PG8_SCHED;
            PG8_LDB(B0, 1, 0); PG8_LDB(B1, 1, 1); PG8_SCHED; PG8_LDA(At, 1, 0); PG8_STAGE_A(PG8_SA(0, 1), a2, s2, 1);
            PG8_WAIT_V(8); PG8_WAIT_L(0); PG8_BAR; PG8_MMA(0, 0, At, B0); PG8_MMA(0, 1, At, B1); PG8_BAR; PG8_SCHED;
            PG8_LDA(At, 1, 1); PG8_STAGE(PG8_SB(1, 0), b3, voffB); PG8_STAGE(PG8_SB(1, 1), b3 + hstep, voffB); PG8_STAGE_A(PG8_SA(1, 0), a3, s2, 0);
            PG8_WAIT_V(8); PG8_WAIT_L(0); PG8_BAR; PG8_MMA(1, 0, At, B0); PG8_MMA(1, 1, At, B1); PG8_BAR; PG8_SCHED;
        }
        if (wr == 0) PG8_BAR;
        E(acc, cur, wr, wc, fr, fq);
        if (!has_next) break;
#pragma unroll
        for (int a = 0; a < 2; ++a)
#pragma unroll
            for (int b = 0; b < 2; ++b)
#pragma unroll
                for (int m = 0; m < 4; ++m)
#pragma unroll
                    for (int n = 0; n < 2; ++n) acc[a][b][m][n] = (f32x4){0.f, 0.f, 0.f, 0.f};
        cur = nxt; cA = nA; cB = nB; ++ui;
        if (wr == 1) PG8_BAR;
    }
    PG8_WAIT_V(0);
    PG8_BAR;
#undef PG8_SA
#undef PG8_SB
#undef PG8_STAGE
#undef PG8_STAGE_A
#undef PG8_LDA
#undef PG8_LDB
#undef PG8_MMA
#undef PG8_WAIT_V
#undef PG8_WAIT_L
#undef PG8_BAR
#undef PG8_SCHED
}
}

#define XB_TMO      128
#define XB_XCNT(j)  (256  + 64 * (j))
#define XB_XSUB(j)  (1280 + 64 * (j))
#define XB_XGEN(j)  (2304 + 64 * (j))
#define XB_TOP      3328
#define XB_TOPGEN   3392
#define XCD_BAR_WORDS 3456
#define XB_SPIN_CAP (1u << 18)
__device__ __forceinline__ unsigned xb_ld(unsigned* p)              { return __hip_atomic_load(p, __ATOMIC_RELAXED, __HIP_MEMORY_SCOPE_AGENT); }
__device__ __forceinline__ unsigned xb_add(unsigned* p, unsigned v) { return __hip_atomic_fetch_add(p, v, __ATOMIC_RELAXED, __HIP_MEMORY_SCOPE_AGENT); }
__device__ __forceinline__ unsigned xb_xcc_id() { return (unsigned)__builtin_amdgcn_s_getreg((3 << 11) | 20) & 0xFu; }
#define XB_SPIN(cond, bar) do { unsigned _sp = 0; while (cond) { __builtin_amdgcn_s_sleep(1); \
    if ((++_sp & 255u) == 0u) { if (xb_ld(&(bar)[XB_TMO])) break; if (_sp > XB_SPIN_CAP) { atomicAdd(&(bar)[XB_TMO], 1u); break; } } } } while (0)
struct XcdBarrier { unsigned* bar; unsigned x; volatile LAS unsigned* st; };
__device__ __forceinline__ XcdBarrier xcd_barrier_post(unsigned* bar, volatile LAS unsigned* st) {
    XcdBarrier b; b.bar = bar; b.x = xb_xcc_id(); b.st = st;
    if (threadIdx.x == 0) (void)xb_add(&bar[XB_XCNT(b.x)], 1u);
    return b;
}
__device__ __forceinline__ void xcd_barrier_complete(unsigned* bar, unsigned x, unsigned& nloc, unsigned& nx) {
    const unsigned G = gridDim.x * gridDim.y * gridDim.z;
    unsigned sum, cnt, mine, sp = 0u;
    for (;;) {
        sum = 0u; cnt = 0u; mine = 0u;
#pragma unroll
        for (unsigned j = 0; j < 16; ++j) { const unsigned c = xb_ld(&bar[XB_XCNT(j)]); sum += c; cnt += (c > 0u) ? 1u : 0u; mine = (j == x) ? c : mine; }
        if (sum == G) break;
        __builtin_amdgcn_s_sleep(1);
        if ((++sp & 255u) == 0u) { if (xb_ld(&bar[XB_TMO])) break; if (sp > XB_SPIN_CAP) { atomicAdd(&bar[XB_TMO], 1u); break; } }
    }
    nloc = mine > 0u ? mine : 1u; nx = cnt > 0u ? cnt : 1u;
}
__device__ __forceinline__ void xcd_barrier(const XcdBarrier& b) {
    asm volatile("s_waitcnt vmcnt(0)" ::: "memory");
    __syncthreads();
    if (threadIdx.x == 0) {
        unsigned* bar = b.bar;
        __builtin_amdgcn_s_waitcnt(0);
        unsigned nloc = b.st[0], nx = b.st[1];
        if (nloc == 0u) { xcd_barrier_complete(bar, b.x, nloc, nx); b.st[0] = nloc; b.st[1] = nx; }
        const unsigned old = xb_add(&bar[XB_XSUB(b.x)], 1u);
        const unsigned gen = old / nloc;
        if (old + 1u == (gen + 1u) * nloc) {
            __builtin_amdgcn_fence(__ATOMIC_RELEASE, "agent");
            asm volatile("s_waitcnt vmcnt(0)" ::: "memory");
            const unsigned og = xb_add(&bar[XB_TOP], 1u);
            const unsigned tg = og / nx;
            if (og + 1u == (tg + 1u) * nx) xb_add(&bar[XB_TOPGEN], 1u);
            else XB_SPIN(xb_ld(&bar[XB_TOPGEN]) == tg, bar);
            __builtin_amdgcn_fence(__ATOMIC_ACQUIRE, "agent");
            xb_add(&bar[XB_XGEN(b.x)], 1u);
            asm volatile("s_waitcnt vmcnt(0)" ::: "memory");
        } else {
            XB_SPIN(xb_ld(&bar[XB_XGEN(b.x)]) == gen, bar);
            __builtin_amdgcn_fence(__ATOMIC_ACQUIRE, "agent");
            asm volatile("s_waitcnt vmcnt(0)" ::: "memory");
        }
    }
    __syncthreads();
}

struct Args { const float* in[27]; float* out; unsigned char* ws; int ph_lo, ph_hi; };
struct Frame {
    LAS unsigned char* lds; volatile LAS unsigned* MISC; gu32* ctl;
    int tid, lane, wave, vcu, G;
    const float* const* in; float* out; unsigned char* ws;
};

__device__ __forceinline__ void p0_transpose_item(const float* W, int N, bf16* WT, int ldt, int k0, int n0, int drow0, LAS float* scr, int lane) {
#pragma unroll 8
    for (int i = 0; i < 32; ++i) { const int kk = 2 * i + (lane >> 5); scr[kk * 33 + (lane & 31)] = W[(size_t)(k0 + kk) * N + n0 + (lane & 31)]; }
    LDS_WAIT(); asm volatile("" ::: "memory");
    const int c = lane & 7;
#pragma unroll
    for (int j = 0; j < 4; ++j) { const int n = (lane >> 3) + 8 * j; const LAS float* s = scr + (8 * c) * 33 + n;
        v4u o; o.x = pk2(s[0 * 33], s[1 * 33]); o.y = pk2(s[2 * 33], s[3 * 33]); o.z = pk2(s[4 * 33], s[5 * 33]); o.w = pk2(s[6 * 33], s[7 * 33]);
        *(GAS v4u*)(WT + (size_t)(drow0 + n) * ldt + k0 + 8 * c) = o; }
    LDS_WAIT(); asm volatile("" ::: "memory");
}
__device__ __forceinline__ void ph0_prologue(Frame& F) {
    const float* c = F.in[1]; const float* wada = F.in[2]; const float* bada = F.in[3];
    float* mod = (float*)(F.ws + WS_MOD);
    LAS float* sc = (LAS float*)(F.lds);
    LAS float* red = (LAS float*)(F.lds + 8192);
    for (int i = F.tid; i < 2 * D; i += NTHR) sc[i] = siluf_(c[i]);
    __syncthreads();
    for (int slab = F.vcu; slab < 256; slab += F.G) {
        const int n0 = slab * 24;
        if (F.tid < 510) {
            const int kq = F.tid / 6, c4 = F.tid % 6; float a[2][4];
#pragma unroll
            for (int b = 0; b < 2; ++b)
#pragma unroll
                for (int j = 0; j < 4; ++j) a[b][j] = 0.f;
            for (int k = kq; k < D; k += 85) { const f32x4 w = *(const f32x4*)(wada + (size_t)k * 6144 + n0 + 4 * c4); const float s0 = sc[k], s1 = sc[D + k];
#pragma unroll
                for (int j = 0; j < 4; ++j) { a[0][j] += s0 * w[j]; a[1][j] += s1 * w[j]; } }
#pragma unroll
            for (int b = 0; b < 2; ++b)
#pragma unroll
                for (int j = 0; j < 4; ++j) red[(kq * 6 + c4) * 8 + b * 4 + j] = a[b][j];
        }
        __syncthreads();
        if (F.tid < 48) { const int b = F.tid / 24, col = F.tid % 24, c4 = col >> 2, j = col & 3; float s = 0.f;
            for (int kq = 0; kq < 85; ++kq) s += red[(kq * 6 + c4) * 8 + b * 4 + j];
            mod[b * 6144 + n0 + col] = s + bada[n0 + col]; }
        __syncthreads();
    }
    const int gt = F.vcu * NTHR + F.tid, NGT = F.G * NTHR;
    if (gt < DH) { const float* g = F.in[9]; ((float*)(F.ws + WS_LB))[gt] = 1.f / (1.f + __expf(g[DH + gt] - g[gt])); }
    for (int e = gt; e < 2 * 8 * 64 * 64; e += NGT) { const int which = e >> 15, r = e & 32767, blk = r >> 12, j = (r >> 6) & 63, i = r & 63;
        const float* w = which ? F.in[15] : F.in[13]; ((bf16*)(F.ws + (which ? WS_WIT : WS_WRT)))[r] = (bf16)f2bf(w[(size_t)(blk * 64 + i) * 64 + j]); }
    LAS float* scr = (LAS float*)(F.lds + 32768 + F.wave * 8704);
    const int gw = F.vcu * NWAVES + F.wave, NGW = F.G * NWAVES;
    constexpr int I_IN = 16 * 96, I_OUT = 16 * 32, I_E = 256 + 256 + 256, NITEMS = I_IN + I_OUT + NE * I_E;
    for (int it = gw; it < NITEMS; it += NGW) {
        int r = it;
        if (r < I_IN) { const int kb = r / 96, nb = r % 96; p0_transpose_item(F.in[8], DIN, (bf16*)(F.ws + WS_WIN), D, 64 * kb, 32 * nb, 32 * nb, scr, F.lane); continue; } r -= I_IN;
        if (r < I_OUT) { const int kb = r / 32, nb = r % 32; p0_transpose_item(F.in[19], D, (bf16*)(F.ws + WS_WOUT), D, 64 * kb, 32 * nb, 32 * nb, scr, F.lane); continue; } r -= I_OUT;
        const int e = r / I_E; r -= e * I_E;
        if (r < 512) { const int w3 = r >> 8, q = r & 255, kb = q >> 4, nb = q & 15, n0 = 32 * nb;
            p0_transpose_item((w3 ? F.in[25] : F.in[24]) + (size_t)e * D * DE, DE, (bf16*)(F.ws + WS_W13) + (size_t)e * D * D, D, 64 * kb, n0, (n0 >> 7) * 256 + (n0 & 127) + 128 * w3, scr, F.lane); }
        else { const int q = r - 512, kb = q >> 5, nb = q & 31;
            p0_transpose_item(F.in[26] + (size_t)e * DE * D, D, (bf16*)(F.ws + WS_W2) + (size_t)e * D * DE, DE, 64 * kb, 32 * nb, 32 * nb, scr, F.lane); }
    }
}

__device__ __forceinline__ void ph1_hrows(Frame& F) {
    const float* x = F.in[0]; const float* g = F.in[4]; const float* mod = (const float*)(F.ws + WS_MOD); bf16* H = (bf16*)(F.ws + WS_H);
    const int gw = F.vcu * NWAVES + F.wave, NGW = F.G * NWAVES, lane = F.lane;
    for (int m = gw; m < T; m += NGW) {
        const int b = m / SEQ; const float* sh = mod + b * 6144; const float* sc = sh + 1024;
        const GAS f32x4* xr = (const GAS f32x4*)(x + (size_t)m * D) + lane; f32x4 v[4]; float s = 0.f;
#pragma unroll
        for (int j = 0; j < 4; ++j) { v[j] = xr[64 * j]; s += v[j].x * v[j].x + v[j].y * v[j].y + v[j].z * v[j].z + v[j].w * v[j].w; }
        const float rstd = rsqrtf(wave_sum(s) * (1.f / D) + EPS);
        GAS unsigned long long* o8 = (GAS unsigned long long*)(H + (size_t)m * D) + lane;
#pragma unroll
        for (int j = 0; j < 4; ++j) { const int c0 = 4 * lane + 256 * j; const f32x4 gg = *(const f32x4*)(g + c0), s1 = *(const f32x4*)(sc + c0), h1 = *(const f32x4*)(sh + c0);
            const float a0 = v[j].x * rstd * gg.x * (1.f + s1.x) + h1.x, a1 = v[j].y * rstd * gg.y * (1.f + s1.y) + h1.y, a2 = v[j].z * rstd * gg.z * (1.f + s1.z) + h1.z, a3 = v[j].w * rstd * gg.w * (1.f + s1.w) + h1.w;
            o8[64 * j] = (unsigned long long)pk2(a0, a1) | ((unsigned long long)pk2(a2, a3) << 32); }
    }
}

constexpr int L_QT = 0;
constexpr int L_QTL = 2048;
constexpr int L_QH = L_QTL + 17408;
constexpr int L_KH = L_QH + 17408;
constexpr int L_VT = L_KH + 43520;
constexpr int L_P = L_VT + 18432;
constexpr int L_SSQ = L_P + 9216;
constexpr int L_RSTD = L_SSQ + 2048;
constexpr int L_KT = L_QTL;
static_assert(L_RSTD + 256 <= RING_BYTES, "mixer LDS map");

__device__ __forceinline__ void hgrn_cumsum(Frame& F, const bf16* LFp, float (&cs)[16], float (&off)[5]) {
    LAS float* QT = (LAS float*)(F.lds + L_QT);
    const int k = F.tid & 127, qr = F.tid >> 7;
    float run = 0.f;
#pragma unroll
    for (int i = 0; i < 16; ++i) { run += bf2f(LFp[(size_t)i * DH]); cs[i] = run; }
    QT[qr * 128 + k] = run;
    __syncthreads();
    off[0] = 0.f; off[1] = QT[k]; off[2] = off[1] + QT[128 + k]; off[3] = off[2] + QT[256 + k]; off[4] = off[3] + QT[384 + k];
}

template <bool FINAL>
__device__ __forceinline__ void rg_wave_task(Frame& F, int b, int n, int cb, unsigned (&valpk)[32]) {
    const int lane = F.lane, fr = lane & 15, fq = lane >> 4, c0 = 64 * cb; const int t0 = b * SEQ + 64 * n;
    const bf16* XR = (const bf16*)(F.ws + WS_PROJ) + 5 * PROJ_S; const bf16* YR = (const bf16*)(F.ws + WS_PROJ) + 6 * PROJ_S;
    const bf16* WRT = (const bf16*)(F.ws + WS_WRT); const bf16* WIT = (const bf16*)(F.ws + WS_WIT);
    const float* cw = F.in[11]; const float* cbias = F.in[12];
    bf16x8 IDf[2][2];
    LAS unsigned char* wl = F.lds + F.wave * 16384;
#pragma unroll
    for (int p = 0; p < 8; ++p) { const int pc = p * 64 + lane, j = pc >> 3, sl = pc & 7; const size_t o = (size_t)(c0 + j) * 64 + 8 * sl;
        *(LAS v4u*)(wl + j * 128 + ((sl ^ (j & 7)) << 4)) = *(const v4u*)(WRT + o); *(LAS v4u*)(wl + 8192 + j * 128 + ((sl ^ (j & 7)) << 4)) = *(const v4u*)(WIT + o); }
    LDS_WAIT();
#pragma unroll
    for (int ks = 0; ks < 2; ++ks)
#pragma unroll
        for (int c2 = 0; c2 < 2; ++c2) { bf16x8 v;
#pragma unroll
            for (int j = 0; j < 8; ++j) v[j] = (short)((8 * fq + j == 16 * c2 + fr) ? 0x3F80 : 0);
            IDf[ks][c2] = v; }
    float br[4], bi[4], ls8[4], hrun[4], arun[4];
#pragma unroll
    for (int ct = 0; ct < 4; ++ct) { const int c = c0 + 16 * ct + fr; br[ct] = F.in[14][c]; bi[ct] = F.in[16][c]; const float lam = F.in[17][c]; ls8[ct] = -8.f * log1pf(__expf(-lam));
        hrun[ct] = FINAL ? ((const float*)(F.ws + WS_CARRY))[(size_t)(b * NCH + n) * DR + c] : 0.f; arun[ct] = 1.f; }
#pragma unroll
    for (int tt = 0; tt < 4; ++tt) {
        const int tl = 16 * tt + fr; const int tpos = 64 * n + tl;
        bf16x8 AX[2], AG[2];
#pragma unroll
        for (int ks = 0; ks < 2; ++ks) { const int cc = c0 + 32 * ks + 8 * fq; float xc[8];
            { const f32x4 b0 = *(const f32x4*)(cbias + cc), b1 = *(const f32x4*)(cbias + cc + 4); xc[0] = b0[0]; xc[1] = b0[1]; xc[2] = b0[2]; xc[3] = b0[3]; xc[4] = b1[0]; xc[5] = b1[1]; xc[6] = b1[2]; xc[7] = b1[3]; }
#pragma unroll
            for (int tap = 0; tap < 4; ++tap) { if (tpos - 3 + tap >= 0) { const v4u xv = *(const v4u*)(XR + (size_t)(t0 + tl - 3 + tap) * DH + cc);
                    const f32x4 w0 = *(const f32x4*)(cw + tap * DR + cc), w1 = *(const f32x4*)(cw + tap * DR + cc + 4);
                    xc[0] += w0[0] * bf2f(xv.x & 0xffffu); xc[1] += w0[1] * bf2f(xv.x >> 16); xc[2] += w0[2] * bf2f(xv.y & 0xffffu); xc[3] += w0[3] * bf2f(xv.y >> 16);
                    xc[4] += w1[0] * bf2f(xv.z & 0xffffu); xc[5] += w1[1] * bf2f(xv.z >> 16); xc[6] += w1[2] * bf2f(xv.w & 0xffffu); xc[7] += w1[3] * bf2f(xv.w >> 16); } }
            v4u pk; pk.x = pk2(xc[0], xc[1]); pk.y = pk2(xc[2], xc[3]); pk.z = pk2(xc[4], xc[5]); pk.w = pk2(xc[6], xc[7]); AX[ks] = __builtin_bit_cast(bf16x8, pk);
            if (FINAL) AG[ks] = *(const bf16x8*)(YR + (size_t)(t0 + tl) * DH + cc);
        }
#pragma unroll
        for (int ct = 0; ct < 4; ++ct) {
            f32x4 aR = {0.f, 0.f, 0.f, 0.f}, aI = {0.f, 0.f, 0.f, 0.f}, aX = {0.f, 0.f, 0.f, 0.f}, aG = {0.f, 0.f, 0.f, 0.f};
#pragma unroll
            for (int ks = 0; ks < 2; ++ks) { const int jr = 16 * ct + fr, so = jr * 128 + (((4 * ks + fq) ^ (jr & 7)) << 4);
                const bf16x8 wr_ = *(const LAS bf16x8*)(wl + so), wi_ = *(const LAS bf16x8*)(wl + 8192 + so);
                aR = __builtin_amdgcn_mfma_f32_16x16x32_bf16(AX[ks], wr_, aR, 0, 0, 0); aI = __builtin_amdgcn_mfma_f32_16x16x32_bf16(AX[ks], wi_, aI, 0, 0, 0); }
            aX = __builtin_amdgcn_mfma_f32_16x16x32_bf16(AX[ct >> 1], IDf[ct >> 1][ct & 1], aX, 0, 0, 0);
            if (FINAL) aG = __builtin_amdgcn_mfma_f32_16x16x32_bf16(AG[ct >> 1], IDf[ct >> 1][ct & 1], aG, 0, 0, 0);
            float a[4], u[4];
#pragma unroll
            for (int r = 0; r < 4; ++r) { const float rr = sigmoidf_(aR[r] + br[ct]), ii = sigmoidf_(aI[r] + bi[ct]); const float la = rr * ls8[ct]; a[r] = __expf(la);
                const float x2 = 2.f * la; const float em = (x2 > -0.03f) ? -x2 * (1.f + x2 * (0.5f + x2 * (0.16666667f + x2 * 0.041666667f))) : 1.f - a[r] * a[r];
                u[r] = sqrtf(em) * (ii * aX[r]); }
            float Af = a[0] * a[1] * a[2] * a[3], Hf = ((u[0] * a[1] + u[1]) * a[2] + u[2]) * a[3] + u[3];
            { const float Ap = __shfl_up(Af, 16), Hp = __shfl_up(Hf, 16); if (fq >= 1) { Hf = Af * Hp + Hf; Af = Ap * Af; } }
            { const float Ap = __shfl_up(Af, 32), Hp = __shfl_up(Hf, 32); if (fq >= 2) { Hf = Af * Hp + Hf; Af = Ap * Af; } }
            float Aex = __shfl_up(Af, 16), Hex = __shfl_up(Hf, 16); if (fq == 0) { Aex = 1.f; Hex = 0.f; }
            const float Atot = __shfl(Af, 48 + fr), Htot = __shfl(Hf, 48 + fr);
            if (FINAL) { float h = Aex * hrun[ct] + Hex;
#pragma unroll
                for (int r = 0; r < 4; ++r) { h = a[r] * h + u[r]; u[r] = h * aG[r]; }
                valpk[(tt * 4 + ct) * 2] = pk2(u[0], u[1]); valpk[(tt * 4 + ct) * 2 + 1] = pk2(u[2], u[3]); }
            hrun[ct] = Atot * hrun[ct] + Htot; arun[ct] *= Atot;
        }
        asm volatile("" ::: "memory");
    }
    if (!FINAL && fq == 0) {
#pragma unroll
        for (int ct = 0; ct < 4; ++ct) { const size_t o = (size_t)(b * NCH + n) * DR + c0 + 16 * ct + fr; ((float*)(F.ws + WS_RGA))[o] = arun[ct]; ((float*)(F.ws + WS_RGH))[o] = hrun[ct]; }
    }
}

__device__ __forceinline__ void ph3_passA(Frame& F) {
    const bf16* PJ = (const bf16*)(F.ws + WS_PROJ); const bf16 *LF = PJ + PROJ_S, *KI = PJ + 2 * PROJ_S, *V = PJ + 3 * PROJ_S;
    bf16* DS = (bf16*)F.out; float* DDp = (float*)(F.ws + WS_DD);
    const int tid = F.tid, lane = F.lane, w = F.wave, fr = lane & 15, fq = lane >> 4, k = tid & 127, qr = tid >> 7;
    LAS bf16* KT = (LAS bf16*)(F.lds + L_KT); LAS bf16* VT = (LAS bf16*)(F.lds + L_VT);
    { const int cn = F.vcu;
        const int b = cn / NCH, n = cn % NCH, t0 = b * SEQ + 64 * n;
        { unsigned dummy[32]; rg_wave_task<false>(F, b, n, w, dummy); }
        __syncthreads();
        for (int h = 0; h < NH; ++h) {
            const int task = (b * NH + h) * NCH + n; const size_t rbase = (size_t)(t0 + 16 * qr) * DH + h * HD + k;
            float cs[16], off[5]; hgrn_cumsum(F, LF + rbase, cs, off);
            const float myoff = qr == 0 ? off[0] : qr == 1 ? off[1] : qr == 2 ? off[2] : off[3], blast = off[4];
            unsigned kp[8], vp[8];
#pragma unroll
            for (int i = 0; i < 16; i += 2) { const float k0 = bf2f(KI[rbase + (size_t)i * DH]) * __expf(blast - (myoff + cs[i])), k1 = bf2f(KI[rbase + (size_t)(i + 1) * DH]) * __expf(blast - (myoff + cs[i + 1]));
                kp[i >> 1] = pk2(k0, k1); vp[i >> 1] = (unsigned)V[rbase + (size_t)i * DH] | ((unsigned)V[rbase + (size_t)(i + 1) * DH] << 16); }
            *(LAS v4u*)(KT + k * 72 + 16 * qr) = (v4u){kp[0], kp[1], kp[2], kp[3]}; *(LAS v4u*)(KT + k * 72 + 16 * qr + 8) = (v4u){kp[4], kp[5], kp[6], kp[7]};
            *(LAS v4u*)(VT + k * 72 + 16 * qr) = (v4u){vp[0], vp[1], vp[2], vp[3]}; *(LAS v4u*)(VT + k * 72 + 16 * qr + 8) = (v4u){vp[4], vp[5], vp[6], vp[7]};
            if (qr == 0) DDp[(size_t)task * HD + k] = __expf(blast);
            __syncthreads();
            bf16x8 bV[2];
#pragma unroll
            for (int ss = 0; ss < 2; ++ss) bV[ss] = *(const LAS bf16x8*)(VT + (16 * w + fr) * 72 + 8 * fq + 32 * ss);
#pragma unroll
            for (int kt = 0; kt < 8; ++kt) { f32x4 acc = {0.f, 0.f, 0.f, 0.f};
#pragma unroll
                for (int ss = 0; ss < 2; ++ss) { const bf16x8 a = *(const LAS bf16x8*)(KT + (16 * kt + fr) * 72 + 8 * fq + 32 * ss); acc = __builtin_amdgcn_mfma_f32_16x16x32_bf16(a, bV[ss], acc, 0, 0, 0); }
                *(v2u*)(DS + (size_t)task * (HD * HD) + (size_t)(16 * w + fr) * HD + 16 * kt + 4 * fq) = (v2u){pk2m(acc[0], acc[1]), pk2m(acc[2], acc[3])}; }
            __syncthreads();
        }
    }
}

__device__ __forceinline__ void ph4_passB(Frame& F) {
    const bf16* DS = (const bf16*)F.out; bf16* SST = (bf16*)F.out + (size_t)BATCH * NH * NCH * HD * HD; const float* DDp = (const float*)(F.ws + WS_DD);
    const int gt = F.vcu * NTHR + F.tid, NGT = F.G * NTHR;
    for (int idx = gt; idx < BATCH * NH * HD * HD / 2 + BATCH * DR; idx += NGT) {
        if (idx < BATCH * NH * HD * HD / 2) {
            const int bh = idx >> 13, pr = idx & 8191, e0 = 2 * pr, kk = e0 & 127;
            float s0 = 0.f, s1 = 0.f;
            const bf16* dsp = DS + (size_t)bh * NCH * (HD * HD) + e0; bf16* sp = SST + (size_t)bh * NCH * (HD * HD) + e0; const float* ddp = DDp + (size_t)bh * NCH * HD + kk;
#pragma unroll 1
            for (int n0 = 0; n0 < NCH; n0 += 8) {
                unsigned dsv[8]; float d0[8], d1[8];
#pragma unroll
                for (int j = 0; j < 8; ++j) { dsv[j] = *(const unsigned*)(dsp + (size_t)(n0 + j) * (HD * HD)); d0[j] = ddp[(n0 + j) * HD]; d1[j] = ddp[(n0 + j) * HD + 1]; }
#pragma unroll
                for (int j = 0; j < 8; ++j) { *(unsigned*)(sp + (size_t)(n0 + j) * (HD * HD)) = pk2(s0, s1);
                    s0 = d0[j] * s0 + bf2f(dsv[j] & 0xffffu); s1 = d1[j] * s1 + bf2f(dsv[j] >> 16); }
            }
        } else {
            const int r = idx - BATCH * NH * HD * HD / 2, b = r / DR, c = r % DR;
            const float* A = (const float*)(F.ws + WS_RGA) + (size_t)b * NCH * DR + c; const float* Hh = (const float*)(F.ws + WS_RGH) + (size_t)b * NCH * DR + c; float* C = (float*)(F.ws + WS_CARRY) + (size_t)b * NCH * DR + c;
            float carry = 0.f;
#pragma unroll 4
            for (int n = 0; n < NCH; ++n) { C[(size_t)n * DR] = carry; carry = A[(size_t)n * DR] * carry + Hh[(size_t)n * DR]; }
        }
    }
}

__device__ __forceinline__ void ph5_passC(Frame& F) {
    const bf16* PJ = (const bf16*)(F.ws + WS_PROJ); const bf16 *Q = PJ, *LF = PJ + PROJ_S, *KI = PJ + 2 * PROJ_S, *V = PJ + 3 * PROJ_S, *GZ = PJ + 4 * PROJ_S;
    const bf16* SST = (const bf16*)F.out + (size_t)BATCH * NH * NCH * HD * HD; bf16* O = (bf16*)(F.ws + WS_H);
    const int tid = F.tid, lane = F.lane, w = F.wave, fr = lane & 15, fq = lane >> 4, k = tid & 127, qr = tid >> 7;
    LAS bf16* QTL = (LAS bf16*)(F.lds + L_QTL); LAS bf16* QH = (LAS bf16*)(F.lds + L_QH); LAS bf16* KH = (LAS bf16*)(F.lds + L_KH);
    LAS bf16* VT = (LAS bf16*)(F.lds + L_VT); LAS bf16* Pm = (LAS bf16*)(F.lds + L_P); LAS float* SSQ = (LAS float*)(F.lds + L_SSQ); LAS float* RSTD = (LAS float*)(F.lds + L_RSTD);
    { const int cn = F.vcu;
        const int b = cn / NCH, n = cn % NCH, t0 = b * SEQ + 64 * n;
        {
            LAS float* SSQ = (LAS float*)(F.lds + X_GTAB); LAS float* RSTD = SSQ + 512;
            unsigned valpk[32]; rg_wave_task<true>(F, b, n, w, valpk);
#pragma unroll
            for (int tt = 0; tt < 4; ++tt) { float s[4] = {0.f, 0.f, 0.f, 0.f};
#pragma unroll
                for (int ct = 0; ct < 4; ++ct) { const unsigned p0 = valpk[(tt * 4 + ct) * 2], p1 = valpk[(tt * 4 + ct) * 2 + 1]; const float v0 = bf2f(p0 & 0xffffu), v1 = bf2f(p0 >> 16), v2 = bf2f(p1 & 0xffffu), v3 = bf2f(p1 >> 16);
                    s[0] += v0 * v0; s[1] += v1 * v1; s[2] += v2 * v2; s[3] += v3 * v3; }
#pragma unroll
                for (int r = 0; r < 4; ++r) { float x = s[r]; x += __shfl_xor(x, 1); x += __shfl_xor(x, 2); x += __shfl_xor(x, 4); x += __shfl_xor(x, 8); if (fr == 0) SSQ[(16 * tt + 4 * fq + r) * 8 + w] = x; } }
            __syncthreads();
            if (tid < 64) { float s = 0.f;
#pragma unroll
                for (int i = 0; i < 8; ++i) s += SSQ[tid * 8 + i];
                RSTD[tid] = rsqrtf(s * (1.f / DR) + EPS); }
            __syncthreads();
            float gn[4];
#pragma unroll
            for (int ct = 0; ct < 4; ++ct) gn[ct] = F.in[18][64 * w + 16 * ct + fr];
#pragma unroll
            for (int tt = 0; tt < 4; ++tt)
#pragma unroll
                for (int ct = 0; ct < 4; ++ct) { const unsigned p0 = valpk[(tt * 4 + ct) * 2], p1 = valpk[(tt * 4 + ct) * 2 + 1]; const float vv[4] = {bf2f(p0 & 0xffffu), bf2f(p0 >> 16), bf2f(p1 & 0xffffu), bf2f(p1 >> 16)};
#pragma unroll
                    for (int r = 0; r < 4; ++r) { const int tl = 16 * tt + 4 * fq + r; O[(size_t)(t0 + tl) * D + DH + 64 * w + 16 * ct + fr] = (bf16)f2bf(vv[r] * RSTD[tl] * gn[ct]); } }
            __syncthreads();
        }
        for (int h = 0; h < NH; ++h) {
            const int task = (b * NH + h) * NCH + n; const size_t rbase = (size_t)(t0 + 16 * qr) * DH + h * HD + k;
            float cs[16], off[5]; hgrn_cumsum(F, LF + rbase, cs, off);
            const float myoff = qr == 0 ? off[0] : qr == 1 ? off[1] : qr == 2 ? off[2] : off[3]; const float em = __expf(myoff);
            unsigned vp[8];
#pragma unroll
            for (int i = 0; i < 16; ++i) { const size_t ro = rbase + (size_t)i * DH; const float q = bf2f(Q[ro]), ki = bf2f(KI[ro]); const unsigned vv = V[ro];
                const float e1 = __expf(cs[i]); const int tl = 16 * qr + i;
                QH[tl * 136 + k] = (bf16)f2bf(q * e1); QTL[tl * 136 + k] = (bf16)f2bf(q * e1 * em);
#pragma unroll
                for (int iq = 0; iq < 4; ++iq) if (iq >= qr) KH[(8 * iq * (iq + 1) + tl) * 136 + k] = (bf16)f2bf(ki * __expf(off[iq] - myoff - cs[i]));
                if (i & 1) vp[i >> 1] |= vv << 16; else vp[i >> 1] = vv; }
            *(LAS v4u*)(VT + k * 72 + 16 * qr) = (v4u){vp[0], vp[1], vp[2], vp[3]}; *(LAS v4u*)(VT + k * 72 + 16 * qr + 8) = (v4u){vp[4], vp[5], vp[6], vp[7]};
            __syncthreads();
#pragma unroll
            for (int pp = 0; pp < 2; ++pp) { const int pi = 2 * w + pp, iq = pi >> 2, jk = pi & 3; f32x4 acc = {0.f, 0.f, 0.f, 0.f};
                if (jk <= iq) {
#pragma unroll
                    for (int ks = 0; ks < 4; ++ks) { const bf16x8 a = *(const LAS bf16x8*)(KH + (8 * iq * (iq + 1) + 16 * jk + fr) * 136 + 8 * fq + 32 * ks); const bf16x8 bq = *(const LAS bf16x8*)(QH + (16 * iq + fr) * 136 + 8 * fq + 32 * ks);
                        acc = __builtin_amdgcn_mfma_f32_16x16x32_bf16(a, bq, acc, 0, 0, 0); }
                    if (jk == iq) {
#pragma unroll
                        for (int r = 0; r < 4; ++r) if (4 * fq + r > fr) acc[r] = 0.f; }
                }
                *(LAS v2u*)(Pm + (16 * iq + fr) * 72 + 16 * jk + 4 * fq) = (v2u){pk2m(acc[0], acc[1]), pk2m(acc[2], acc[3])}; }
            __syncthreads();
            f32x4 oacc[4];
            { bf16x8 bV[2], bS[4];
#pragma unroll
              for (int ss = 0; ss < 2; ++ss) bV[ss] = *(const LAS bf16x8*)(VT + (16 * w + fr) * 72 + 8 * fq + 32 * ss);
#pragma unroll
              for (int ks = 0; ks < 4; ++ks) bS[ks] = *(const bf16x8*)(SST + (size_t)task * (HD * HD) + (size_t)(16 * w + fr) * HD + 8 * fq + 32 * ks);
#ifdef DBG_NOSTATE
              for (int ks = 0; ks < 4; ++ks) bS[ks] = (bf16x8){0,0,0,0,0,0,0,0};
#endif
#pragma unroll
              for (int tt = 0; tt < 4; ++tt) { f32x4 acc = {0.f, 0.f, 0.f, 0.f};
#pragma unroll
                  for (int ss = 0; ss < 2; ++ss) { const bf16x8 a = *(const LAS bf16x8*)(Pm + (16 * tt + fr) * 72 + 8 * fq + 32 * ss); acc = __builtin_amdgcn_mfma_f32_16x16x32_bf16(a, bV[ss], acc, 0, 0, 0); }
#pragma unroll
                  for (int ks = 0; ks < 4; ++ks) { const bf16x8 a = *(const LAS bf16x8*)(QTL + (16 * tt + fr) * 136 + 8 * fq + 32 * ks); acc = __builtin_amdgcn_mfma_f32_16x16x32_bf16(a, bS[ks], acc, 0, 0, 0); }
                  oacc[tt] = acc; } }
#pragma unroll
            for (int tt = 0; tt < 4; ++tt)
#pragma unroll
                for (int r = 0; r < 4; ++r) { float x = oacc[tt][r] * oacc[tt][r]; x += __shfl_xor(x, 1); x += __shfl_xor(x, 2); x += __shfl_xor(x, 4); x += __shfl_xor(x, 8); if (fr == 0) SSQ[(16 * tt + 4 * fq + r) * 8 + w] = x; }
            __syncthreads();
            if (tid < 64) { float s = 0.f;
#pragma unroll
                for (int i = 0; i < 8; ++i) s += SSQ[tid * 8 + i];
                RSTD[tid] = rsqrtf(s * (1.f / HD) + EPS); }
            __syncthreads();
            const float gh = F.in[10][h * HD + 16 * w + fr];
#pragma unroll
            for (int tt = 0; tt < 4; ++tt)
#pragma unroll
                for (int r = 0; r < 4; ++r) { const int tl = 16 * tt + 4 * fq + r; const float gz = bf2f(GZ[(size_t)(t0 + tl) * DH + h * HD + 16 * w + fr]);
                    O[(size_t)(t0 + tl) * D + h * HD + 16 * w + fr] = (bf16)f2bf(oacc[tt][r] * RSTD[tl] * gh * gz); }
            __syncthreads();
        }
    }
}

__device__ __forceinline__ void ph7_rows(Frame& F) {
    const float* x = F.in[0]; const float* mod = (const float*)(F.ws + WS_MOD); const float* mix = (const float*)(F.ws + WS_MIX);
    const float *gpm = F.in[5], *gpf = F.in[6], *wrg = F.in[20], *brg = F.in[21], *wre = F.in[22], *bre = F.in[23];
    bf16* H = (bf16*)(F.ws + WS_H); float* wgt = (float*)(F.ws + WS_WGT);
    unsigned* cnt = (unsigned*)(F.ws + WS_CTL) + CW_CNT; int* list = (int*)(F.ws + WS_LIST);
    LAS float* WL = (LAS float*)F.lds;
    for (int idx = F.tid; idx < D * 36; idx += NTHR) { const int p = idx / 36, o = idx - p * 36, kk = 4 * (p & 63) + 256 * (p >> 8) + ((p >> 6) & 3); WL[idx] = o < 4 ? wrg[kk * NG + o] : wre[kk * NE + o - 4]; }
    __syncthreads();
    const int gw = F.vcu * NWAVES + F.wave, NGW = F.G * NWAVES;
    for (int mp = gw; mp < T / 2; mp += NGW) {
        int lane = F.lane; asm volatile("" : "+v"(lane));
        float hh[2][16];
#pragma unroll
        for (int rr = 0; rr < 2; ++rr) {
            const int m = 2 * mp + rr, b = m / SEQ; const float* mb = mod + b * 6144; const float *gt1 = mb + 2048, *sh2 = mb + 3072, *sc2 = mb + 4096;
            f32x4 v[4], xv[4]; float s = 0.f;
#pragma unroll
            for (int j = 0; j < 4; ++j) { v[j] = ((const GAS f32x4*)(mix + (size_t)m * D) + lane)[64 * j]; xv[j] = ((const GAS f32x4*)(x + (size_t)m * D) + lane)[64 * j]; s += v[j].x * v[j].x + v[j].y * v[j].y + v[j].z * v[j].z + v[j].w * v[j].w; }
            const float rs1 = rsqrtf(wave_sum(s) * (1.f / D) + EPS); float s2 = 0.f;
#pragma unroll
            for (int j = 0; j < 4; ++j) { const int c0 = 4 * lane + 256 * j; const f32x4 gg = *(const f32x4*)(gpm + c0), gt = *(const f32x4*)(gt1 + c0);
                xv[j].x += gt.x * (v[j].x * rs1 * gg.x); xv[j].y += gt.y * (v[j].y * rs1 * gg.y); xv[j].z += gt.z * (v[j].z * rs1 * gg.z); xv[j].w += gt.w * (v[j].w * rs1 * gg.w);
                ((GAS f32x4*)(F.out + (size_t)m * D) + lane)[64 * j] = xv[j];
                s2 += xv[j].x * xv[j].x + xv[j].y * xv[j].y + xv[j].z * xv[j].z + xv[j].w * xv[j].w; }
            const float rs2 = rsqrtf(wave_sum(s2) * (1.f / D) + EPS);
#pragma unroll
            for (int j = 0; j < 4; ++j) { const int c0 = 4 * lane + 256 * j; const f32x4 gg = *(const f32x4*)(gpf + c0), sc = *(const f32x4*)(sc2 + c0), sh = *(const f32x4*)(sh2 + c0);
                const float h0 = xv[j].x * rs2 * gg.x * (1.f + sc.x) + sh.x, h1 = xv[j].y * rs2 * gg.y * (1.f + sc.y) + sh.y, h2 = xv[j].z * rs2 * gg.z * (1.f + sc.z) + sh.z, h3 = xv[j].w * rs2 * gg.w * (1.f + sc.w) + sh.w;
                hh[rr][4 * j] = h0; hh[rr][4 * j + 1] = h1; hh[rr][4 * j + 2] = h2; hh[rr][4 * j + 3] = h3;
                ((GAS unsigned long long*)(H + (size_t)m * D) + lane)[64 * j] = (unsigned long long)pk2(h0, h1) | ((unsigned long long)pk2(h2, h3) << 32); }
            asm volatile("" ::: "memory");
        }
        float acc[2][36];
#pragma unroll
        for (int o = 0; o < 36; ++o) { acc[0][o] = 0.f; acc[1][o] = 0.f; }
#pragma unroll
        for (int i = 0; i < 16; ++i) { const LAS f32x4* wp = (const LAS f32x4*)(WL + (lane + 64 * i) * 36);
#pragma unroll
            for (int o4 = 0; o4 < 9; ++o4) { const f32x4 wv = wp[o4];
#pragma unroll
                for (int j = 0; j < 4; ++j) { acc[0][4 * o4 + j] += hh[0][i] * wv[j]; acc[1][4 * o4 + j] += hh[1][i] * wv[j]; } }
            asm volatile("" ::: "memory"); }
        float lgl[36];
#pragma unroll
        for (int o = 0; o < 36; ++o) { const float a0 = wave_sum(acc[0][o]), a1 = wave_sum(acc[1][o]); lgl[o] = (lane == 1 ? a1 : a0) + (o < 4 ? brg[o] : bre[o - 4]); }
        if (lane < 2) {
            const int m = 2 * mp + lane;
            int gs = 0; float gm = lgl[0];
#pragma unroll
            for (int o = 1; o < NG; ++o) if (lgl[o] > gm) { gm = lgl[o]; gs = o; }
            float den = 0.f;
#pragma unroll
            for (int o = 0; o < NG; ++o) den += __expf(lgl[o] - gm);
            const float gate = 1.f / den;
            float sel[EPG];
#pragma unroll
            for (int o = 0; o < EPG; ++o) sel[o] = gs == 0 ? lgl[4 + o] : gs == 1 ? lgl[12 + o] : gs == 2 ? lgl[20 + o] : lgl[28 + o];
            int i1 = 0; float m1 = sel[0];
#pragma unroll
            for (int o = 1; o < EPG; ++o) if (sel[o] > m1) { m1 = sel[o]; i1 = o; }
            int i2 = -1; float m2 = -3.0e38f;
#pragma unroll
            for (int o = 0; o < EPG; ++o) if (o != i1 && sel[o] > m2) { m2 = sel[o]; i2 = o; }
            const float e2 = __expf(m2 - m1), w1 = gate / (1.f + e2), w2 = gate * e2 / (1.f + e2);
            if (i2 < 0) i2 = (i1 + 1) & 7;
            const int ea = gs * EPG + i1, eb = gs * EPG + i2;
            wgt[2 * m] = w1; wgt[2 * m + 1] = w2;
            const unsigned pa = atomicAdd(&cnt[ea], 1u), pb = atomicAdd(&cnt[eb], 1u);
            list[ea * 32768 + pa] = 2 * m; list[eb * 32768 + pb] = 2 * m + 1;
        }
    }
    __syncthreads();
}

__device__ __forceinline__ int moe_tables(Frame& F) {
    LAS int* MBE = (LAS int*)(F.lds + X_MBE); LAS int* MBS = MBE + MAXMB; LAS int* NMB = MBS + 33;
    if (F.tid == 0) { int mb = 0;
        for (int e = 0; e < NE; ++e) { const int c = (int)__hip_atomic_load(F.ctl + CW_CNT + e, RLX_AGENT); MBS[e] = mb; const int nb = (c + 255) >> 8; for (int j = 0; j < nb && mb < MAXMB; ++j) MBE[mb++] = e; }
        MBS[NE] = mb; NMB[0] = mb; }
    __syncthreads();
    return NMB[0];
}
template <bool FOR_A>
__device__ __forceinline__ void moe_fill_tab(Frame& F, const pg8::MoeOrder& S) {
    LAS int* MBE = (LAS int*)(F.lds + X_MBE); LAS int* MBS = MBE + MAXMB; LAS int* tab = (LAS int*)(F.lds + X_GTAB); const int* list = (const int*)(F.ws + WS_LIST);
    pg8::Unit u;
    for (int i = 0; i < 4 && S.next(i, u); ++i) {
        if (F.tid < 256) { const int e = MBE[u.pm], pos = (u.pm - MBS[e]) * 256 + F.tid, c = (int)__hip_atomic_load(F.ctl + CW_CNT + e, RLX_AGENT);
            const int aid = pos < c ? list[e * 32768 + pos] : -1;
            tab[i * 256 + F.tid] = FOR_A ? (aid >= 0 ? (aid >> 1) * (D * 2) : 0) : aid; }
    }
    __syncthreads();
}

__device__ __forceinline__ void ph10_final(Frame& F) {
    const float* mod = (const float*)(F.ws + WS_MOD); const bf16* YA = (const bf16*)(F.ws + WS_YA); const float* gp = F.in[7];
    const int gw = F.vcu * NWAVES + F.wave, NGW = F.G * NWAVES, lane = F.lane;
    for (int m = gw; m < T; m += NGW) {
        const int b = m / SEQ; const float* gt2 = mod + b * 6144 + 5120;
        float y[4][4]; float s = 0.f;
#pragma unroll
        for (int j = 0; j < 4; ++j) { const v2u a = ((const GAS v2u*)(YA + (size_t)(2 * m) * D) + lane)[64 * j], c = ((const GAS v2u*)(YA + (size_t)(2 * m + 1) * D) + lane)[64 * j];
            y[j][0] = bf2f(a.x & 0xffffu) + bf2f(c.x & 0xffffu); y[j][1] = bf2f(a.x >> 16) + bf2f(c.x >> 16); y[j][2] = bf2f(a.y & 0xffffu) + bf2f(c.y & 0xffffu); y[j][3] = bf2f(a.y >> 16) + bf2f(c.y >> 16);
#pragma unroll
            for (int i = 0; i < 4; ++i) s += y[j][i] * y[j][i]; }
        const float rs = rsqrtf(wave_sum(s) * (1.f / D) + EPS);
#pragma unroll
        for (int j = 0; j < 4; ++j) { const int c0 = 4 * lane + 256 * j; const f32x4 gg = *(const f32x4*)(gp + c0), gt = *(const f32x4*)(gt2 + c0);
            GAS f32x4* o = (GAS f32x4*)(F.out + (size_t)m * D) + lane + 64 * j; f32x4 xv = *o;
            xv.x += gt.x * (y[j][0] * rs * gg.x); xv.y += gt.y * (y[j][1] * rs * gg.y); xv.z += gt.z * (y[j][2] * rs * gg.z); xv.w += gt.w * (y[j][3] * rs * gg.w); *o = xv; }
    }
}

constexpr int NPH = 11;
__global__ void __launch_bounds__(NTHR, 2) skel_fwd(Args args) {
    extern __shared__ __attribute__((aligned(16))) unsigned char lds[];
    Frame F;
    F.lds = (LAS unsigned char*)lds; F.MISC = (volatile LAS unsigned*)(F.lds + X_MISC);
    F.tid = threadIdx.x; F.lane = F.tid & 63; F.wave = __builtin_amdgcn_readfirstlane(F.tid >> 6);
    F.G = gridDim.x; { const int bx = blockIdx.x; F.vcu = (F.G % 8 == 0) ? (bx % 8) * (F.G / 8) + bx / 8 : bx; }
    F.in = args.in; F.out = args.out; F.ws = args.ws; F.ctl = (gu32*)(args.ws + WS_CTL);
    if (F.tid < 32) F.MISC[F.tid] = 0u;
    __syncthreads();
    XcdBarrier bar; bar.bar = (unsigned*)(F.ctl + CW_BAR); bar.x = 0; bar.st = nullptr;
    const int lo = args.ph_lo, hi = args.ph_hi;
    const bool one = (hi - lo) > 1;
    if (one) bar = xcd_barrier_post((unsigned*)(F.ctl + CW_BAR), F.MISC + 8);
#ifndef PHMASK
#define PHMASK 0x7FF
#endif
#define IN(k) (((PHMASK >> (k)) & 1) && lo <= (k) && (k) < hi)
#define SEAM(k) do { if (IN(k) && IN((k) + 1)) xcd_barrier(bar); } while (0)

    if (IN(0)) { ph0_prologue(F); } SEAM(0);
    if (IN(1)) { ph1_hrows(F); } SEAM(1);
    if (IN(2)) {
        pg8::Gemm g{(const bf16*)(F.ws + WS_H), (const bf16*)(F.ws + WS_WIN), D}; pg8::StaticOrder S; S.init(T, DIN, D, F.G, (int)blockIdx.x);
        pg8::EpiProj E{(bf16*)(F.ws + WS_PROJ), (const float*)(F.ws + WS_LB)};
        pg8::gemm_phase<pg8::EpiProj, pg8::StaticOrder, false>(F.lds, g, S, E, nullptr);
    } SEAM(2);
    if (IN(3)) { ph3_passA(F); } SEAM(3);
    if (IN(4)) { ph4_passB(F); } SEAM(4);
    if (IN(5)) { ph5_passC(F); } SEAM(5);
    if (IN(6)) {
        pg8::Gemm g{(const bf16*)(F.ws + WS_H), (const bf16*)(F.ws + WS_WOUT), D}; pg8::StaticOrder S; S.init(T, D, D, F.G, (int)blockIdx.x);
        pg8::EpiF32 E{(float*)(F.ws + WS_MIX), D};
        pg8::gemm_phase<pg8::EpiF32, pg8::StaticOrder, false>(F.lds, g, S, E, nullptr);
    } SEAM(6);
    if (IN(7)) { ph7_rows(F); } SEAM(7);
    if (IN(8)) {
        const int nmb = moe_tables(F);
        pg8::MoeOrder S{4 * nmb, F.G, (int)blockIdx.x, D, (const LAS int*)(F.lds + X_MBE), (size_t)D * D * 2};
        moe_fill_tab<true>(F, S);
        pg8::Gemm g{(const bf16*)(F.ws + WS_H), (const bf16*)(F.ws + WS_W13), D}; pg8::EpiAct E{(bf16*)(F.ws + WS_ACT)};
        pg8::gemm_phase<pg8::EpiAct, pg8::MoeOrder, true>(F.lds, g, S, E, (const LAS unsigned*)(F.lds + X_GTAB));
    } SEAM(8);
    if (IN(9)) {
        const int nmb = moe_tables(F);
        pg8::MoeOrder S{4 * nmb, F.G, (int)blockIdx.x, DE, (const LAS int*)(F.lds + X_MBE), (size_t)D * DE * 2};
        moe_fill_tab<false>(F, S);
        pg8::Gemm g{(const bf16*)(F.ws + WS_ACT), (const bf16*)(F.ws + WS_W2), DE}; pg8::EpiYa E{(bf16*)(F.ws + WS_YA), (const float*)(F.ws + WS_WGT), (const LAS int*)(F.lds + X_GTAB)};
        pg8::gemm_phase<pg8::EpiYa, pg8::MoeOrder, false>(F.lds, g, S, E, nullptr);
    } SEAM(9);
    if (IN(10)) { ph10_final(F); }
#undef IN
#undef SEAM
}


#ifdef HYBRID
struct P {
    const float* in[27]; float* out; unsigned char* ws;
};

__global__ void __launch_bounds__(256) k_mod(P p) {
    const int idx = blockIdx.x * blockDim.x + threadIdx.x;
    const float* c = p.in[1]; const float* w = p.in[2]; const float* bias = p.in[3];
    float* mod = (float*)(p.ws + WS_MOD);
    if (idx < 2 * 6144) {
        const int b = idx / 6144, n = idx % 6144; float s = 0.f;
        for (int k = 0; k < D; ++k) s += siluf_(c[b * D + k]) * w[(size_t)k * 6144 + n];
        mod[idx] = s + bias[n];
    }
    if (idx < DH) { const float* g = p.in[9]; ((float*)(p.ws + WS_LB))[idx] = 1.f / (1.f + __expf(g[DH + idx] - g[idx])); }
}

__global__ void __launch_bounds__(256) k_h(P p) {
    const int lane = threadIdx.x & 63, gw = (blockIdx.x * blockDim.x + threadIdx.x) >> 6, ngw = (gridDim.x * blockDim.x) >> 6;
    const float* x = p.in[0]; const float* g = p.in[4]; const float* mod = (const float*)(p.ws + WS_MOD);
    bf16* H = (bf16*)(p.ws + WS_H);
    for (int m = gw; m < T; m += ngw) {
        const int b = m / SEQ; const float* sh = mod + b * 6144; const float* sc = sh + 1024;
        const f32x4* xr = (const f32x4*)(x + (size_t)m * D) + lane; f32x4 v[4]; float s = 0.f;
#pragma unroll
        for (int j = 0; j < 4; ++j) { v[j] = xr[64 * j]; s += v[j].x * v[j].x + v[j].y * v[j].y + v[j].z * v[j].z + v[j].w * v[j].w; }
        const float rstd = rsqrtf(wave_sum(s) * (1.f / D) + EPS);
        unsigned long long* o8 = (unsigned long long*)(H + (size_t)m * D) + lane;
#pragma unroll
        for (int j = 0; j < 4; ++j) { const int c0 = 4 * lane + 256 * j; const f32x4 gg = *(const f32x4*)(g + c0), s1 = *(const f32x4*)(sc + c0), h1 = *(const f32x4*)(sh + c0);
            const float a0 = v[j].x * rstd * gg.x * (1.f + s1.x) + h1.x, a1 = v[j].y * rstd * gg.y * (1.f + s1.y) + h1.y, a2 = v[j].z * rstd * gg.z * (1.f + s1.z) + h1.z, a3 = v[j].w * rstd * gg.w * (1.f + s1.w) + h1.w;
            o8[64 * j] = (unsigned long long)pk2(a0, a1) | ((unsigned long long)pk2(a2, a3) << 32); }
    }
}

template <int NB, class RowFn, class Epi>
__device__ __forceinline__ void gemm_tile_naive(const bf16* A, int lda, const float* B0, const float* B1, int ldb, int K, int m0, int n0, int mvalid, const RowFn& rowfn, const Epi& epi) {
    __shared__ float As[16][65]; __shared__ float Bs[NB][16][64]; __shared__ long long rowoff[64];
    const int tid = threadIdx.x, ty = tid >> 4, tx = tid & 15;
    if (tid < 64) rowoff[tid] = (tid < mvalid) ? (long long)rowfn(m0 + tid) * lda : -1;
    __syncthreads();
    float acc[NB][4][4];
#pragma unroll
    for (int q = 0; q < NB; ++q)
#pragma unroll
        for (int i = 0; i < 4; ++i)
#pragma unroll
            for (int j = 0; j < 4; ++j) acc[q][i][j] = 0.f;
    for (int k0 = 0; k0 < K; k0 += 16) {
        { const int r = tid >> 2, kk = (tid & 3) * 4; const long long ro = rowoff[r];
          if (ro >= 0) { const v2u w = *(const v2u*)(A + ro + k0 + kk); As[kk][r] = bf2f(w.x & 0xffffu); As[kk + 1][r] = bf2f(w.x >> 16); As[kk + 2][r] = bf2f(w.y & 0xffffu); As[kk + 3][r] = bf2f(w.y >> 16); }
          else { As[kk][r] = 0.f; As[kk + 1][r] = 0.f; As[kk + 2][r] = 0.f; As[kk + 3][r] = 0.f; } }
        { const int kr = tid >> 4, c4 = (tid & 15) * 4;
          *(f32x4*)&Bs[0][kr][c4] = *(const f32x4*)(B0 + (size_t)(k0 + kr) * ldb + n0 + c4);
          if (NB == 2) *(f32x4*)&Bs[NB - 1][kr][c4] = *(const f32x4*)(B1 + (size_t)(k0 + kr) * ldb + n0 + c4); }
        __syncthreads();
#pragma unroll
        for (int kk = 0; kk < 16; ++kk) {
            float a[4];
#pragma unroll
            for (int i = 0; i < 4; ++i) a[i] = As[kk][ty * 4 + i];
#pragma unroll
            for (int q = 0; q < NB; ++q) { const f32x4 b = *(const f32x4*)&Bs[q][kk][tx * 4];
#pragma unroll
                for (int i = 0; i < 4; ++i) { acc[q][i][0] += a[i] * b.x; acc[q][i][1] += a[i] * b.y; acc[q][i][2] += a[i] * b.z; acc[q][i][3] += a[i] * b.w; } }
        }
        __syncthreads();
    }
#pragma unroll
    for (int i = 0; i < 4; ++i) { const int r = ty * 4 + i; if (r < mvalid) {
#pragma unroll
        for (int j = 0; j < 4; ++j) epi(m0 + r, n0 + tx * 4 + j, acc[0][i][j], NB == 2 ? acc[NB - 1][i][j] : 0.f); } }
}
struct RowId { __device__ int operator()(int m) const { return m; } };

struct NEpiProj {
    bf16* base; const float* lb;
    __device__ void operator()(int m, int n, float v, float) const {
        const int grp = n >> 9, c = n & 511; bf16* o = base + (size_t)m * DH + c; const size_t S = PROJ_S;
        if (grp == 0) o[0] = (bf16)f2bf(siluf_(v));
        else if (grp == 1) { const float l = lb[c], sg = sigmoidf_(v); o[S] = (bf16)f2bf(__logf(l + (1.f - l) * sg)); o[2 * S] = (bf16)f2bf((1.f - l) * (1.f - sg)); }
        else if (grp == 2) o[3 * S] = (bf16)f2bf(v);
        else if (grp == 3) o[4 * S] = (bf16)f2bf(siluf_(v));
        else if (grp == 4) o[5 * S] = (bf16)f2bf(v);
        else o[6 * S] = (bf16)f2bf(gelu_tanh_(v));
    }
};
__global__ void __launch_bounds__(256) k_proj(P p) {
    NEpiProj e{(bf16*)(p.ws + WS_PROJ), (const float*)(p.ws + WS_LB)};
    gemm_tile_naive<1>((const bf16*)(p.ws + WS_H), D, p.in[8], nullptr, DIN, D, blockIdx.y * 64, blockIdx.x * 64, 64, RowId{}, e);
}

__global__ void __launch_bounds__(128) k_hgrn(P p) {
    const int b = blockIdx.x / NH, h = blockIdx.x % NH, v = threadIdx.x;
    const size_t S = PROJ_S; const bf16* PJ = (const bf16*)(p.ws + WS_PROJ);
    const bf16 *Q = PJ, *LF = PJ + S, *KI = PJ + 2 * S, *V = PJ + 3 * S, *GZ = PJ + 4 * S;
    bf16* O = (bf16*)(p.ws + WS_H); const float g = p.in[10][h * HD + v];
    __shared__ float sq[HD], sk[HD], sf[HD], red[2];
    float St[HD];
#pragma unroll
    for (int k = 0; k < HD; ++k) St[k] = 0.f;
    for (int t = 0; t < SEQ; ++t) {
#ifdef DBG_NOSTATE
        if ((t & 63) == 0) {
#pragma unroll
            for (int k = 0; k < HD; ++k) St[k] = 0.f; }
#endif
        const size_t row = (size_t)(b * SEQ + t) * DH + h * HD;
        sq[v] = bf2f(Q[row + v]); sk[v] = bf2f(KI[row + v]); sf[v] = __expf(bf2f(LF[row + v]));
        const float vv = bf2f(V[row + v]);
        __syncthreads();
        float o = 0.f;
#pragma unroll
        for (int k = 0; k < HD; ++k) { St[k] = sf[k] * St[k] + sk[k] * vv; o += St[k] * sq[k]; }
        const float ss = wave_sum(o * o);
        if ((v & 63) == 0) red[v >> 6] = ss;
        __syncthreads();
        const float rstd = rsqrtf((red[0] + red[1]) * (1.f / HD) + EPS);
        O[(size_t)(b * SEQ + t) * D + h * HD + v] = (bf16)f2bf(o * rstd * g * bf2f(GZ[row + v]));
    }
}

__global__ void __launch_bounds__(512) k_rg(P p) {
    const int b = blockIdx.x, ch = threadIdx.x, blk = ch >> 6, cl = ch & 63;
    const size_t S = PROJ_S; const bf16* PJ = (const bf16*)(p.ws + WS_PROJ);
    const bf16 *XR = PJ + 5 * S, *YR = PJ + 6 * S; bf16* O = (bf16*)(p.ws + WS_H);
    const float* cw = p.in[11]; const float cb = p.in[12][ch];
    const float c0 = cw[ch], c1 = cw[DR + ch], c2 = cw[2 * DR + ch], c3 = cw[3 * DR + ch];
    float wr[RBD], wi[RBD];
#pragma unroll
    for (int i = 0; i < RBD; ++i) { wr[i] = p.in[13][(size_t)(blk * RBD + i) * RBD + cl]; wi[i] = p.in[15][(size_t)(blk * RBD + i) * RBD + cl]; }
    const float br = p.in[14][ch], bi = p.in[16][ch], lam = p.in[17][ch], gn = p.in[18][ch];
    const float logsig = -log1pf(__expf(-lam));
    __shared__ float sx[DR], red[8];
    float hst = 0.f, x0 = 0.f, x1 = 0.f, x2 = 0.f;
    for (int t = 0; t < SEQ; ++t) {
        const size_t row = (size_t)(b * SEQ + t) * DH;
        const float x3 = bf2f(XR[row + ch]);
        const float xc = c0 * x0 + c1 * x1 + c2 * x2 + c3 * x3 + cb; x0 = x1; x1 = x2; x2 = x3;
        sx[ch] = xc; __syncthreads();
        float ar = br, ai = bi;
#pragma unroll
        for (int i = 0; i < RBD; ++i) { const float xi = sx[blk * RBD + i]; ar += xi * wr[i]; ai += xi * wi[i]; }
        const float r = sigmoidf_(ar), ig = sigmoidf_(ai);
        const float la = 8.f * r * logsig, a = __expf(la), u = sqrtf(-expm1f(2.f * la)) * (ig * xc);
        hst = a * hst + u;
        const float val = hst * bf2f(YR[row + ch]);
        const float ss = wave_sum(val * val);
        if ((ch & 63) == 0) red[ch >> 6] = ss;
        __syncthreads();
        float tot = 0.f;
#pragma unroll
        for (int i = 0; i < 8; ++i) tot += red[i];
        O[(size_t)(b * SEQ + t) * D + DH + ch] = (bf16)f2bf(val * rsqrtf(tot * (1.f / DR) + EPS) * gn);
    }
}

struct NEpiF32 { float* C; int ldc; __device__ void operator()(int m, int n, float v, float) const { C[(size_t)m * ldc + n] = v; } };
__global__ void __launch_bounds__(256) k_mix(P p) {
    NEpiF32 e{(float*)(p.ws + WS_MIX), D};
    gemm_tile_naive<1>((const bf16*)(p.ws + WS_H), D, p.in[19], nullptr, D, D, blockIdx.y * 64, blockIdx.x * 64, 64, RowId{}, e);
}

__global__ void __launch_bounds__(256) k_row2(P p) {
    const int lane = threadIdx.x & 63, gw = (blockIdx.x * blockDim.x + threadIdx.x) >> 6, ngw = (gridDim.x * blockDim.x) >> 6;
    const float* x = p.in[0]; const float* mod = (const float*)(p.ws + WS_MOD); const float* mix = (const float*)(p.ws + WS_MIX);
    const float *gpm = p.in[5], *gpf = p.in[6], *wrg = p.in[20], *brg = p.in[21], *wre = p.in[22], *bre = p.in[23];
    bf16* H = (bf16*)(p.ws + WS_H); float* wgt = (float*)(p.ws + WS_WGT);
    unsigned* cnt = (unsigned*)(p.ws + WS_CTL) + CW_CNT; int* list = (int*)(p.ws + WS_LIST);
    for (int m = gw; m < T; m += ngw) {
        const int b = m / SEQ; const float* mb = mod + b * 6144; const float *gt1 = mb + 2048, *sh2 = mb + 3072, *sc2 = mb + 4096;
        f32x4 v[4], xv[4]; float s = 0.f;
#pragma unroll
        for (int j = 0; j < 4; ++j) { v[j] = ((const f32x4*)(mix + (size_t)m * D) + lane)[64 * j]; xv[j] = ((const f32x4*)(x + (size_t)m * D) + lane)[64 * j]; s += v[j].x * v[j].x + v[j].y * v[j].y + v[j].z * v[j].z + v[j].w * v[j].w; }
        const float rs1 = rsqrtf(wave_sum(s) * (1.f / D) + EPS); float s2 = 0.f;
#pragma unroll
        for (int j = 0; j < 4; ++j) { const int c0 = 4 * lane + 256 * j; const f32x4 gg = *(const f32x4*)(gpm + c0), gt = *(const f32x4*)(gt1 + c0);
            xv[j].x += gt.x * (v[j].x * rs1 * gg.x); xv[j].y += gt.y * (v[j].y * rs1 * gg.y); xv[j].z += gt.z * (v[j].z * rs1 * gg.z); xv[j].w += gt.w * (v[j].w * rs1 * gg.w);
            ((f32x4*)(p.out + (size_t)m * D) + lane)[64 * j] = xv[j];
            s2 += xv[j].x * xv[j].x + xv[j].y * xv[j].y + xv[j].z * xv[j].z + xv[j].w * xv[j].w; }
        const float rs2 = rsqrtf(wave_sum(s2) * (1.f / D) + EPS);
        float hh[4][4];
#pragma unroll
        for (int j = 0; j < 4; ++j) { const int c0 = 4 * lane + 256 * j; const f32x4 gg = *(const f32x4*)(gpf + c0), sc = *(const f32x4*)(sc2 + c0), sh = *(const f32x4*)(sh2 + c0);
            hh[j][0] = xv[j].x * rs2 * gg.x * (1.f + sc.x) + sh.x; hh[j][1] = xv[j].y * rs2 * gg.y * (1.f + sc.y) + sh.y; hh[j][2] = xv[j].z * rs2 * gg.z * (1.f + sc.z) + sh.z; hh[j][3] = xv[j].w * rs2 * gg.w * (1.f + sc.w) + sh.w;
            ((unsigned long long*)(H + (size_t)m * D) + lane)[64 * j] = (unsigned long long)pk2(hh[j][0], hh[j][1]) | ((unsigned long long)pk2(hh[j][2], hh[j][3]) << 32); }
        float lg[NG], le[NE];
#pragma unroll
        for (int o = 0; o < NG; ++o) lg[o] = 0.f;
#pragma unroll
        for (int o = 0; o < NE; ++o) le[o] = 0.f;
#pragma unroll
        for (int j = 0; j < 4; ++j)
#pragma unroll
            for (int i = 0; i < 4; ++i) { const int k = 4 * lane + 256 * j + i; const float hv = hh[j][i];
                const f32x4 wg = *(const f32x4*)(wrg + (size_t)k * NG); lg[0] += hv * wg.x; lg[1] += hv * wg.y; lg[2] += hv * wg.z; lg[3] += hv * wg.w;
#pragma unroll
                for (int o4 = 0; o4 < NE / 4; ++o4) { const f32x4 we = *(const f32x4*)(wre + (size_t)k * NE + 4 * o4); le[4 * o4] += hv * we.x; le[4 * o4 + 1] += hv * we.y; le[4 * o4 + 2] += hv * we.z; le[4 * o4 + 3] += hv * we.w; } }
#pragma unroll
        for (int o = 0; o < NG; ++o) lg[o] = wave_sum(lg[o]) + brg[o];
#pragma unroll
        for (int o = 0; o < NE; ++o) le[o] = wave_sum(le[o]) + bre[o];
        if (lane == 0) {
            int gs = 0; float gm = lg[0];
#pragma unroll
            for (int o = 1; o < NG; ++o) if (lg[o] > gm) { gm = lg[o]; gs = o; }
            float den = 0.f;
#pragma unroll
            for (int o = 0; o < NG; ++o) den += __expf(lg[o] - gm);
            const float gate = 1.f / den;
            float sel[EPG];
#pragma unroll
            for (int o = 0; o < EPG; ++o) sel[o] = gs == 0 ? le[o] : gs == 1 ? le[8 + o] : gs == 2 ? le[16 + o] : le[24 + o];
            int i1 = 0; float m1 = sel[0];
#pragma unroll
            for (int o = 1; o < EPG; ++o) if (sel[o] > m1) { m1 = sel[o]; i1 = o; }
            int i2 = -1; float m2 = -3.0e38f;
#pragma unroll
            for (int o = 0; o < EPG; ++o) if (o != i1 && sel[o] > m2) { m2 = sel[o]; i2 = o; }
            const float e2 = __expf(m2 - m1), w1 = gate / (1.f + e2), w2 = gate * e2 / (1.f + e2);
            const int ea = gs * EPG + i1, eb = gs * EPG + i2;
            wgt[2 * m] = w1; wgt[2 * m + 1] = w2;
            const unsigned pa = atomicAdd(&cnt[ea], 1u), pb = atomicAdd(&cnt[eb], 1u);
            list[ea * 32768 + pa] = 2 * m; list[eb * 32768 + pb] = 2 * m + 1;
        }
    }
}

struct RowList { const int* lst; __device__ int operator()(int m) const { return lst[m] >> 1; } };
struct RowAid { const int* lst; __device__ int operator()(int m) const { return lst[m]; } };
struct NEpiAct { bf16* act; const int* lst; __device__ void operator()(int m, int n, float a, float b) const { act[(size_t)lst[m] * DE + n] = (bf16)f2bf(siluf_(a) * b); } };
struct NEpiYa { bf16* ya; const int* lst; const float* wgt; __device__ void operator()(int m, int n, float v, float) const { const int aid = lst[m]; ya[(size_t)aid * D + n] = (bf16)f2bf(v * wgt[aid]); } };
__global__ void __launch_bounds__(256) k_moe1(P p) {
    const int e = blockIdx.z; const unsigned* cnt = (const unsigned*)(p.ws + WS_CTL) + CW_CNT; const int c = (int)cnt[e];
    const int m0 = blockIdx.y * 64; if (m0 >= c) return;
    const int* lst = (const int*)(p.ws + WS_LIST) + e * 32768;
    NEpiAct ep{(bf16*)(p.ws + WS_ACT), lst};
    gemm_tile_naive<2>((const bf16*)(p.ws + WS_H), D, p.in[24] + (size_t)e * D * DE, p.in[25] + (size_t)e * D * DE, DE, D, m0, blockIdx.x * 64, min(64, c - m0), RowList{lst}, ep);
}
__global__ void __launch_bounds__(256) k_moe2(P p) {
    const int e = blockIdx.z; const unsigned* cnt = (const unsigned*)(p.ws + WS_CTL) + CW_CNT; const int c = (int)cnt[e];
    const int m0 = blockIdx.y * 64; if (m0 >= c) return;
    const int* lst = (const int*)(p.ws + WS_LIST) + e * 32768;
    NEpiYa ep{(bf16*)(p.ws + WS_YA), lst, (const float*)(p.ws + WS_WGT)};
    gemm_tile_naive<1>((const bf16*)(p.ws + WS_ACT), DE, p.in[26] + (size_t)e * DE * D, nullptr, D, DE, m0, blockIdx.x * 64, min(64, c - m0), RowAid{lst}, ep);
}

__global__ void __launch_bounds__(256) k_final(P p) {
    const int lane = threadIdx.x & 63, gw = (blockIdx.x * blockDim.x + threadIdx.x) >> 6, ngw = (gridDim.x * blockDim.x) >> 6;
    const float* mod = (const float*)(p.ws + WS_MOD); const bf16* YA = (const bf16*)(p.ws + WS_YA); const float* gp = p.in[7];
    for (int m = gw; m < T; m += ngw) {
        const int b = m / SEQ; const float* gt2 = mod + b * 6144 + 5120;
        float y[4][4]; float s = 0.f;
#pragma unroll
        for (int j = 0; j < 4; ++j) { const v2u a = ((const v2u*)(YA + (size_t)(2 * m) * D) + lane)[64 * j], c = ((const v2u*)(YA + (size_t)(2 * m + 1) * D) + lane)[64 * j];
            y[j][0] = bf2f(a.x & 0xffffu) + bf2f(c.x & 0xffffu); y[j][1] = bf2f(a.x >> 16) + bf2f(c.x >> 16); y[j][2] = bf2f(a.y & 0xffffu) + bf2f(c.y & 0xffffu); y[j][3] = bf2f(a.y >> 16) + bf2f(c.y >> 16);
#pragma unroll
            for (int i = 0; i < 4; ++i) s += y[j][i] * y[j][i]; }
        const float rs = rsqrtf(wave_sum(s) * (1.f / D) + EPS);
#pragma unroll
        for (int j = 0; j < 4; ++j) { const int c0 = 4 * lane + 256 * j; const f32x4 gg = *(const f32x4*)(gp + c0), gt = *(const f32x4*)(gt2 + c0);
            f32x4* o = (f32x4*)(p.out + (size_t)m * D) + lane + 64 * j; f32x4 xv = *o;
            xv.x += gt.x * (y[j][0] * rs * gg.x); xv.y += gt.y * (y[j][1] * rs * gg.y); xv.z += gt.z * (y[j][2] * rs * gg.z); xv.w += gt.w * (y[j][3] * rs * gg.w); *o = xv; }
    }
}

#endif

extern "C" void kernel_launch(void* const* d_in, const int* in_sizes, int n_in, void* d_out, int out_size, void* d_ws, size_t ws_size, hipStream_t stream) {
    static int grid = 0;
    if (grid == 0) {
        if (n_in != 27 || out_size != T * D || ws_size < WS_END) { fprintf(stderr, "kernel_launch: unexpected n_in %d / out %d / ws %zu\n", n_in, out_size, ws_size); grid = -1; return; }
        int dev = 0, cus = 0, per_cu = 0;
        if (hipGetDevice(&dev) != hipSuccess || hipDeviceGetAttribute(&cus, hipDeviceAttributeMultiprocessorCount, dev) != hipSuccess) { grid = -1; return; }
        if (hipFuncSetAttribute((const void*)skel_fwd, hipFuncAttributeMaxDynamicSharedMemorySize, LDS_BYTES) != hipSuccess) { fprintf(stderr, "kernel_launch: hipFuncSetAttribute failed\n"); grid = -1; return; }
        if (hipOccupancyMaxActiveBlocksPerMultiprocessor(&per_cu, (const void*)skel_fwd, NTHR, LDS_BYTES) != hipSuccess || per_cu < 1) { fprintf(stderr, "kernel_launch: occupancy query says %d blocks per CU\n", per_cu); per_cu = 1; }
        (void)hipGetLastError();
        if (cus < 256) { fprintf(stderr, "kernel_launch: needs 256 CUs (one resident workgroup per chunk), device has %d\n", cus); grid = -1; return; }
        grid = 256;
        fprintf(stderr, "kernel_launch: grid %d, occupancy query %d per CU, ws %zu MiB\n", grid, per_cu, ws_size >> 20);
    }
    if (grid < 0) return;
    (void)hipMemsetAsync((char*)d_ws + WS_CTL, 0, CTL_ZERO_BYTES, stream);
    Args a{};
    for (int i = 0; i < 27; ++i) a.in[i] = (const float*)d_in[i];
    a.out = (float*)d_out; a.ws = (unsigned char*)d_ws;
#ifdef HYBRID
    P p{}; for (int i = 0; i < 27; ++i) p.in[i] = (const float*)d_in[i]; p.out = (float*)d_out; p.ws = (unsigned char*)d_ws;
#define RUNPH(lo_, hi_) do { for (int ph = (lo_); ph < (hi_); ++ph) { a.ph_lo = ph; a.ph_hi = ph + 1; hipLaunchKernelGGL(skel_fwd, dim3(grid), dim3(NTHR), LDS_BYTES, stream, a); } } while (0)
    RUNPH(0, 1);
    if (HYBRID & 1) RUNPH(1, 2); else k_h<<<1024, 256, 0, stream>>>(p);
    if (HYBRID & 2) RUNPH(2, 3); else k_proj<<<dim3(DIN / 64, T / 64), 256, 0, stream>>>(p);
    if (HYBRID & 4) { RUNPH(3, 6); if (HYBRID & 128) k_rg<<<BATCH, 512, 0, stream>>>(p); if (HYBRID & 256) k_hgrn<<<BATCH * NH, 128, 0, stream>>>(p); } else { k_hgrn<<<BATCH * NH, 128, 0, stream>>>(p); k_rg<<<BATCH, 512, 0, stream>>>(p); }
    if (HYBRID & 8) RUNPH(6, 7); else k_mix<<<dim3(D / 64, T / 64), 256, 0, stream>>>(p);
    if (HYBRID & 16) RUNPH(7, 8); else k_row2<<<1024, 256, 0, stream>>>(p);
    if (HYBRID & 32) RUNPH(8, 10); else { k_moe1<<<dim3(DE / 64, 512, NE), 256, 0, stream>>>(p); k_moe2<<<dim3(D / 64, 512, NE), 256, 0, stream>>>(p); }
    if (HYBRID & 64) RUNPH(10, 11); else k_final<<<1024, 256, 0, stream>>>(p);
#elif MK_N_LAUNCHES == 1
    a.ph_lo = 0; a.ph_hi = NPH;
    hipLaunchKernelGGL(skel_fwd, dim3(grid), dim3(NTHR), LDS_BYTES, stream, a);
#else
    for (int ph = 0; ph < NPH; ++ph) { a.ph_lo = ph; a.ph_hi = ph + 1; hipLaunchKernelGGL(skel_fwd, dim3(grid), dim3(NTHR), LDS_BYTES, stream, a); }
#endif
}
```

```cpp
#include <hip/hip_runtime.h>
#include <cstdio>
#include <cstdint>

#ifndef PROBE_H5
#define PROBE_H5 1
#endif
#ifndef PROBE_G2
#define PROBE_G2 1
#endif
#ifndef PROBE_R7
#define PROBE_R7 1
#endif
#ifndef PROBE_R10
#define PROBE_R10 1
#endif
#ifndef PROBE_RG5
#define PROBE_RG5 1
#endif
#ifndef PROBE_M8
#define PROBE_M8 1
#endif
#ifndef PROBE_M9
#define PROBE_M9 1
#endif
#ifndef PROBE_BAR
#define PROBE_BAR 1
#endif
#ifndef PROBE_ALL
#define PROBE_ALL 1
#endif
#ifndef MK_N_LAUNCHES
#define MK_N_LAUNCHES 1
#endif

constexpr int BATCH = 2, SEQ = 8192, D = 1024, T = BATCH * SEQ;
constexpr int DH = 512, HD = 128, NH = 4, CHK = 64, NCH = SEQ / CHK;
constexpr int DR = 512, RBD = 64;
constexpr int DIN = 3072;
constexpr int NG = 4, EPG = 8, NE = 32, DE = 512;
constexpr int MAXMB = 160;
constexpr float EPS = 1e-6f;
constexpr int NWAVES = 8, NTHR = 512;

#define GAS __attribute__((address_space(1)))
#define LAS __attribute__((address_space(3)))
typedef unsigned short bf16;
typedef unsigned v4u __attribute__((ext_vector_type(4)));
typedef unsigned v2u __attribute__((ext_vector_type(2)));
typedef float f32x4 __attribute__((ext_vector_type(4)));
typedef short bf16x8 __attribute__((ext_vector_type(8)));
typedef GAS unsigned gu32;
#define RLX_AGENT __ATOMIC_RELAXED, __HIP_MEMORY_SCOPE_AGENT
#define LDS_WAIT() asm volatile("s_waitcnt lgkmcnt(0)" ::: "memory")
#define VM_WAIT() asm volatile("s_waitcnt vmcnt(0)" ::: "memory")

__device__ __forceinline__ unsigned f2bf(float f) { unsigned u = __builtin_bit_cast(unsigned, f); return (u + 0x7fffu + ((u >> 16) & 1u)) >> 16; }
__device__ __forceinline__ float bf2f(unsigned h) { return __builtin_bit_cast(float, h << 16); }
typedef float f32x2_t __attribute__((ext_vector_type(2))); typedef __bf16 bf16x2_t __attribute__((ext_vector_type(2)));
__device__ __forceinline__ unsigned pk2m(float lo, float hi) { f32x2_t v = {lo, hi}; bf16x2_t b = __builtin_convertvector(v, bf16x2_t); return __builtin_bit_cast(unsigned, b); }
__device__ __forceinline__ unsigned pk2(float lo, float hi) { unsigned r; asm volatile("v_cvt_pk_bf16_f32 %0, %1, %2" : "=v"(r) : "v"(lo), "v"(hi)); return r; }
__device__ __forceinline__ float frcp(float v) { return __builtin_amdgcn_rcpf(v); }
__device__ __forceinline__ float sigmoidf_(float v) { return frcp(1.f + __expf(-v)); }
__device__ __forceinline__ float siluf_(float v) { return v * frcp(1.f + __expf(-v)); }
__device__ __forceinline__ float gelu_tanh_(float v) { const float u = 1.5957691216057308f * (v + 0.044715f * v * v * v); return v * frcp(1.f + __expf(-u)); }
__device__ __forceinline__ float wave_sum(float v) {
#pragma unroll
    for (int o = 1; o < 64; o <<= 1) v += __shfl_xor(v, o);
    return v;
}

constexpr size_t MiB = 1u << 20, KiB = 1u << 10;
constexpr size_t WS_CTL = 0, CTL_ZERO_BYTES = 1 * MiB;
constexpr size_t WS_MOD = 1 * MiB;
constexpr size_t WS_LB = WS_MOD + 64 * KiB;
constexpr size_t WS_WRT = WS_MOD + 128 * KiB;
constexpr size_t WS_WIT = WS_WRT + 64 * KiB;
constexpr size_t WS_RRH = WS_WIT + 64 * KiB;
constexpr size_t WS_RRL = WS_RRH + 96 * KiB;
constexpr size_t WS_RGA = 2 * MiB;
constexpr size_t WS_RGH = WS_RGA + 512 * KiB;
constexpr size_t WS_CARRY = WS_RGH + 512 * KiB;
constexpr size_t WS_DD = WS_CARRY + 512 * KiB;
constexpr size_t WS_WGT = 4 * MiB;
constexpr size_t WS_LIST = 5 * MiB;
constexpr size_t WS_WIN = 10 * MiB;
constexpr size_t WS_WOUT = 16 * MiB;
constexpr size_t WS_W13 = 18 * MiB;
constexpr size_t WS_W2 = 82 * MiB;
constexpr size_t WS_H = 114 * MiB;
constexpr size_t WS_PROJ = 146 * MiB;
constexpr size_t WS_MIX = WS_PROJ;
constexpr size_t WS_YA = WS_PROJ;
constexpr size_t WS_ACT = WS_PROJ + 64 * MiB;
constexpr size_t WS_END = 258 * MiB;
constexpr size_t PROJ_S = (size_t)T * DH;
constexpr int CW_CNT = 64;
constexpr int CW_MODCNT = 128;
constexpr int CW_BAR = 4096;

constexpr int RING_BYTES = 131072;
constexpr int RTAB_BYTES = 1024 * 36 * 4;
constexpr int X_OFF = RTAB_BYTES;
constexpr int X_GTAB = X_OFF;
constexpr int X_MBE = X_OFF + 4096;
constexpr int X_MISC = X_OFF + 6144;
constexpr int LDS_BYTES = X_OFF + 8192;

namespace pg8 {
constexpr int BM = 256, BK = 64, HALF = 128, HTB = HALF * BK * 2, NXCD = 8, WGM = 8;
__host__ __device__ __forceinline__ int lds_byte(int r, int c) { const int st = (r >> 4) * 2 + (c >> 5), rr = r & 15, cc = c & 31, ob = rr * 64 + cc * 2; return st * 1024 + (ob ^ (((ob >> 9) & 1) << 5)); }
__host__ __device__ __forceinline__ void stage_rc(int b, int& R, int& C) { const int st = b / 1024, sb = b % 1024, swz = sb ^ (((sb >> 9) & 1) << 5); R = (st >> 1) * 16 + swz / 64; C = (st & 1) * 32 + (swz % 64) / 2; }
__host__ __device__ __forceinline__ int perm32(int rho) { const int n = rho >> 4, i = rho & 15; return 8 * (i >> 2) + 4 * n + (i & 3); }

struct Unit { int pm, pn, slot; };
struct Gemm { const bf16* A; const bf16* Bt; int K; };

struct StaticOrder {
    int nM, nN, nwg, G, c, K, rep;
    __device__ void init(int M, int N, int K_, int G_, int c_, int rep_ = 1) { nM = M / BM; nN = N / BM; nwg = nM * nN; G = G_; c = c_; K = K_; rep = rep_; }
    __device__ bool next(int i, Unit& u) const {
        long L = (long)i * G + c; if (L >= (long)nwg * rep) return false; L %= nwg;
        int wgid = (int)L; { const int q = nwg / NXCD, r = nwg % NXCD, xcd = wgid % NXCD, off = wgid / NXCD; wgid = (xcd < r ? xcd * (q + 1) : r * (q + 1) + (xcd - r) * q) + off; }
        const int nig = WGM * nN, gid = wgid / nig, fm = gid * WGM, gsz = (nM - fm) < WGM ? (nM - fm) : WGM;
        u.pm = fm + ((wgid % nig) % gsz); u.pn = (wgid % nig) / gsz; u.slot = i; return true;
    }
    __device__ size_t aoff(const Unit& u) const { return (size_t)u.pm * BM * K * 2; }
    __device__ size_t boff(const Unit& u) const { return (size_t)u.pn * BM * K * 2; }
};
struct MoeOrder {
    int nunits, G, c, K; const LAS int* mbe; size_t estride; int rep;
    __device__ bool next(int i, Unit& u) const {
        const int x = c & 7, ci = c >> 3; const int lo = (int)(((long)nunits * x) >> 3), hi = (int)(((long)nunits * (x + 1)) >> 3);
        const int mine = (hi - lo - ci + 31) >> 5; if (mine <= 0 || i >= mine * rep) return false;
        const int ii = i % mine; const long L = lo + ci + 32 * ii;
        u.pm = (int)(L >> 2); u.pn = (int)(L & 3); u.slot = ii; return true;
    }
    __device__ size_t aoff(const Unit& u) const { return (size_t)u.pm * BM * K * 2; }
    __device__ size_t boff(const Unit& u) const { return (size_t)mbe[u.pm] * estride + (size_t)u.pn * BM * K * 2; }
};

struct EpiProj {
    static constexpr bool PERM = true;
    bf16* base; const float* lb;
    __device__ __forceinline__ void operator()(const f32x4 (&acc)[2][2][4][2], const Unit& u, int wr, int wc, int fr, int fq) const {
        const int grp = u.pn >> 1, c0 = (u.pn & 1) * 256 + wc * 32 + 8 * fq, row0 = u.pm * BM + wr * 64 + fr;
        bf16* ob = base + (grp == 0 ? 0 : grp == 1 ? PROJ_S : (size_t)(grp + 1) * PROJ_S);
        float lbv[2][8];
        if (grp == 1) {
#pragma unroll
            for (int bj = 0; bj < 2; ++bj) { const f32x4 a = *(const f32x4*)(lb + c0 + bj * HALF), b = *(const f32x4*)(lb + c0 + bj * HALF + 4);
                lbv[bj][0] = a[0]; lbv[bj][1] = a[1]; lbv[bj][2] = a[2]; lbv[bj][3] = a[3]; lbv[bj][4] = b[0]; lbv[bj][5] = b[1]; lbv[bj][6] = b[2]; lbv[bj][7] = b[3]; }
        }
#pragma unroll
        for (int ai = 0; ai < 2; ++ai)
#pragma unroll
            for (int m = 0; m < 4; ++m) { bf16* rowp = ob + (size_t)(row0 + ai * HALF + m * 16) * DH + c0;
#pragma unroll
                for (int bj = 0; bj < 2; ++bj) {
                    float v[8];
#pragma unroll
                    for (int j = 0; j < 4; ++j) { v[j] = acc[ai][bj][m][0][j]; v[4 + j] = acc[ai][bj][m][1][j]; }
                    if (grp == 1) {
                        float kv[8];
#pragma unroll
                        for (int j = 0; j < 8; ++j) { const float l = lbv[bj][j], sg = sigmoidf_(v[j]); kv[j] = (1.f - l) * (1.f - sg); v[j] = __logf(l + (1.f - l) * sg); }
                        v4u w; w.x = pk2(kv[0], kv[1]); w.y = pk2(kv[2], kv[3]); w.z = pk2(kv[4], kv[5]); w.w = pk2(kv[6], kv[7]);
                        *(v4u*)(rowp + PROJ_S + bj * HALF) = w;
                    } else if (grp == 0 || grp == 3) {
#pragma unroll
                        for (int j = 0; j < 8; ++j) v[j] = siluf_(v[j]);
                    } else if (grp == 5) {
#pragma unroll
                        for (int j = 0; j < 8; ++j) v[j] = gelu_tanh_(v[j]);
                    }
                    v4u w; w.x = pk2m(v[0], v[1]); w.y = pk2m(v[2], v[3]); w.z = pk2m(v[4], v[5]); w.w = pk2m(v[6], v[7]);
                    *(v4u*)(rowp + bj * HALF) = w;
                } }
    }
};
struct EpiF32 {
    static constexpr bool PERM = false;
    float* C; int ldc;
    __device__ __forceinline__ void operator()(const f32x4 (&acc)[2][2][4][2], const Unit& u, int wr, int wc, int fr, int fq) const {
        const int row0 = u.pm * BM + wr * 64 + fr, col0 = u.pn * BM + wc * 32 + 4 * fq;
#pragma unroll
        for (int ai = 0; ai < 2; ++ai)
#pragma unroll
            for (int m = 0; m < 4; ++m) { float* rowp = C + (size_t)(row0 + ai * HALF + m * 16) * ldc + col0;
#pragma unroll
                for (int bj = 0; bj < 2; ++bj)
#pragma unroll
                    for (int n = 0; n < 2; ++n) *(f32x4*)(rowp + bj * HALF + n * 16) = acc[ai][bj][m][n]; }
    }
};
struct EpiMixB {
    static constexpr bool PERM = true;
    bf16* C; int ldc;
    __device__ __forceinline__ void operator()(const f32x4 (&acc)[2][2][4][2], const Unit& u, int wr, int wc, int fr, int fq) const {
        const int row0 = u.pm * BM + wr * 64 + fr, col0 = u.pn * BM + wc * 32 + 8 * fq;
#pragma unroll
        for (int ai = 0; ai < 2; ++ai)
#pragma unroll
            for (int m = 0; m < 4; ++m) { bf16* rowp = C + (size_t)(row0 + ai * HALF + m * 16) * ldc + col0;
#pragma unroll
                for (int bj = 0; bj < 2; ++bj) { const f32x4 a = acc[ai][bj][m][0], b = acc[ai][bj][m][1];
                    v4u w; w.x = pk2m(a[0], a[1]); w.y = pk2m(a[2], a[3]); w.z = pk2m(b[0], b[1]); w.w = pk2m(b[2], b[3]);
                    *(v4u*)(rowp + bj * HALF) = w; } }
    }
};
struct EpiAct {
    static constexpr bool PERM = true;
    bf16* act;
    __device__ __forceinline__ void operator()(const f32x4 (&acc)[2][2][4][2], const Unit& u, int wr, int wc, int fr, int fq) const {
        const int row0 = u.pm * BM + wr * 64 + fr, col0 = u.pn * HALF + wc * 32 + 8 * fq;
#pragma unroll
        for (int ai = 0; ai < 2; ++ai)
#pragma unroll
            for (int m = 0; m < 4; ++m) {
                float v[8];
#pragma unroll
                for (int j = 0; j < 4; ++j) { v[j] = siluf_(acc[ai][0][m][0][j]) * acc[ai][1][m][0][j]; v[4 + j] = siluf_(acc[ai][0][m][1][j]) * acc[ai][1][m][1][j]; }
                v4u w; w.x = pk2(v[0], v[1]); w.y = pk2(v[2], v[3]); w.z = pk2(v[4], v[5]); w.w = pk2(v[6], v[7]);
                *(v4u*)(act + (size_t)(row0 + ai * HALF + m * 16) * DE + col0) = w; }
    }
};
struct EpiYa {
    static constexpr bool PERM = true;
    bf16* ya; const float* wgt; const LAS int* tab;
    __device__ __forceinline__ void operator()(const f32x4 (&acc)[2][2][4][2], const Unit& u, int wr, int wc, int fr, int fq) const {
        const int col0 = u.pn * BM + wc * 32 + 8 * fq;
#pragma unroll
        for (int ai = 0; ai < 2; ++ai)
#pragma unroll
            for (int m = 0; m < 4; ++m) { const int aid = tab[u.slot * 256 + ai * HALF + wr * 64 + m * 16 + fr];
                if (aid >= 0) { const float w8 = wgt[aid]; bf16* rowp = ya + (size_t)aid * D + col0;
#pragma unroll
                    for (int bj = 0; bj < 2; ++bj) { const f32x4 a = acc[ai][bj][m][0] * w8, b = acc[ai][bj][m][1] * w8;
                        v4u w; w.x = pk2(a[0], a[1]); w.y = pk2(a[2], a[3]); w.z = pk2(b[0], b[1]); w.w = pk2(b[2], b[3]);
                        *(v4u*)(rowp + bj * HALF) = w; } } }
    }
};

template <class Epi, class Sched, bool GATHER>
__device__ __forceinline__ void gemm_phase(LAS unsigned char* lds, const Gemm g, const Sched& S, const Epi& E, const LAS unsigned* gtab) {
    const int tid = threadIdx.x, wid = __builtin_amdgcn_readfirstlane(tid >> 6), lane = tid & 63, wr = wid >> 2, wc = wid & 3, fr = lane & 15, fq = lane >> 4;
    const int K = g.K, nt = K / BK;
    unsigned voffA[2], voffB[2]; int rowA[2];
#pragma unroll
    for (int i = 0; i < 2; ++i) { int R, C; stage_rc(tid * 16 + i * 8192, R, C); const int Rb = Epi::PERM ? ((R & ~31) + perm32(R & 31)) : R;
        voffA[i] = GATHER ? (unsigned)(C * 2) : (unsigned)(R * K + C) * 2u; voffB[i] = (unsigned)(Rb * K + C) * 2u; rowA[i] = R; }
    const size_t kstep = (size_t)(BK * 2);
    const size_t hstep = (size_t)HALF * K * 2;
    const unsigned ldsw = (unsigned)wid * 1024u;
    const int aoff = lds_byte(wr * 64 + fr, fq * 8), boff = lds_byte(wc * 32 + fr, fq * 8);
#define PG8_SA(b, h) (((b) * 2 + (h)) * HTB)
#define PG8_SB(b, h) ((4 + (b) * 2 + (h)) * HTB)
#define PG8_STAGE(bufoff, gbase, voff) do { _Pragma("unroll") for (int _i = 0; _i < 2; ++_i) \
        __builtin_amdgcn_global_load_lds((const unsigned*)((const char*)(gbase) + (voff)[_i]), (LAS unsigned*)(lds + (bufoff) + ldsw + _i * 8192), 16, 0, 0); } while (0)
#define PG8_STAGE_A(bufoff, gbase, slot, h) do { if constexpr (GATHER) { _Pragma("unroll") for (int _i = 0; _i < 2; ++_i) { const unsigned _ro = gtab[(slot) * 256 + (h) * HALF + rowA[_i]]; \
        __builtin_amdgcn_global_load_lds((const unsigned*)((const char*)(gbase) + _ro + voffA[_i]), (LAS unsigned*)(lds + (bufoff) + ldsw + _i * 8192), 16, 0, 0); } } \
        else { PG8_STAGE(bufoff, (const char*)(gbase) + (h) * hstep, voffA); } } while (0)
#define PG8_LDA(dst, b, h) do { _Pragma("unroll") for (int m = 0; m < 4; ++m) _Pragma("unroll") for (int k = 0; k < 2; ++k) dst[m][k] = *(const LAS bf16x8*)(lds + PG8_SA(b, h) + aoff + m * 2048 + k * 1024); } while (0)
#define PG8_LDB(dst, b, h) do { _Pragma("unroll") for (int n = 0; n < 2; ++n) _Pragma("unroll") for (int k = 0; k < 2; ++k) dst[n][k] = *(const LAS bf16x8*)(lds + PG8_SB(b, h) + boff + n * 2048 + k * 1024); } while (0)
#define PG8_MMA(ai, bj, At, Bt) do { __builtin_amdgcn_s_setprio(1); _Pragma("unroll") for (int m = 0; m < 4; ++m) _Pragma("unroll") for (int n = 0; n < 2; ++n) _Pragma("unroll") for (int k = 0; k < 2; ++k) \
        acc[ai][bj][m][n] = __builtin_amdgcn_mfma_f32_16x16x32_bf16(Bt[n][k], At[m][k], acc[ai][bj][m][n], 0, 0, 0); __builtin_amdgcn_s_setprio(0); } while (0)
#define PG8_WAIT_V(n) asm volatile("s_waitcnt vmcnt(" #n ")" ::: "memory")
#define PG8_WAIT_L(n) asm volatile("s_waitcnt lgkmcnt(" #n ")" ::: "memory")
#define PG8_BAR __builtin_amdgcn_s_barrier()
#define PG8_SCHED __builtin_amdgcn_sched_barrier(0)
    Unit cur, nxt; int ui = 0;
    if (!S.next(0, cur)) return;
    f32x4 acc[2][2][4][2];
#pragma unroll
    for (int a = 0; a < 2; ++a)
#pragma unroll
        for (int b = 0; b < 2; ++b)
#pragma unroll
            for (int m = 0; m < 4; ++m)
#pragma unroll
                for (int n = 0; n < 2; ++n) acc[a][b][m][n] = (f32x4){0.f, 0.f, 0.f, 0.f};
    bf16x8 At[4][2], B0[2][2], B1[2][2];
    const char* cA = (const char*)g.A + (GATHER ? (size_t)0 : S.aoff(cur)); const char* cB = (const char*)g.Bt + S.boff(cur);
    PG8_STAGE(PG8_SB(0, 0), cB, voffB); PG8_STAGE(PG8_SB(0, 1), cB + hstep, voffB); PG8_STAGE_A(PG8_SA(0, 0), cA, 0, 0); PG8_STAGE_A(PG8_SA(0, 1), cA, 0, 1);
    if (wr == 1) PG8_BAR;
    PG8_WAIT_V(2); PG8_BAR;
    PG8_STAGE(PG8_SB(1, 0), cB + kstep, voffB); PG8_STAGE_A(PG8_SA(1, 0), cA + kstep, 0, 0); PG8_STAGE(PG8_SB(1, 1), cB + hstep + kstep, voffB);
    PG8_WAIT_V(6); PG8_BAR;
    for (;;) {
        const bool has_next = S.next(ui + 1, nxt);
        const char* nA = has_next ? (const char*)g.A + (GATHER ? (size_t)0 : S.aoff(nxt)) : cA; const char* nB = has_next ? (const char*)g.Bt + S.boff(nxt) : cB;
        const int nslot = has_next ? nxt.slot : cur.slot, cslot = cur.slot;
        for (int t = 0; t < nt; t += 2) {
            const bool last = (t == nt - 2);
            const char* a1 = cA + (size_t)(t + 1) * kstep;
            const char* a2 = last ? nA : cA + (size_t)(t + 2) * kstep; const char* b2 = last ? nB : cB + (size_t)(t + 2) * kstep;
            const char* a3 = a2 + kstep; const char* b3 = b2 + kstep;
            const int s2 = last ? nslot : cslot;
            PG8_LDB(B0, 0, 0); PG8_LDB(B1, 0, 1); PG8_SCHED; PG8_LDA(At, 0, 0); PG8_STAGE_A(PG8_SA(1, 1), a1, cslot, 1);
            PG8_WAIT_V(8); PG8_WAIT_L(0); PG8_BAR; PG8_MMA(0, 0, At, B0); PG8_MMA(0, 1, At, B1); PG8_BAR; PG8_SCHED;
            PG8_LDA(At, 0, 1); PG8_STAGE(PG8_SB(0, 0), b2, voffB); PG8_STAGE(PG8_SB(0, 1), b2 + hstep, voffB); PG8_STAGE_A(PG8_SA(0, 0), a2, s2, 0);
            PG8_WAIT_V(8); PG8_WAIT_L(0); PG8_BAR; PG8_MMA(1, 0, At, B0); PG8_MMA(1, 1, At, B1); PG8_BAR; PG8_SCHED;
            PG8_LDB(B0, 1, 0); PG8_LDB(B1, 1, 1); PG8_SCHED; PG8_LDA(At, 1, 0); PG8_STAGE_A(PG8_SA(0, 1), a2, s2, 1);
            PG8_WAIT_V(8); PG8_WAIT_L(0); PG8_BAR; PG8_MMA(0, 0, At, B0); PG8_MMA(0, 1, At, B1); PG8_BAR; PG8_SCHED;
            PG8_LDA(At, 1, 1); PG8_STAGE(PG8_SB(1, 0), b3, voffB); PG8_STAGE(PG8_SB(1, 1), b3 + hstep, voffB); PG8_STAGE_A(PG8_SA(1, 0), a3, s2, 0);
            PG8_WAIT_V(8); PG8_WAIT_L(0); PG8_BAR; PG8_MMA(1, 0, At, B0); PG8_MMA(1, 1, At, B1); PG8_BAR; PG8_SCHED;
        }
        if (wr == 0) PG8_BAR;
        E(acc, cur, wr, wc, fr, fq);
        if (!has_next) break;
#pragma unroll
        for (int a = 0; a < 2; ++a)
#pragma unroll
            for (int b = 0; b < 2; ++b)
#pragma unroll
                for (int m = 0; m < 4; ++m)
#pragma unroll
                    for (int n = 0; n < 2; ++n) acc[a][b][m][n] = (f32x4){0.f, 0.f, 0.f, 0.f};
        cur = nxt; cA = nA; cB = nB; ++ui;
        if (wr == 1) PG8_BAR;
    }
    PG8_WAIT_V(0);
    PG8_BAR;
#undef PG8_SA
#undef PG8_SB
#undef PG8_STAGE
#undef PG8_STAGE_A
#undef PG8_LDA
#undef PG8_LDB
#undef PG8_MMA
#undef PG8_WAIT_V
#undef PG8_WAIT_L
#undef PG8_BAR
#undef PG8_SCHED
}
}

#define XB_TMO      128
#define XB_XCNT(j)  (256  + 64 * (j))
#define XB_XSUB(j)  (1280 + 64 * (j))
#define XB_XGEN(j)  (2304 + 64 * (j))
#define XB_TOP      3328
#define XB_TOPGEN   3392
#define XCD_BAR_WORDS 3456
#define XB_SPIN_CAP (1u << 18)
__device__ __forceinline__ unsigned xb_ld(unsigned* p)              { return __hip_atomic_load(p, __ATOMIC_RELAXED, __HIP_MEMORY_SCOPE_AGENT); }
__device__ __forceinline__ unsigned xb_add(unsigned* p, unsigned v) { return __hip_atomic_fetch_add(p, v, __ATOMIC_RELAXED, __HIP_MEMORY_SCOPE_AGENT); }
__device__ __forceinline__ unsigned xb_xcc_id() { return (unsigned)__builtin_amdgcn_s_getreg((3 << 11) | 20) & 0xFu; }
#define XB_SPIN(cond, bar) do { unsigned _sp = 0; while (cond) { __builtin_amdgcn_s_sleep(1); \
    if ((++_sp & 255u) == 0u) { if (xb_ld(&(bar)[XB_TMO])) break; if (_sp > XB_SPIN_CAP) { atomicAdd(&(bar)[XB_TMO], 1u); break; } } } } while (0)
struct XcdBarrier { unsigned* bar; unsigned x; volatile LAS unsigned* st; };
__device__ __forceinline__ XcdBarrier xcd_barrier_post(unsigned* bar, volatile LAS unsigned* st) {
    XcdBarrier b; b.bar = bar; b.x = xb_xcc_id(); b.st = st;
    if (threadIdx.x == 0) (void)xb_add(&bar[XB_XCNT(b.x)], 1u);
    return b;
}
__device__ __forceinline__ void xcd_barrier_complete(unsigned* bar, unsigned x, unsigned& nloc, unsigned& nx) {
    const unsigned G = gridDim.x * gridDim.y * gridDim.z;
    unsigned sum, cnt, mine, sp = 0u;
    for (;;) {
        sum = 0u; cnt = 0u; mine = 0u;
#pragma unroll
        for (unsigned j = 0; j < 16; ++j) { const unsigned c = xb_ld(&bar[XB_XCNT(j)]); sum += c; cnt += (c > 0u) ? 1u : 0u; mine = (j == x) ? c : mine; }
        if (sum == G) break;
        __builtin_amdgcn_s_sleep(1);
        if ((++sp & 255u) == 0u) { if (xb_ld(&bar[XB_TMO])) break; if (sp > XB_SPIN_CAP) { atomicAdd(&bar[XB_TMO], 1u); break; } }
    }
    nloc = mine > 0u ? mine : 1u; nx = cnt > 0u ? cnt : 1u;
}
__device__ __forceinline__ void xcd_barrier(const XcdBarrier& b) {
    asm volatile("s_waitcnt vmcnt(0)" ::: "memory");
    __syncthreads();
    if (threadIdx.x == 0) {
        unsigned* bar = b.bar;
        __builtin_amdgcn_s_waitcnt(0);
        unsigned nloc = b.st[0], nx = b.st[1];
        if (nloc == 0u) { xcd_barrier_complete(bar, b.x, nloc, nx); b.st[0] = nloc; b.st[1] = nx; }
        const unsigned old = xb_add(&bar[XB_XSUB(b.x)], 1u);
        const unsigned gen = old / nloc;
        if (old + 1u == (gen + 1u) * nloc) {
            __builtin_amdgcn_fence(__ATOMIC_RELEASE, "agent");
            asm volatile("s_waitcnt vmcnt(0)" ::: "memory");
            const unsigned og = xb_add(&bar[XB_TOP], 1u);
            const unsigned tg = og / nx;
            if (og + 1u == (tg + 1u) * nx) xb_add(&bar[XB_TOPGEN], 1u);
            else XB_SPIN(xb_ld(&bar[XB_TOPGEN]) == tg, bar);
            __builtin_amdgcn_fence(__ATOMIC_ACQUIRE, "agent");
            xb_add(&bar[XB_XGEN(b.x)], 1u);
            asm volatile("s_waitcnt vmcnt(0)" ::: "memory");
        } else {
            XB_SPIN(xb_ld(&bar[XB_XGEN(b.x)]) == gen, bar);
            __builtin_amdgcn_fence(__ATOMIC_ACQUIRE, "agent");
            asm volatile("s_waitcnt vmcnt(0)" ::: "memory");
        }
    }
    __syncthreads();
}

struct Args { const float* in[27]; float* out; unsigned char* ws; int ph_lo, ph_hi; };
struct Frame {
    LAS unsigned char* lds; volatile LAS unsigned* MISC; gu32* ctl;
    int tid, lane, wave, vcu, G;
    const float* const* in; float* out; unsigned char* ws;
};

__device__ __forceinline__ void p0_transpose_item(const float* W, int N, bf16* WT, int ldt, int k0, int n0, int drow0, LAS float* scr, int lane) {
#pragma unroll 8
    for (int i = 0; i < 32; ++i) { const int kk = 2 * i + (lane >> 5); scr[kk * 33 + (lane & 31)] = W[(size_t)(k0 + kk) * N + n0 + (lane & 31)]; }
    LDS_WAIT(); asm volatile("" ::: "memory");
    const int c = lane & 7;
#pragma unroll
    for (int j = 0; j < 4; ++j) { const int n = (lane >> 3) + 8 * j; const LAS float* s = scr + (8 * c) * 33 + n;
        v4u o; o.x = pk2(s[0 * 33], s[1 * 33]); o.y = pk2(s[2 * 33], s[3 * 33]); o.z = pk2(s[4 * 33], s[5 * 33]); o.w = pk2(s[6 * 33], s[7 * 33]);
        *(GAS v4u*)(WT + (size_t)(drow0 + n) * ldt + k0 + 8 * c) = o; }
    LDS_WAIT(); asm volatile("" ::: "memory");
}
__device__ __forceinline__ void ph1_hrows(Frame& F);
__device__ __forceinline__ void ph0_prologue(Frame& F) {
    const float* c = F.in[1]; const float* wada = F.in[2]; const float* bada = F.in[3];
    float* mod = (float*)(F.ws + WS_MOD);
    LAS float* sc = (LAS float*)(F.lds);
    LAS float* red = (LAS float*)(F.lds + 8192);
    for (int i = F.tid; i < 2 * D; i += NTHR) sc[i] = siluf_(c[i]);
    __syncthreads();
    for (int slab = F.vcu; slab < 256; slab += F.G) {
        const int n0 = slab * 24;
        if (F.tid < 510) {
            const int kq = F.tid / 6, c4 = F.tid % 6; float a[2][4];
#pragma unroll
            for (int b = 0; b < 2; ++b)
#pragma unroll
                for (int j = 0; j < 4; ++j) a[b][j] = 0.f;
            for (int k = kq; k < D; k += 85) { const f32x4 w = *(const f32x4*)(wada + (size_t)k * 6144 + n0 + 4 * c4); const float s0 = sc[k], s1 = sc[D + k];
#pragma unroll
                for (int j = 0; j < 4; ++j) { a[0][j] += s0 * w[j]; a[1][j] += s1 * w[j]; } }
#pragma unroll
            for (int b = 0; b < 2; ++b)
#pragma unroll
                for (int j = 0; j < 4; ++j) red[(kq * 6 + c4) * 8 + b * 4 + j] = a[b][j];
        }
        __syncthreads();
        if (F.tid < 48) { const int b = F.tid / 24, col = F.tid % 24, c4 = col >> 2, j = col & 3; float s = 0.f;
            for (int kq = 0; kq < 85; ++kq) s += red[(kq * 6 + c4) * 8 + b * 4 + j];
            mod[b * 6144 + n0 + col] = s + bada[n0 + col]; }
        __syncthreads();
    }
    VM_WAIT(); __syncthreads();
    if (F.tid == 0) { __builtin_amdgcn_fence(__ATOMIC_RELEASE, "agent"); VM_WAIT(); __hip_atomic_fetch_add(F.ctl + CW_MODCNT, 1u, RLX_AGENT); }
    const int gt = F.vcu * NTHR + F.tid, NGT = F.G * NTHR;
    if (gt < DH) { const float* g = F.in[9]; ((float*)(F.ws + WS_LB))[gt] = 1.f / (1.f + __expf(g[DH + gt] - g[gt])); }
    for (int e = gt; e < 48 * D; e += NGT) { const int n = e >> 10, kk = e & 1023; const float wv = n < NG ? F.in[20][kk * NG + n] : n < NG + NE ? F.in[22][kk * NE + n - NG] : 0.f;
        const unsigned hi = f2bf(wv); ((bf16*)(F.ws + WS_RRH))[e] = (bf16)hi; ((bf16*)(F.ws + WS_RRL))[e] = (bf16)f2bf(wv - bf2f(hi)); }
    for (int e = gt; e < 2 * 8 * 64 * 64; e += NGT) { const int which = e >> 15, r = e & 32767, blk = r >> 12, j = (r >> 6) & 63, i = r & 63;
        const float* w = which ? F.in[15] : F.in[13]; ((bf16*)(F.ws + (which ? WS_WIT : WS_WRT)))[r] = (bf16)f2bf(w[(size_t)(blk * 64 + i) * 64 + j]); }
    LAS float* scr = (LAS float*)(F.lds + 32768 + F.wave * 8704);
    const int gw = F.vcu * NWAVES + F.wave, NGW = F.G * NWAVES;
    constexpr int I_IN = 16 * 96, I_OUT = 16 * 32, I_E = 256 + 256 + 256, NITEMS = I_IN + I_OUT + NE * I_E;
    for (int it = gw; it < NITEMS; it += NGW) {
        int r = it;
        if (r < I_IN) { const int kb = r / 96, nb = r % 96; p0_transpose_item(F.in[8], DIN, (bf16*)(F.ws + WS_WIN), D, 64 * kb, 32 * nb, 32 * nb, scr, F.lane); continue; } r -= I_IN;
        if (r < I_OUT) { const int kb = r / 32, nb = r % 32; p0_transpose_item(F.in[19], D, (bf16*)(F.ws + WS_WOUT), D, 64 * kb, 32 * nb, 32 * nb, scr, F.lane); continue; } r -= I_OUT;
        const int e = r / I_E; r -= e * I_E;
        if (r < 512) { const int w3 = r >> 8, q = r & 255, kb = q >> 4, nb = q & 15, n0 = 32 * nb;
            p0_transpose_item((w3 ? F.in[25] : F.in[24]) + (size_t)e * D * DE, DE, (bf16*)(F.ws + WS_W13) + (size_t)e * D * D, D, 64 * kb, n0, (n0 >> 7) * 256 + (n0 & 127) + 128 * w3, scr, F.lane); }
        else { const int q = r - 512, kb = q >> 5, nb = q & 31;
            p0_transpose_item(F.in[26] + (size_t)e * DE * D, D, (bf16*)(F.ws + WS_W2) + (size_t)e * D * DE, DE, 64 * kb, 32 * nb, 32 * nb, scr, F.lane); }
    }
    if (F.tid < 64) { unsigned sp = 0;
        while ((unsigned)__builtin_amdgcn_readfirstlane(__hip_atomic_load(F.ctl + CW_MODCNT, RLX_AGENT)) < (unsigned)F.G) { __builtin_amdgcn_s_sleep(2); if (++sp > (1u << 20)) break; }
        __builtin_amdgcn_fence(__ATOMIC_ACQUIRE, "agent"); VM_WAIT(); }
    __syncthreads();
    ph1_hrows(F);
}

__device__ __forceinline__ void ph1_hrows(Frame& F) {
    const float* x = F.in[0]; const float* g = F.in[4]; const float* mod = (const float*)(F.ws + WS_MOD); bf16* H = (bf16*)(F.ws + WS_H);
    const int gw = F.vcu * NWAVES + F.wave, NGW = F.G * NWAVES;
    for (int m0 = gw; m0 < T / 2; m0 += NGW) {
        int lane = F.lane; asm volatile("" : "+v"(lane));
        f32x4 v[2][4];
#pragma unroll
        for (int r = 0; r < 2; ++r)
#pragma unroll
            for (int j = 0; j < 4; ++j) v[r][j] = ((const GAS f32x4*)(x + (size_t)(m0 + r * (T / 2)) * D) + lane)[64 * j];
#pragma unroll
        for (int r = 0; r < 2; ++r) { const int m = m0 + r * (T / 2); const float* sh = mod + r * 6144; const float* sc = sh + 1024; float s = 0.f;
#pragma unroll
            for (int j = 0; j < 4; ++j) s += v[r][j].x * v[r][j].x + v[r][j].y * v[r][j].y + v[r][j].z * v[r][j].z + v[r][j].w * v[r][j].w;
            const float rstd = rsqrtf(wave_sum(s) * (1.f / D) + EPS);
            GAS unsigned long long* o8 = (GAS unsigned long long*)(H + (size_t)m * D) + lane;
#pragma unroll
            for (int j = 0; j < 4; ++j) { const int c0 = 4 * lane + 256 * j; const f32x4 gg = *(const f32x4*)(g + c0), s1 = *(const f32x4*)(sc + c0), h1 = *(const f32x4*)(sh + c0);
                const float a0 = v[r][j].x * rstd * gg.x * (1.f + s1.x) + h1.x, a1 = v[r][j].y * rstd * gg.y * (1.f + s1.y) + h1.y, a2 = v[r][j].z * rstd * gg.z * (1.f + s1.z) + h1.z, a3 = v[r][j].w * rstd * gg.w * (1.f + s1.w) + h1.w;
                o8[64 * j] = (unsigned long long)pk2(a0, a1) | ((unsigned long long)pk2(a2, a3) << 32); } }
    }
}

constexpr int L_QT = 0;
constexpr int L_QTL = 2048;
constexpr int L_QH = L_QTL + 17408;
constexpr int L_KH = L_QH + 17408;
constexpr int L_VT = L_KH + 43520;
constexpr int L_P = L_VT + 18432;
constexpr int L_SSQ = L_P + 9216;
constexpr int L_RSTD = L_SSQ + 2048;
constexpr int L_KT = L_QTL;
static_assert(L_RSTD + 256 <= RING_BYTES, "mixer LDS map");

__device__ __forceinline__ void hgrn_cumsum(Frame& F, const bf16* LFp, float (&cs)[16], float (&off)[5]) {
    LAS float* QT = (LAS float*)(F.lds + L_QT);
    const int k = F.tid & 127, qr = F.tid >> 7;
    float run = 0.f;
#pragma unroll
    for (int i = 0; i < 16; ++i) { run += bf2f(LFp[(size_t)i * DH]); cs[i] = run; }
    QT[qr * 128 + k] = run;
    __syncthreads();
    off[0] = 0.f; off[1] = QT[k]; off[2] = off[1] + QT[128 + k]; off[3] = off[2] + QT[256 + k]; off[4] = off[3] + QT[384 + k];
}

template <bool FINAL>
__device__ __forceinline__ void rg_wave_task(Frame& F, int b, int n, int cb, unsigned (&valpk)[32]) {
    const int lane = F.lane, fr = lane & 15, fq = lane >> 4, c0 = 64 * cb; const int t0 = b * SEQ + 64 * n;
    const bf16* XR = (const bf16*)(F.ws + WS_PROJ) + 5 * PROJ_S; const bf16* YR = (const bf16*)(F.ws + WS_PROJ) + 6 * PROJ_S;
    const bf16* WRT = (const bf16*)(F.ws + WS_WRT); const bf16* WIT = (const bf16*)(F.ws + WS_WIT);
    const float* cw = F.in[11]; const float* cbias = F.in[12];
    bf16x8 IDf[2][2];
    LAS unsigned char* wl = F.lds + F.wave * 16384;
#pragma unroll
    for (int p = 0; p < 8; ++p) { const int pc = p * 64 + lane, j = pc >> 3, sl = pc & 7; const size_t o = (size_t)(c0 + j) * 64 + 8 * sl;
        *(LAS v4u*)(wl + j * 128 + ((sl ^ (j & 7)) << 4)) = *(const v4u*)(WRT + o); *(LAS v4u*)(wl + 8192 + j * 128 + ((sl ^ (j & 7)) << 4)) = *(const v4u*)(WIT + o); }
    LDS_WAIT();
#pragma unroll
    for (int ks = 0; ks < 2; ++ks)
#pragma unroll
        for (int c2 = 0; c2 < 2; ++c2) { bf16x8 v;
#pragma unroll
            for (int j = 0; j < 8; ++j) v[j] = (short)((8 * fq + j == 16 * c2 + fr) ? 0x3F80 : 0);
            IDf[ks][c2] = v; }
    float br[4], bi[4], ls8[4], hrun[4], arun[4];
#pragma unroll
    for (int ct = 0; ct < 4; ++ct) { const int c = c0 + 16 * ct + fr; br[ct] = F.in[14][c]; bi[ct] = F.in[16][c]; const float lam = F.in[17][c]; ls8[ct] = -8.f * log1pf(__expf(-lam));
        hrun[ct] = FINAL ? ((const float*)(F.ws + WS_CARRY))[(size_t)(b * NCH + n) * DR + c] : 0.f; arun[ct] = 1.f; }
#pragma unroll
    for (int tt = 0; tt < 4; ++tt) {
        const int tl = 16 * tt + fr; const int tpos = 64 * n + tl;
        bf16x8 AX[2], AG[2];
#pragma unroll
        for (int ks = 0; ks < 2; ++ks) { const int cc = c0 + 32 * ks + 8 * fq; float xc[8];
            { const f32x4 b0 = *(const f32x4*)(cbias + cc), b1 = *(const f32x4*)(cbias + cc + 4); xc[0] = b0[0]; xc[1] = b0[1]; xc[2] = b0[2]; xc[3] = b0[3]; xc[4] = b1[0]; xc[5] = b1[1]; xc[6] = b1[2]; xc[7] = b1[3]; }
#pragma unroll
            for (int tap = 0; tap < 4; ++tap) { if (tpos - 3 + tap >= 0) { const v4u xv = *(const v4u*)(XR + (size_t)(t0 + tl - 3 + tap) * DH + cc);
                    const f32x4 w0 = *(const f32x4*)(cw + tap * DR + cc), w1 = *(const f32x4*)(cw + tap * DR + cc + 4);
                    xc[0] += w0[0] * bf2f(xv.x & 0xffffu); xc[1] += w0[1] * bf2f(xv.x >> 16); xc[2] += w0[2] * bf2f(xv.y & 0xffffu); xc[3] += w0[3] * bf2f(xv.y >> 16);
                    xc[4] += w1[0] * bf2f(xv.z & 0xffffu); xc[5] += w1[1] * bf2f(xv.z >> 16); xc[6] += w1[2] * bf2f(xv.w & 0xffffu); xc[7] += w1[3] * bf2f(xv.w >> 16); } }
            v4u pk; pk.x = pk2(xc[0], xc[1]); pk.y = pk2(xc[2], xc[3]); pk.z = pk2(xc[4], xc[5]); pk.w = pk2(xc[6], xc[7]); AX[ks] = __builtin_bit_cast(bf16x8, pk);
            if (FINAL) AG[ks] = *(const bf16x8*)(YR + (size_t)(t0 + tl) * DH + cc);
        }
#pragma unroll
        for (int ct = 0; ct < 4; ++ct) {
            f32x4 aR = {0.f, 0.f, 0.f, 0.f}, aI = {0.f, 0.f, 0.f, 0.f}, aX = {0.f, 0.f, 0.f, 0.f}, aG = {0.f, 0.f, 0.f, 0.f};
#pragma unroll
            for (int ks = 0; ks < 2; ++ks) { const int jr = 16 * ct + fr, so = jr * 128 + (((4 * ks + fq) ^ (jr & 7)) << 4);
                const bf16x8 wr_ = *(const LAS bf16x8*)(wl + so), wi_ = *(const LAS bf16x8*)(wl + 8192 + so);
                aR = __builtin_amdgcn_mfma_f32_16x16x32_bf16(AX[ks], wr_, aR, 0, 0, 0); aI = __builtin_amdgcn_mfma_f32_16x16x32_bf16(AX[ks], wi_, aI, 0, 0, 0); }
            aX = __builtin_amdgcn_mfma_f32_16x16x32_bf16(AX[ct >> 1], IDf[ct >> 1][ct & 1], aX, 0, 0, 0);
            if (FINAL) aG = __builtin_amdgcn_mfma_f32_16x16x32_bf16(AG[ct >> 1], IDf[ct >> 1][ct & 1], aG, 0, 0, 0);
            float a[4], u[4];
#pragma unroll
            for (int r = 0; r < 4; ++r) { const float rr = sigmoidf_(aR[r] + br[ct]), ii = sigmoidf_(aI[r] + bi[ct]); const float la = rr * ls8[ct]; a[r] = __expf(la);
                const float x2 = 2.f * la; const float em = (x2 > -0.03f) ? -x2 * (1.f + x2 * (0.5f + x2 * (0.16666667f + x2 * 0.041666667f))) : 1.f - a[r] * a[r];
                u[r] = sqrtf(em) * (ii * aX[r]); }
            float Af = a[0] * a[1] * a[2] * a[3], Hf = ((u[0] * a[1] + u[1]) * a[2] + u[2]) * a[3] + u[3];
            { const float Ap = __shfl_up(Af, 16), Hp = __shfl_up(Hf, 16); if (fq >= 1) { Hf = Af * Hp + Hf; Af = Ap * Af; } }
            { const float Ap = __shfl_up(Af, 32), Hp = __shfl_up(Hf, 32); if (fq >= 2) { Hf = Af * Hp + Hf; Af = Ap * Af; } }
            float Aex = __shfl_up(Af, 16), Hex = __shfl_up(Hf, 16); if (fq == 0) { Aex = 1.f; Hex = 0.f; }
            const float Atot = __shfl(Af, 48 + fr), Htot = __shfl(Hf, 48 + fr);
            if (FINAL) { float h = Aex * hrun[ct] + Hex;
#pragma unroll
                for (int r = 0; r < 4; ++r) { h = a[r] * h + u[r]; u[r] = h * aG[r]; }
                valpk[(tt * 4 + ct) * 2] = pk2(u[0], u[1]); valpk[(tt * 4 + ct) * 2 + 1] = pk2(u[2], u[3]); }
            hrun[ct] = Atot * hrun[ct] + Htot; arun[ct] *= Atot;
        }
        asm volatile("" ::: "memory");
    }
    if (!FINAL && fq == 0) {
#pragma unroll
        for (int ct = 0; ct < 4; ++ct) { const size_t o = (size_t)(b * NCH + n) * DR + c0 + 16 * ct + fr; ((float*)(F.ws + WS_RGA))[o] = arun[ct]; ((float*)(F.ws + WS_RGH))[o] = hrun[ct]; }
    }
}

__device__ __forceinline__ void ph3_passA(Frame& F) {
    const bf16* PJ = (const bf16*)(F.ws + WS_PROJ); const bf16 *LF = PJ + PROJ_S, *KI = PJ + 2 * PROJ_S, *V = PJ + 3 * PROJ_S;
    bf16* DS = (bf16*)F.out; float* DDp = (float*)(F.ws + WS_DD);
    const int tid = F.tid, lane = F.lane, w = F.wave, fr = lane & 15, fq = lane >> 4, k = tid & 127, qr = tid >> 7;
    LAS bf16* KT = (LAS bf16*)(F.lds + L_KT); LAS bf16* VT = (LAS bf16*)(F.lds + L_VT);
    { const int cn = F.vcu;
        const int b = cn / NCH, n = cn % NCH, t0 = b * SEQ + 64 * n;
        { unsigned dummy[32]; rg_wave_task<false>(F, b, n, w, dummy); }
        __syncthreads();
        for (int h = 0; h < NH; ++h) {
            const int task = (b * NH + h) * NCH + n; const size_t rbase = (size_t)(t0 + 16 * qr) * DH + h * HD + k;
            float cs[16], off[5]; hgrn_cumsum(F, LF + rbase, cs, off);
            const float myoff = qr == 0 ? off[0] : qr == 1 ? off[1] : qr == 2 ? off[2] : off[3], blast = off[4];
            unsigned kp[8], vp[8];
#pragma unroll
            for (int i = 0; i < 16; i += 2) { const float k0 = bf2f(KI[rbase + (size_t)i * DH]) * __expf(blast - (myoff + cs[i])), k1 = bf2f(KI[rbase + (size_t)(i + 1) * DH]) * __expf(blast - (myoff + cs[i + 1]));
                kp[i >> 1] = pk2(k0, k1); vp[i >> 1] = (unsigned)V[rbase + (size_t)i * DH] | ((unsigned)V[rbase + (size_t)(i + 1) * DH] << 16); }
            *(LAS v4u*)(KT + k * 72 + 16 * qr) = (v4u){kp[0], kp[1], kp[2], kp[3]}; *(LAS v4u*)(KT + k * 72 + 16 * qr + 8) = (v4u){kp[4], kp[5], kp[6], kp[7]};
            *(LAS v4u*)(VT + k * 72 + 16 * qr) = (v4u){vp[0], vp[1], vp[2], vp[3]}; *(LAS v4u*)(VT + k * 72 + 16 * qr + 8) = (v4u){vp[4], vp[5], vp[6], vp[7]};
            if (qr == 0) DDp[(size_t)task * HD + k] = __expf(blast);
            __syncthreads();
            bf16x8 bV[2];
#pragma unroll
            for (int ss = 0; ss < 2; ++ss) bV[ss] = *(const LAS bf16x8*)(VT + (16 * w + fr) * 72 + 8 * fq + 32 * ss);
#pragma unroll
            for (int kt = 0; kt < 8; ++kt) { f32x4 acc = {0.f, 0.f, 0.f, 0.f};
#pragma unroll
                for (int ss = 0; ss < 2; ++ss) { const bf16x8 a = *(const LAS bf16x8*)(KT + (16 * kt + fr) * 72 + 8 * fq + 32 * ss); acc = __builtin_amdgcn_mfma_f32_16x16x32_bf16(a, bV[ss], acc, 0, 0, 0); }
                *(v2u*)(DS + (size_t)task * (HD * HD) + (size_t)(16 * w + fr) * HD + 16 * kt + 4 * fq) = (v2u){pk2m(acc[0], acc[1]), pk2m(acc[2], acc[3])}; }
            __syncthreads();
        }
    }
}

__device__ __forceinline__ void ph4_passB(Frame& F) {
    const bf16* DS = (const bf16*)F.out; bf16* SST = (bf16*)F.out + (size_t)BATCH * NH * NCH * HD * HD; const float* DDp = (const float*)(F.ws + WS_DD);
    const int gt = F.vcu * NTHR + F.tid, NGT = F.G * NTHR;
    for (int idx = gt; idx < BATCH * NH * HD * HD / 2 + BATCH * DR; idx += NGT) {
        if (idx < BATCH * NH * HD * HD / 2) {
            const int bh = idx >> 13, pr = idx & 8191, e0 = 2 * pr, kk = e0 & 127;
            float s0 = 0.f, s1 = 0.f;
            const bf16* dsp = DS + (size_t)bh * NCH * (HD * HD) + e0; bf16* sp = SST + (size_t)bh * NCH * (HD * HD) + e0; const float* ddp = DDp + (size_t)bh * NCH * HD + kk;
#pragma unroll 1
            for (int n0 = 0; n0 < NCH; n0 += 8) {
                unsigned dsv[8]; float d0[8], d1[8];
#pragma unroll
                for (int j = 0; j < 8; ++j) { dsv[j] = *(const unsigned*)(dsp + (size_t)(n0 + j) * (HD * HD)); d0[j] = ddp[(n0 + j) * HD]; d1[j] = ddp[(n0 + j) * HD + 1]; }
#pragma unroll
                for (int j = 0; j < 8; ++j) { *(unsigned*)(sp + (size_t)(n0 + j) * (HD * HD)) = pk2(s0, s1);
                    s0 = d0[j] * s0 + bf2f(dsv[j] & 0xffffu); s1 = d1[j] * s1 + bf2f(dsv[j] >> 16); }
            }
        } else {
            const int r = idx - BATCH * NH * HD * HD / 2, b = r / DR, c = r % DR;
            const float* A = (const float*)(F.ws + WS_RGA) + (size_t)b * NCH * DR + c; const float* Hh = (const float*)(F.ws + WS_RGH) + (size_t)b * NCH * DR + c; float* C = (float*)(F.ws + WS_CARRY) + (size_t)b * NCH * DR + c;
            float carry = 0.f;
#pragma unroll 4
            for (int n = 0; n < NCH; ++n) { C[(size_t)n * DR] = carry; carry = A[(size_t)n * DR] * carry + Hh[(size_t)n * DR]; }
        }
    }
}

__device__ __forceinline__ void ph5_passC(Frame& F) {
    const bf16* PJ = (const bf16*)(F.ws + WS_PROJ); const bf16 *Q = PJ, *LF = PJ + PROJ_S, *KI = PJ + 2 * PROJ_S, *V = PJ + 3 * PROJ_S, *GZ = PJ + 4 * PROJ_S;
    const bf16* SST = (const bf16*)F.out + (size_t)BATCH * NH * NCH * HD * HD; bf16* O = (bf16*)(F.ws + WS_H);
    const int tid = F.tid, lane = F.lane, w = F.wave, fr = lane & 15, fq = lane >> 4, k = tid & 127, qr = tid >> 7;
    LAS bf16* QTL = (LAS bf16*)(F.lds + L_QTL); LAS bf16* QH = (LAS bf16*)(F.lds + L_QH); LAS bf16* KH = (LAS bf16*)(F.lds + L_KH);
    LAS bf16* VT = (LAS bf16*)(F.lds + L_VT); LAS bf16* Pm = (LAS bf16*)(F.lds + L_P); LAS float* SSQ = (LAS float*)(F.lds + L_SSQ); LAS float* RSTD = (LAS float*)(F.lds + L_RSTD);
    { const int cn = F.vcu;
        const int b = cn / NCH, n = cn % NCH, t0 = b * SEQ + 64 * n;
        {
            LAS float* SSQ = (LAS float*)(F.lds + X_GTAB); LAS float* RSTD = SSQ + 512;
            unsigned valpk[32];
            for (int rrg = 0; rrg < PROBE_RG5; ++rrg) rg_wave_task<true>(F, b, n, w, valpk);
#pragma unroll
            for (int tt = 0; tt < 4; ++tt) { float s[4] = {0.f, 0.f, 0.f, 0.f};
#pragma unroll
                for (int ct = 0; ct < 4; ++ct) { const unsigned p0 = valpk[(tt * 4 + ct) * 2], p1 = valpk[(tt * 4 + ct) * 2 + 1]; const float v0 = bf2f(p0 & 0xffffu), v1 = bf2f(p0 >> 16), v2 = bf2f(p1 & 0xffffu), v3 = bf2f(p1 >> 16);
                    s[0] += v0 * v0; s[1] += v1 * v1; s[2] += v2 * v2; s[3] += v3 * v3; }
#pragma unroll
                for (int r = 0; r < 4; ++r) { float x = s[r]; x += __shfl_xor(x, 1); x += __shfl_xor(x, 2); x += __shfl_xor(x, 4); x += __shfl_xor(x, 8); if (fr == 0) SSQ[(16 * tt + 4 * fq + r) * 8 + w] = x; } }
            __syncthreads();
            if (tid < 64) { float s = 0.f;
#pragma unroll
                for (int i = 0; i < 8; ++i) s += SSQ[tid * 8 + i];
                RSTD[tid] = rsqrtf(s * (1.f / DR) + EPS); }
            __syncthreads();
            float gn[4];
#pragma unroll
            for (int ct = 0; ct < 4; ++ct) gn[ct] = F.in[18][64 * w + 16 * ct + fr];
#pragma unroll
            for (int tt = 0; tt < 4; ++tt)
#pragma unroll
                for (int ct = 0; ct < 4; ++ct) { const unsigned p0 = valpk[(tt * 4 + ct) * 2], p1 = valpk[(tt * 4 + ct) * 2 + 1]; const float vv[4] = {bf2f(p0 & 0xffffu), bf2f(p0 >> 16), bf2f(p1 & 0xffffu), bf2f(p1 >> 16)};
#pragma unroll
                    for (int r = 0; r < 4; ++r) { const int tl = 16 * tt + 4 * fq + r; O[(size_t)(t0 + tl) * D + DH + 64 * w + 16 * ct + fr] = (bf16)f2bf(vv[r] * RSTD[tl] * gn[ct]); } }
            __syncthreads();
        }
        for (int hx = 0; hx < NH * PROBE_H5; ++hx) { const int h = hx & (NH - 1);
            const int task = (b * NH + h) * NCH + n; const size_t rbase = (size_t)(t0 + 16 * qr) * DH + h * HD + k;
            float cs[16], off[5]; hgrn_cumsum(F, LF + rbase, cs, off);
            const float myoff = qr == 0 ? off[0] : qr == 1 ? off[1] : qr == 2 ? off[2] : off[3]; const float em = __expf(myoff);
            unsigned vp[8];
#pragma unroll
            for (int i = 0; i < 16; ++i) { const size_t ro = rbase + (size_t)i * DH; const float q = bf2f(Q[ro]), ki = bf2f(KI[ro]); const unsigned vv = V[ro];
                const float e1 = __expf(cs[i]); const int tl = 16 * qr + i;
                QH[tl * 136 + k] = (bf16)f2bf(q * e1); QTL[tl * 136 + k] = (bf16)f2bf(q * e1 * em);
#pragma unroll
                for (int iq = 0; iq < 4; ++iq) if (iq >= qr) KH[(8 * iq * (iq + 1) + tl) * 136 + k] = (bf16)f2bf(ki * __expf(off[iq] - myoff - cs[i]));
                if (i & 1) vp[i >> 1] |= vv << 16; else vp[i >> 1] = vv; }
            *(LAS v4u*)(VT + k * 72 + 16 * qr) = (v4u){vp[0], vp[1], vp[2], vp[3]}; *(LAS v4u*)(VT + k * 72 + 16 * qr + 8) = (v4u){vp[4], vp[5], vp[6], vp[7]};
            __syncthreads();
#pragma unroll
            for (int pp = 0; pp < 2; ++pp) { const int pi = 2 * w + pp, iq = pi >> 2, jk = pi & 3; f32x4 acc = {0.f, 0.f, 0.f, 0.f};
                if (jk <= iq) {
#pragma unroll
                    for (int ks = 0; ks < 4; ++ks) { const bf16x8 a = *(const LAS bf16x8*)(KH + (8 * iq * (iq + 1) + 16 * jk + fr) * 136 + 8 * fq + 32 * ks); const bf16x8 bq = *(const LAS bf16x8*)(QH + (16 * iq + fr) * 136 + 8 * fq + 32 * ks);
                        acc = __builtin_amdgcn_mfma_f32_16x16x32_bf16(a, bq, acc, 0, 0, 0); }
                    if (jk == iq) {
#pragma unroll
                        for (int r = 0; r < 4; ++r) if (4 * fq + r > fr) acc[r] = 0.f; }
                }
                *(LAS v2u*)(Pm + (16 * iq + fr) * 72 + 16 * jk + 4 * fq) = (v2u){pk2m(acc[0], acc[1]), pk2m(acc[2], acc[3])}; }
            __syncthreads();
            f32x4 oacc[4];
            { bf16x8 bV[2], bS[4];
#pragma unroll
              for (int ss = 0; ss < 2; ++ss) bV[ss] = *(const LAS bf16x8*)(VT + (16 * w + fr) * 72 + 8 * fq + 32 * ss);
#pragma unroll
              for (int ks = 0; ks < 4; ++ks) bS[ks] = *(const bf16x8*)(SST + (size_t)task * (HD * HD) + (size_t)(16 * w + fr) * HD + 8 * fq + 32 * ks);
#ifdef DBG_NOSTATE
              for (int ks = 0; ks < 4; ++ks) bS[ks] = (bf16x8){0,0,0,0,0,0,0,0};
#endif
#pragma unroll
              for (int tt = 0; tt < 4; ++tt) { f32x4 acc = {0.f, 0.f, 0.f, 0.f};
#pragma unroll
                  for (int ss = 0; ss < 2; ++ss) { const bf16x8 a = *(const LAS bf16x8*)(Pm + (16 * tt + fr) * 72 + 8 * fq + 32 * ss); acc = __builtin_amdgcn_mfma_f32_16x16x32_bf16(a, bV[ss], acc, 0, 0, 0); }
#pragma unroll
                  for (int ks = 0; ks < 4; ++ks) { const bf16x8 a = *(const LAS bf16x8*)(QTL + (16 * tt + fr) * 136 + 8 * fq + 32 * ks); acc = __builtin_amdgcn_mfma_f32_16x16x32_bf16(a, bS[ks], acc, 0, 0, 0); }
                  oacc[tt] = acc; } }
#pragma unroll
            for (int tt = 0; tt < 4; ++tt)
#pragma unroll
                for (int r = 0; r < 4; ++r) { float x = oacc[tt][r] * oacc[tt][r]; x += __shfl_xor(x, 1); x += __shfl_xor(x, 2); x += __shfl_xor(x, 4); x += __shfl_xor(x, 8); if (fr == 0) SSQ[(16 * tt + 4 * fq + r) * 8 + w] = x; }
            __syncthreads();
            if (tid < 64) { float s = 0.f;
#pragma unroll
                for (int i = 0; i < 8; ++i) s += SSQ[tid * 8 + i];
                RSTD[tid] = rsqrtf(s * (1.f / HD) + EPS); }
            __syncthreads();
            const float gh = F.in[10][h * HD + 16 * w + fr];
#pragma unroll
            for (int tt = 0; tt < 4; ++tt)
#pragma unroll
                for (int r = 0; r < 4; ++r) { const int tl = 16 * tt + 4 * fq + r; const float gz = bf2f(GZ[(size_t)(t0 + tl) * DH + h * HD + 16 * w + fr]);
                    O[(size_t)(t0 + tl) * D + h * HD + 16 * w + fr] = (bf16)f2bf(oacc[tt][r] * RSTD[tl] * gh * gz); }
            __syncthreads();
        }
    }
}

constexpr int L7_HI = 0, L7_LO = 32768, L7_PART = 65536;
__device__ __forceinline__ void ph7_rows(Frame& F) {
    const float* x = F.in[0]; const float* mod = (const float*)(F.ws + WS_MOD); const bf16* mix = (const bf16*)(F.ws + WS_MIX);
    const float *gpm = F.in[5], *gpf = F.in[6], *brg = F.in[21], *bre = F.in[23];
    const bf16* RRH = (const bf16*)(F.ws + WS_RRH); const bf16* RRL = (const bf16*)(F.ws + WS_RRL);
    bf16* H = (bf16*)(F.ws + WS_H); float* wgt = (float*)(F.ws + WS_WGT);
    unsigned* cnt = (unsigned*)(F.ws + WS_CTL) + CW_CNT; int* list = (int*)(F.ws + WS_LIST);
    LAS float* PART = (LAS float*)(F.lds + L7_PART);
    const int w = F.wave;
#pragma unroll 1
    for (int tile = F.vcu; tile < T / 16; tile += F.G) {
        int lane = F.lane; asm volatile("" : "+v"(lane)); const int fr = lane & 15, fq = lane >> 4; int tid16 = F.tid; asm volatile("" : "+v"(tid16));
#pragma unroll
        for (int rr = 0; rr < 2; ++rr) {
            const int rl = 2 * w + rr, m = 16 * tile + rl, b = m / SEQ; const float* mb = mod + b * 6144; const float *gt1 = mb + 2048, *sh2 = mb + 3072, *sc2 = mb + 4096;
            f32x4 v[4], xv[4]; float s = 0.f;
#pragma unroll
            for (int j = 0; j < 4; ++j) { const v2u mv = ((const GAS v2u*)(mix + (size_t)m * D) + lane)[64 * j]; v[j] = (f32x4){bf2f(mv.x & 0xffffu), bf2f(mv.x >> 16), bf2f(mv.y & 0xffffu), bf2f(mv.y >> 16)};
                xv[j] = ((const GAS f32x4*)(x + (size_t)m * D) + lane)[64 * j]; s += v[j].x * v[j].x + v[j].y * v[j].y + v[j].z * v[j].z + v[j].w * v[j].w; }
            const float rs1 = rsqrtf(wave_sum(s) * (1.f / D) + EPS); float s2 = 0.f;
#pragma unroll
            for (int j = 0; j < 4; ++j) { const int c0 = 4 * lane + 256 * j; const f32x4 gg = *(const f32x4*)(gpm + c0), gt = *(const f32x4*)(gt1 + c0);
                xv[j].x += gt.x * (v[j].x * rs1 * gg.x); xv[j].y += gt.y * (v[j].y * rs1 * gg.y); xv[j].z += gt.z * (v[j].z * rs1 * gg.z); xv[j].w += gt.w * (v[j].w * rs1 * gg.w);
                ((GAS f32x4*)(F.out + (size_t)m * D) + lane)[64 * j] = xv[j];
                s2 += xv[j].x * xv[j].x + xv[j].y * xv[j].y + xv[j].z * xv[j].z + xv[j].w * xv[j].w; }
            const float rs2 = rsqrtf(wave_sum(s2) * (1.f / D) + EPS);
#pragma unroll
            for (int j = 0; j < 4; ++j) { const int c0 = 4 * lane + 256 * j; const f32x4 gg = *(const f32x4*)(gpf + c0), sc = *(const f32x4*)(sc2 + c0), sh = *(const f32x4*)(sh2 + c0);
                const float h0 = xv[j].x * rs2 * gg.x * (1.f + sc.x) + sh.x, h1 = xv[j].y * rs2 * gg.y * (1.f + sc.y) + sh.y, h2 = xv[j].z * rs2 * gg.z * (1.f + sc.z) + sh.z, h3 = xv[j].w * rs2 * gg.w * (1.f + sc.w) + sh.w;
                const unsigned p01 = pk2(h0, h1), p23 = pk2(h2, h3);
                ((GAS unsigned long long*)(H + (size_t)m * D) + lane)[64 * j] = (unsigned long long)p01 | ((unsigned long long)p23 << 32);
                const unsigned q01 = pk2(h0 - bf2f(p01 & 0xffffu), h1 - bf2f(p01 >> 16)), q23 = pk2(h2 - bf2f(p23 & 0xffffu), h3 - bf2f(p23 >> 16));
                const int so = rl * 2048 + ((((lane >> 1) + 32 * j) ^ rl) << 4) + (lane & 1) * 8;
                *(LAS v2u*)(F.lds + L7_HI + so) = (v2u){p01, p23}; *(LAS v2u*)(F.lds + L7_LO + so) = (v2u){q01, q23}; }
        }
        __syncthreads();
        f32x4 acc[3] = {{0.f, 0.f, 0.f, 0.f}, {0.f, 0.f, 0.f, 0.f}, {0.f, 0.f, 0.f, 0.f}};
#pragma unroll
        for (int ks = 0; ks < 4; ++ks) { const int slot = 16 * w + 4 * ks + fq, so = fr * 2048 + ((slot ^ fr) << 4);
            const bf16x8 ah = *(const LAS bf16x8*)(F.lds + L7_HI + so), al = *(const LAS bf16x8*)(F.lds + L7_LO + so);
#pragma unroll
            for (int nt = 0; nt < 3; ++nt) { const size_t wo = (size_t)(16 * nt + fr) * D + 128 * w + 32 * ks + 8 * fq; const bf16x8 bh = *(const bf16x8*)(RRH + wo), bl = *(const bf16x8*)(RRL + wo);
                acc[nt] = __builtin_amdgcn_mfma_f32_16x16x32_bf16(ah, bh, acc[nt], 0, 0, 0); acc[nt] = __builtin_amdgcn_mfma_f32_16x16x32_bf16(ah, bl, acc[nt], 0, 0, 0); acc[nt] = __builtin_amdgcn_mfma_f32_16x16x32_bf16(al, bh, acc[nt], 0, 0, 0); } }
#pragma unroll
        for (int nt = 0; nt < 3; ++nt)
#pragma unroll
            for (int r = 0; r < 4; ++r) PART[(w * 16 + 4 * fq + r) * 48 + 16 * nt + fr] = acc[nt][r];
        __syncthreads();
        { LAS float* LG = PART + 8 * 16 * 48;
          for (int e = tid16; e < 16 * 36; e += NTHR) { const int row = e / 36, o = e - row * 36; float a = o < 4 ? brg[o] : bre[o - 4];
#pragma unroll
              for (int ww = 0; ww < 8; ++ww) a += PART[(ww * 16 + row) * 48 + o];
              LG[e] = a; } }
        __syncthreads();
        if (tid16 < 16) {
            const int m = 16 * tile + tid16; const LAS float* lgl = PART + 8 * 16 * 48 + tid16 * 36;
            int gs = 0; float gm = lgl[0];
#pragma unroll
            for (int o = 1; o < NG; ++o) if (lgl[o] > gm) { gm = lgl[o]; gs = o; }
            float den = 0.f;
#pragma unroll
            for (int o = 0; o < NG; ++o) den += __expf(lgl[o] - gm);
            const float gate = 1.f / den;
            float sel[EPG];
#pragma unroll
            for (int o = 0; o < EPG; ++o) sel[o] = lgl[4 + 8 * gs + o];
            int i1 = 0; float m1 = sel[0];
#pragma unroll
            for (int o = 1; o < EPG; ++o) if (sel[o] > m1) { m1 = sel[o]; i1 = o; }
            int i2 = -1; float m2 = -3.0e38f;
#pragma unroll
            for (int o = 0; o < EPG; ++o) if (o != i1 && sel[o] > m2) { m2 = sel[o]; i2 = o; }
            if (i2 < 0) i2 = (i1 + 1) & 7;
            const float e2 = __expf(m2 - m1), w1 = gate / (1.f + e2), w2 = gate * e2 / (1.f + e2);
            const int ea = gs * EPG + i1, eb = gs * EPG + i2;
            wgt[2 * m] = w1; wgt[2 * m + 1] = w2;
            const unsigned pa = atomicAdd(&cnt[ea], 1u), pb = atomicAdd(&cnt[eb], 1u);
            list[ea * 32768 + pa] = 2 * m; list[eb * 32768 + pb] = 2 * m + 1;
        }
    }
    __syncthreads();
}

__device__ __forceinline__ int moe_tables(Frame& F) {
    LAS int* MBE = (LAS int*)(F.lds + X_MBE); LAS int* MBS = MBE + MAXMB; LAS int* NMB = MBS + 33;
    if (F.tid == 0) { int mb = 0;
        for (int e = 0; e < NE; ++e) { const int c = (int)__hip_atomic_load(F.ctl + CW_CNT + e, RLX_AGENT); MBS[e] = mb; const int nb = (c + 255) >> 8; for (int j = 0; j < nb && mb < MAXMB; ++j) MBE[mb++] = e; }
        MBS[NE] = mb; NMB[0] = mb; }
    __syncthreads();
    return NMB[0];
}
template <bool FOR_A>
__device__ __forceinline__ void moe_fill_tab(Frame& F, const pg8::MoeOrder& S) {
    LAS int* MBE = (LAS int*)(F.lds + X_MBE); LAS int* MBS = MBE + MAXMB; LAS int* tab = (LAS int*)(F.lds + X_GTAB); const int* list = (const int*)(F.ws + WS_LIST);
    pg8::Unit u;
    for (int i = 0; i < 4 && S.next(i, u) && u.slot == i; ++i) {
        if (F.tid < 256) { const int e = MBE[u.pm], pos = (u.pm - MBS[e]) * 256 + F.tid, c = (int)__hip_atomic_load(F.ctl + CW_CNT + e, RLX_AGENT);
            const int aid = pos < c ? list[e * 32768 + pos] : -1;
            tab[i * 256 + F.tid] = FOR_A ? (aid >= 0 ? (aid >> 1) * (D * 2) : 0) : aid; }
    }
    __syncthreads();
}

__device__ __forceinline__ void ph10_final(Frame& F) {
    const float* mod = (const float*)(F.ws + WS_MOD); const bf16* YA = (const bf16*)(F.ws + WS_YA); const float* gp = F.in[7];
    const int gw = F.vcu * NWAVES + F.wave, NGW = F.G * NWAVES, lane = F.lane;
    for (int rep10 = 0; rep10 < PROBE_R10; ++rep10)
    for (int m = gw; m < T; m += NGW) {
        const int b = m / SEQ; const float* gt2 = mod + b * 6144 + 5120;
        float y[4][4]; float s = 0.f;
#pragma unroll
        for (int j = 0; j < 4; ++j) { const v2u a = ((const GAS v2u*)(YA + (size_t)(2 * m) * D) + lane)[64 * j], c = ((const GAS v2u*)(YA + (size_t)(2 * m + 1) * D) + lane)[64 * j];
            y[j][0] = bf2f(a.x & 0xffffu) + bf2f(c.x & 0xffffu); y[j][1] = bf2f(a.x >> 16) + bf2f(c.x >> 16); y[j][2] = bf2f(a.y & 0xffffu) + bf2f(c.y & 0xffffu); y[j][3] = bf2f(a.y >> 16) + bf2f(c.y >> 16);
#pragma unroll
            for (int i = 0; i < 4; ++i) s += y[j][i] * y[j][i]; }
        const float rs = rsqrtf(wave_sum(s) * (1.f / D) + EPS);
#pragma unroll
        for (int j = 0; j < 4; ++j) { const int c0 = 4 * lane + 256 * j; const f32x4 gg = *(const f32x4*)(gp + c0), gt = *(const f32x4*)(gt2 + c0);
            GAS f32x4* o = (GAS f32x4*)(F.out + (size_t)m * D) + lane + 64 * j; f32x4 xv = *o;
            xv.x += gt.x * (y[j][0] * rs * gg.x); xv.y += gt.y * (y[j][1] * rs * gg.y); xv.z += gt.z * (y[j][2] * rs * gg.z); xv.w += gt.w * (y[j][3] * rs * gg.w);
            if (rep10 == PROBE_R10 - 1) *o = xv; else *((GAS f32x4*)(F.ws + WS_H + (size_t)(m >> 1) * D * 4) + lane + 64 * j) = xv; }
    }
}

constexpr int NPH = 11;
__global__ void __launch_bounds__(NTHR, 2) skel_fwd(Args args) {
    extern __shared__ __attribute__((aligned(16))) unsigned char lds[];
    Frame F;
    F.lds = (LAS unsigned char*)lds; F.MISC = (volatile LAS unsigned*)(F.lds + X_MISC);
    F.tid = threadIdx.x; F.lane = F.tid & 63; F.wave = __builtin_amdgcn_readfirstlane(F.tid >> 6);
    F.G = gridDim.x; { const int bx = blockIdx.x; F.vcu = (F.G % 8 == 0) ? (bx % 8) * (F.G / 8) + bx / 8 : bx; }
    F.in = args.in; F.out = args.out; F.ws = args.ws; F.ctl = (gu32*)(args.ws + WS_CTL);
    if (F.tid < 32) F.MISC[F.tid] = 0u;
    __syncthreads();
    XcdBarrier bar; bar.bar = (unsigned*)(F.ctl + CW_BAR); bar.x = 0; bar.st = nullptr;
    const int lo = args.ph_lo, hi = args.ph_hi;
    const bool one = (hi - lo) > 1;
    if (one) bar = xcd_barrier_post((unsigned*)(F.ctl + CW_BAR), F.MISC + 8);
#ifndef PHMASK
#define PHMASK 0x7FF
#endif
#define IN(k) (((PHMASK >> (k)) & 1) && lo <= (k) && (k) < hi)
#define SEAM(k) do { if (IN(k) && IN((k) + 1)) xcd_barrier(bar); } while (0)
#ifndef REPMASK
#define REPMASK 0
#endif
#define REP(k) (((REPMASK >> (k)) & 1) != 0)

    if (IN(0)) { ph0_prologue(F); if (REP(0)) { xcd_barrier(bar); ph0_prologue(F); } } if (IN(0) && IN(2)) xcd_barrier(bar);
    if (IN(2)) for (int rep_ = 0; rep_ < (REP(2) ? 2 : 1); ++rep_) {
        if (rep_) xcd_barrier(bar);
        pg8::Gemm g{(const bf16*)(F.ws + WS_H), (const bf16*)(F.ws + WS_WIN), D}; pg8::StaticOrder S; S.init(T, DIN, D, F.G, (int)blockIdx.x, PROBE_G2);
        pg8::EpiProj E{(bf16*)(F.ws + WS_PROJ), (const float*)(F.ws + WS_LB)};
        pg8::gemm_phase<pg8::EpiProj, pg8::StaticOrder, false>(F.lds, g, S, E, nullptr);
    } SEAM(2);
    if (IN(3)) { ph3_passA(F); if (REP(3)) { xcd_barrier(bar); ph3_passA(F); } } SEAM(3);
    if (IN(4)) { ph4_passB(F); if (REP(4)) { xcd_barrier(bar); ph4_passB(F); } } SEAM(4);
    for (int xb_ = 1; xb_ < PROBE_BAR; ++xb_) xcd_barrier(bar);
    if (IN(5)) { ph5_passC(F); if (REP(5)) { xcd_barrier(bar); ph5_passC(F); } } SEAM(5);
    if (IN(6)) for (int rep_ = 0; rep_ < (REP(6) ? 2 : 1); ++rep_) {
        if (rep_) xcd_barrier(bar);
        pg8::Gemm g{(const bf16*)(F.ws + WS_H), (const bf16*)(F.ws + WS_WOUT), D}; pg8::StaticOrder S; S.init(T, D, D, F.G, (int)blockIdx.x);
        pg8::EpiMixB E{(bf16*)(F.ws + WS_MIX), D};
        pg8::gemm_phase<pg8::EpiMixB, pg8::StaticOrder, false>(F.lds, g, S, E, nullptr);
    } SEAM(6);
    if (IN(7)) { ph7_rows(F); } SEAM(7);
    if (IN(8)) for (int rep_ = 0; rep_ < (REP(8) ? 2 : 1); ++rep_) { if (rep_) xcd_barrier(bar);
        const int nmb = moe_tables(F);
        pg8::MoeOrder S{4 * nmb, F.G, (int)blockIdx.x, D, (const LAS int*)(F.lds + X_MBE), (size_t)D * D * 2, PROBE_M8};
        moe_fill_tab<true>(F, S);
        pg8::Gemm g{(const bf16*)(F.ws + WS_H), (const bf16*)(F.ws + WS_W13), D}; pg8::EpiAct E{(bf16*)(F.ws + WS_ACT)};
        pg8::gemm_phase<pg8::EpiAct, pg8::MoeOrder, true>(F.lds, g, S, E, (const LAS unsigned*)(F.lds + X_GTAB));
    } SEAM(8);
    if (IN(9)) for (int rep_ = 0; rep_ < (REP(9) ? 2 : 1); ++rep_) { if (rep_) xcd_barrier(bar);
        const int nmb = moe_tables(F);
        pg8::MoeOrder S{4 * nmb, F.G, (int)blockIdx.x, DE, (const LAS int*)(F.lds + X_MBE), (size_t)D * DE * 2, PROBE_M9};
        moe_fill_tab<false>(F, S);
        pg8::Gemm g{(const bf16*)(F.ws + WS_ACT), (const bf16*)(F.ws + WS_W2), DE}; pg8::EpiYa E{(bf16*)(F.ws + WS_YA), (const float*)(F.ws + WS_WGT), (const LAS int*)(F.lds + X_GTAB)};
        pg8::gemm_phase<pg8::EpiYa, pg8::MoeOrder, false>(F.lds, g, S, E, nullptr);
    } SEAM(9);
    if (IN(10)) { ph10_final(F); }
#undef IN
#undef SEAM
}


#ifdef HYBRID
struct P {
    const float* in[27]; float* out; unsigned char* ws;
};

__global__ void __launch_bounds__(256) k_mod(P p) {
    const int idx = blockIdx.x * blockDim.x + threadIdx.x;
    const float* c = p.in[1]; const float* w = p.in[2]; const float* bias = p.in[3];
    float* mod = (float*)(p.ws + WS_MOD);
    if (idx < 2 * 6144) {
        const int b = idx / 6144, n = idx % 6144; float s = 0.f;
        for (int k = 0; k < D; ++k) s += siluf_(c[b * D + k]) * w[(size_t)k * 6144 + n];
        mod[idx] = s + bias[n];
    }
    if (idx < DH) { const float* g = p.in[9]; ((float*)(p.ws + WS_LB))[idx] = 1.f / (1.f + __expf(g[DH + idx] - g[idx])); }
}

__global__ void __launch_bounds__(256) k_h(P p) {
    const int lane = threadIdx.x & 63, gw = (blockIdx.x * blockDim.x + threadIdx.x) >> 6, ngw = (gridDim.x * blockDim.x) >> 6;
    const float* x = p.in[0]; const float* g = p.in[4]; const float* mod = (const float*)(p.ws + WS_MOD);
    bf16* H = (bf16*)(p.ws + WS_H);
    for (int m = gw; m < T; m += ngw) {
        const int b = m / SEQ; const float* sh = mod + b * 6144; const float* sc = sh + 1024;
        const f32x4* xr = (const f32x4*)(x + (size_t)m * D) + lane; f32x4 v[4]; float s = 0.f;
#pragma unroll
        for (int j = 0; j < 4; ++j) { v[j] = xr[64 * j]; s += v[j].x * v[j].x + v[j].y * v[j].y + v[j].z * v[j].z + v[j].w * v[j].w; }
        const float rstd = rsqrtf(wave_sum(s) * (1.f / D) + EPS);
        unsigned long long* o8 = (unsigned long long*)(H + (size_t)m * D) + lane;
#pragma unroll
        for (int j = 0; j < 4; ++j) { const int c0 = 4 * lane + 256 * j; const f32x4 gg = *(const f32x4*)(g + c0), s1 = *(const f32x4*)(sc + c0), h1 = *(const f32x4*)(sh + c0);
            const float a0 = v[j].x * rstd * gg.x * (1.f + s1.x) + h1.x, a1 = v[j].y * rstd * gg.y * (1.f + s1.y) + h1.y, a2 = v[j].z * rstd * gg.z * (1.f + s1.z) + h1.z, a3 = v[j].w * rstd * gg.w * (1.f + s1.w) + h1.w;
            o8[64 * j] = (unsigned long long)pk2(a0, a1) | ((unsigned long long)pk2(a2, a3) << 32); }
    }
}

template <int NB, class RowFn, class Epi>
__device__ __forceinline__ void gemm_tile_naive(const bf16* A, int lda, const float* B0, const float* B1, int ldb, int K, int m0, int n0, int mvalid, const RowFn& rowfn, const Epi& epi) {
    __shared__ float As[16][65]; __shared__ float Bs[NB][16][64]; __shared__ long long rowoff[64];
    const int tid = threadIdx.x, ty = tid >> 4, tx = tid & 15;
    if (tid < 64) rowoff[tid] = (tid < mvalid) ? (long long)rowfn(m0 + tid) * lda : -1;
    __syncthreads();
    float acc[NB][4][4];
#pragma unroll
    for (int q = 0; q < NB; ++q)
#pragma unroll
        for (int i = 0; i < 4; ++i)
#pragma unroll
            for (int j = 0; j < 4; ++j) acc[q][i][j] = 0.f;
    for (int k0 = 0; k0 < K; k0 += 16) {
        { const int r = tid >> 2, kk = (tid & 3) * 4; const long long ro = rowoff[r];
          if (ro >= 0) { const v2u w = *(const v2u*)(A + ro + k0 + kk); As[kk][r] = bf2f(w.x & 0xffffu); As[kk + 1][r] = bf2f(w.x >> 16); As[kk + 2][r] = bf2f(w.y & 0xffffu); As[kk + 3][r] = bf2f(w.y >> 16); }
          else { As[kk][r] = 0.f; As[kk + 1][r] = 0.f; As[kk + 2][r] = 0.f; As[kk + 3][r] = 0.f; } }
        { const int kr = tid >> 4, c4 = (tid & 15) * 4;
          *(f32x4*)&Bs[0][kr][c4] = *(const f32x4*)(B0 + (size_t)(k0 + kr) * ldb + n0 + c4);
          if (NB == 2) *(f32x4*)&Bs[NB - 1][kr][c4] = *(const f32x4*)(B1 + (size_t)(k0 + kr) * ldb + n0 + c4); }
        __syncthreads();
#pragma unroll
        for (int kk = 0; kk < 16; ++kk) {
            float a[4];
#pragma unroll
            for (int i = 0; i < 4; ++i) a[i] = As[kk][ty * 4 + i];
#pragma unroll
            for (int q = 0; q < NB; ++q) { const f32x4 b = *(const f32x4*)&Bs[q][kk][tx * 4];
#pragma unroll
                for (int i = 0; i < 4; ++i) { acc[q][i][0] += a[i] * b.x; acc[q][i][1] += a[i] * b.y; acc[q][i][2] += a[i] * b.z; acc[q][i][3] += a[i] * b.w; } }
        }
        __syncthreads();
    }
#pragma unroll
    for (int i = 0; i < 4; ++i) { const int r = ty * 4 + i; if (r < mvalid) {
#pragma unroll
        for (int j = 0; j < 4; ++j) epi(m0 + r, n0 + tx * 4 + j, acc[0][i][j], NB == 2 ? acc[NB - 1][i][j] : 0.f); } }
}
struct RowId { __device__ int operator()(int m) const { return m; } };

struct NEpiProj {
    bf16* base; const float* lb;
    __device__ void operator()(int m, int n, float v, float) const {
        const int grp = n >> 9, c = n & 511; bf16* o = base + (size_t)m * DH + c; const size_t S = PROJ_S;
        if (grp == 0) o[0] = (bf16)f2bf(siluf_(v));
        else if (grp == 1) { const float l = lb[c], sg = sigmoidf_(v); o[S] = (bf16)f2bf(__logf(l + (1.f - l) * sg)); o[2 * S] = (bf16)f2bf((1.f - l) * (1.f - sg)); }
        else if (grp == 2) o[3 * S] = (bf16)f2bf(v);
        else if (grp == 3) o[4 * S] = (bf16)f2bf(siluf_(v));
        else if (grp == 4) o[5 * S] = (bf16)f2bf(v);
        else o[6 * S] = (bf16)f2bf(gelu_tanh_(v));
    }
};
__global__ void __launch_bounds__(256) k_proj(P p) {
    NEpiProj e{(bf16*)(p.ws + WS_PROJ), (const float*)(p.ws + WS_LB)};
    gemm_tile_naive<1>((const bf16*)(p.ws + WS_H), D, p.in[8], nullptr, DIN, D, blockIdx.y * 64, blockIdx.x * 64, 64, RowId{}, e);
}

__global__ void __launch_bounds__(128) k_hgrn(P p) {
    const int b = blockIdx.x / NH, h = blockIdx.x % NH, v = threadIdx.x;
    const size_t S = PROJ_S; const bf16* PJ = (const bf16*)(p.ws + WS_PROJ);
    const bf16 *Q = PJ, *LF = PJ + S, *KI = PJ + 2 * S, *V = PJ + 3 * S, *GZ = PJ + 4 * S;
    bf16* O = (bf16*)(p.ws + WS_H); const float g = p.in[10][h * HD + v];
    __shared__ float sq[HD], sk[HD], sf[HD], red[2];
    float St[HD];
#pragma unroll
    for (int k = 0; k < HD; ++k) St[k] = 0.f;
    for (int t = 0; t < SEQ; ++t) {
#ifdef DBG_NOSTATE
        if ((t & 63) == 0) {
#pragma unroll
            for (int k = 0; k < HD; ++k) St[k] = 0.f; }
#endif
        const size_t row = (size_t)(b * SEQ + t) * DH + h * HD;
        sq[v] = bf2f(Q[row + v]); sk[v] = bf2f(KI[row + v]); sf[v] = __expf(bf2f(LF[row + v]));
        const float vv = bf2f(V[row + v]);
        __syncthreads();
        float o = 0.f;
#pragma unroll
        for (int k = 0; k < HD; ++k) { St[k] = sf[k] * St[k] + sk[k] * vv; o += St[k] * sq[k]; }
        const float ss = wave_sum(o * o);
        if ((v & 63) == 0) red[v >> 6] = ss;
        __syncthreads();
        const float rstd = rsqrtf((red[0] + red[1]) * (1.f / HD) + EPS);
        O[(size_t)(b * SEQ + t) * D + h * HD + v] = (bf16)f2bf(o * rstd * g * bf2f(GZ[row + v]));
    }
}

__global__ void __launch_bounds__(512) k_rg(P p) {
    const int b = blockIdx.x, ch = threadIdx.x, blk = ch >> 6, cl = ch & 63;
    const size_t S = PROJ_S; const bf16* PJ = (const bf16*)(p.ws + WS_PROJ);
    const bf16 *XR = PJ + 5 * S, *YR = PJ + 6 * S; bf16* O = (bf16*)(p.ws + WS_H);
    const float* cw = p.in[11]; const float cb = p.in[12][ch];
    const float c0 = cw[ch], c1 = cw[DR + ch], c2 = cw[2 * DR + ch], c3 = cw[3 * DR + ch];
    float wr[RBD], wi[RBD];
#pragma unroll
    for (int i = 0; i < RBD; ++i) { wr[i] = p.in[13][(size_t)(blk * RBD + i) * RBD + cl]; wi[i] = p.in[15][(size_t)(blk * RBD + i) * RBD + cl]; }
    const float br = p.in[14][ch], bi = p.in[16][ch], lam = p.in[17][ch], gn = p.in[18][ch];
    const float logsig = -log1pf(__expf(-lam));
    __shared__ float sx[DR], red[8];
    float hst = 0.f, x0 = 0.f, x1 = 0.f, x2 = 0.f;
    for (int t = 0; t < SEQ; ++t) {
        const size_t row = (size_t)(b * SEQ + t) * DH;
        const float x3 = bf2f(XR[row + ch]);
        const float xc = c0 * x0 + c1 * x1 + c2 * x2 + c3 * x3 + cb; x0 = x1; x1 = x2; x2 = x3;
        sx[ch] = xc; __syncthreads();
        float ar = br, ai = bi;
#pragma unroll
        for (int i = 0; i < RBD; ++i) { const float xi = sx[blk * RBD + i]; ar += xi * wr[i]; ai += xi * wi[i]; }
        const float r = sigmoidf_(ar), ig = sigmoidf_(ai);
        const float la = 8.f * r * logsig, a = __expf(la), u = sqrtf(-expm1f(2.f * la)) * (ig * xc);
        hst = a * hst + u;
        const float val = hst * bf2f(YR[row + ch]);
        const float ss = wave_sum(val * val);
        if ((ch & 63) == 0) red[ch >> 6] = ss;
        __syncthreads();
        float tot = 0.f;
#pragma unroll
        for (int i = 0; i < 8; ++i) tot += red[i];
        O[(size_t)(b * SEQ + t) * D + DH + ch] = (bf16)f2bf(val * rsqrtf(tot * (1.f / DR) + EPS) * gn);
    }
}

struct NEpiF32 { float* C; int ldc; __device__ void operator()(int m, int n, float v, float) const { C[(size_t)m * ldc + n] = v; } };
__global__ void __launch_bounds__(256) k_mix(P p) {
    NEpiF32 e{(float*)(p.ws + WS_MIX), D};
    gemm_tile_naive<1>((const bf16*)(p.ws + WS_H), D, p.in[19], nullptr, D, D, blockIdx.y * 64, blockIdx.x * 64, 64, RowId{}, e);
}

__global__ void __launch_bounds__(256) k_row2(P p) {
    const int lane = threadIdx.x & 63, gw = (blockIdx.x * blockDim.x + threadIdx.x) >> 6, ngw = (gridDim.x * blockDim.x) >> 6;
    const float* x = p.in[0]; const float* mod = (const float*)(p.ws + WS_MOD); const float* mix = (const float*)(p.ws + WS_MIX);
    const float *gpm = p.in[5], *gpf = p.in[6], *wrg = p.in[20], *brg = p.in[21], *wre = p.in[22], *bre = p.in[23];
    bf16* H = (bf16*)(p.ws + WS_H); float* wgt = (float*)(p.ws + WS_WGT);
    unsigned* cnt = (unsigned*)(p.ws + WS_CTL) + CW_CNT; int* list = (int*)(p.ws + WS_LIST);
    for (int m = gw; m < T; m += ngw) {
        const int b = m / SEQ; const float* mb = mod + b * 6144; const float *gt1 = mb + 2048, *sh2 = mb + 3072, *sc2 = mb + 4096;
        f32x4 v[4], xv[4]; float s = 0.f;
#pragma unroll
        for (int j = 0; j < 4; ++j) { v[j] = ((const f32x4*)(mix + (size_t)m * D) + lane)[64 * j]; xv[j] = ((const f32x4*)(x + (size_t)m * D) + lane)[64 * j]; s += v[j].x * v[j].x + v[j].y * v[j].y + v[j].z * v[j].z + v[j].w * v[j].w; }
        const float rs1 = rsqrtf(wave_sum(s) * (1.f / D) + EPS); float s2 = 0.f;
#pragma unroll
        for (int j = 0; j < 4; ++j) { const int c0 = 4 * lane + 256 * j; const f32x4 gg = *(const f32x4*)(gpm + c0), gt = *(const f32x4*)(gt1 + c0);
            xv[j].x += gt.x * (v[j].x * rs1 * gg.x); xv[j].y += gt.y * (v[j].y * rs1 * gg.y); xv[j].z += gt.z * (v[j].z * rs1 * gg.z); xv[j].w += gt.w * (v[j].w * rs1 * gg.w);
            ((f32x4*)(p.out + (size_t)m * D) + lane)[64 * j] = xv[j];
            s2 += xv[j].x * xv[j].x + xv[j].y * xv[j].y + xv[j].z * xv[j].z + xv[j].w * xv[j].w; }
        const float rs2 = rsqrtf(wave_sum(s2) * (1.f / D) + EPS);
        float hh[4][4];
#pragma unroll
        for (int j = 0; j < 4; ++j) { const int c0 = 4 * lane + 256 * j; const f32x4 gg = *(const f32x4*)(gpf + c0), sc = *(const f32x4*)(sc2 + c0), sh = *(const f32x4*)(sh2 + c0);
            hh[j][0] = xv[j].x * rs2 * gg.x * (1.f + sc.x) + sh.x; hh[j][1] = xv[j].y * rs2 * gg.y * (1.f + sc.y) + sh.y; hh[j][2] = xv[j].z * rs2 * gg.z * (1.f + sc.z) + sh.z; hh[j][3] = xv[j].w * rs2 * gg.w * (1.f + sc.w) + sh.w;
            ((unsigned long long*)(H + (size_t)m * D) + lane)[64 * j] = (unsigned long long)pk2(hh[j][0], hh[j][1]) | ((unsigned long long)pk2(hh[j][2], hh[j][3]) << 32); }
        float lg[NG], le[NE];
#pragma unroll
        for (int o = 0; o < NG; ++o) lg[o] = 0.f;
#pragma unroll
        for (int o = 0; o < NE; ++o) le[o] = 0.f;
#pragma unroll
        for (int j = 0; j < 4; ++j)
#pragma unroll
            for (int i = 0; i < 4; ++i) { const int k = 4 * lane + 256 * j + i; const float hv = hh[j][i];
                const f32x4 wg = *(const f32x4*)(wrg + (size_t)k * NG); lg[0] += hv * wg.x; lg[1] += hv * wg.y; lg[2] += hv * wg.z; lg[3] += hv * wg.w;
#pragma unroll
                for (int o4 = 0; o4 < NE / 4; ++o4) { const f32x4 we = *(const f32x4*)(wre + (size_t)k * NE + 4 * o4); le[4 * o4] += hv * we.x; le[4 * o4 + 1] += hv * we.y; le[4 * o4 + 2] += hv * we.z; le[4 * o4 + 3] += hv * we.w; } }
#pragma unroll
        for (int o = 0; o < NG; ++o) lg[o] = wave_sum(lg[o]) + brg[o];
#pragma unroll
        for (int o = 0; o < NE; ++o) le[o] = wave_sum(le[o]) + bre[o];
        if (lane == 0) {
            int gs = 0; float gm = lg[0];
#pragma unroll
            for (int o = 1; o < NG; ++o) if (lg[o] > gm) { gm = lg[o]; gs = o; }
            float den = 0.f;
#pragma unroll
            for (int o = 0; o < NG; ++o) den += __expf(lg[o] - gm);
            const float gate = 1.f / den;
            float sel[EPG];
#pragma unroll
            for (int o = 0; o < EPG; ++o) sel[o] = gs == 0 ? le[o] : gs == 1 ? le[8 + o] : gs == 2 ? le[16 + o] : le[24 + o];
            int i1 = 0; float m1 = sel[0];
#pragma unroll
            for (int o = 1; o < EPG; ++o) if (sel[o] > m1) { m1 = sel[o]; i1 = o; }
            int i2 = -1; float m2 = -3.0e38f;
#pragma unroll
            for (int o = 0; o < EPG; ++o) if (o != i1 && sel[o] > m2) { m2 = sel[o]; i2 = o; }
            const float e2 = __expf(m2 - m1), w1 = gate / (1.f + e2), w2 = gate * e2 / (1.f + e2);
            const int ea = gs * EPG + i1, eb = gs * EPG + i2;
            wgt[2 * m] = w1; wgt[2 * m + 1] = w2;
            const unsigned pa = atomicAdd(&cnt[ea], 1u), pb = atomicAdd(&cnt[eb], 1u);
            list[ea * 32768 + pa] = 2 * m; list[eb * 32768 + pb] = 2 * m + 1;
        }
    }
}

struct RowList { const int* lst; __device__ int operator()(int m) const { return lst[m] >> 1; } };
struct RowAid { const int* lst; __device__ int operator()(int m) const { return lst[m]; } };
struct NEpiAct { bf16* act; const int* lst; __device__ void operator()(int m, int n, float a, float b) const { act[(size_t)lst[m] * DE + n] = (bf16)f2bf(siluf_(a) * b); } };
struct NEpiYa { bf16* ya; const int* lst; const float* wgt; __device__ void operator()(int m, int n, float v, float) const { const int aid = lst[m]; ya[(size_t)aid * D + n] = (bf16)f2bf(v * wgt[aid]); } };
__global__ void __launch_bounds__(256) k_moe1(P p) {
    const int e = blockIdx.z; const unsigned* cnt = (const unsigned*)(p.ws + WS_CTL) + CW_CNT; const int c = (int)cnt[e];
    const int m0 = blockIdx.y * 64; if (m0 >= c) return;
    const int* lst = (const int*)(p.ws + WS_LIST) + e * 32768;
    NEpiAct ep{(bf16*)(p.ws + WS_ACT), lst};
    gemm_tile_naive<2>((const bf16*)(p.ws + WS_H), D, p.in[24] + (size_t)e * D * DE, p.in[25] + (size_t)e * D * DE, DE, D, m0, blockIdx.x * 64, min(64, c - m0), RowList{lst}, ep);
}
__global__ void __launch_bounds__(256) k_moe2(P p) {
    const int e = blockIdx.z; const unsigned* cnt = (const unsigned*)(p.ws + WS_CTL) + CW_CNT; const int c = (int)cnt[e];
    const int m0 = blockIdx.y * 64; if (m0 >= c) return;
    const int* lst = (const int*)(p.ws + WS_LIST) + e * 32768;
    NEpiYa ep{(bf16*)(p.ws + WS_YA), lst, (const float*)(p.ws + WS_WGT)};
    gemm_tile_naive<1>((const bf16*)(p.ws + WS_ACT), DE, p.in[26] + (size_t)e * DE * D, nullptr, D, DE, m0, blockIdx.x * 64, min(64, c - m0), RowAid{lst}, ep);
}

__global__ void __launch_bounds__(256) k_final(P p) {
    const int lane = threadIdx.x & 63, gw = (blockIdx.x * blockDim.x + threadIdx.x) >> 6, ngw = (gridDim.x * blockDim.x) >> 6;
    const float* mod = (const float*)(p.ws + WS_MOD); const bf16* YA = (const bf16*)(p.ws + WS_YA); const float* gp = p.in[7];
    for (int m = gw; m < T; m += ngw) {
        const int b = m / SEQ; const float* gt2 = mod + b * 6144 + 5120;
        float y[4][4]; float s = 0.f;
#pragma unroll
        for (int j = 0; j < 4; ++j) { const v2u a = ((const v2u*)(YA + (size_t)(2 * m) * D) + lane)[64 * j], c = ((const v2u*)(YA + (size_t)(2 * m + 1) * D) + lane)[64 * j];
            y[j][0] = bf2f(a.x & 0xffffu) + bf2f(c.x & 0xffffu); y[j][1] = bf2f(a.x >> 16) + bf2f(c.x >> 16); y[j][2] = bf2f(a.y & 0xffffu) + bf2f(c.y & 0xffffu); y[j][3] = bf2f(a.y >> 16) + bf2f(c.y >> 16);
#pragma unroll
            for (int i = 0; i < 4; ++i) s += y[j][i] * y[j][i]; }
        const float rs = rsqrtf(wave_sum(s) * (1.f / D) + EPS);
#pragma unroll
        for (int j = 0; j < 4; ++j) { const int c0 = 4 * lane + 256 * j; const f32x4 gg = *(const f32x4*)(gp + c0), gt = *(const f32x4*)(gt2 + c0);
            f32x4* o = (f32x4*)(p.out + (size_t)m * D) + lane + 64 * j; f32x4 xv = *o;
            xv.x += gt.x * (y[j][0] * rs * gg.x); xv.y += gt.y * (y[j][1] * rs * gg.y); xv.z += gt.z * (y[j][2] * rs * gg.z); xv.w += gt.w * (y[j][3] * rs * gg.w);
            if (rep10 == PROBE_R10 - 1) *o = xv; else *((GAS f32x4*)(F.ws + WS_H + (size_t)(m >> 1) * D * 4) + lane + 64 * j) = xv; }
    }
}

#endif

extern "C" void kernel_launch(void* const* d_in, const int* in_sizes, int n_in, void* d_out, int out_size, void* d_ws, size_t ws_size, hipStream_t stream) {
    static int grid = 0;
    if (grid == 0) {
        if (n_in != 27 || out_size != T * D || ws_size < WS_END) { fprintf(stderr, "kernel_launch: unexpected n_in %d / out %d / ws %zu\n", n_in, out_size, ws_size); grid = -1; return; }
        int dev = 0, cus = 0, per_cu = 0;
        if (hipGetDevice(&dev) != hipSuccess || hipDeviceGetAttribute(&cus, hipDeviceAttributeMultiprocessorCount, dev) != hipSuccess) { grid = -1; return; }
        if (hipFuncSetAttribute((const void*)skel_fwd, hipFuncAttributeMaxDynamicSharedMemorySize, LDS_BYTES) != hipSuccess) { fprintf(stderr, "kernel_launch: hipFuncSetAttribute failed\n"); grid = -1; return; }
        if (hipOccupancyMaxActiveBlocksPerMultiprocessor(&per_cu, (const void*)skel_fwd, NTHR, LDS_BYTES) != hipSuccess || per_cu < 1) { fprintf(stderr, "kernel_launch: occupancy query says %d blocks per CU\n", per_cu); per_cu = 1; }
        (void)hipGetLastError();
        if (cus < 256) { fprintf(stderr, "kernel_launch: needs 256 CUs (one resident workgroup per chunk), device has %d\n", cus); grid = -1; return; }
        grid = 256;
        fprintf(stderr, "kernel_launch: grid %d, occupancy query %d per CU, ws %zu MiB\n", grid, per_cu, ws_size >> 20);
    }
    if (grid < 0) return;
    (void)hipMemsetAsync((char*)d_ws + WS_CTL, 0, CTL_ZERO_BYTES, stream);
    Args a{};
    for (int i = 0; i < 27; ++i) a.in[i] = (const float*)d_in[i];
    a.out = (float*)d_out; a.ws = (unsigned char*)d_ws;
#ifdef HYBRID
    P p{}; for (int i = 0; i < 27; ++i) p.in[i] = (const float*)d_in[i]; p.out = (float*)d_out; p.ws = (unsigned char*)d_ws;
#define RUNPH(lo_, hi_) do { for (int ph = (lo_); ph < (hi_); ++ph) { a.ph_lo = ph; a.ph_hi = ph + 1; hipLaunchKernelGGL(skel_fwd, dim3(grid), dim3(NTHR), LDS_BYTES, stream, a); } } while (0)
    RUNPH(0, 1);
    if (HYBRID & 1) RUNPH(1, 2); else k_h<<<1024, 256, 0, stream>>>(p);
    if (HYBRID & 2) RUNPH(2, 3); else k_proj<<<dim3(DIN / 64, T / 64), 256, 0, stream>>>(p);
    if (HYBRID & 4) { RUNPH(3, 6); if (HYBRID & 128) k_rg<<<BATCH, 512, 0, stream>>>(p); if (HYBRID & 256) k_hgrn<<<BATCH * NH, 128, 0, stream>>>(p); } else { k_hgrn<<<BATCH * NH, 128, 0, stream>>>(p); k_rg<<<BATCH, 512, 0, stream>>>(p); }
    if (HYBRID & 8) RUNPH(6, 7); else k_mix<<<dim3(D / 64, T / 64), 256, 0, stream>>>(p);
    if (HYBRID & 16) RUNPH(7, 8); else k_row2<<<1024, 256, 0, stream>>>(p);
    if (HYBRID & 32) RUNPH(8, 10); else { k_moe1<<<dim3(DE / 64, 512, NE), 256, 0, stream>>>(p); k_moe2<<<dim3(D / 64, 512, NE), 256, 0, stream>>>(p); }
    if (HYBRID & 64) RUNPH(10, 11); else k_final<<<1024, 256, 0, stream>>>(p);
#elif MK_N_LAUNCHES == 1
    a.ph_lo = 0; a.ph_hi = NPH;
    hipLaunchKernelGGL(skel_fwd, dim3(grid), dim3(NTHR), LDS_BYTES, stream, a);
    for (int all_ = 1; all_ < PROBE_ALL; ++all_) { (void)hipMemsetAsync((char*)d_ws + WS_CTL, 0, CTL_ZERO_BYTES, stream); hipLaunchKernelGGL(skel_fwd, dim3(grid), dim3(NTHR), LDS_BYTES, stream, a); }
#else
    for (int ph = 0; ph < NPH; ++ph) { a.ph_lo = ph; a.ph_hi = ph + 1; hipLaunchKernelGGL(skel_fwd, dim3(grid), dim3(NTHR), LDS_BYTES, stream, a); }
#endif
}
```

```cpp
#include <hip/hip_runtime.h>
#include <cstdio>
#include <cstdint>

#ifndef PROBE_H5
#define PROBE_H5 1
#endif
#ifndef PROBE_G2
#define PROBE_G2 1
#endif
#ifndef PROBE_R7
#define PROBE_R7 1
#endif
#ifndef PROBE_R10
#define PROBE_R10 1
#endif
#ifndef PROBE_RG5
#define PROBE_RG5 1
#endif
#ifndef PROBE_M8
#define PROBE_M8 1
#endif
#ifndef PROBE_M9
#define PROBE_M9 1
#endif
#ifndef PROBE_BAR
#define PROBE_BAR 1
#endif
#ifndef PROBE_ALL
#define PROBE_ALL 1
#endif
#ifndef PROBE_SEAM
#define PROBE_SEAM 1
#endif
#ifndef PROBE_ROTA
#define PROBE_ROTA 1
#endif
#ifndef PROBE_ROTC
#define PROBE_ROTC 1
#endif
#ifndef PROBE_TAIL
#define PROBE_TAIL 1
#endif
#ifndef PROBE_TAIL67
#define PROBE_TAIL67 1
#endif
#ifndef MK_N_LAUNCHES
#define MK_N_LAUNCHES 1
#endif

constexpr int BATCH = 2, SEQ = 8192, D = 1024, T = BATCH * SEQ;
constexpr int DH = 512, HD = 128, NH = 4, CHK = 64, NCH = SEQ / CHK;
constexpr int DR = 512, RBD = 64;
constexpr int DIN = 3072;
constexpr int NG = 4, EPG = 8, NE = 32, DE = 512;
constexpr int MAXMB = 160;
constexpr float EPS = 1e-6f;
constexpr int NWAVES = 8, NTHR = 512;

#define GAS __attribute__((address_space(1)))
#define LAS __attribute__((address_space(3)))
typedef unsigned short bf16;
typedef unsigned v4u __attribute__((ext_vector_type(4)));
typedef unsigned v2u __attribute__((ext_vector_type(2)));
typedef float f32x4 __attribute__((ext_vector_type(4)));
typedef short bf16x8 __attribute__((ext_vector_type(8)));
typedef GAS unsigned gu32;
#define RLX_AGENT __ATOMIC_RELAXED, __HIP_MEMORY_SCOPE_AGENT
#define LDS_WAIT() asm volatile("s_waitcnt lgkmcnt(0)" ::: "memory")
#define VM_WAIT() asm volatile("s_waitcnt vmcnt(0)" ::: "memory")

__device__ __forceinline__ unsigned f2bf(float f) { unsigned u = __builtin_bit_cast(unsigned, f); return (u + 0x7fffu + ((u >> 16) & 1u)) >> 16; }
__device__ __forceinline__ float bf2f(unsigned h) { return __builtin_bit_cast(float, h << 16); }
typedef float f32x2_t __attribute__((ext_vector_type(2))); typedef __bf16 bf16x2_t __attribute__((ext_vector_type(2)));
__device__ __forceinline__ unsigned pk2m(float lo, float hi) { f32x2_t v = {lo, hi}; bf16x2_t b = __builtin_convertvector(v, bf16x2_t); return __builtin_bit_cast(unsigned, b); }
__device__ __forceinline__ unsigned pk2(float lo, float hi) { unsigned r; asm volatile("v_cvt_pk_bf16_f32 %0, %1, %2" : "=v"(r) : "v"(lo), "v"(hi)); return r; }
__device__ __forceinline__ float frcp(float v) { return __builtin_amdgcn_rcpf(v); }
__device__ __forceinline__ float sigmoidf_(float v) { return frcp(1.f + __expf(-v)); }
__device__ __forceinline__ float siluf_(float v) { return v * frcp(1.f + __expf(-v)); }
__device__ __forceinline__ float gelu_tanh_(float v) { const float u = 1.5957691216057308f * (v + 0.044715f * v * v * v); return v * frcp(1.f + __expf(-u)); }
__device__ __forceinline__ float wave_sum(float v) {
#pragma unroll
    for (int o = 1; o < 64; o <<= 1) v += __shfl_xor(v, o);
    return v;
}

constexpr size_t MiB = 1u << 20, KiB = 1u << 10;
constexpr size_t WS_CTL = 0, CTL_ZERO_BYTES = 1 * MiB;
constexpr size_t WS_MOD = 1 * MiB;
constexpr size_t WS_LB = WS_MOD + 64 * KiB;
constexpr size_t WS_WRT = WS_MOD + 128 * KiB;
constexpr size_t WS_WIT = WS_WRT + 64 * KiB;
constexpr size_t WS_RRH = WS_WIT + 64 * KiB;
constexpr size_t WS_RRL = WS_RRH + 96 * KiB;
constexpr size_t WS_RGA = 2 * MiB;
constexpr size_t WS_RGH = WS_RGA + 512 * KiB;
constexpr size_t WS_CARRY = WS_RGH + 512 * KiB;
constexpr size_t WS_DD = WS_CARRY + 512 * KiB;
constexpr size_t WS_WGT = 4 * MiB;
constexpr size_t WS_LIST = 5 * MiB;
constexpr size_t WS_WIN = 10 * MiB;
constexpr size_t WS_WOUT = 16 * MiB;
constexpr size_t WS_W13 = 18 * MiB;
constexpr size_t WS_W2 = 82 * MiB;
constexpr size_t WS_H = 114 * MiB;
constexpr size_t WS_PROJ = 146 * MiB;
constexpr size_t WS_MIX = WS_PROJ;
constexpr size_t WS_YA = WS_PROJ;
constexpr size_t WS_ACT = WS_PROJ + 64 * MiB;
constexpr size_t WS_END = 258 * MiB;
constexpr size_t PROJ_S = (size_t)T * DH;
constexpr int CW_CNT = 32768;
constexpr int CW_MODCNT = 128;
constexpr int CW_BAR = 4096;
constexpr int CW_MB = 16384;

constexpr int RING_BYTES = 131072;
constexpr int RTAB_BYTES = 1024 * 36 * 4;
constexpr int X_OFF = RTAB_BYTES;
constexpr int X_GTAB = X_OFF;
constexpr int X_MBE = X_OFF + 4096;
constexpr int X_MISC = X_OFF + 6144;
constexpr int LDS_BYTES = X_OFF + 8192;

namespace pg8 {
constexpr int BM = 256, BK = 64, HALF = 128, HTB = HALF * BK * 2, NXCD = 8, WGM = 8;
__host__ __device__ __forceinline__ int lds_byte(int r, int c) { const int st = (r >> 4) * 2 + (c >> 5), rr = r & 15, cc = c & 31, ob = rr * 64 + cc * 2; return st * 1024 + (ob ^ (((ob >> 9) & 1) << 5)); }
__host__ __device__ __forceinline__ void stage_rc(int b, int& R, int& C) { const int st = b / 1024, sb = b % 1024, swz = sb ^ (((sb >> 9) & 1) << 5); R = (st >> 1) * 16 + swz / 64; C = (st & 1) * 32 + (swz % 64) / 2; }
__host__ __device__ __forceinline__ int perm32(int rho) { const int n = rho >> 4, i = rho & 15; return 8 * (i >> 2) + 4 * n + (i & 3); }

struct Unit { int pm, pn, slot; };
struct Gemm { const bf16* A; const bf16* Bt; int K; };

struct StaticOrder {
    int nM, nN, nwg, G, c, K, rep;
    __device__ __forceinline__ void init(int M, int N, int K_, int G_, int c_, int rep_ = 1) { nM = M / BM; nN = N / BM; nwg = nM * nN; G = G_; c = c_; K = K_; rep = rep_; }
    __device__ __forceinline__ bool next(int i, Unit& u) const {
        long L = (long)i * G + c; if (L >= (long)nwg * rep) return false; L %= nwg;
        int wgid = (int)L; { const int q = nwg / NXCD, r = nwg % NXCD, xcd = wgid % NXCD, off = wgid / NXCD; wgid = (xcd < r ? xcd * (q + 1) : r * (q + 1) + (xcd - r) * q) + off; }
        const int nig = WGM * nN, gid = wgid / nig, fm = gid * WGM, gsz = (nM - fm) < WGM ? (nM - fm) : WGM;
        u.pm = fm + ((wgid % nig) % gsz); u.pn = (wgid % nig) / gsz; u.slot = i; return true;
    }
    __device__ __forceinline__ size_t aoff(const Unit& u) const { return (size_t)u.pm * BM * K * 2; }
    __device__ __forceinline__ size_t boff(const Unit& u) const { return (size_t)u.pn * BM * K * 2; }
    __device__ __forceinline__ void done(const Unit&) const {}
};
struct MoeOrder {
    int nunits, G, c, K; const LAS int* mbe; size_t estride; int rep;
    int rev; unsigned* done_cnt;
    __device__ __forceinline__ bool next(int i, Unit& u) const {
        const int x = c & 7, ci = c >> 3; const int lo = (int)(((long)nunits * x) >> 3), hi = (int)(((long)nunits * (x + 1)) >> 3);
        int mine; long L0; int stride;
        if (!rev) { mine = (hi - lo - ci + 31) >> 5; L0 = lo + ci; stride = 32; }
        else {
            const int U = hi - lo, base = U >> 5, rem = U & 31, Tc = (3 * U + 31) >> 5; int start = 0;
            for (int cc = 0; cc < ci; ++cc) { const int d = Tc - 2 * (base + (cc < rem ? 1 : 0)); start += d > 0 ? d : 0; }
            int dn = Tc - 2 * (base + (ci < rem ? 1 : 0)); dn = dn > 0 ? dn : 0;
            const int s0 = start < U ? start : U, s1 = (start + dn) < U ? (start + dn) : U; mine = s1 - s0; L0 = lo + s0; stride = 1; }
        if (mine <= 0 || i >= mine * rep) return false;
        const int ii = i % mine; const long L = L0 + (long)stride * ii;
        u.pm = (int)(L >> 2); u.pn = (int)(L & 3); u.slot = ii; return true;
    }
    __device__ __forceinline__ size_t aoff(const Unit& u) const { return (size_t)u.pm * BM * K * 2; }
    __device__ __forceinline__ size_t boff(const Unit& u) const { return (size_t)mbe[u.pm] * estride + (size_t)u.pn * BM * K * 2; }
    __device__ __forceinline__ void done(const Unit& u) const {
        if (done_cnt) { asm volatile("s_waitcnt vmcnt(0)" ::: "memory"); if ((threadIdx.x & 63) == 0) __hip_atomic_fetch_add(done_cnt + 64 * u.pm, 1u, __ATOMIC_RELAXED, __HIP_MEMORY_SCOPE_AGENT); }
    }
};

struct EpiProj {
    static constexpr bool PERM = true;
    bf16* base; const float* lb;
    __device__ __forceinline__ void operator()(const f32x4 (&acc)[2][2][4][2], const Unit& u, int wr, int wc, int fr, int fq) const {
        const int grp = u.pn >> 1, c0 = (u.pn & 1) * 256 + wc * 32 + 8 * fq, row0 = u.pm * BM + wr * 64 + fr;
        bf16* ob = base + (grp == 0 ? 0 : grp == 1 ? PROJ_S : (size_t)(grp + 1) * PROJ_S);
        float lbv[2][8];
        if (grp == 1) {
#pragma unroll
            for (int bj = 0; bj < 2; ++bj) { const f32x4 a = *(const f32x4*)(lb + c0 + bj * HALF), b = *(const f32x4*)(lb + c0 + bj * HALF + 4);
                lbv[bj][0] = a[0]; lbv[bj][1] = a[1]; lbv[bj][2] = a[2]; lbv[bj][3] = a[3]; lbv[bj][4] = b[0]; lbv[bj][5] = b[1]; lbv[bj][6] = b[2]; lbv[bj][7] = b[3]; }
        }
#pragma unroll
        for (int ai = 0; ai < 2; ++ai)
#pragma unroll
            for (int m = 0; m < 4; ++m) { bf16* rowp = ob + (size_t)(row0 + ai * HALF + m * 16) * DH + c0;
#pragma unroll
                for (int bj = 0; bj < 2; ++bj) {
                    float v[8];
#pragma unroll
                    for (int j = 0; j < 4; ++j) { v[j] = acc[ai][bj][m][0][j]; v[4 + j] = acc[ai][bj][m][1][j]; }
                    if (grp == 1) {
                        float kv[8];
#pragma unroll
                        for (int j = 0; j < 8; ++j) { const float l = lbv[bj][j], sg = sigmoidf_(v[j]); kv[j] = (1.f - l) * (1.f - sg); v[j] = __logf(l + (1.f - l) * sg); }
                        v4u w; w.x = pk2(kv[0], kv[1]); w.y = pk2(kv[2], kv[3]); w.z = pk2(kv[4], kv[5]); w.w = pk2(kv[6], kv[7]);
                        *(v4u*)(rowp + PROJ_S + bj * HALF) = w;
                    } else if (grp == 0 || grp == 3) {
#pragma unroll
                        for (int j = 0; j < 8; ++j) v[j] = siluf_(v[j]);
                    } else if (grp == 5) {
#pragma unroll
                        for (int j = 0; j < 8; ++j) v[j] = gelu_tanh_(v[j]);
                    }
                    v4u w; w.x = pk2m(v[0], v[1]); w.y = pk2m(v[2], v[3]); w.z = pk2m(v[4], v[5]); w.w = pk2m(v[6], v[7]);
                    *(v4u*)(rowp + bj * HALF) = w;
                } }
    }
};
struct EpiF32 {
    static constexpr bool PERM = false;
    float* C; int ldc;
    __device__ __forceinline__ void operator()(const f32x4 (&acc)[2][2][4][2], const Unit& u, int wr, int wc, int fr, int fq) const {
        const int row0 = u.pm * BM + wr * 64 + fr, col0 = u.pn * BM + wc * 32 + 4 * fq;
#pragma unroll
        for (int ai = 0; ai < 2; ++ai)
#pragma unroll
            for (int m = 0; m < 4; ++m) { float* rowp = C + (size_t)(row0 + ai * HALF + m * 16) * ldc + col0;
#pragma unroll
                for (int bj = 0; bj < 2; ++bj)
#pragma unroll
                    for (int n = 0; n < 2; ++n) *(f32x4*)(rowp + bj * HALF + n * 16) = acc[ai][bj][m][n]; }
    }
};
struct EpiMixB {
    static constexpr bool PERM = true;
    bf16* C; int ldc;
    __device__ __forceinline__ void operator()(const f32x4 (&acc)[2][2][4][2], const Unit& u, int wr, int wc, int fr, int fq) const {
        const int row0 = u.pm * BM + wr * 64 + fr, col0 = u.pn * BM + wc * 32 + 8 * fq;
#pragma unroll
        for (int ai = 0; ai < 2; ++ai)
#pragma unroll
            for (int m = 0; m < 4; ++m) { bf16* rowp = C + (size_t)(row0 + ai * HALF + m * 16) * ldc + col0;
#pragma unroll
                for (int bj = 0; bj < 2; ++bj) { const f32x4 a = acc[ai][bj][m][0], b = acc[ai][bj][m][1];
                    v4u w; w.x = pk2m(a[0], a[1]); w.y = pk2m(a[2], a[3]); w.z = pk2m(b[0], b[1]); w.w = pk2m(b[2], b[3]);
                    *(v4u*)(rowp + bj * HALF) = w; } }
    }
};
struct EpiAct {
    static constexpr bool PERM = true;
    bf16* act;
    __device__ __forceinline__ void operator()(const f32x4 (&acc)[2][2][4][2], const Unit& u, int wr, int wc, int fr, int fq) const {
        const int row0 = u.pm * BM + wr * 64 + fr, col0 = u.pn * HALF + wc * 32 + 8 * fq;
#pragma unroll
        for (int ai = 0; ai < 2; ++ai)
#pragma unroll
            for (int m = 0; m < 4; ++m) {
                float v[8];
#pragma unroll
                for (int j = 0; j < 4; ++j) { v[j] = siluf_(acc[ai][0][m][0][j]) * acc[ai][1][m][0][j]; v[4 + j] = siluf_(acc[ai][0][m][1][j]) * acc[ai][1][m][1][j]; }
                v4u w; w.x = pk2(v[0], v[1]); w.y = pk2(v[2], v[3]); w.z = pk2(v[4], v[5]); w.w = pk2(v[6], v[7]);
                bf16* dst = act + (size_t)(row0 + ai * HALF + m * 16) * DE + col0;
                asm volatile("global_store_dwordx4 %0, %1, off sc1\n\ts_nop 1" :: "v"(dst), "v"(w) : "memory"); }
    }
};
struct EpiYa {
    static constexpr bool PERM = true;
    bf16* ya; const float* wgt; const LAS int* tab;
    __device__ __forceinline__ void operator()(const f32x4 (&acc)[2][2][4][2], const Unit& u, int wr, int wc, int fr, int fq) const {
        const int col0 = u.pn * BM + wc * 32 + 8 * fq;
#pragma unroll
        for (int ai = 0; ai < 2; ++ai)
#pragma unroll
            for (int m = 0; m < 4; ++m) { const int aid = tab[u.slot * 256 + ai * HALF + wr * 64 + m * 16 + fr];
                if (aid >= 0) { const float w8 = wgt[aid]; bf16* rowp = ya + (size_t)aid * D + col0;
#pragma unroll
                    for (int bj = 0; bj < 2; ++bj) { const f32x4 a = acc[ai][bj][m][0] * w8, b = acc[ai][bj][m][1] * w8;
                        v4u w; w.x = pk2(a[0], a[1]); w.y = pk2(a[2], a[3]); w.z = pk2(b[0], b[1]); w.w = pk2(b[2], b[3]);
                        *(v4u*)(rowp + bj * HALF) = w; } } }
    }
};

template <class Epi, class Sched, bool GATHER>
__device__ __forceinline__ void gemm_phase(LAS unsigned char* lds, const Gemm g, const Sched& S, const Epi& E, const LAS unsigned* gtab) {
    const int tid = threadIdx.x, wid = __builtin_amdgcn_readfirstlane(tid >> 6), lane = tid & 63, wr = wid >> 2, wc = wid & 3, fr = lane & 15, fq = lane >> 4;
    const int K = g.K, nt = K / BK;
    unsigned voffA[2], voffB[2]; int rowA[2];
#pragma unroll
    for (int i = 0; i < 2; ++i) { int R, C; stage_rc(tid * 16 + i * 8192, R, C); const int Rb = Epi::PERM ? ((R & ~31) + perm32(R & 31)) : R;
        voffA[i] = GATHER ? (unsigned)(C * 2) : (unsigned)(R * K + C) * 2u; voffB[i] = (unsigned)(Rb * K + C) * 2u; rowA[i] = R; }
    const size_t kstep = (size_t)(BK * 2);
    const size_t hstep = (size_t)HALF * K * 2;
    const unsigned ldsw = (unsigned)wid * 1024u;
    const int aoff = lds_byte(wr * 64 + fr, fq * 8), boff = lds_byte(wc * 32 + fr, fq * 8);
#define PG8_SA(b, h) (((b) * 2 + (h)) * HTB)
#define PG8_SB(b, h) ((4 + (b) * 2 + (h)) * HTB)
#define PG8_STAGE(bufoff, gbase, voff) do { _Pragma("unroll") for (int _i = 0; _i < 2; ++_i) \
        __builtin_amdgcn_global_load_lds((const unsigned*)((const char*)(gbase) + (voff)[_i]), (LAS unsigned*)(lds + (bufoff) + ldsw + _i * 8192), 16, 0, 0); } while (0)
#define PG8_STAGE_A(bufoff, gbase, slot, h) do { if constexpr (GATHER) { _Pragma("unroll") for (int _i = 0; _i < 2; ++_i) { const unsigned _ro = gtab[(slot) * 256 + (h) * HALF + rowA[_i]]; \
        __builtin_amdgcn_global_load_lds((const unsigned*)((const char*)(gbase) + _ro + voffA[_i]), (LAS unsigned*)(lds + (bufoff) + ldsw + _i * 8192), 16, 0, 0); } } \
        else { PG8_STAGE(bufoff, (const char*)(gbase) + (h) * hstep, voffA); } } while (0)
#define PG8_LDA(dst, b, h) do { _Pragma("unroll") for (int m = 0; m < 4; ++m) _Pragma("unroll") for (int k = 0; k < 2; ++k) dst[m][k] = *(const LAS bf16x8*)(lds + PG8_SA(b, h) + aoff + m * 2048 + k * 1024); } while (0)
#define PG8_LDB(dst, b, h) do { _Pragma("unroll") for (int n = 0; n < 2; ++n) _Pragma("unroll") for (int k = 0; k < 2; ++k) dst[n][k] = *(const LAS bf16x8*)(lds + PG8_SB(b, h) + boff + n * 2048 + k * 1024); } while (0)
#define PG8_MMA(ai, bj, At, Bt) do { __builtin_amdgcn_s_setprio(1); _Pragma("unroll") for (int m = 0; m < 4; ++m) _Pragma("unroll") for (int n = 0; n < 2; ++n) _Pragma("unroll") for (int k = 0; k < 2; ++k) \
        acc[ai][bj][m][n] = __builtin_amdgcn_mfma_f32_16x16x32_bf16(Bt[n][k], At[m][k], acc[ai][bj][m][n], 0, 0, 0); __builtin_amdgcn_s_setprio(0); } while (0)
#define PG8_WAIT_V(n) asm volatile("s_waitcnt vmcnt(" #n ")" ::: "memory")
#define PG8_WAIT_L(n) asm volatile("s_waitcnt lgkmcnt(" #n ")" ::: "memory")
#define PG8_BAR __builtin_amdgcn_s_barrier()
#define PG8_SCHED __builtin_amdgcn_sched_barrier(0)
    Unit cur, nxt; int ui = 0;
    if (!S.next(0, cur)) return;
    f32x4 acc[2][2][4][2];
#pragma unroll
    for (int a = 0; a < 2; ++a)
#pragma unroll
        for (int b = 0; b < 2; ++b)
#pragma unroll
            for (int m = 0; m < 4; ++m)
#pragma unroll
                for (int n = 0; n < 2; ++n) acc[a][b][m][n] = (f32x4){0.f, 0.f, 0.f, 0.f};
    bf16x8 At[4][2], B0[2][2], B1[2][2];
    const char* cA = (const char*)g.A + (GATHER ? (size_t)0 : S.aoff(cur)); const char* cB = (const char*)g.Bt + S.boff(cur);
    PG8_STAGE(PG8_SB(0, 0), cB, voffB); PG8_STAGE(PG8_SB(0, 1), cB + hstep, voffB); PG8_STAGE_A(PG8_SA(0, 0), cA, 0, 0); PG8_STAGE_A(PG8_SA(0, 1), cA, 0, 1);
    if (wr == 1) PG8_BAR;
    PG8_WAIT_V(2); PG8_BAR;
    PG8_STAGE(PG8_SB(1, 0), cB + kstep, voffB); PG8_STAGE_A(PG8_SA(1, 0), cA + kstep, 0, 0); PG8_STAGE(PG8_SB(1, 1), cB + hstep + kstep, voffB);
    PG8_WAIT_V(6); PG8_BAR;
    for (;;) {
        const bool has_next = S.next(ui + 1, nxt);
        const char* nA = has_next ? (const char*)g.A + (GATHER ? (size_t)0 : S.aoff(nxt)) : cA; const char* nB = has_next ? (const char*)g.Bt + S.boff(nxt) : cB;
        const int nslot = has_next ? nxt.slot : cur.slot, cslot = cur.slot;
        for (int t = 0; t < nt; t += 2) {
            const bool last = (t == nt - 2);
            const char* a1 = cA + (size_t)(t + 1) * kstep;
            const char* a2 = last ? nA : cA + (size_t)(t + 2) * kstep; const char* b2 = last ? nB : cB + (size_t)(t + 2) * kstep;
            const char* a3 = a2 + kstep; const char* b3 = b2 + kstep;
            const int s2 = last ? nslot : cslot;
            PG8_LDB(B0, 0, 0); PG8_LDB(B1, 0, 1); PG8_SCHED; PG8_LDA(At, 0, 0); PG8_STAGE_A(PG8_SA(1, 1), a1, cslot, 1);
            PG8_WAIT_V(8); PG8_WAIT_L(0); PG8_BAR; PG8_MMA(0, 0, At, B0); PG8_MMA(0, 1, At, B1); PG8_BAR; PG8_SCHED;
            PG8_LDA(At, 0, 1); PG8_STAGE(PG8_SB(0, 0), b2, voffB); PG8_STAGE(PG8_SB(0, 1), b2 + hstep, voffB); PG8_STAGE_A(PG8_SA(0, 0), a2, s2, 0);
            PG8_WAIT_V(8); PG8_WAIT_L(0); PG8_BAR; PG8_MMA(1, 0, At, B0); PG8_MMA(1, 1, At, B1); PG8_BAR; PG8_SCHED;
            PG8_LDB(B0, 1, 0); PG8_LDB(B1, 1, 1); PG8_SCHED; PG8_LDA(At, 1, 0); PG8_STAGE_A(PG8_SA(0, 1), a2, s2, 1);
            PG8_WAIT_V(8); PG8_WAIT_L(0); PG8_BAR; PG8_MMA(0, 0, At, B0); PG8_MMA(0, 1, At, B1); PG8_BAR; PG8_SCHED;
            PG8_LDA(At, 1, 1); PG8_STAGE(PG8_SB(1, 0), b3, voffB); PG8_STAGE(PG8_SB(1, 1), b3 + hstep, voffB); PG8_STAGE_A(PG8_SA(1, 0), a3, s2, 0);
            PG8_WAIT_V(8); PG8_WAIT_L(0); PG8_BAR; PG8_MMA(1, 0, At, B0); PG8_MMA(1, 1, At, B1); PG8_BAR; PG8_SCHED;
        }
        if (wr == 0) PG8_BAR;
        E(acc, cur, wr, wc, fr, fq); S.done(cur);
        if (!has_next) break;
#pragma unroll
        for (int a = 0; a < 2; ++a)
#pragma unroll
            for (int b = 0; b < 2; ++b)
#pragma unroll
                for (int m = 0; m < 4; ++m)
#pragma unroll
                    for (int n = 0; n < 2; ++n) acc[a][b][m][n] = (f32x4){0.f, 0.f, 0.f, 0.f};
        cur = nxt; cA = nA; cB = nB; ++ui;
        if (wr == 1) PG8_BAR;
    }
    PG8_WAIT_V(0);
    PG8_BAR;
#undef PG8_SA
#undef PG8_SB
#undef PG8_STAGE
#undef PG8_STAGE_A
#undef PG8_LDA
#undef PG8_LDB
#undef PG8_MMA
#undef PG8_WAIT_V
#undef PG8_WAIT_L
#undef PG8_BAR
#undef PG8_SCHED
}
}

#define XB_TMO      128
#define XB_XCNT(j)  (256  + 64 * (j))
#define XB_XSUB(j)  (1280 + 64 * (j))
#define XB_XGEN(j)  (2304 + 64 * (j))
#define XB_TOP      3328
#define XB_TOPGEN   3392
#define XCD_BAR_WORDS 3456
#define XB_SPIN_CAP (1u << 18)
__device__ __forceinline__ unsigned xb_ld(unsigned* p)              { return __hip_atomic_load(p, __ATOMIC_RELAXED, __HIP_MEMORY_SCOPE_AGENT); }
__device__ __forceinline__ unsigned xb_add(unsigned* p, unsigned v) { return __hip_atomic_fetch_add(p, v, __ATOMIC_RELAXED, __HIP_MEMORY_SCOPE_AGENT); }
__device__ __forceinline__ unsigned xb_xcc_id() { return (unsigned)__builtin_amdgcn_s_getreg((3 << 11) | 20) & 0xFu; }
#define XB_SPIN(cond, bar) do { unsigned _sp = 0; while (cond) { __builtin_amdgcn_s_sleep(1); \
    if ((++_sp & 255u) == 0u) { if (xb_ld(&(bar)[XB_TMO])) break; if (_sp > XB_SPIN_CAP) { atomicAdd(&(bar)[XB_TMO], 1u); break; } } } } while (0)
struct XcdBarrier { unsigned* bar; unsigned x; volatile LAS unsigned* st; };
__device__ __forceinline__ XcdBarrier xcd_barrier_post(unsigned* bar, volatile LAS unsigned* st) {
    XcdBarrier b; b.bar = bar; b.x = xb_xcc_id(); b.st = st;
    if (threadIdx.x == 0) (void)xb_add(&bar[XB_XCNT(b.x)], 1u);
    return b;
}
__device__ __forceinline__ void xcd_barrier_complete(unsigned* bar, unsigned x, unsigned& nloc, unsigned& nx) {
    const unsigned G = gridDim.x * gridDim.y * gridDim.z;
    unsigned sum, cnt, mine, sp = 0u;
    for (;;) {
        sum = 0u; cnt = 0u; mine = 0u;
#pragma unroll
        for (unsigned j = 0; j < 16; ++j) { const unsigned c = xb_ld(&bar[XB_XCNT(j)]); sum += c; cnt += (c > 0u) ? 1u : 0u; mine = (j == x) ? c : mine; }
        if (sum == G) break;
        __builtin_amdgcn_s_sleep(1);
        if ((++sp & 255u) == 0u) { if (xb_ld(&bar[XB_TMO])) break; if (sp > XB_SPIN_CAP) { atomicAdd(&bar[XB_TMO], 1u); break; } }
    }
    nloc = mine > 0u ? mine : 1u; nx = cnt > 0u ? cnt : 1u;
}
__device__ __forceinline__ void xcd_barrier(const XcdBarrier& b) {
    asm volatile("s_waitcnt vmcnt(0)" ::: "memory");
    __syncthreads();
    if (threadIdx.x == 0) {
        unsigned* bar = b.bar;
        __builtin_amdgcn_s_waitcnt(0);
        unsigned nloc = b.st[0], nx = b.st[1];
        if (nloc == 0u) { xcd_barrier_complete(bar, b.x, nloc, nx); b.st[0] = nloc; b.st[1] = nx; }
        const unsigned old = xb_add(&bar[XB_XSUB(b.x)], 1u);
        const unsigned gen = old / nloc;
        if (old + 1u == (gen + 1u) * nloc) {
            __builtin_amdgcn_fence(__ATOMIC_RELEASE, "agent");
            asm volatile("s_waitcnt vmcnt(0)" ::: "memory");
            const unsigned og = xb_add(&bar[XB_TOP], 1u);
            const unsigned tg = og / nx;
            if (og + 1u == (tg + 1u) * nx) xb_add(&bar[XB_TOPGEN], 1u);
            else XB_SPIN(xb_ld(&bar[XB_TOPGEN]) == tg, bar);
            __builtin_amdgcn_fence(__ATOMIC_ACQUIRE, "agent");
            xb_add(&bar[XB_XGEN(b.x)], 1u);
            asm volatile("s_waitcnt vmcnt(0)" ::: "memory");
        } else {
            XB_SPIN(xb_ld(&bar[XB_XGEN(b.x)]) == gen, bar);
            __builtin_amdgcn_fence(__ATOMIC_ACQUIRE, "agent");
            asm volatile("s_waitcnt vmcnt(0)" ::: "memory");
        }
    }
    __syncthreads();
}

struct Args { const float* in[27]; float* out; unsigned char* ws; unsigned char* dsb; int ph_lo, ph_hi; };
struct Frame {
    LAS unsigned char* lds; volatile LAS unsigned* MISC; gu32* ctl;
    int tid, lane, wave, vcu, G;
    const float* const* in; float* out; unsigned char* ws; unsigned char* dsb;
};

__device__ __forceinline__ void p0_transpose_item(const float* W, int N, bf16* WT, int ldt, int k0, int n0, int drow0, LAS unsigned* Tl, int lane) {
    const int kq = lane >> 3, c4 = lane & 7;
    f32x4 a[4], b[4];
#pragma unroll
    for (int i = 0; i < 4; ++i) { const float* p = W + (size_t)(k0 + 16 * i + 2 * kq) * N + n0 + 4 * c4; a[i] = *(const f32x4*)p; b[i] = *(const f32x4*)(p + N); }
#pragma unroll
    for (int i = 0; i < 4; ++i)
#pragma unroll
        for (int j = 0; j < 4; ++j) Tl[(4 * c4 + j) * 32 + ((8 * i + kq) ^ (4 * c4))] = pk2(a[i][j], b[i][j]);
    LDS_WAIT(); asm volatile("" ::: "memory");
#pragma unroll
    for (int jj = 0; jj < 4; ++jj) { const int n = (lane >> 3) + 8 * jj, c = lane & 7;
        const v4u o = *(const LAS v4u*)(Tl + n * 32 + 4 * (c ^ (n >> 2)));
        *(GAS v4u*)(WT + (size_t)(drow0 + n) * ldt + k0 + 8 * c) = o; }
    LDS_WAIT(); asm volatile("" ::: "memory");
}
__device__ __forceinline__ void ph1_hrows(Frame& F);
__device__ __forceinline__ void ph0_prologue(Frame& F) {
    const float* c = F.in[1]; const float* wada = F.in[2]; const float* bada = F.in[3];
    float* mod = (float*)(F.ws + WS_MOD);
    LAS float* sc = (LAS float*)(F.lds);
    LAS float* red = (LAS float*)(F.lds + 8192);
    for (int i = F.tid; i < 2 * D; i += NTHR) sc[i] = siluf_(c[i]);
    __syncthreads();
    for (int slab = F.vcu; slab < 256; slab += F.G) {
        const int n0 = slab * 24;
        if (F.tid < 510) {
            const int kq = F.tid / 6, c4 = F.tid % 6; float a[2][4];
#pragma unroll
            for (int b = 0; b < 2; ++b)
#pragma unroll
                for (int j = 0; j < 4; ++j) a[b][j] = 0.f;
            for (int k = kq; k < D; k += 85) { const f32x4 w = *(const f32x4*)(wada + (size_t)k * 6144 + n0 + 4 * c4); const float s0 = sc[k], s1 = sc[D + k];
#pragma unroll
                for (int j = 0; j < 4; ++j) { a[0][j] += s0 * w[j]; a[1][j] += s1 * w[j]; } }
#pragma unroll
            for (int b = 0; b < 2; ++b)
#pragma unroll
                for (int j = 0; j < 4; ++j) red[(kq * 6 + c4) * 8 + b * 4 + j] = a[b][j];
        }
        __syncthreads();
        if (F.tid < 48) { const int b = F.tid / 24, col = F.tid % 24, c4 = col >> 2, j = col & 3; float s = 0.f;
            for (int kq = 0; kq < 85; ++kq) s += red[(kq * 6 + c4) * 8 + b * 4 + j];
            mod[b * 6144 + n0 + col] = s + bada[n0 + col]; }
        __syncthreads();
    }
    VM_WAIT(); __syncthreads();
    if (F.tid == 0) { __builtin_amdgcn_fence(__ATOMIC_RELEASE, "agent"); VM_WAIT(); __hip_atomic_fetch_add(F.ctl + CW_MODCNT, 1u, RLX_AGENT); }
    const int gt = F.vcu * NTHR + F.tid, NGT = F.G * NTHR;
    if (gt < DH) { const float* g = F.in[9]; ((float*)(F.ws + WS_LB))[gt] = 1.f / (1.f + __expf(g[DH + gt] - g[gt])); }
    for (int e = gt; e < 48 * D; e += NGT) { const int n = e >> 10, kk = e & 1023; const float wv = n < NG ? F.in[20][kk * NG + n] : n < NG + NE ? F.in[22][kk * NE + n - NG] : 0.f;
        const unsigned hi = f2bf(wv); ((bf16*)(F.ws + WS_RRH))[e] = (bf16)hi; ((bf16*)(F.ws + WS_RRL))[e] = (bf16)f2bf(wv - bf2f(hi)); }
    for (int e = gt; e < 2 * 8 * 64 * 64; e += NGT) { const int which = e >> 15, r = e & 32767, blk = r >> 12, j = (r >> 6) & 63, i = r & 63;
        const float* w = which ? F.in[15] : F.in[13]; ((bf16*)(F.ws + (which ? WS_WIT : WS_WRT)))[r] = (bf16)f2bf(w[(size_t)(blk * 64 + i) * 64 + j]); }
    LAS unsigned* scr = (LAS unsigned*)(F.lds + 32768 + F.wave * 4096);
    const int gw = F.vcu * NWAVES + F.wave, NGW = F.G * NWAVES;
    constexpr int I_IN = 16 * 96, I_OUT = 16 * 32, I_E = 256 + 256 + 256, NITEMS = I_IN + I_OUT + NE * I_E;
    for (int it = gw; it < NITEMS; it += NGW) {
        int r = it;
        if (r < I_IN) { const int kb = r / 96, nb = r % 96; p0_transpose_item(F.in[8], DIN, (bf16*)(F.ws + WS_WIN), D, 64 * kb, 32 * nb, 32 * nb, scr, F.lane); continue; } r -= I_IN;
        if (r < I_OUT) { const int kb = r / 32, nb = r % 32; p0_transpose_item(F.in[19], D, (bf16*)(F.ws + WS_WOUT), D, 64 * kb, 32 * nb, 32 * nb, scr, F.lane); continue; } r -= I_OUT;
        const int e = r / I_E; r -= e * I_E;
        if (r < 512) { const int w3 = r >> 8, q = r & 255, kb = q >> 4, nb = q & 15, n0 = 32 * nb;
            p0_transpose_item((w3 ? F.in[25] : F.in[24]) + (size_t)e * D * DE, DE, (bf16*)(F.ws + WS_W13) + (size_t)e * D * D, D, 64 * kb, n0, (n0 >> 7) * 256 + (n0 & 127) + 128 * w3, scr, F.lane); }
        else { const int q = r - 512, kb = q >> 5, nb = q & 31;
            p0_transpose_item(F.in[26] + (size_t)e * DE * D, D, (bf16*)(F.ws + WS_W2) + (size_t)e * D * DE, DE, 64 * kb, 32 * nb, 32 * nb, scr, F.lane); }
    }
    if (F.tid < 64) { unsigned sp = 0;
        while ((unsigned)__builtin_amdgcn_readfirstlane(__hip_atomic_load(F.ctl + CW_MODCNT, RLX_AGENT)) < (unsigned)F.G) { __builtin_amdgcn_s_sleep(2); if (++sp > (1u << 20)) break; }
        __builtin_amdgcn_fence(__ATOMIC_ACQUIRE, "agent"); VM_WAIT(); }
    __syncthreads();
    ph1_hrows(F);
}

__device__ __forceinline__ void ph1_hrows(Frame& F) {
    const float* x = F.in[0]; const float* g = F.in[4]; const float* mod = (const float*)(F.ws + WS_MOD); bf16* H = (bf16*)(F.ws + WS_H);
    const int gw = F.vcu * NWAVES + F.wave, NGW = F.G * NWAVES;
    for (int m0 = gw; m0 < T / 2; m0 += NGW) {
        int lane = F.lane; asm volatile("" : "+v"(lane));
        f32x4 v[2][4];
#pragma unroll
        for (int r = 0; r < 2; ++r)
#pragma unroll
            for (int j = 0; j < 4; ++j) v[r][j] = ((const GAS f32x4*)(x + (size_t)(m0 + r * (T / 2)) * D) + lane)[64 * j];
#pragma unroll
        for (int r = 0; r < 2; ++r) { const int m = m0 + r * (T / 2); const float* sh = mod + r * 6144; const float* sc = sh + 1024; float s = 0.f;
#pragma unroll
            for (int j = 0; j < 4; ++j) s += v[r][j].x * v[r][j].x + v[r][j].y * v[r][j].y + v[r][j].z * v[r][j].z + v[r][j].w * v[r][j].w;
            const float rstd = rsqrtf(wave_sum(s) * (1.f / D) + EPS);
            GAS unsigned long long* o8 = (GAS unsigned long long*)(H + (size_t)m * D) + lane;
#pragma unroll
            for (int j = 0; j < 4; ++j) { const int c0 = 4 * lane + 256 * j; const f32x4 gg = *(const f32x4*)(g + c0), s1 = *(const f32x4*)(sc + c0), h1 = *(const f32x4*)(sh + c0);
                const float a0 = v[r][j].x * rstd * gg.x * (1.f + s1.x) + h1.x, a1 = v[r][j].y * rstd * gg.y * (1.f + s1.y) + h1.y, a2 = v[r][j].z * rstd * gg.z * (1.f + s1.z) + h1.z, a3 = v[r][j].w * rstd * gg.w * (1.f + s1.w) + h1.w;
                o8[64 * j] = (unsigned long long)pk2(a0, a1) | ((unsigned long long)pk2(a2, a3) << 32); } }
    }
}

constexpr int L_GT = 0;
constexpr int L_QTL = 4096;
constexpr int L_QH = L_QTL + 17408;
constexpr int L_KH = L_QH + 17408;
constexpr int L_VT = L_KH + 17408;
constexpr int L_P = L_VT + 18432;
constexpr int L_SSQ = L_P + 9216;
constexpr int L_RSTD = L_SSQ + 2048;
constexpr int L_OT = L_RSTD + 256;
constexpr int L_KT = L_QTL;
static_assert(L_OT + 17408 <= RING_BYTES, "mixer LDS map");

struct HgLoad { unsigned lf[8], ki[8], vv[8], q[8]; };
template <bool NEEDQ>
__device__ __forceinline__ void hg_load(Frame& F, int t0, int h, HgLoad& L) {
    const bf16* PJ = (const bf16*)(F.ws + WS_PROJ); const size_t base = (size_t)(t0 + 8 * F.wave) * DH + h * HD + 2 * (F.tid & 63);
#pragma unroll
    for (int i = 0; i < 8; ++i) { const size_t o = base + (size_t)i * DH; L.lf[i] = *(const unsigned*)(PJ + PROJ_S + o); L.ki[i] = *(const unsigned*)(PJ + 2 * PROJ_S + o); L.vv[i] = *(const unsigned*)(PJ + 3 * PROJ_S + o);
        if (NEEDQ) L.q[i] = *(const unsigned*)(PJ + o); }
}
__device__ __forceinline__ void hg_cumsum(Frame& F, const HgLoad& L, float (&c0)[8], float (&c1)[8], float (&off)[2], float (&bmid)[2], float (&blast)[2]) {
    LAS float* GT = (LAS float*)(F.lds + L_GT); const int kp = F.tid & 63, w = F.wave;
    float r0 = 0.f, r1 = 0.f;
#pragma unroll
    for (int i = 0; i < 8; ++i) { r0 += bf2f(L.lf[i] & 0xffffu); r1 += bf2f(L.lf[i] >> 16); c0[i] = r0; c1[i] = r1; }
    *(LAS f32x2_t*)(GT + w * 128 + 2 * kp) = (f32x2_t){r0, r1};
    __syncthreads();
    float a0 = 0.f, a1 = 0.f; off[0] = 0.f; off[1] = 0.f; bmid[0] = 0.f; bmid[1] = 0.f;
#pragma unroll
    for (int g = 0; g < 8; ++g) { const f32x2_t v = *(const LAS f32x2_t*)(GT + g * 128 + 2 * kp); if (g == w) { off[0] = a0; off[1] = a1; } a0 += v.x; a1 += v.y; if (g == 3) { bmid[0] = a0; bmid[1] = a1; } }
    blast[0] = a0; blast[1] = a1;
}
__device__ __forceinline__ void hg_store_vt(Frame& F, const HgLoad& L, LAS bf16* VT) {
    const int kp = F.tid & 63, w = F.wave; v4u lo, hi;
    lo.x = (L.vv[0] & 0xffffu) | (L.vv[1] << 16); lo.y = (L.vv[2] & 0xffffu) | (L.vv[3] << 16); lo.z = (L.vv[4] & 0xffffu) | (L.vv[5] << 16); lo.w = (L.vv[6] & 0xffffu) | (L.vv[7] << 16);
    hi.x = (L.vv[0] >> 16) | (L.vv[1] & 0xffff0000u); hi.y = (L.vv[2] >> 16) | (L.vv[3] & 0xffff0000u); hi.z = (L.vv[4] >> 16) | (L.vv[5] & 0xffff0000u); hi.w = (L.vv[6] >> 16) | (L.vv[7] & 0xffff0000u);
    *(LAS v4u*)(VT + (2 * kp) * 72 + 8 * w) = lo; *(LAS v4u*)(VT + (2 * kp + 1) * 72 + 8 * w) = hi;
}

template <bool FINAL>
__device__ __forceinline__ void rg_wave_task(Frame& F, int b, int n, int cb, unsigned (&valpk)[32]) {
    const int lane = F.lane, fr = lane & 15, fq = lane >> 4, c0 = 64 * cb; const int t0 = b * SEQ + 64 * n;
    const bf16* XR = (const bf16*)(F.ws + WS_PROJ) + 5 * PROJ_S; const bf16* YR = (const bf16*)(F.ws + WS_PROJ) + 6 * PROJ_S;
    const bf16* WRT = (const bf16*)(F.ws + WS_WRT); const bf16* WIT = (const bf16*)(F.ws + WS_WIT);
    bf16x8 IDf[2][2];
    v4u xq[2][4], gq[2];
#define RG_LOAD_TILE(tt_) do { const int tl_ = 16 * (tt_) + fr, tp_ = 64 * n + tl_; _Pragma("unroll") for (int ks = 0; ks < 2; ++ks) { const int cc = c0 + 32 * ks + 8 * fq; \
        _Pragma("unroll") for (int tap = 0; tap < 4; ++tap) { const bool ok_ = (tp_ - 3 + tap >= 0); const v4u x_ = *(const v4u*)(XR + (size_t)(t0 + (ok_ ? tl_ - 3 + tap : 0)) * DH + cc); \
            xq[ks][tap] = (v4u){ok_ ? x_.x : 0u, ok_ ? x_.y : 0u, ok_ ? x_.z : 0u, ok_ ? x_.w : 0u}; } \
        if (FINAL) gq[ks] = *(const v4u*)(YR + (size_t)(t0 + tl_) * DH + cc); } } while (0)
    RG_LOAD_TILE(0);
    LAS unsigned char* wl = F.lds + F.wave * 16384; LAS float* cwl = (LAS float*)(F.lds + RING_BYTES + F.wave * 2048);
#pragma unroll
    for (int p = 0; p < 8; ++p) { const int pc = p * 64 + lane, j = pc >> 3, sl = pc & 7; const size_t o = (size_t)(c0 + j) * 64 + 8 * sl;
        *(LAS v4u*)(wl + j * 128 + ((sl ^ (j & 7)) << 4)) = *(const v4u*)(WRT + o); *(LAS v4u*)(wl + 8192 + j * 128 + ((sl ^ (j & 7)) << 4)) = *(const v4u*)(WIT + o); }
#pragma unroll
    for (int tap = 0; tap < 4; ++tap) cwl[tap * 64 + lane] = F.in[11][tap * DR + c0 + lane];
    cwl[256 + lane] = F.in[12][c0 + lane];
    LDS_WAIT();
#pragma unroll
    for (int ks = 0; ks < 2; ++ks)
#pragma unroll
        for (int c2 = 0; c2 < 2; ++c2) { bf16x8 v;
#pragma unroll
            for (int j = 0; j < 8; ++j) v[j] = (short)((8 * fq + j == 16 * c2 + fr) ? 0x3F80 : 0);
            IDf[ks][c2] = v; }
    float br[4], bi[4], ls8[4], hrun[4], arun[4];
#pragma unroll
    for (int ct = 0; ct < 4; ++ct) { const int c = c0 + 16 * ct + fr; br[ct] = F.in[14][c]; bi[ct] = F.in[16][c]; const float lam = F.in[17][c]; ls8[ct] = -8.f * log1pf(__expf(-lam));
        hrun[ct] = FINAL ? ((const float*)(F.ws + WS_CARRY))[(size_t)(b * NCH + n) * DR + c] : 0.f; arun[ct] = 1.f; }
#pragma unroll
    for (int tt = 0; tt < 4; ++tt) {
        bf16x8 AX[2], AG[2];
#pragma unroll
        for (int ks = 0; ks < 2; ++ks) { const int cl = 32 * ks + 8 * fq; float xc[8];
            { const f32x4 b0 = *(const LAS f32x4*)(cwl + 256 + cl), b1 = *(const LAS f32x4*)(cwl + 256 + cl + 4); xc[0] = b0[0]; xc[1] = b0[1]; xc[2] = b0[2]; xc[3] = b0[3]; xc[4] = b1[0]; xc[5] = b1[1]; xc[6] = b1[2]; xc[7] = b1[3]; }
#pragma unroll
            for (int tap = 0; tap < 4; ++tap) { const v4u xv = xq[ks][tap];
                const f32x4 w0 = *(const LAS f32x4*)(cwl + tap * 64 + cl), w1 = *(const LAS f32x4*)(cwl + tap * 64 + cl + 4);
                xc[0] += w0[0] * bf2f(xv.x & 0xffffu); xc[1] += w0[1] * bf2f(xv.x >> 16); xc[2] += w0[2] * bf2f(xv.y & 0xffffu); xc[3] += w0[3] * bf2f(xv.y >> 16);
                xc[4] += w1[0] * bf2f(xv.z & 0xffffu); xc[5] += w1[1] * bf2f(xv.z >> 16); xc[6] += w1[2] * bf2f(xv.w & 0xffffu); xc[7] += w1[3] * bf2f(xv.w >> 16); }
            v4u pk; pk.x = pk2(xc[0], xc[1]); pk.y = pk2(xc[2], xc[3]); pk.z = pk2(xc[4], xc[5]); pk.w = pk2(xc[6], xc[7]); AX[ks] = __builtin_bit_cast(bf16x8, pk);
            if (FINAL) AG[ks] = __builtin_bit_cast(bf16x8, gq[ks]);
        }
        if (tt < 3) RG_LOAD_TILE(tt + 1);
        asm volatile("" ::: "memory");
#pragma unroll
        for (int ct = 0; ct < 4; ++ct) {
            f32x4 aR = {0.f, 0.f, 0.f, 0.f}, aI = {0.f, 0.f, 0.f, 0.f}, aX = {0.f, 0.f, 0.f, 0.f}, aG = {0.f, 0.f, 0.f, 0.f};
#pragma unroll
            for (int ks = 0; ks < 2; ++ks) { const int jr = 16 * ct + fr, so = jr * 128 + (((4 * ks + fq) ^ (jr & 7)) << 4);
                const bf16x8 wr_ = *(const LAS bf16x8*)(wl + so), wi_ = *(const LAS bf16x8*)(wl + 8192 + so);
                aR = __builtin_amdgcn_mfma_f32_16x16x32_bf16(AX[ks], wr_, aR, 0, 0, 0); aI = __builtin_amdgcn_mfma_f32_16x16x32_bf16(AX[ks], wi_, aI, 0, 0, 0); }
            aX = __builtin_amdgcn_mfma_f32_16x16x32_bf16(AX[ct >> 1], IDf[ct >> 1][ct & 1], aX, 0, 0, 0);
            if (FINAL) aG = __builtin_amdgcn_mfma_f32_16x16x32_bf16(AG[ct >> 1], IDf[ct >> 1][ct & 1], aG, 0, 0, 0);
            float a[4], u[4];
#pragma unroll
            for (int r = 0; r < 4; ++r) { const float rr = sigmoidf_(aR[r] + br[ct]), ii = sigmoidf_(aI[r] + bi[ct]); const float la = rr * ls8[ct]; a[r] = __expf(la);
                const float x2 = 2.f * la; const float em = (x2 > -0.03f) ? -x2 * (1.f + x2 * (0.5f + x2 * (0.16666667f + x2 * 0.041666667f))) : 1.f - a[r] * a[r];
                u[r] = sqrtf(em) * (ii * aX[r]); }
            float Af = a[0] * a[1] * a[2] * a[3], Hf = ((u[0] * a[1] + u[1]) * a[2] + u[2]) * a[3] + u[3];
            { const float Ap = __shfl_up(Af, 16), Hp = __shfl_up(Hf, 16); if (fq >= 1) { Hf = Af * Hp + Hf; Af = Ap * Af; } }
            { const float Ap = __shfl_up(Af, 32), Hp = __shfl_up(Hf, 32); if (fq >= 2) { Hf = Af * Hp + Hf; Af = Ap * Af; } }
            float Aex = __shfl_up(Af, 16), Hex = __shfl_up(Hf, 16); if (fq == 0) { Aex = 1.f; Hex = 0.f; }
            const float Atot = __shfl(Af, 48 + fr), Htot = __shfl(Hf, 48 + fr);
            if (FINAL) { float h = Aex * hrun[ct] + Hex;
#pragma unroll
                for (int r = 0; r < 4; ++r) { h = a[r] * h + u[r]; u[r] = h * aG[r]; }
                valpk[(tt * 4 + ct) * 2] = pk2(u[0], u[1]); valpk[(tt * 4 + ct) * 2 + 1] = pk2(u[2], u[3]); }
            hrun[ct] = Atot * hrun[ct] + Htot; arun[ct] *= Atot;
        }
    }
#undef RG_LOAD_TILE
    if (!FINAL && fq == 0) {
#pragma unroll
        for (int ct = 0; ct < 4; ++ct) { const size_t o = (size_t)(b * NCH + n) * DR + c0 + 16 * ct + fr; ((float*)(F.ws + WS_RGA))[o] = arun[ct]; ((float*)(F.ws + WS_RGH))[o] = hrun[ct]; }
    }
}

__device__ __forceinline__ void ph3_passA(Frame& F, int cn_rot = 0) {
    bf16* DS = (bf16*)F.dsb; float* DDp = (float*)(F.ws + WS_DD);
    const int lane = F.lane, w = F.wave, fr = lane & 15, fq = lane >> 4, kp = F.tid & 63;
    LAS bf16* KT = (LAS bf16*)(F.lds + L_KT); LAS bf16* VT = (LAS bf16*)(F.lds + L_VT);
    { const int cn = (F.vcu + cn_rot) & 255;
        const int b = cn / NCH, n = cn % NCH, t0 = b * SEQ + 64 * n;
        HgLoad L; hg_load<false>(F, t0, 0, L);
        { unsigned dummy[32]; rg_wave_task<false>(F, b, n, w, dummy); }
        __syncthreads();
#pragma unroll
        for (int h = 0; h < NH; ++h) {
            const int task = (b * NH + h) * NCH + n;
            float c0[8], c1[8], off[2], bmid[2], blast[2]; hg_cumsum(F, L, c0, c1, off, bmid, blast);
            unsigned k0p[4], k1p[4];
#pragma unroll
            for (int i = 0; i < 8; i += 2) {
                const float a0 = bf2f(L.ki[i] & 0xffffu) * __expf(blast[0] - (off[0] + c0[i])), a1 = bf2f(L.ki[i + 1] & 0xffffu) * __expf(blast[0] - (off[0] + c0[i + 1]));
                const float d0 = bf2f(L.ki[i] >> 16) * __expf(blast[1] - (off[1] + c1[i])), d1 = bf2f(L.ki[i + 1] >> 16) * __expf(blast[1] - (off[1] + c1[i + 1]));
                k0p[i >> 1] = pk2(a0, a1); k1p[i >> 1] = pk2(d0, d1); }
            *(LAS v4u*)(KT + (2 * kp) * 72 + 8 * w) = (v4u){k0p[0], k0p[1], k0p[2], k0p[3]}; *(LAS v4u*)(KT + (2 * kp + 1) * 72 + 8 * w) = (v4u){k1p[0], k1p[1], k1p[2], k1p[3]};
            hg_store_vt(F, L, VT);
            if (w == 0) *(f32x2_t*)(DDp + (size_t)task * HD + 2 * kp) = (f32x2_t){__expf(blast[0]), __expf(blast[1])};
            if (h + 1 < NH) hg_load<false>(F, t0, h + 1, L);
            __syncthreads();
            bf16x8 bV[2];
#pragma unroll
            for (int ss = 0; ss < 2; ++ss) bV[ss] = *(const LAS bf16x8*)(VT + (16 * w + fr) * 72 + 8 * fq + 32 * ss);
#pragma unroll
            for (int kt = 0; kt < 8; ++kt) { f32x4 acc = {0.f, 0.f, 0.f, 0.f};
#pragma unroll
                for (int ss = 0; ss < 2; ++ss) { const bf16x8 a = *(const LAS bf16x8*)(KT + (16 * kt + fr) * 72 + 8 * fq + 32 * ss); acc = __builtin_amdgcn_mfma_f32_16x16x32_bf16(a, bV[ss], acc, 0, 0, 0); }
                *(v2u*)(DS + (size_t)task * (HD * HD) + (size_t)(16 * w + fr) * HD + 16 * kt + 4 * fq) = (v2u){pk2m(acc[0], acc[1]), pk2m(acc[2], acc[3])}; }
            __syncthreads();
        }
    }
}

__device__ __forceinline__ void ph4_passB(Frame& F) {
    const bf16* DS = (const bf16*)F.dsb; bf16* SST = (bf16*)F.dsb + (size_t)BATCH * NH * NCH * HD * HD; const float* DDp = (const float*)(F.ws + WS_DD);
    const int gt = F.vcu * NTHR + F.tid, NGT = F.G * NTHR;
    for (int idx = gt; idx < BATCH * NH * HD * HD / 2 + BATCH * DR; idx += NGT) {
        if (idx < BATCH * NH * HD * HD / 2) {
            const int bh = idx >> 13, pr = idx & 8191, e0 = 2 * pr, kk = e0 & 127;
            float s0 = 0.f, s1 = 0.f;
            const bf16* dsp = DS + (size_t)bh * NCH * (HD * HD) + e0; bf16* sp = SST + (size_t)bh * NCH * (HD * HD) + e0; const float* ddp = DDp + (size_t)bh * NCH * HD + kk;
#pragma unroll 1
            for (int n0 = 0; n0 < NCH; n0 += 8) {
                unsigned dsv[8]; float d0[8], d1[8];
#pragma unroll
                for (int j = 0; j < 8; ++j) { dsv[j] = *(const unsigned*)(dsp + (size_t)(n0 + j) * (HD * HD)); d0[j] = ddp[(n0 + j) * HD]; d1[j] = ddp[(n0 + j) * HD + 1]; }
#pragma unroll
                for (int j = 0; j < 8; ++j) { *(unsigned*)(sp + (size_t)(n0 + j) * (HD * HD)) = pk2(s0, s1);
                    s0 = d0[j] * s0 + bf2f(dsv[j] & 0xffffu); s1 = d1[j] * s1 + bf2f(dsv[j] >> 16); }
            }
        } else {
            const int r = idx - BATCH * NH * HD * HD / 2, b = r / DR, c = r % DR;
            const float* A = (const float*)(F.ws + WS_RGA) + (size_t)b * NCH * DR + c; const float* Hh = (const float*)(F.ws + WS_RGH) + (size_t)b * NCH * DR + c; float* C = (float*)(F.ws + WS_CARRY) + (size_t)b * NCH * DR + c;
            float carry = 0.f;
#pragma unroll 4
            for (int n = 0; n < NCH; ++n) { C[(size_t)n * DR] = carry; carry = A[(size_t)n * DR] * carry + Hh[(size_t)n * DR]; }
        }
    }
}

__device__ __forceinline__ void ph5_passC(Frame& F, int cn_rot = 0) {
    const bf16* PJ = (const bf16*)(F.ws + WS_PROJ); const bf16* GZ = PJ + 4 * PROJ_S;
    const bf16* SST = (const bf16*)F.dsb + (size_t)BATCH * NH * NCH * HD * HD; bf16* O = (bf16*)(F.ws + WS_H);
    const int tid = F.tid, lane = F.lane, w = F.wave, fr = lane & 15, fq = lane >> 4, kp = tid & 63;
    LAS bf16* QTL = (LAS bf16*)(F.lds + L_QTL); LAS bf16* QH = (LAS bf16*)(F.lds + L_QH); LAS bf16* KH = (LAS bf16*)(F.lds + L_KH);
    LAS bf16* VT = (LAS bf16*)(F.lds + L_VT); LAS bf16* Pm = (LAS bf16*)(F.lds + L_P); LAS float* SSQ = (LAS float*)(F.lds + L_SSQ); LAS float* RSTD = (LAS float*)(F.lds + L_RSTD);
    { const int cn = (F.vcu + cn_rot) & 255;
        const int b = cn / NCH, n = cn % NCH, t0 = b * SEQ + 64 * n;
        {
            LAS float* SSQ = (LAS float*)(F.lds + X_GTAB); LAS float* RSTD = SSQ + 512;
            unsigned valpk[32];
            for (int rrg = 0; rrg < PROBE_RG5; ++rrg) rg_wave_task<true>(F, b, n, w, valpk);
#pragma unroll
            for (int tt = 0; tt < 4; ++tt) { float s[4] = {0.f, 0.f, 0.f, 0.f};
#pragma unroll
                for (int ct = 0; ct < 4; ++ct) { const unsigned p0 = valpk[(tt * 4 + ct) * 2], p1 = valpk[(tt * 4 + ct) * 2 + 1]; const float v0 = bf2f(p0 & 0xffffu), v1 = bf2f(p0 >> 16), v2 = bf2f(p1 & 0xffffu), v3 = bf2f(p1 >> 16);
                    s[0] += v0 * v0; s[1] += v1 * v1; s[2] += v2 * v2; s[3] += v3 * v3; }
#pragma unroll
                for (int r = 0; r < 4; ++r) { float x = s[r]; x += __shfl_xor(x, 1); x += __shfl_xor(x, 2); x += __shfl_xor(x, 4); x += __shfl_xor(x, 8); if (fr == 0) SSQ[(16 * tt + 4 * fq + r) * 8 + w] = x; } }
            __syncthreads();
            if (tid < 64) { float s = 0.f;
#pragma unroll
                for (int i = 0; i < 8; ++i) s += SSQ[tid * 8 + i];
                RSTD[tid] = rsqrtf(s * (1.f / DR) + EPS); }
            __syncthreads();
            { LAS bf16* VL = (LAS bf16*)(F.lds + w * 16384);
#pragma unroll
              for (int tt = 0; tt < 4; ++tt)
#pragma unroll
                  for (int ct = 0; ct < 4; ++ct) { const unsigned p0 = valpk[(tt * 4 + ct) * 2], p1 = valpk[(tt * 4 + ct) * 2 + 1]; const int tb = 16 * tt + 4 * fq, ch = 16 * ct + fr;
                      VL[(tb + 0) * 72 + ch] = (bf16)(p0 & 0xffffu); VL[(tb + 1) * 72 + ch] = (bf16)(p0 >> 16); VL[(tb + 2) * 72 + ch] = (bf16)(p1 & 0xffffu); VL[(tb + 3) * 72 + ch] = (bf16)(p1 >> 16); }
              LDS_WAIT();
              const int pc = lane & 7; const f32x4 g0 = *(const f32x4*)(F.in[18] + 64 * w + 8 * pc), g1 = *(const f32x4*)(F.in[18] + 64 * w + 8 * pc + 4);
#pragma unroll
              for (int p = 0; p < 8; ++p) { const int row = 8 * p + (lane >> 3); const v4u vv = *(const LAS v4u*)(VL + row * 72 + 8 * pc); const float rs = RSTD[row];
                  v4u o; o.x = pk2(bf2f(vv.x & 0xffffu) * rs * g0[0], bf2f(vv.x >> 16) * rs * g0[1]); o.y = pk2(bf2f(vv.y & 0xffffu) * rs * g0[2], bf2f(vv.y >> 16) * rs * g0[3]);
                  o.z = pk2(bf2f(vv.z & 0xffffu) * rs * g1[0], bf2f(vv.z >> 16) * rs * g1[1]); o.w = pk2(bf2f(vv.w & 0xffffu) * rs * g1[2], bf2f(vv.w >> 16) * rs * g1[3]);
                  *(v4u*)(O + (size_t)(t0 + row) * D + DH + 64 * w + 8 * pc) = o; } }
            __syncthreads();
        }
        HgLoad L; hg_load<true>(F, t0, 0, L);
        LAS bf16* OT = (LAS bf16*)(F.lds + L_OT);
#pragma unroll 1
        for (int hx = 0; hx < NH * PROBE_H5; ++hx) { const int h = hx & (NH - 1);
            const int task = (b * NH + h) * NCH + n;
            const int pr0 = tid >> 4, pc0 = (tid & 15) * 8;
            const v4u gz0 = *(const v4u*)(GZ + (size_t)(t0 + pr0) * DH + h * HD + pc0), gz1 = *(const v4u*)(GZ + (size_t)(t0 + pr0 + 32) * DH + h * HD + pc0);
            bf16x8 bS[4];
#pragma unroll
            for (int ks = 0; ks < 4; ++ks) bS[ks] = *(const bf16x8*)(SST + (size_t)task * (HD * HD) + (size_t)(16 * w + fr) * HD + 8 * fq + 32 * ks);
            float c0[8], c1[8], off[2], bmid[2], blast[2]; hg_cumsum(F, L, c0, c1, off, bmid, blast);
#pragma unroll
            for (int i = 0; i < 8; ++i) { const int tl = 8 * w + i; const float b0 = off[0] + c0[i], b1 = off[1] + c1[i];
                const float q0 = bf2f(L.q[i] & 0xffffu), q1 = bf2f(L.q[i] >> 16), k0 = bf2f(L.ki[i] & 0xffffu), k1 = bf2f(L.ki[i] >> 16);
                const float eq0 = __expf(fminf(b0 - bmid[0], 80.f)), eq1 = __expf(fminf(b1 - bmid[1], 80.f)), ek0 = __expf(fminf(bmid[0] - b0, 80.f)), ek1 = __expf(fminf(bmid[1] - b1, 80.f));
                *(LAS unsigned*)(QH + tl * 136 + 2 * kp) = pk2(q0 * eq0, q1 * eq1); *(LAS unsigned*)(KH + tl * 136 + 2 * kp) = pk2(k0 * ek0, k1 * ek1);
                *(LAS unsigned*)(QTL + tl * 136 + 2 * kp) = pk2(q0 * __expf(b0), q1 * __expf(b1)); }
            hg_store_vt(F, L, VT);
            if (hx + 1 < NH * PROBE_H5) hg_load<true>(F, t0, (hx + 1) & (NH - 1), L);
            __syncthreads();
#pragma unroll
            for (int pp = 0; pp < 2; ++pp) { const int pi = 2 * w + pp, iq = pi >> 2, jk = pi & 3; f32x4 acc = {0.f, 0.f, 0.f, 0.f};
                if (jk <= iq) {
#pragma unroll
                    for (int ks = 0; ks < 4; ++ks) { const bf16x8 a = *(const LAS bf16x8*)(KH + (16 * jk + fr) * 136 + 8 * fq + 32 * ks); const bf16x8 bq = *(const LAS bf16x8*)(QH + (16 * iq + fr) * 136 + 8 * fq + 32 * ks);
                        acc = __builtin_amdgcn_mfma_f32_16x16x32_bf16(a, bq, acc, 0, 0, 0); }
                    if (jk == iq) {
#pragma unroll
                        for (int r = 0; r < 4; ++r) if (4 * fq + r > fr) acc[r] = 0.f; }
                }
                *(LAS v2u*)(Pm + (16 * iq + fr) * 72 + 16 * jk + 4 * fq) = (v2u){pk2m(acc[0], acc[1]), pk2m(acc[2], acc[3])}; }
            __syncthreads();
            f32x4 oacc[4];
            { bf16x8 bV[2];
#pragma unroll
              for (int ss = 0; ss < 2; ++ss) bV[ss] = *(const LAS bf16x8*)(VT + (16 * w + fr) * 72 + 8 * fq + 32 * ss);
#pragma unroll
              for (int tt = 0; tt < 4; ++tt) { f32x4 acc = {0.f, 0.f, 0.f, 0.f};
#pragma unroll
                  for (int ss = 0; ss < 2; ++ss) { const bf16x8 a = *(const LAS bf16x8*)(Pm + (16 * tt + fr) * 72 + 8 * fq + 32 * ss); acc = __builtin_amdgcn_mfma_f32_16x16x32_bf16(a, bV[ss], acc, 0, 0, 0); }
#pragma unroll
                  for (int ks = 0; ks < 4; ++ks) { const bf16x8 a = *(const LAS bf16x8*)(QTL + (16 * tt + fr) * 136 + 8 * fq + 32 * ks); acc = __builtin_amdgcn_mfma_f32_16x16x32_bf16(a, bS[ks], acc, 0, 0, 0); }
                  oacc[tt] = acc; } }
            const float gh = F.in[10][h * HD + 16 * w + fr];
#pragma unroll
            for (int tt = 0; tt < 4; ++tt)
#pragma unroll
                for (int r = 0; r < 4; ++r) { const float ov = oacc[tt][r]; float x = ov * ov; x += __shfl_xor(x, 1); x += __shfl_xor(x, 2); x += __shfl_xor(x, 4); x += __shfl_xor(x, 8);
                    const int tl = 16 * tt + 4 * fq + r; if (fr == 0) SSQ[tl * 8 + w] = x; OT[tl * 136 + 16 * w + fr] = (bf16)f2bf(ov * gh); }
            __syncthreads();
            if (tid < 64) { float s = 0.f;
#pragma unroll
                for (int i = 0; i < 8; ++i) s += SSQ[tid * 8 + i];
                RSTD[tid] = rsqrtf(s * (1.f / HD) + EPS); }
            __syncthreads();
#pragma unroll
            for (int pz = 0; pz < 2; ++pz) { const int row = pr0 + 32 * pz; const v4u ot = *(const LAS v4u*)(OT + row * 136 + pc0), gz = pz ? gz1 : gz0; const float rs = RSTD[row];
                v4u o;
                o.x = pk2(bf2f(ot.x & 0xffffu) * rs * bf2f(gz.x & 0xffffu), bf2f(ot.x >> 16) * rs * bf2f(gz.x >> 16)); o.y = pk2(bf2f(ot.y & 0xffffu) * rs * bf2f(gz.y & 0xffffu), bf2f(ot.y >> 16) * rs * bf2f(gz.y >> 16));
                o.z = pk2(bf2f(ot.z & 0xffffu) * rs * bf2f(gz.z & 0xffffu), bf2f(ot.z >> 16) * rs * bf2f(gz.z >> 16)); o.w = pk2(bf2f(ot.w & 0xffffu) * rs * bf2f(gz.w & 0xffffu), bf2f(ot.w >> 16) * rs * bf2f(gz.w >> 16));
                *(v4u*)(O + (size_t)(t0 + row) * D + h * HD + pc0) = o; }
            __syncthreads();
        }
    }
}

constexpr int L7_HI = 0, L7_LO = 32768, L7_PART = 65536, L7_LG = L7_PART + 24576, L7_ROUT = L7_LG + 2304;
__device__ __forceinline__ void ph7_rows(Frame& F) {
    const float* x = F.in[0]; const float* mod = (const float*)(F.ws + WS_MOD); const bf16* mix = (const bf16*)(F.ws + WS_MIX);
    const float *gpm = F.in[5], *gpf = F.in[6], *brg = F.in[21], *bre = F.in[23];
    const bf16* RRH = (const bf16*)(F.ws + WS_RRH); const bf16* RRL = (const bf16*)(F.ws + WS_RRL);
    bf16* H = (bf16*)(F.ws + WS_H); float* wgt = (float*)(F.ws + WS_WGT);
    unsigned* cnt = (unsigned*)(F.ws + WS_CTL) + CW_CNT; int* list = (int*)(F.ws + WS_LIST);
    LAS float* PART = (LAS float*)(F.lds + L7_PART); LAS float* LG = (LAS float*)(F.lds + L7_LG); LAS float* ROUT = (LAS float*)(F.lds + L7_ROUT);
    const int w = F.wave, fr = F.lane & 15, fq = F.lane >> 4, row0 = 64 * F.vcu;
    bf16x8 bh[4][3], bl[4][3];
#pragma unroll
    for (int ks = 0; ks < 4; ++ks)
#pragma unroll
        for (int nt = 0; nt < 3; ++nt) { const size_t wo = (size_t)(16 * nt + fr) * D + 128 * w + 32 * ks + 8 * fq; bh[ks][nt] = *(const bf16x8*)(RRH + wo); bl[ks][nt] = *(const bf16x8*)(RRL + wo); }
    v2u mv[2][4]; f32x4 xv[2][4];
#define P7_LOAD(it_) do { _Pragma("unroll") for (int rr = 0; rr < 2; ++rr) { const int m_ = row0 + 16 * (it_) + 2 * w + rr; _Pragma("unroll") for (int j = 0; j < 4; ++j) { \
        mv[rr][j] = ((const GAS v2u*)(mix + (size_t)m_ * D) + lane)[64 * j]; xv[rr][j] = ((const GAS f32x4*)(x + (size_t)m_ * D) + lane)[64 * j]; } } } while (0)
    { const int lane = F.lane; P7_LOAD(0); }
#pragma unroll 1
    for (int it = 0; it < 4; ++it) {
        int lane = F.lane; asm volatile("" : "+v"(lane));
#pragma unroll
        for (int rr = 0; rr < 2; ++rr) {
            const int rl = 2 * w + rr, m = row0 + 16 * it + rl, b = m / SEQ; const float* mb = mod + b * 6144; const float *gt1 = mb + 2048, *sh2 = mb + 3072, *sc2 = mb + 4096;
            f32x4 v[4], xr_[4]; float s = 0.f;
#pragma unroll
            for (int j = 0; j < 4; ++j) { v[j] = (f32x4){bf2f(mv[rr][j].x & 0xffffu), bf2f(mv[rr][j].x >> 16), bf2f(mv[rr][j].y & 0xffffu), bf2f(mv[rr][j].y >> 16)}; xr_[j] = xv[rr][j];
                s += v[j].x * v[j].x + v[j].y * v[j].y + v[j].z * v[j].z + v[j].w * v[j].w; }
            const float rs1 = rsqrtf(wave_sum(s) * (1.f / D) + EPS); float s2 = 0.f;
#pragma unroll
            for (int j = 0; j < 4; ++j) { const int c0 = 4 * lane + 256 * j; const f32x4 gg = *(const f32x4*)(gpm + c0), gt = *(const f32x4*)(gt1 + c0);
                xr_[j].x += gt.x * (v[j].x * rs1 * gg.x); xr_[j].y += gt.y * (v[j].y * rs1 * gg.y); xr_[j].z += gt.z * (v[j].z * rs1 * gg.z); xr_[j].w += gt.w * (v[j].w * rs1 * gg.w);
                ((GAS f32x4*)(F.out + (size_t)m * D) + lane)[64 * j] = xr_[j];
                s2 += xr_[j].x * xr_[j].x + xr_[j].y * xr_[j].y + xr_[j].z * xr_[j].z + xr_[j].w * xr_[j].w; }
            const float rs2 = rsqrtf(wave_sum(s2) * (1.f / D) + EPS);
#pragma unroll
            for (int j = 0; j < 4; ++j) { const int c0 = 4 * lane + 256 * j; const f32x4 gg = *(const f32x4*)(gpf + c0), sc = *(const f32x4*)(sc2 + c0), sh = *(const f32x4*)(sh2 + c0);
                const float h0 = xr_[j].x * rs2 * gg.x * (1.f + sc.x) + sh.x, h1 = xr_[j].y * rs2 * gg.y * (1.f + sc.y) + sh.y, h2 = xr_[j].z * rs2 * gg.z * (1.f + sc.z) + sh.z, h3 = xr_[j].w * rs2 * gg.w * (1.f + sc.w) + sh.w;
                const unsigned p01 = pk2(h0, h1), p23 = pk2(h2, h3);
                ((GAS unsigned long long*)(H + (size_t)m * D) + lane)[64 * j] = (unsigned long long)p01 | ((unsigned long long)p23 << 32);
                const unsigned q01 = pk2(h0 - bf2f(p01 & 0xffffu), h1 - bf2f(p01 >> 16)), q23 = pk2(h2 - bf2f(p23 & 0xffffu), h3 - bf2f(p23 >> 16));
                const int so = rl * 2048 + ((((lane >> 1) + 32 * j) ^ rl) << 4) + (lane & 1) * 8;
                *(LAS v2u*)(F.lds + L7_HI + so) = (v2u){p01, p23}; *(LAS v2u*)(F.lds + L7_LO + so) = (v2u){q01, q23}; }
        }
        if (it < 3) P7_LOAD(it + 1);
        __syncthreads();
        f32x4 acc[3] = {{0.f, 0.f, 0.f, 0.f}, {0.f, 0.f, 0.f, 0.f}, {0.f, 0.f, 0.f, 0.f}};
#pragma unroll
        for (int ks = 0; ks < 4; ++ks) { const int slot = 16 * w + 4 * ks + fq, so = fr * 2048 + ((slot ^ fr) << 4);
            const bf16x8 ah = *(const LAS bf16x8*)(F.lds + L7_HI + so), al = *(const LAS bf16x8*)(F.lds + L7_LO + so);
#pragma unroll
            for (int nt = 0; nt < 3; ++nt) {
                acc[nt] = __builtin_amdgcn_mfma_f32_16x16x32_bf16(ah, bh[ks][nt], acc[nt], 0, 0, 0); acc[nt] = __builtin_amdgcn_mfma_f32_16x16x32_bf16(ah, bl[ks][nt], acc[nt], 0, 0, 0); acc[nt] = __builtin_amdgcn_mfma_f32_16x16x32_bf16(al, bh[ks][nt], acc[nt], 0, 0, 0); } }
#pragma unroll
        for (int nt = 0; nt < 3; ++nt)
#pragma unroll
            for (int r = 0; r < 4; ++r) PART[(w * 16 + 4 * fq + r) * 48 + 16 * nt + fr] = acc[nt][r];
        __syncthreads();
        int tid16 = F.tid; asm volatile("" : "+v"(tid16));
        for (int e = tid16; e < 16 * 36; e += NTHR) { const int row = e / 36, o = e - row * 36; float a = o < 4 ? brg[o] : bre[o - 4];
#pragma unroll
            for (int ww = 0; ww < 8; ++ww) a += PART[(ww * 16 + row) * 48 + o];
            LG[e] = a; }
        __syncthreads();
        if (tid16 < 16) {
            const LAS float* lgl = LG + tid16 * 36;
            int gs = 0; float gm = lgl[0];
#pragma unroll
            for (int o = 1; o < NG; ++o) if (lgl[o] > gm) { gm = lgl[o]; gs = o; }
            float den = 0.f;
#pragma unroll
            for (int o = 0; o < NG; ++o) den += __expf(lgl[o] - gm);
            const float gate = 1.f / den;
            float sel[EPG];
#pragma unroll
            for (int o = 0; o < EPG; ++o) sel[o] = lgl[4 + 8 * gs + o];
            int i1 = 0; float m1 = sel[0];
#pragma unroll
            for (int o = 1; o < EPG; ++o) if (sel[o] > m1) { m1 = sel[o]; i1 = o; }
            int i2 = -1; float m2 = -3.0e38f;
#pragma unroll
            for (int o = 0; o < EPG; ++o) if (o != i1 && sel[o] > m2) { m2 = sel[o]; i2 = o; }
            if (i2 < 0) i2 = (i1 + 1) & 7;
            const float e2 = __expf(m2 - m1);
            *(LAS f32x4*)(ROUT + (16 * it + tid16) * 4) = (f32x4){__int_as_float(gs * EPG + i1), __int_as_float(gs * EPG + i2), gate / (1.f + e2), gate * e2 / (1.f + e2)};
        }
    }
#undef P7_LOAD
    LAS unsigned* HIST = (LAS unsigned*)(F.lds + L7_ROUT + 1024); LAS unsigned* BASE = HIST + 32;
    if (F.tid < 32) HIST[F.tid] = 0u;
    __syncthreads();
    int e_ = 0; unsigned rank_ = 0u;
    if (F.tid < 128) { const int rl = F.tid >> 1, kx = F.tid & 1; e_ = __float_as_int(ROUT[rl * 4 + kx]); rank_ = atomicAdd((unsigned*)(HIST + e_), 1u); wgt[2 * (row0 + rl) + kx] = ROUT[rl * 4 + 2 + kx]; }
    __syncthreads();
    if (F.tid < 32) { const unsigned c = HIST[F.tid]; BASE[F.tid] = c ? atomicAdd(&cnt[64 * F.tid], c) : 0u; }
    __syncthreads();
    if (F.tid < 128) list[e_ * 32768 + BASE[e_] + rank_] = 2 * row0 + F.tid;
    __syncthreads();
}

__device__ __forceinline__ int moe_tables(Frame& F) {
    LAS int* MBE = (LAS int*)(F.lds + X_MBE); LAS int* MBS = MBE + MAXMB; LAS int* NMB = MBS + 33;
    if (F.tid == 0) { int mb = 0;
        for (int e = 0; e < NE; ++e) { const int c = (int)__hip_atomic_load(F.ctl + CW_CNT + 64 * e, RLX_AGENT); MBS[e] = mb; const int nb = (c + 255) >> 8; for (int j = 0; j < nb && mb < MAXMB; ++j) MBE[mb++] = e; }
        MBS[NE] = mb; NMB[0] = mb; }
    __syncthreads();
    return NMB[0];
}
template <bool FOR_A>
__device__ __forceinline__ void moe_fill_tab(Frame& F, const pg8::MoeOrder& S) {
    LAS int* MBE = (LAS int*)(F.lds + X_MBE); LAS int* MBS = MBE + MAXMB; LAS int* tab = (LAS int*)(F.lds + X_GTAB); const int* list = (const int*)(F.ws + WS_LIST);
    pg8::Unit u;
    for (int i = 0; i < 4 && S.next(i, u) && u.slot == i; ++i) {
        if (F.tid < 256) { const int e = MBE[u.pm], pos = (u.pm - MBS[e]) * 256 + F.tid, c = (int)__hip_atomic_load(F.ctl + CW_CNT + 64 * e, RLX_AGENT);
            const int aid = pos < c ? list[e * 32768 + pos] : -1;
            tab[i * 256 + F.tid] = FOR_A ? (aid >= 0 ? (aid >> 1) * (D * 2) : 0) : aid; }
    }
    __syncthreads();
}

__device__ __forceinline__ void ph10_final(Frame& F) {
    const float* mod = (const float*)(F.ws + WS_MOD); const bf16* YA = (const bf16*)(F.ws + WS_YA); const float* gp = F.in[7];
    const int gw = F.vcu * NWAVES + F.wave, NGW = F.G * NWAVES, lane = F.lane;
    for (int rep10 = 0; rep10 < PROBE_R10; ++rep10)
    for (int m = gw; m < T; m += NGW) {
        const int b = m / SEQ; const float* gt2 = mod + b * 6144 + 5120;
        float y[4][4]; float s = 0.f;
#pragma unroll
        for (int j = 0; j < 4; ++j) { const v2u a = ((const GAS v2u*)(YA + (size_t)(2 * m) * D) + lane)[64 * j], c = ((const GAS v2u*)(YA + (size_t)(2 * m + 1) * D) + lane)[64 * j];
            y[j][0] = bf2f(a.x & 0xffffu) + bf2f(c.x & 0xffffu); y[j][1] = bf2f(a.x >> 16) + bf2f(c.x >> 16); y[j][2] = bf2f(a.y & 0xffffu) + bf2f(c.y & 0xffffu); y[j][3] = bf2f(a.y >> 16) + bf2f(c.y >> 16);
#pragma unroll
            for (int i = 0; i < 4; ++i) s += y[j][i] * y[j][i]; }
        const float rs = rsqrtf(wave_sum(s) * (1.f / D) + EPS);
#pragma unroll
        for (int j = 0; j < 4; ++j) { const int c0 = 4 * lane + 256 * j; const f32x4 gg = *(const f32x4*)(gp + c0), gt = *(const f32x4*)(gt2 + c0);
            GAS f32x4* o = (GAS f32x4*)(F.out + (size_t)m * D) + lane + 64 * j; f32x4 xv = *o;
            xv.x += gt.x * (y[j][0] * rs * gg.x); xv.y += gt.y * (y[j][1] * rs * gg.y); xv.z += gt.z * (y[j][2] * rs * gg.z); xv.w += gt.w * (y[j][3] * rs * gg.w);
            if (rep10 == PROBE_R10 - 1) *o = xv; else *((GAS f32x4*)(F.ws + WS_H + (size_t)(m >> 1) * D * 4) + lane + 64 * j) = xv; }
    }
}

constexpr int NPH = 11;
__global__ void __launch_bounds__(NTHR, 2) skel_fwd(Args args) {
    extern __shared__ __attribute__((aligned(16))) unsigned char lds[];
    Frame F;
    F.lds = (LAS unsigned char*)lds; F.MISC = (volatile LAS unsigned*)(F.lds + X_MISC);
    F.tid = threadIdx.x; F.lane = F.tid & 63; F.wave = __builtin_amdgcn_readfirstlane(F.tid >> 6);
    F.G = gridDim.x; { const int bx = blockIdx.x; F.vcu = (F.G % 8 == 0) ? (bx % 8) * (F.G / 8) + bx / 8 : bx; }
    F.in = args.in; F.out = args.out; F.ws = args.ws; F.dsb = args.dsb; F.ctl = (gu32*)(args.ws + WS_CTL);
    if (F.tid < 32) F.MISC[F.tid] = 0u;
    __syncthreads();
    XcdBarrier bar; bar.bar = (unsigned*)(F.ctl + CW_BAR); bar.x = 0; bar.st = nullptr;
    const int lo = args.ph_lo, hi = args.ph_hi;
    const bool one = (hi - lo) > 1;
    if (one) bar = xcd_barrier_post((unsigned*)(F.ctl + CW_BAR), F.MISC + 8);
#ifndef PHMASK
#define PHMASK 0x7FF
#endif
#define IN(k) (((PHMASK >> (k)) & 1) && lo <= (k) && (k) < hi)
#define SEAM(k) do { if (IN(k) && IN((k) + 1)) for (int sb_ = 0; sb_ < PROBE_SEAM; ++sb_) xcd_barrier(bar); } while (0)
#ifndef REPMASK
#define REPMASK 0
#endif
#define REP(k) (((REPMASK >> (k)) & 1) != 0)

    if (IN(0)) { ph0_prologue(F); if (REP(0)) { xcd_barrier(bar); ph0_prologue(F); } } if (IN(0) && IN(2)) xcd_barrier(bar);
    if (IN(2)) for (int rep_ = 0; rep_ < (REP(2) ? 2 : 1); ++rep_) {
        if (rep_) xcd_barrier(bar);
        pg8::Gemm g{(const bf16*)(F.ws + WS_H), (const bf16*)(F.ws + WS_WIN), D}; pg8::StaticOrder S; S.init(T, DIN, D, F.G, (int)blockIdx.x, PROBE_G2);
        pg8::EpiProj E{(bf16*)(F.ws + WS_PROJ), (const float*)(F.ws + WS_LB)};
        pg8::gemm_phase<pg8::EpiProj, pg8::StaticOrder, false>(F.lds, g, S, E, nullptr);
    } SEAM(2);
    if (IN(3)) { ph3_passA(F); if (REP(3)) { xcd_barrier(bar); ph3_passA(F); } if (PROBE_ROTA > 1) { xcd_barrier(bar); ph3_passA(F, 77); } } SEAM(3);
    if (IN(4)) { ph4_passB(F); if (REP(4)) { xcd_barrier(bar); ph4_passB(F); } } SEAM(4);
    for (int xb_ = 1; xb_ < PROBE_BAR; ++xb_) xcd_barrier(bar);
    if (IN(5)) { ph5_passC(F); if (REP(5)) { xcd_barrier(bar); ph5_passC(F); } if (PROBE_ROTC > 1) { xcd_barrier(bar); ph5_passC(F, 77); } } SEAM(5);
    if (IN(6)) for (int rep_ = 0; rep_ < (REP(6) ? 2 : 1); ++rep_) {
        if (rep_) xcd_barrier(bar);
        pg8::Gemm g{(const bf16*)(F.ws + WS_H), (const bf16*)(F.ws + WS_WOUT), D}; pg8::StaticOrder S; S.init(T, D, D, F.G, (int)blockIdx.x);
        pg8::EpiMixB E{(bf16*)(F.ws + WS_MIX), D};
        pg8::gemm_phase<pg8::EpiMixB, pg8::StaticOrder, false>(F.lds, g, S, E, nullptr);
    } SEAM(6);
    if (IN(7)) { ph7_rows(F); } SEAM(7);
    if (IN(8)) {
        const int nmb = moe_tables(F);
        unsigned* mbc = (unsigned*)(F.ctl + CW_MB);
        { pg8::MoeOrder S{4 * nmb, F.G, (int)blockIdx.x, D, (const LAS int*)(F.lds + X_MBE), (size_t)D * D * 2, PROBE_M8, 0, mbc};
          moe_fill_tab<true>(F, S);
          pg8::Gemm g{(const bf16*)(F.ws + WS_H), (const bf16*)(F.ws + WS_W13), D}; pg8::EpiAct E{(bf16*)(F.ws + WS_ACT)};
          pg8::gemm_phase<pg8::EpiAct, pg8::MoeOrder, true>(F.lds, g, S, E, (const LAS unsigned*)(F.lds + X_GTAB)); }
        { pg8::MoeOrder S{4 * nmb, F.G, (int)blockIdx.x, DE, (const LAS int*)(F.lds + X_MBE), (size_t)D * DE * 2, PROBE_M9, 1, nullptr};
          moe_fill_tab<false>(F, S);
          if (F.tid < 64) { pg8::Unit u; unsigned sp = 0;
              for (int i = 0; i < 4 && S.next(i, u) && u.slot == i; ++i)
                  while ((unsigned)__builtin_amdgcn_readfirstlane(__hip_atomic_load(F.ctl + CW_MB + 64 * u.pm, RLX_AGENT)) < 32u) { __builtin_amdgcn_s_sleep(2); if (++sp > (1u << 22)) break; }
              __builtin_amdgcn_fence(__ATOMIC_ACQUIRE, "agent"); VM_WAIT(); }
          __syncthreads();
          pg8::Gemm g{(const bf16*)(F.ws + WS_ACT), (const bf16*)(F.ws + WS_W2), DE}; pg8::EpiYa E{(bf16*)(F.ws + WS_YA), (const float*)(F.ws + WS_WGT), (const LAS int*)(F.lds + X_GTAB)};
          pg8::gemm_phase<pg8::EpiYa, pg8::MoeOrder, false>(F.lds, g, S, E, nullptr); }
    } if (IN(8) && IN(10)) xcd_barrier(bar);
    if (IN(10)) { ph10_final(F); }
#undef IN
#undef SEAM
}


extern "C" void kernel_launch(void* const* d_in, const int* in_sizes, int n_in, void* d_out, int out_size, void* d_ws, size_t ws_size, hipStream_t stream) {
    static int grid = 0;
    if (grid == 0) {
        if (n_in != 27 || out_size != T * D || ws_size < WS_END) { fprintf(stderr, "kernel_launch: unexpected n_in %d / out %d / ws %zu\n", n_in, out_size, ws_size); grid = -1; return; }
        int dev = 0, cus = 0, per_cu = 0;
        if (hipGetDevice(&dev) != hipSuccess || hipDeviceGetAttribute(&cus, hipDeviceAttributeMultiprocessorCount, dev) != hipSuccess) { grid = -1; return; }
        if (hipFuncSetAttribute((const void*)skel_fwd, hipFuncAttributeMaxDynamicSharedMemorySize, LDS_BYTES) != hipSuccess) { fprintf(stderr, "kernel_launch: hipFuncSetAttribute failed\n"); grid = -1; return; }
        if (hipOccupancyMaxActiveBlocksPerMultiprocessor(&per_cu, (const void*)skel_fwd, NTHR, LDS_BYTES) != hipSuccess || per_cu < 1) { fprintf(stderr, "kernel_launch: occupancy query says %d blocks per CU\n", per_cu); per_cu = 1; }
        (void)hipGetLastError();
        if (cus < 256) { fprintf(stderr, "kernel_launch: needs 256 CUs (one resident workgroup per chunk), device has %d\n", cus); grid = -1; return; }
        grid = 256;
        fprintf(stderr, "kernel_launch: grid %d, occupancy query %d per CU, ws %zu MiB\n", grid, per_cu, ws_size >> 20);
    }
    if (grid < 0) return;
    (void)hipMemsetAsync((char*)d_ws + WS_CTL, 0, CTL_ZERO_BYTES, stream);
    Args a{};
    for (int i = 0; i < 27; ++i) a.in[i] = (const float*)d_in[i];
    a.out = (float*)d_out; a.ws = (unsigned char*)d_ws; a.dsb = (unsigned char*)d_out;
#if MK_N_LAUNCHES == 1
    a.ph_lo = 0; a.ph_hi = NPH;
    hipLaunchKernelGGL(skel_fwd, dim3(grid), dim3(NTHR), LDS_BYTES, stream, a);
    if (PROBE_TAIL > 1) { a.dsb = (unsigned char*)d_ws + WS_W13; a.ph_lo = 0; a.ph_hi = PROBE_TAIL; (void)hipMemsetAsync((char*)d_ws + WS_CTL, 0, CTL_ZERO_BYTES, stream); hipLaunchKernelGGL(skel_fwd, dim3(grid), dim3(NTHR), LDS_BYTES, stream, a); }
    if (PROBE_TAIL67 > 1) { a.out = (float*)((unsigned char*)d_ws + WS_W13); a.ph_lo = 6; a.ph_hi = 6 + PROBE_TAIL67 - 1; (void)hipMemsetAsync((char*)d_ws + WS_CTL, 0, CTL_ZERO_BYTES, stream); hipLaunchKernelGGL(skel_fwd, dim3(grid), dim3(NTHR), LDS_BYTES, stream, a); }
    for (int all_ = 1; all_ < PROBE_ALL; ++all_) { (void)hipMemsetAsync((char*)d_ws + WS_CTL, 0, CTL_ZERO_BYTES, stream); hipLaunchKernelGGL(skel_fwd, dim3(grid), dim3(NTHR), LDS_BYTES, stream, a); }
#else
    for (int ph = 0; ph < NPH; ++ph) { a.ph_lo = ph; a.ph_hi = ph + 1; hipLaunchKernelGGL(skel_fwd, dim3(grid), dim3(NTHR), LDS_BYTES, stream, a); }
#endif
}
```

```cpp
#include <hip/hip_runtime.h>
#include <cstdio>
#include <cstdint>

#ifndef PROBE_H5
#define PROBE_H5 1
#endif
#ifndef PROBE_G2
#define PROBE_G2 1
#endif
#ifndef PROBE_R7
#define PROBE_R7 1
#endif
#ifndef PROBE_R10
#define PROBE_R10 1
#endif
#ifndef PROBE_RG5
#define PROBE_RG5 1
#endif
#ifndef PROBE_M8
#define PROBE_M8 1
#endif
#ifndef PROBE_M9
#define PROBE_M9 1
#endif
#ifndef PROBE_BAR
#define PROBE_BAR 1
#endif
#ifndef PROBE_ALL
#define PROBE_ALL 1
#endif
#ifndef PROBE_SEAM
#define PROBE_SEAM 1
#endif
#ifndef PROBE_ROTA
#define PROBE_ROTA 1
#endif
#ifndef PROBE_ROTC
#define PROBE_ROTC 1
#endif
#ifndef PROBE_TAIL
#define PROBE_TAIL 1
#endif
#ifndef PROBE_TAIL67
#define PROBE_TAIL67 1
#endif
#ifndef PROBE_TAIL8
#define PROBE_TAIL8 1
#endif
#ifndef PROBE_TAIL10
#define PROBE_TAIL10 1
#endif
#ifndef MK_N_LAUNCHES
#define MK_N_LAUNCHES 1
#endif

constexpr int BATCH = 2, SEQ = 8192, D = 1024, T = BATCH * SEQ;
constexpr int DH = 512, HD = 128, NH = 4, CHK = 64, NCH = SEQ / CHK;
constexpr int DR = 512, RBD = 64;
constexpr int DIN = 3072;
constexpr int NG = 4, EPG = 8, NE = 32, DE = 512;
constexpr int MAXMB = 160;
constexpr float EPS = 1e-6f;
constexpr int NWAVES = 8, NTHR = 512;

#define GAS __attribute__((address_space(1)))
#define LAS __attribute__((address_space(3)))
typedef unsigned short bf16;
typedef unsigned v4u __attribute__((ext_vector_type(4)));
typedef unsigned v2u __attribute__((ext_vector_type(2)));
typedef float f32x4 __attribute__((ext_vector_type(4)));
typedef short bf16x8 __attribute__((ext_vector_type(8)));
typedef GAS unsigned gu32;
#define RLX_AGENT __ATOMIC_RELAXED, __HIP_MEMORY_SCOPE_AGENT
#define LDS_WAIT() asm volatile("s_waitcnt lgkmcnt(0)" ::: "memory")
#define VM_WAIT() asm volatile("s_waitcnt vmcnt(0)" ::: "memory")

__device__ __forceinline__ unsigned f2bf(float f) { unsigned u = __builtin_bit_cast(unsigned, f); return (u + 0x7fffu + ((u >> 16) & 1u)) >> 16; }
__device__ __forceinline__ float bf2f(unsigned h) { return __builtin_bit_cast(float, h << 16); }
typedef float f32x2_t __attribute__((ext_vector_type(2))); typedef __bf16 bf16x2_t __attribute__((ext_vector_type(2)));
__device__ __forceinline__ unsigned pk2m(float lo, float hi) { f32x2_t v = {lo, hi}; bf16x2_t b = __builtin_convertvector(v, bf16x2_t); return __builtin_bit_cast(unsigned, b); }
__device__ __forceinline__ unsigned pk2(float lo, float hi) { unsigned r; asm volatile("v_cvt_pk_bf16_f32 %0, %1, %2" : "=v"(r) : "v"(lo), "v"(hi)); return r; }
__device__ __forceinline__ float frcp(float v) { return __builtin_amdgcn_rcpf(v); }
__device__ __forceinline__ float sigmoidf_(float v) { return frcp(1.f + __expf(-v)); }
__device__ __forceinline__ float siluf_(float v) { return v * frcp(1.f + __expf(-v)); }
__device__ __forceinline__ float gelu_tanh_(float v) { const float u = 1.5957691216057308f * (v + 0.044715f * v * v * v); return v * frcp(1.f + __expf(-u)); }
__device__ __forceinline__ float wave_sum(float v) {
#pragma unroll
    for (int o = 1; o < 64; o <<= 1) v += __shfl_xor(v, o);
    return v;
}

constexpr size_t MiB = 1u << 20, KiB = 1u << 10;
constexpr size_t WS_CTL = 0, CTL_ZERO_BYTES = 1 * MiB;
constexpr size_t WS_MOD = 1 * MiB;
constexpr size_t WS_LB = WS_MOD + 64 * KiB;
constexpr size_t WS_WRT = WS_MOD + 128 * KiB;
constexpr size_t WS_WIT = WS_WRT + 64 * KiB;
constexpr size_t WS_RRH = WS_WIT + 64 * KiB;
constexpr size_t WS_RRL = WS_RRH + 96 * KiB;
constexpr size_t WS_RGA = 2 * MiB;
constexpr size_t WS_RGH = WS_RGA + 512 * KiB;
constexpr size_t WS_CARRY = WS_RGH + 512 * KiB;
constexpr size_t WS_DD = WS_CARRY + 512 * KiB;
constexpr size_t WS_WGT = 4 * MiB;
constexpr size_t WS_LIST = 5 * MiB;
constexpr size_t WS_WIN = 10 * MiB;
constexpr size_t WS_WOUT = 16 * MiB;
constexpr size_t WS_W13 = 18 * MiB;
constexpr size_t WS_W2 = 82 * MiB;
constexpr size_t WS_H = 114 * MiB;
constexpr size_t WS_PROJ = 146 * MiB;
constexpr size_t WS_MIX = WS_PROJ;
constexpr size_t WS_YA = WS_PROJ;
constexpr size_t WS_ACT = WS_PROJ + 64 * MiB;
constexpr size_t WS_X1B = 258 * MiB;
constexpr size_t WS_END = 290 * MiB;
constexpr size_t PROJ_S = (size_t)T * DH;
constexpr int CW_CNT = 32768;
constexpr int CW_MODCNT = 128;
constexpr int CW_BAR = 4096;
constexpr int CW_MB = 16384;

constexpr int RING_BYTES = 131072;
constexpr int RTAB_BYTES = 1024 * 36 * 4;
constexpr int X_OFF = RTAB_BYTES;
constexpr int X_GTAB = X_OFF;
constexpr int X_MBE = X_OFF + 8192;
constexpr int X_MISC = X_OFF + 10240;
constexpr int LDS_BYTES = X_OFF + 12288;

namespace pg8 {
constexpr int BM = 256, BK = 64, HALF = 128, HTB = HALF * BK * 2, NXCD = 8, WGM = 8;
__host__ __device__ __forceinline__ int lds_byte(int r, int c) { const int st = (r >> 4) * 2 + (c >> 5), rr = r & 15, cc = c & 31, ob = rr * 64 + cc * 2; return st * 1024 + (ob ^ (((ob >> 9) & 1) << 5)); }
__host__ __device__ __forceinline__ void stage_rc(int b, int& R, int& C) { const int st = b / 1024, sb = b % 1024, swz = sb ^ (((sb >> 9) & 1) << 5); R = (st >> 1) * 16 + swz / 64; C = (st & 1) * 32 + (swz % 64) / 2; }
__host__ __device__ __forceinline__ int perm32(int rho) { const int n = rho >> 4, i = rho & 15; return 8 * (i >> 2) + 4 * n + (i & 3); }

struct Unit { int pm, pn, slot; };
struct Gemm { const bf16* A; const bf16* Bt; int K; };

struct StaticOrder {
    int nM, nN, nwg, G, c, K, rep;
    __device__ __forceinline__ void init(int M, int N, int K_, int G_, int c_, int rep_ = 1) { nM = M / BM; nN = N / BM; nwg = nM * nN; G = G_; c = c_; K = K_; rep = rep_; }
    __device__ __forceinline__ bool next(int i, Unit& u) const {
        long L = (long)i * G + c; if (L >= (long)nwg * rep) return false; L %= nwg;
        int wgid = (int)L; { const int q = nwg / NXCD, r = nwg % NXCD, xcd = wgid % NXCD, off = wgid / NXCD; wgid = (xcd < r ? xcd * (q + 1) : r * (q + 1) + (xcd - r) * q) + off; }
        const int nig = WGM * nN, gid = wgid / nig, fm = gid * WGM, gsz = (nM - fm) < WGM ? (nM - fm) : WGM;
        u.pm = fm + ((wgid % nig) % gsz); u.pn = (wgid % nig) / gsz; u.slot = i; return true;
    }
    __device__ __forceinline__ size_t aoff(const Unit& u) const { return (size_t)u.pm * BM * K * 2; }
    __device__ __forceinline__ size_t boff(const Unit& u) const { return (size_t)u.pn * BM * K * 2; }
    __device__ __forceinline__ void done(const Unit&) const {}
};
struct MoeOrder {
    int nunits, G, c, K; const LAS int* mbe; size_t estride; int rep;
    int rev; unsigned* done_cnt;
    __device__ __forceinline__ bool next(int i, Unit& u) const {
        const int x = c & 7, ci = c >> 3; const int lo = (int)(((long)nunits * x) >> 3), hi = (int)(((long)nunits * (x + 1)) >> 3);
        int mine; long L0; int stride;
        if (!rev) { mine = (hi - lo - ci + 31) >> 5; L0 = lo + ci; stride = 32; }
        else {
            const int U = hi - lo, base = U >> 5, rem = U & 31, Tc = (3 * U + 31) >> 5;
            int dhi = Tc - 2 * (base + 1); dhi = dhi > 0 ? dhi : 0; int dlo = Tc - 2 * base; dlo = dlo > 0 ? dlo : 0;
            int tailn = rem * dhi; tailn = tailn < U ? tailn : U; const int headn = U - tailn;
            int s0, s1;
            if (ci < rem) { s1 = U - ci * dhi; s0 = s1 - dhi; s0 = s0 > headn ? s0 : headn; s1 = s1 > headn ? s1 : headn; }
            else { s0 = (ci - rem) * dlo; s1 = s0 + dlo; s0 = s0 < headn ? s0 : headn; s1 = s1 < headn ? s1 : headn; }
            mine = s1 - s0; L0 = lo + s0; stride = 1; }
        if (mine <= 0 || i >= mine * rep) return false;
        const int ii = i % mine; const long L = L0 + (long)stride * ii;
        u.pm = (int)(L >> 2); u.pn = (int)(L & 3); u.slot = ii; return true;
    }
    __device__ __forceinline__ size_t aoff(const Unit& u) const { return (size_t)u.pm * BM * K * 2; }
    __device__ __forceinline__ size_t boff(const Unit& u) const { return (size_t)mbe[u.pm] * estride + (size_t)u.pn * BM * K * 2; }
    __device__ __forceinline__ void done(const Unit& u) const {
        if (done_cnt) { asm volatile("s_waitcnt vmcnt(0)" ::: "memory"); if ((threadIdx.x & 63) == 0) __hip_atomic_fetch_add(done_cnt + 64 * u.pm, 1u, __ATOMIC_RELAXED, __HIP_MEMORY_SCOPE_AGENT); }
    }
};

struct EpiProj {
    static constexpr bool PERM = true;
    bf16* base; const float* lb;
    __device__ __forceinline__ void operator()(const f32x4 (&acc)[2][2][4][2], const Unit& u, int wr, int wc, int fr, int fq) const {
        const int grp = u.pn >> 1, c0 = (u.pn & 1) * 256 + wc * 32 + 8 * fq, row0 = u.pm * BM + wr * 64 + fr;
        bf16* ob = base + (grp == 0 ? 0 : grp == 1 ? PROJ_S : (size_t)(grp + 1) * PROJ_S);
        float lbv[2][8];
        if (grp == 1) {
#pragma unroll
            for (int bj = 0; bj < 2; ++bj) { const f32x4 a = *(const f32x4*)(lb + c0 + bj * HALF), b = *(const f32x4*)(lb + c0 + bj * HALF + 4);
                lbv[bj][0] = a[0]; lbv[bj][1] = a[1]; lbv[bj][2] = a[2]; lbv[bj][3] = a[3]; lbv[bj][4] = b[0]; lbv[bj][5] = b[1]; lbv[bj][6] = b[2]; lbv[bj][7] = b[3]; }
        }
#pragma unroll
        for (int ai = 0; ai < 2; ++ai)
#pragma unroll
            for (int m = 0; m < 4; ++m) { bf16* rowp = ob + (size_t)(row0 + ai * HALF + m * 16) * DH + c0;
#pragma unroll
                for (int bj = 0; bj < 2; ++bj) {
                    float v[8];
#pragma unroll
                    for (int j = 0; j < 4; ++j) { v[j] = acc[ai][bj][m][0][j]; v[4 + j] = acc[ai][bj][m][1][j]; }
                    if (grp == 1) {
                        float kv[8];
#pragma unroll
                        for (int j = 0; j < 8; ++j) { const float l = lbv[bj][j], sg = sigmoidf_(v[j]); kv[j] = (1.f - l) * (1.f - sg); v[j] = __logf(l + (1.f - l) * sg); }
                        v4u w; w.x = pk2(kv[0], kv[1]); w.y = pk2(kv[2], kv[3]); w.z = pk2(kv[4], kv[5]); w.w = pk2(kv[6], kv[7]);
                        *(v4u*)(rowp + PROJ_S + bj * HALF) = w;
                    } else if (grp == 0 || grp == 3) {
#pragma unroll
                        for (int j = 0; j < 8; ++j) v[j] = siluf_(v[j]);
                    } else if (grp == 5) {
#pragma unroll
                        for (int j = 0; j < 8; ++j) v[j] = gelu_tanh_(v[j]);
                    }
                    v4u w; w.x = pk2m(v[0], v[1]); w.y = pk2m(v[2], v[3]); w.z = pk2m(v[4], v[5]); w.w = pk2m(v[6], v[7]);
                    *(v4u*)(rowp + bj * HALF) = w;
                } }
    }
};
struct EpiF32 {
    static constexpr bool PERM = false;
    float* C; int ldc;
    __device__ __forceinline__ void operator()(const f32x4 (&acc)[2][2][4][2], const Unit& u, int wr, int wc, int fr, int fq) const {
        const int row0 = u.pm * BM + wr * 64 + fr, col0 = u.pn * BM + wc * 32 + 4 * fq;
#pragma unroll
        for (int ai = 0; ai < 2; ++ai)
#pragma unroll
            for (int m = 0; m < 4; ++m) { float* rowp = C + (size_t)(row0 + ai * HALF + m * 16) * ldc + col0;
#pragma unroll
                for (int bj = 0; bj < 2; ++bj)
#pragma unroll
                    for (int n = 0; n < 2; ++n) *(f32x4*)(rowp + bj * HALF + n * 16) = acc[ai][bj][m][n]; }
    }
};
struct EpiMixB {
    static constexpr bool PERM = true;
    bf16* C; int ldc;
    __device__ __forceinline__ void operator()(const f32x4 (&acc)[2][2][4][2], const Unit& u, int wr, int wc, int fr, int fq) const {
        const int row0 = u.pm * BM + wr * 64 + fr, col0 = u.pn * BM + wc * 32 + 8 * fq;
#pragma unroll
        for (int ai = 0; ai < 2; ++ai)
#pragma unroll
            for (int m = 0; m < 4; ++m) { bf16* rowp = C + (size_t)(row0 + ai * HALF + m * 16) * ldc + col0;
#pragma unroll
                for (int bj = 0; bj < 2; ++bj) { const f32x4 a = acc[ai][bj][m][0], b = acc[ai][bj][m][1];
                    v4u w; w.x = pk2m(a[0], a[1]); w.y = pk2m(a[2], a[3]); w.z = pk2m(b[0], b[1]); w.w = pk2m(b[2], b[3]);
                    *(v4u*)(rowp + bj * HALF) = w; } }
    }
};
struct EpiAct {
    static constexpr bool PERM = true;
    bf16* act;
    __device__ __forceinline__ void operator()(const f32x4 (&acc)[2][2][4][2], const Unit& u, int wr, int wc, int fr, int fq) const {
        const int row0 = u.pm * BM + wr * 64 + fr, col0 = u.pn * HALF + wc * 32 + 8 * fq;
#pragma unroll
        for (int ai = 0; ai < 2; ++ai)
#pragma unroll
            for (int m = 0; m < 4; ++m) {
                float v[8];
#pragma unroll
                for (int j = 0; j < 4; ++j) { v[j] = siluf_(acc[ai][0][m][0][j]) * acc[ai][1][m][0][j]; v[4 + j] = siluf_(acc[ai][0][m][1][j]) * acc[ai][1][m][1][j]; }
                v4u w; w.x = pk2(v[0], v[1]); w.y = pk2(v[2], v[3]); w.z = pk2(v[4], v[5]); w.w = pk2(v[6], v[7]);
                bf16* dst = act + (size_t)(row0 + ai * HALF + m * 16) * DE + col0;
                asm volatile("global_store_dwordx4 %0, %1, off sc1\n\ts_nop 1" :: "v"(dst), "v"(w) : "memory"); }
    }
};
struct EpiYa {
    static constexpr bool PERM = true;
    bf16* ya; const float* wgt; const LAS int* tab;
    __device__ __forceinline__ void operator()(const f32x4 (&acc)[2][2][4][2], const Unit& u, int wr, int wc, int fr, int fq) const {
        const int col0 = u.pn * BM + wc * 32 + 8 * fq;
#pragma unroll
        for (int ai = 0; ai < 2; ++ai)
#pragma unroll
            for (int m = 0; m < 4; ++m) { const int aid = tab[u.slot * 256 + ai * HALF + wr * 64 + m * 16 + fr];
                if (aid >= 0) { const float w8 = wgt[aid]; bf16* rowp = ya + (size_t)aid * D + col0;
#pragma unroll
                    for (int bj = 0; bj < 2; ++bj) { const f32x4 a = acc[ai][bj][m][0] * w8, b = acc[ai][bj][m][1] * w8;
                        v4u w; w.x = pk2(a[0], a[1]); w.y = pk2(a[2], a[3]); w.z = pk2(b[0], b[1]); w.w = pk2(b[2], b[3]);
                        *(v4u*)(rowp + bj * HALF) = w; } } }
    }
};

template <class Epi, class Sched, bool GATHER, bool ALIGN_EPI = true>
__device__ __forceinline__ void gemm_phase(LAS unsigned char* lds, const Gemm g, const Sched& S, const Epi& E, const LAS unsigned* gtab) {
    const int tid = threadIdx.x, wid = __builtin_amdgcn_readfirstlane(tid >> 6), lane = tid & 63, wr = wid >> 2, wc = wid & 3, fr = lane & 15, fq = lane >> 4;
    const int K = g.K, nt = K / BK;
    unsigned voffA[2], voffB[2]; int rowA[2];
#pragma unroll
    for (int i = 0; i < 2; ++i) { int R, C; stage_rc(tid * 16 + i * 8192, R, C); const int Rb = Epi::PERM ? ((R & ~31) + perm32(R & 31)) : R;
        voffA[i] = GATHER ? (unsigned)(C * 2) : (unsigned)(R * K + C) * 2u; voffB[i] = (unsigned)(Rb * K + C) * 2u; rowA[i] = R; }
    const size_t kstep = (size_t)(BK * 2);
    const size_t hstep = (size_t)HALF * K * 2;
    const unsigned ldsw = (unsigned)wid * 1024u;
    const int aoff = lds_byte(wr * 64 + fr, fq * 8), boff = lds_byte(wc * 32 + fr, fq * 8);
#define PG8_SA(b, h) (((b) * 2 + (h)) * HTB)
#define PG8_SB(b, h) ((4 + (b) * 2 + (h)) * HTB)
#define PG8_STAGE(bufoff, gbase, voff) do { _Pragma("unroll") for (int _i = 0; _i < 2; ++_i) \
        __builtin_amdgcn_global_load_lds((const unsigned*)((const char*)(gbase) + (voff)[_i]), (LAS unsigned*)(lds + (bufoff) + ldsw + _i * 8192), 16, 0, 0); } while (0)
#define PG8_STAGE_A(bufoff, gbase, slot, h) do { if constexpr (GATHER) { _Pragma("unroll") for (int _i = 0; _i < 2; ++_i) { const unsigned _ro = gtab[(slot) * 256 + (h) * HALF + rowA[_i]]; \
        __builtin_amdgcn_global_load_lds((const unsigned*)((const char*)(gbase) + _ro + voffA[_i]), (LAS unsigned*)(lds + (bufoff) + ldsw + _i * 8192), 16, 0, 0); } } \
        else { PG8_STAGE(bufoff, (const char*)(gbase) + (h) * hstep, voffA); } } while (0)
#define PG8_LDA(dst, b, h) do { _Pragma("unroll") for (int m = 0; m < 4; ++m) _Pragma("unroll") for (int k = 0; k < 2; ++k) dst[m][k] = *(const LAS bf16x8*)(lds + PG8_SA(b, h) + aoff + m * 2048 + k * 1024); } while (0)
#define PG8_LDB(dst, b, h) do { _Pragma("unroll") for (int n = 0; n < 2; ++n) _Pragma("unroll") for (int k = 0; k < 2; ++k) dst[n][k] = *(const LAS bf16x8*)(lds + PG8_SB(b, h) + boff + n * 2048 + k * 1024); } while (0)
#define PG8_MMA(ai, bj, At, Bt) do { __builtin_amdgcn_s_setprio(1); _Pragma("unroll") for (int m = 0; m < 4; ++m) _Pragma("unroll") for (int n = 0; n < 2; ++n) _Pragma("unroll") for (int k = 0; k < 2; ++k) \
        acc[ai][bj][m][n] = __builtin_amdgcn_mfma_f32_16x16x32_bf16(Bt[n][k], At[m][k], acc[ai][bj][m][n], 0, 0, 0); __builtin_amdgcn_s_setprio(0); } while (0)
#define PG8_WAIT_V(n) asm volatile("s_waitcnt vmcnt(" #n ")" ::: "memory")
#define PG8_WAIT_L(n) asm volatile("s_waitcnt lgkmcnt(" #n ")" ::: "memory")
#define PG8_BAR __builtin_amdgcn_s_barrier()
#define PG8_SCHED __builtin_amdgcn_sched_barrier(0)
    Unit cur, nxt; int ui = 0;
    if (!S.next(0, cur)) return;
    f32x4 acc[2][2][4][2];
#pragma unroll
    for (int a = 0; a < 2; ++a)
#pragma unroll
        for (int b = 0; b < 2; ++b)
#pragma unroll
            for (int m = 0; m < 4; ++m)
#pragma unroll
                for (int n = 0; n < 2; ++n) acc[a][b][m][n] = (f32x4){0.f, 0.f, 0.f, 0.f};
    bf16x8 At[4][2], B0[2][2], B1[2][2];
    const char* cA = (const char*)g.A + (GATHER ? (size_t)0 : S.aoff(cur)); const char* cB = (const char*)g.Bt + S.boff(cur);
    PG8_STAGE(PG8_SB(0, 0), cB, voffB); PG8_STAGE(PG8_SB(0, 1), cB + hstep, voffB); PG8_STAGE_A(PG8_SA(0, 0), cA, 0, 0); PG8_STAGE_A(PG8_SA(0, 1), cA, 0, 1);
    if (wr == 1) PG8_BAR;
    PG8_WAIT_V(2); PG8_BAR;
    PG8_STAGE(PG8_SB(1, 0), cB + kstep, voffB); PG8_STAGE_A(PG8_SA(1, 0), cA + kstep, 0, 0); PG8_STAGE(PG8_SB(1, 1), cB + hstep + kstep, voffB);
    PG8_WAIT_V(6); PG8_BAR;
    for (;;) {
        const bool has_next = S.next(ui + 1, nxt);
        const char* nA = has_next ? (const char*)g.A + (GATHER ? (size_t)0 : S.aoff(nxt)) : cA; const char* nB = has_next ? (const char*)g.Bt + S.boff(nxt) : cB;
        const int nslot = has_next ? nxt.slot : cur.slot, cslot = cur.slot;
        for (int t = 0; t < nt; t += 2) {
            const bool last = (t == nt - 2);
            const char* a1 = cA + (size_t)(t + 1) * kstep;
            const char* a2 = last ? nA : cA + (size_t)(t + 2) * kstep; const char* b2 = last ? nB : cB + (size_t)(t + 2) * kstep;
            const char* a3 = a2 + kstep; const char* b3 = b2 + kstep;
            const int s2 = last ? nslot : cslot;
            PG8_LDB(B0, 0, 0); PG8_LDB(B1, 0, 1); PG8_SCHED; PG8_LDA(At, 0, 0); PG8_STAGE_A(PG8_SA(1, 1), a1, cslot, 1);
            PG8_WAIT_V(8); PG8_WAIT_L(0); PG8_BAR; PG8_MMA(0, 0, At, B0); PG8_MMA(0, 1, At, B1); PG8_BAR; PG8_SCHED;
            PG8_LDA(At, 0, 1); PG8_STAGE(PG8_SB(0, 0), b2, voffB); PG8_STAGE(PG8_SB(0, 1), b2 + hstep, voffB); PG8_STAGE_A(PG8_SA(0, 0), a2, s2, 0);
            PG8_WAIT_V(8); PG8_WAIT_L(0); PG8_BAR; PG8_MMA(1, 0, At, B0); PG8_MMA(1, 1, At, B1); PG8_BAR; PG8_SCHED;
            PG8_LDB(B0, 1, 0); PG8_LDB(B1, 1, 1); PG8_SCHED; PG8_LDA(At, 1, 0); PG8_STAGE_A(PG8_SA(0, 1), a2, s2, 1);
            PG8_WAIT_V(8); PG8_WAIT_L(0); PG8_BAR; PG8_MMA(0, 0, At, B0); PG8_MMA(0, 1, At, B1); PG8_BAR; PG8_SCHED;
            PG8_LDA(At, 1, 1); PG8_STAGE(PG8_SB(1, 0), b3, voffB); PG8_STAGE(PG8_SB(1, 1), b3 + hstep, voffB); PG8_STAGE_A(PG8_SA(1, 0), a3, s2, 0);
            PG8_WAIT_V(8); PG8_WAIT_L(0); PG8_BAR; PG8_MMA(1, 0, At, B0); PG8_MMA(1, 1, At, B1); PG8_BAR; PG8_SCHED;
        }
        if constexpr (ALIGN_EPI) { if (wr == 0) PG8_BAR; }
        E(acc, cur, wr, wc, fr, fq); S.done(cur);
        if (!has_next) break;
#pragma unroll
        for (int a = 0; a < 2; ++a)
#pragma unroll
            for (int b = 0; b < 2; ++b)
#pragma unroll
                for (int m = 0; m < 4; ++m)
#pragma unroll
                    for (int n = 0; n < 2; ++n) acc[a][b][m][n] = (f32x4){0.f, 0.f, 0.f, 0.f};
        cur = nxt; cA = nA; cB = nB; ++ui;
        if constexpr (ALIGN_EPI) { if (wr == 1) PG8_BAR; }
    }
    PG8_WAIT_V(0);
    if constexpr (!ALIGN_EPI) { if (wr == 0) PG8_BAR; }
    PG8_BAR;
#undef PG8_SA
#undef PG8_SB
#undef PG8_STAGE
#undef PG8_STAGE_A
#undef PG8_LDA
#undef PG8_LDB
#undef PG8_MMA
#undef PG8_WAIT_V
#undef PG8_WAIT_L
#undef PG8_BAR
#undef PG8_SCHED
}
}

#define XB_TMO      128
#define XB_XCNT(j)  (256  + 64 * (j))
#define XB_XSUB(j)  (1280 + 64 * (j))
#define XB_XGEN(j)  (2304 + 64 * (j))
#define XB_TOP      3328
#define XB_TOPGEN   3392
#define XCD_BAR_WORDS 3456
#define XB_SPIN_CAP (1u << 18)
__device__ __forceinline__ unsigned xb_ld(unsigned* p)              { return __hip_atomic_load(p, __ATOMIC_RELAXED, __HIP_MEMORY_SCOPE_AGENT); }
__device__ __forceinline__ unsigned xb_add(unsigned* p, unsigned v) { return __hip_atomic_fetch_add(p, v, __ATOMIC_RELAXED, __HIP_MEMORY_SCOPE_AGENT); }
__device__ __forceinline__ unsigned xb_xcc_id() { return (unsigned)__builtin_amdgcn_s_getreg((3 << 11) | 20) & 0xFu; }
#define XB_SPIN(cond, bar) do { unsigned _sp = 0; while (cond) { __builtin_amdgcn_s_sleep(1); \
    if ((++_sp & 255u) == 0u) { if (xb_ld(&(bar)[XB_TMO])) break; if (_sp > XB_SPIN_CAP) { atomicAdd(&(bar)[XB_TMO], 1u); break; } } } } while (0)
struct XcdBarrier { unsigned* bar; unsigned x; volatile LAS unsigned* st; };
__device__ __forceinline__ XcdBarrier xcd_barrier_post(unsigned* bar, volatile LAS unsigned* st) {
    XcdBarrier b; b.bar = bar; b.x = xb_xcc_id(); b.st = st;
    if (threadIdx.x == 0) (void)xb_add(&bar[XB_XCNT(b.x)], 1u);
    return b;
}
__device__ __forceinline__ void xcd_barrier_complete(unsigned* bar, unsigned x, unsigned& nloc, unsigned& nx) {
    const unsigned G = gridDim.x * gridDim.y * gridDim.z;
    unsigned sum, cnt, mine, sp = 0u;
    for (;;) {
        sum = 0u; cnt = 0u; mine = 0u;
#pragma unroll
        for (unsigned j = 0; j < 16; ++j) { const unsigned c = xb_ld(&bar[XB_XCNT(j)]); sum += c; cnt += (c > 0u) ? 1u : 0u; mine = (j == x) ? c : mine; }
        if (sum == G) break;
        __builtin_amdgcn_s_sleep(1);
        if ((++sp & 255u) == 0u) { if (xb_ld(&bar[XB_TMO])) break; if (sp > XB_SPIN_CAP) { atomicAdd(&bar[XB_TMO], 1u); break; } }
    }
    nloc = mine > 0u ? mine : 1u; nx = cnt > 0u ? cnt : 1u;
}
__device__ __forceinline__ void xcd_barrier(const XcdBarrier& b) {
    asm volatile("s_waitcnt vmcnt(0)" ::: "memory");
    __syncthreads();
    if (threadIdx.x == 0) {
        unsigned* bar = b.bar;
        __builtin_amdgcn_s_waitcnt(0);
        unsigned nloc = b.st[0], nx = b.st[1];
        if (nloc == 0u) { xcd_barrier_complete(bar, b.x, nloc, nx); b.st[0] = nloc; b.st[1] = nx; }
        const unsigned old = xb_add(&bar[XB_XSUB(b.x)], 1u);
        const unsigned gen = old / nloc;
        if (old + 1u == (gen + 1u) * nloc) {
            __builtin_amdgcn_fence(__ATOMIC_RELEASE, "agent");
            asm volatile("s_waitcnt vmcnt(0)" ::: "memory");
            const unsigned og = xb_add(&bar[XB_TOP], 1u);
            const unsigned tg = og / nx;
            if (og + 1u == (tg + 1u) * nx) xb_add(&bar[XB_TOPGEN], 1u);
            else XB_SPIN(xb_ld(&bar[XB_TOPGEN]) == tg, bar);
            __builtin_amdgcn_fence(__ATOMIC_ACQUIRE, "agent");
            xb_add(&bar[XB_XGEN(b.x)], 1u);
            asm volatile("s_waitcnt vmcnt(0)" ::: "memory");
        } else {
            XB_SPIN(xb_ld(&bar[XB_XGEN(b.x)]) == gen, bar);
            __builtin_amdgcn_fence(__ATOMIC_ACQUIRE, "agent");
            asm volatile("s_waitcnt vmcnt(0)" ::: "memory");
        }
    }
    __syncthreads();
}

struct Args { const float* in[27]; float* out; unsigned char* ws; unsigned char* dsb; int ph_lo, ph_hi; };
struct Frame {
    LAS unsigned char* lds; volatile LAS unsigned* MISC; gu32* ctl;
    int tid, lane, wave, vcu, G;
    const float* const* in; float* out; unsigned char* ws; unsigned char* dsb;
};

__device__ __forceinline__ void p0_transpose_item(const float* W, int N, bf16* WT, int ldt, int k0, int n0, int drow0, LAS unsigned* Tl, int lane) {
    const int kq = lane >> 3, c4 = lane & 7;
    f32x4 a[4], b[4];
#pragma unroll
    for (int i = 0; i < 4; ++i) { const float* p = W + (size_t)(k0 + 16 * i + 2 * kq) * N + n0 + 4 * c4; a[i] = *(const f32x4*)p; b[i] = *(const f32x4*)(p + N); }
#pragma unroll
    for (int i = 0; i < 4; ++i)
#pragma unroll
        for (int j = 0; j < 4; ++j) Tl[(4 * c4 + j) * 32 + ((8 * i + kq) ^ (4 * c4))] = pk2(a[i][j], b[i][j]);
    LDS_WAIT(); asm volatile("" ::: "memory");
#pragma unroll
    for (int jj = 0; jj < 4; ++jj) { const int n = (lane >> 3) + 8 * jj, c = lane & 7;
        const v4u o = *(const LAS v4u*)(Tl + n * 32 + 4 * (c ^ (n >> 2)));
        *(GAS v4u*)(WT + (size_t)(drow0 + n) * ldt + k0 + 8 * c) = o; }
    LDS_WAIT(); asm volatile("" ::: "memory");
}
__device__ __forceinline__ void ph1_hrows(Frame& F);
__device__ __forceinline__ void ph0_prologue(Frame& F) {
    const float* c = F.in[1]; const float* wada = F.in[2]; const float* bada = F.in[3];
    float* mod = (float*)(F.ws + WS_MOD);
    LAS float* sc = (LAS float*)(F.lds);
    LAS float* red = (LAS float*)(F.lds + 8192);
    for (int i = F.tid; i < 2 * D; i += NTHR) sc[i] = siluf_(c[i]);
    __syncthreads();
    for (int slab = F.vcu; slab < 256; slab += F.G) {
        const int n0 = slab * 24;
        if (F.tid < 510) {
            const int kq = F.tid / 6, c4 = F.tid % 6; float a[2][4];
#pragma unroll
            for (int b = 0; b < 2; ++b)
#pragma unroll
                for (int j = 0; j < 4; ++j) a[b][j] = 0.f;
            for (int k = kq; k < D; k += 85) { const f32x4 w = *(const f32x4*)(wada + (size_t)k * 6144 + n0 + 4 * c4); const float s0 = sc[k], s1 = sc[D + k];
#pragma unroll
                for (int j = 0; j < 4; ++j) { a[0][j] += s0 * w[j]; a[1][j] += s1 * w[j]; } }
#pragma unroll
            for (int b = 0; b < 2; ++b)
#pragma unroll
                for (int j = 0; j < 4; ++j) red[(kq * 6 + c4) * 8 + b * 4 + j] = a[b][j];
        }
        __syncthreads();
        if (F.tid < 48) { const int b = F.tid / 24, col = F.tid % 24, c4 = col >> 2, j = col & 3; float s = 0.f;
            for (int kq = 0; kq < 85; ++kq) s += red[(kq * 6 + c4) * 8 + b * 4 + j];
            mod[b * 6144 + n0 + col] = s + bada[n0 + col]; }
        __syncthreads();
    }
    VM_WAIT(); __syncthreads();
    if (F.tid == 0) { __builtin_amdgcn_fence(__ATOMIC_RELEASE, "agent"); VM_WAIT(); __hip_atomic_fetch_add(F.ctl + CW_MODCNT, 1u, RLX_AGENT); }
    const int gt = F.vcu * NTHR + F.tid, NGT = F.G * NTHR;
    if (gt < DH) { const float* g = F.in[9]; ((float*)(F.ws + WS_LB))[gt] = 1.f / (1.f + __expf(g[DH + gt] - g[gt])); }
    for (int e = gt; e < 48 * D; e += NGT) { const int n = e >> 10, kk = e & 1023; const float wv = n < NG ? F.in[20][kk * NG + n] : n < NG + NE ? F.in[22][kk * NE + n - NG] : 0.f;
        const unsigned hi = f2bf(wv); ((bf16*)(F.ws + WS_RRH))[e] = (bf16)hi; ((bf16*)(F.ws + WS_RRL))[e] = (bf16)f2bf(wv - bf2f(hi)); }
    for (int e = gt; e < 2 * 8 * 64 * 64; e += NGT) { const int which = e >> 15, r = e & 32767, blk = r >> 12, j = (r >> 6) & 63, i = r & 63;
        const float* w = which ? F.in[15] : F.in[13]; ((bf16*)(F.ws + (which ? WS_WIT : WS_WRT)))[r] = (bf16)f2bf(w[(size_t)(blk * 64 + i) * 64 + j]); }
    LAS unsigned* scr = (LAS unsigned*)(F.lds + 32768 + F.wave * 4096);
    const int gw = F.vcu * NWAVES + F.wave, NGW = F.G * NWAVES;
    constexpr int I_IN = 16 * 96, I_OUT = 16 * 32, I_E = 256 + 256 + 256, NITEMS = I_IN + I_OUT + NE * I_E;
    for (int it = gw; it < NITEMS; it += NGW) {
        int r = it;
        if (r < I_IN) { const int kb = r / 96, nb = r % 96; p0_transpose_item(F.in[8], DIN, (bf16*)(F.ws + WS_WIN), D, 64 * kb, 32 * nb, 32 * nb, scr, F.lane); continue; } r -= I_IN;
        if (r < I_OUT) { const int kb = r / 32, nb = r % 32; p0_transpose_item(F.in[19], D, (bf16*)(F.ws + WS_WOUT), D, 64 * kb, 32 * nb, 32 * nb, scr, F.lane); continue; } r -= I_OUT;
        const int e = r / I_E; r -= e * I_E;
        if (r < 512) { const int w3 = r >> 8, q = r & 255, kb = q >> 4, nb = q & 15, n0 = 32 * nb;
            p0_transpose_item((w3 ? F.in[25] : F.in[24]) + (size_t)e * D * DE, DE, (bf16*)(F.ws + WS_W13) + (size_t)e * D * D, D, 64 * kb, n0, (n0 >> 7) * 256 + (n0 & 127) + 128 * w3, scr, F.lane); }
        else { const int q = r - 512, kb = q >> 5, nb = q & 31;
            p0_transpose_item(F.in[26] + (size_t)e * DE * D, D, (bf16*)(F.ws + WS_W2) + (size_t)e * D * DE, DE, 64 * kb, 32 * nb, 32 * nb, scr, F.lane); }
    }
    if (F.tid < 64) { unsigned sp = 0;
        while ((unsigned)__builtin_amdgcn_readfirstlane(__hip_atomic_load(F.ctl + CW_MODCNT, RLX_AGENT)) < (unsigned)F.G) { __builtin_amdgcn_s_sleep(2); if (++sp > (1u << 20)) break; }
        __builtin_amdgcn_fence(__ATOMIC_ACQUIRE, "agent"); VM_WAIT(); }
    __syncthreads();
    ph1_hrows(F);
}

__device__ __forceinline__ void ph1_hrows(Frame& F) {
    const float* x = F.in[0]; const float* g = F.in[4]; const float* mod = (const float*)(F.ws + WS_MOD); bf16* H = (bf16*)(F.ws + WS_H);
    const int gw = F.vcu * NWAVES + F.wave, NGW = F.G * NWAVES;
    for (int m0 = gw; m0 < T / 2; m0 += NGW) {
        int lane = F.lane; asm volatile("" : "+v"(lane));
        f32x4 v[2][4];
#pragma unroll
        for (int r = 0; r < 2; ++r)
#pragma unroll
            for (int j = 0; j < 4; ++j) v[r][j] = ((const GAS f32x4*)(x + (size_t)(m0 + r * (T / 2)) * D) + lane)[64 * j];
#pragma unroll
        for (int r = 0; r < 2; ++r) { const int m = m0 + r * (T / 2); const float* sh = mod + r * 6144; const float* sc = sh + 1024; float s = 0.f;
#pragma unroll
            for (int j = 0; j < 4; ++j) s += v[r][j].x * v[r][j].x + v[r][j].y * v[r][j].y + v[r][j].z * v[r][j].z + v[r][j].w * v[r][j].w;
            const float rstd = rsqrtf(wave_sum(s) * (1.f / D) + EPS);
            GAS unsigned long long* o8 = (GAS unsigned long long*)(H + (size_t)m * D) + lane;
#pragma unroll
            for (int j = 0; j < 4; ++j) { const int c0 = 4 * lane + 256 * j; const f32x4 gg = *(const f32x4*)(g + c0), s1 = *(const f32x4*)(sc + c0), h1 = *(const f32x4*)(sh + c0);
                const float a0 = v[r][j].x * rstd * gg.x * (1.f + s1.x) + h1.x, a1 = v[r][j].y * rstd * gg.y * (1.f + s1.y) + h1.y, a2 = v[r][j].z * rstd * gg.z * (1.f + s1.z) + h1.z, a3 = v[r][j].w * rstd * gg.w * (1.f + s1.w) + h1.w;
                o8[64 * j] = (unsigned long long)pk2(a0, a1) | ((unsigned long long)pk2(a2, a3) << 32); } }
    }
}

constexpr int L_GT = 0;
constexpr int L_QTL = 4096;
constexpr int L_QH = L_QTL + 17408;
constexpr int L_KH = L_QH + 17408;
constexpr int L_VT = L_KH + 17408;
constexpr int L_P = L_VT + 18432;
constexpr int L_SSQ = L_P + 9216;
constexpr int L_RSTD = L_SSQ + 2048;
constexpr int L_OT = L_RSTD + 256;
constexpr int L_KT = L_QTL;
static_assert(L_OT + 17408 <= RING_BYTES, "mixer LDS map");

struct HgLoad { unsigned lf[8], ki[8], vv[8], q[8]; };
template <bool NEEDQ>
__device__ __forceinline__ void hg_load(Frame& F, int t0, int h, HgLoad& L) {
    const bf16* PJ = (const bf16*)(F.ws + WS_PROJ); const size_t base = (size_t)(t0 + 8 * F.wave) * DH + h * HD + 2 * (F.tid & 63);
#pragma unroll
    for (int i = 0; i < 8; ++i) { const size_t o = base + (size_t)i * DH; L.lf[i] = *(const unsigned*)(PJ + PROJ_S + o); L.ki[i] = *(const unsigned*)(PJ + 2 * PROJ_S + o); L.vv[i] = *(const unsigned*)(PJ + 3 * PROJ_S + o);
        if (NEEDQ) L.q[i] = *(const unsigned*)(PJ + o); }
}
__device__ __forceinline__ void hg_cumsum(Frame& F, const HgLoad& L, float (&c0)[8], float (&c1)[8], float (&off)[2], float (&bmid)[2], float (&blast)[2]) {
    LAS float* GT = (LAS float*)(F.lds + L_GT); const int kp = F.tid & 63, w = F.wave;
    float r0 = 0.f, r1 = 0.f;
#pragma unroll
    for (int i = 0; i < 8; ++i) { r0 += bf2f(L.lf[i] & 0xffffu); r1 += bf2f(L.lf[i] >> 16); c0[i] = r0; c1[i] = r1; }
    *(LAS f32x2_t*)(GT + w * 128 + 2 * kp) = (f32x2_t){r0, r1};
    __syncthreads();
    float a0 = 0.f, a1 = 0.f; off[0] = 0.f; off[1] = 0.f; bmid[0] = 0.f; bmid[1] = 0.f;
#pragma unroll
    for (int g = 0; g < 8; ++g) { const f32x2_t v = *(const LAS f32x2_t*)(GT + g * 128 + 2 * kp); if (g == w) { off[0] = a0; off[1] = a1; } a0 += v.x; a1 += v.y; if (g == 3) { bmid[0] = a0; bmid[1] = a1; } }
    blast[0] = a0; blast[1] = a1;
}
__device__ __forceinline__ void hg_store_vt(Frame& F, const HgLoad& L, LAS bf16* VT) {
    const int kp = F.tid & 63, w = F.wave; v4u lo, hi;
    lo.x = (L.vv[0] & 0xffffu) | (L.vv[1] << 16); lo.y = (L.vv[2] & 0xffffu) | (L.vv[3] << 16); lo.z = (L.vv[4] & 0xffffu) | (L.vv[5] << 16); lo.w = (L.vv[6] & 0xffffu) | (L.vv[7] << 16);
    hi.x = (L.vv[0] >> 16) | (L.vv[1] & 0xffff0000u); hi.y = (L.vv[2] >> 16) | (L.vv[3] & 0xffff0000u); hi.z = (L.vv[4] >> 16) | (L.vv[5] & 0xffff0000u); hi.w = (L.vv[6] >> 16) | (L.vv[7] & 0xffff0000u);
    *(LAS v4u*)(VT + (2 * kp) * 72 + 8 * w) = lo; *(LAS v4u*)(VT + (2 * kp + 1) * 72 + 8 * w) = hi;
}

template <bool FINAL>
__device__ __forceinline__ void rg_wave_task(Frame& F, int b, int n, int cb, unsigned (&valpk)[32]) {
    const int lane = F.lane, fr = lane & 15, fq = lane >> 4, c0 = 64 * cb; const int t0 = b * SEQ + 64 * n;
    const bf16* XR = (const bf16*)(F.ws + WS_PROJ) + 5 * PROJ_S; const bf16* YR = (const bf16*)(F.ws + WS_PROJ) + 6 * PROJ_S;
    const bf16* WRT = (const bf16*)(F.ws + WS_WRT); const bf16* WIT = (const bf16*)(F.ws + WS_WIT);
    bf16x8 IDf[2][2];
    v4u xq[2][4], gq[2];
#define RG_LOAD_TILE(tt_) do { const int tl_ = 16 * (tt_) + fr, tp_ = 64 * n + tl_; _Pragma("unroll") for (int ks = 0; ks < 2; ++ks) { const int cc = c0 + 32 * ks + 8 * fq; \
        _Pragma("unroll") for (int tap = 0; tap < 4; ++tap) { const bool ok_ = (tp_ - 3 + tap >= 0); const v4u x_ = *(const v4u*)(XR + (size_t)(t0 + (ok_ ? tl_ - 3 + tap : 0)) * DH + cc); \
            xq[ks][tap] = (v4u){ok_ ? x_.x : 0u, ok_ ? x_.y : 0u, ok_ ? x_.z : 0u, ok_ ? x_.w : 0u}; } \
        if (FINAL) gq[ks] = *(const v4u*)(YR + (size_t)(t0 + tl_) * DH + cc); } } while (0)
    RG_LOAD_TILE(0);
    LAS unsigned char* wl = F.lds + F.wave * 16384; LAS float* cwl = (LAS float*)(F.lds + RING_BYTES + F.wave * 2048);
#pragma unroll
    for (int p = 0; p < 8; ++p) { const int pc = p * 64 + lane, j = pc >> 3, sl = pc & 7; const size_t o = (size_t)(c0 + j) * 64 + 8 * sl;
        *(LAS v4u*)(wl + j * 128 + ((sl ^ (j & 7)) << 4)) = *(const v4u*)(WRT + o); *(LAS v4u*)(wl + 8192 + j * 128 + ((sl ^ (j & 7)) << 4)) = *(const v4u*)(WIT + o); }
#pragma unroll
    for (int tap = 0; tap < 4; ++tap) cwl[tap * 64 + lane] = F.in[11][tap * DR + c0 + lane];
    cwl[256 + lane] = F.in[12][c0 + lane];
    LDS_WAIT();
#pragma unroll
    for (int ks = 0; ks < 2; ++ks)
#pragma unroll
        for (int c2 = 0; c2 < 2; ++c2) { bf16x8 v;
#pragma unroll
            for (int j = 0; j < 8; ++j) v[j] = (short)((8 * fq + j == 16 * c2 + fr) ? 0x3F80 : 0);
            IDf[ks][c2] = v; }
    float br[4], bi[4], ls8[4], hrun[4], arun[4];
#pragma unroll
    for (int ct = 0; ct < 4; ++ct) { const int c = c0 + 16 * ct + fr; br[ct] = F.in[14][c]; bi[ct] = F.in[16][c]; const float lam = F.in[17][c]; ls8[ct] = -8.f * log1pf(__expf(-lam));
        hrun[ct] = FINAL ? ((const float*)(F.ws + WS_CARRY))[(size_t)(b * NCH + n) * DR + c] : 0.f; arun[ct] = 1.f; }
#pragma unroll
    for (int tt = 0; tt < 4; ++tt) {
        bf16x8 AX[2], AG[2];
#pragma unroll
        for (int ks = 0; ks < 2; ++ks) { const int cl = 32 * ks + 8 * fq; float xc[8];
            { const f32x4 b0 = *(const LAS f32x4*)(cwl + 256 + cl), b1 = *(const LAS f32x4*)(cwl + 256 + cl + 4); xc[0] = b0[0]; xc[1] = b0[1]; xc[2] = b0[2]; xc[3] = b0[3]; xc[4] = b1[0]; xc[5] = b1[1]; xc[6] = b1[2]; xc[7] = b1[3]; }
#pragma unroll
            for (int tap = 0; tap < 4; ++tap) { const v4u xv = xq[ks][tap];
                const f32x4 w0 = *(const LAS f32x4*)(cwl + tap * 64 + cl), w1 = *(const LAS f32x4*)(cwl + tap * 64 + cl + 4);
                xc[0] += w0[0] * bf2f(xv.x & 0xffffu); xc[1] += w0[1] * bf2f(xv.x >> 16); xc[2] += w0[2] * bf2f(xv.y & 0xffffu); xc[3] += w0[3] * bf2f(xv.y >> 16);
                xc[4] += w1[0] * bf2f(xv.z & 0xffffu); xc[5] += w1[1] * bf2f(xv.z >> 16); xc[6] += w1[2] * bf2f(xv.w & 0xffffu); xc[7] += w1[3] * bf2f(xv.w >> 16); }
            v4u pk; pk.x = pk2(xc[0], xc[1]); pk.y = pk2(xc[2], xc[3]); pk.z = pk2(xc[4], xc[5]); pk.w = pk2(xc[6], xc[7]); AX[ks] = __builtin_bit_cast(bf16x8, pk);
            if (FINAL) AG[ks] = __builtin_bit_cast(bf16x8, gq[ks]);
        }
        if (tt < 3) RG_LOAD_TILE(tt + 1);
        asm volatile("" ::: "memory");
#pragma unroll
        for (int ct = 0; ct < 4; ++ct) {
            f32x4 aR = {0.f, 0.f, 0.f, 0.f}, aI = {0.f, 0.f, 0.f, 0.f}, aX = {0.f, 0.f, 0.f, 0.f}, aG = {0.f, 0.f, 0.f, 0.f};
#pragma unroll
            for (int ks = 0; ks < 2; ++ks) { const int jr = 16 * ct + fr, so = jr * 128 + (((4 * ks + fq) ^ (jr & 7)) << 4);
                const bf16x8 wr_ = *(const LAS bf16x8*)(wl + so), wi_ = *(const LAS bf16x8*)(wl + 8192 + so);
                aR = __builtin_amdgcn_mfma_f32_16x16x32_bf16(AX[ks], wr_, aR, 0, 0, 0); aI = __builtin_amdgcn_mfma_f32_16x16x32_bf16(AX[ks], wi_, aI, 0, 0, 0); }
            aX = __builtin_amdgcn_mfma_f32_16x16x32_bf16(AX[ct >> 1], IDf[ct >> 1][ct & 1], aX, 0, 0, 0);
            if (FINAL) aG = __builtin_amdgcn_mfma_f32_16x16x32_bf16(AG[ct >> 1], IDf[ct >> 1][ct & 1], aG, 0, 0, 0);
            float a[4], u[4];
#pragma unroll
            for (int r = 0; r < 4; ++r) { const float rr = sigmoidf_(aR[r] + br[ct]), ii = sigmoidf_(aI[r] + bi[ct]); const float la = rr * ls8[ct]; a[r] = __expf(la);
                const float x2 = 2.f * la; const float em = (x2 > -0.03f) ? -x2 * (1.f + x2 * (0.5f + x2 * (0.16666667f + x2 * 0.041666667f))) : 1.f - a[r] * a[r];
                u[r] = sqrtf(em) * (ii * aX[r]); }
            float Af = a[0] * a[1] * a[2] * a[3], Hf = ((u[0] * a[1] + u[1]) * a[2] + u[2]) * a[3] + u[3];
            { const float Ap = __shfl_up(Af, 16), Hp = __shfl_up(Hf, 16); if (fq >= 1) { Hf = Af * Hp + Hf; Af = Ap * Af; } }
            { const float Ap = __shfl_up(Af, 32), Hp = __shfl_up(Hf, 32); if (fq >= 2) { Hf = Af * Hp + Hf; Af = Ap * Af; } }
            float Aex = __shfl_up(Af, 16), Hex = __shfl_up(Hf, 16); if (fq == 0) { Aex = 1.f; Hex = 0.f; }
            const float Atot = __shfl(Af, 48 + fr), Htot = __shfl(Hf, 48 + fr);
            if (FINAL) { float h = Aex * hrun[ct] + Hex;
#pragma unroll
                for (int r = 0; r < 4; ++r) { h = a[r] * h + u[r]; u[r] = h * aG[r]; }
                valpk[(tt * 4 + ct) * 2] = pk2(u[0], u[1]); valpk[(tt * 4 + ct) * 2 + 1] = pk2(u[2], u[3]); }
            hrun[ct] = Atot * hrun[ct] + Htot; arun[ct] *= Atot;
        }
    }
#undef RG_LOAD_TILE
    if (!FINAL && fq == 0) {
#pragma unroll
        for (int ct = 0; ct < 4; ++ct) { const size_t o = (size_t)(b * NCH + n) * DR + c0 + 16 * ct + fr; ((float*)(F.ws + WS_RGA))[o] = arun[ct]; ((float*)(F.ws + WS_RGH))[o] = hrun[ct]; }
    }
}

__device__ __forceinline__ void ph3_passA(Frame& F, int cn_rot = 0) {
    bf16* DS = (bf16*)F.dsb; float* DDp = (float*)(F.ws + WS_DD);
    const int lane = F.lane, w = F.wave, fr = lane & 15, fq = lane >> 4, kp = F.tid & 63;
    LAS bf16* KT = (LAS bf16*)(F.lds + L_KT); LAS bf16* VT = (LAS bf16*)(F.lds + L_VT);
    { const int cn = (F.vcu + cn_rot) & 255;
        const int b = cn / NCH, n = cn % NCH, t0 = b * SEQ + 64 * n;
        HgLoad L; hg_load<false>(F, t0, 0, L);
        { unsigned dummy[32]; rg_wave_task<false>(F, b, n, w, dummy); }
        __syncthreads();
#pragma unroll
        for (int h = 0; h < NH; ++h) {
            const int task = (b * NH + h) * NCH + n;
            float c0[8], c1[8], off[2], bmid[2], blast[2]; hg_cumsum(F, L, c0, c1, off, bmid, blast);
            unsigned k0p[4], k1p[4];
#pragma unroll
            for (int i = 0; i < 8; i += 2) {
                const float a0 = bf2f(L.ki[i] & 0xffffu) * __expf(blast[0] - (off[0] + c0[i])), a1 = bf2f(L.ki[i + 1] & 0xffffu) * __expf(blast[0] - (off[0] + c0[i + 1]));
                const float d0 = bf2f(L.ki[i] >> 16) * __expf(blast[1] - (off[1] + c1[i])), d1 = bf2f(L.ki[i + 1] >> 16) * __expf(blast[1] - (off[1] + c1[i + 1]));
                k0p[i >> 1] = pk2(a0, a1); k1p[i >> 1] = pk2(d0, d1); }
            *(LAS v4u*)(KT + (2 * kp) * 72 + 8 * w) = (v4u){k0p[0], k0p[1], k0p[2], k0p[3]}; *(LAS v4u*)(KT + (2 * kp + 1) * 72 + 8 * w) = (v4u){k1p[0], k1p[1], k1p[2], k1p[3]};
            hg_store_vt(F, L, VT);
            if (w == 0) *(f32x2_t*)(DDp + (size_t)task * HD + 2 * kp) = (f32x2_t){__expf(blast[0]), __expf(blast[1])};
            if (h + 1 < NH) hg_load<false>(F, t0, h + 1, L);
            __syncthreads();
            bf16x8 bV[2];
#pragma unroll
            for (int ss = 0; ss < 2; ++ss) bV[ss] = *(const LAS bf16x8*)(VT + (16 * w + fr) * 72 + 8 * fq + 32 * ss);
#pragma unroll
            for (int kt = 0; kt < 8; ++kt) { f32x4 acc = {0.f, 0.f, 0.f, 0.f};
#pragma unroll
                for (int ss = 0; ss < 2; ++ss) { const bf16x8 a = *(const LAS bf16x8*)(KT + (16 * kt + fr) * 72 + 8 * fq + 32 * ss); acc = __builtin_amdgcn_mfma_f32_16x16x32_bf16(a, bV[ss], acc, 0, 0, 0); }
                *(v2u*)(DS + (size_t)task * (HD * HD) + (size_t)(16 * w + fr) * HD + 16 * kt + 4 * fq) = (v2u){pk2m(acc[0], acc[1]), pk2m(acc[2], acc[3])}; }
            __syncthreads();
        }
    }
}

__device__ __forceinline__ void ph4_passB(Frame& F) {
    const bf16* DS = (const bf16*)F.dsb; bf16* SST = (bf16*)F.dsb + (size_t)BATCH * NH * NCH * HD * HD; const float* DDp = (const float*)(F.ws + WS_DD);
    const int gt = F.vcu * NTHR + F.tid, NGT = F.G * NTHR;
    for (int idx = gt; idx < BATCH * NH * HD * HD / 2 + BATCH * DR; idx += NGT) {
        if (idx < BATCH * NH * HD * HD / 2) {
            const int bh = idx >> 13, pr = idx & 8191, e0 = 2 * pr, kk = e0 & 127;
            float s0 = 0.f, s1 = 0.f;
            const bf16* dsp = DS + (size_t)bh * NCH * (HD * HD) + e0; bf16* sp = SST + (size_t)bh * NCH * (HD * HD) + e0; const float* ddp = DDp + (size_t)bh * NCH * HD + kk;
#pragma unroll 1
            for (int n0 = 0; n0 < NCH; n0 += 8) {
                unsigned dsv[8]; float d0[8], d1[8];
#pragma unroll
                for (int j = 0; j < 8; ++j) { dsv[j] = *(const unsigned*)(dsp + (size_t)(n0 + j) * (HD * HD)); d0[j] = ddp[(n0 + j) * HD]; d1[j] = ddp[(n0 + j) * HD + 1]; }
#pragma unroll
                for (int j = 0; j < 8; ++j) { *(unsigned*)(sp + (size_t)(n0 + j) * (HD * HD)) = pk2(s0, s1);
                    s0 = d0[j] * s0 + bf2f(dsv[j] & 0xffffu); s1 = d1[j] * s1 + bf2f(dsv[j] >> 16); }
            }
        } else {
            const int r = idx - BATCH * NH * HD * HD / 2, b = r / DR, c = r % DR;
            const float* A = (const float*)(F.ws + WS_RGA) + (size_t)b * NCH * DR + c; const float* Hh = (const float*)(F.ws + WS_RGH) + (size_t)b * NCH * DR + c; float* C = (float*)(F.ws + WS_CARRY) + (size_t)b * NCH * DR + c;
            float carry = 0.f;
#pragma unroll 4
            for (int n = 0; n < NCH; ++n) { C[(size_t)n * DR] = carry; carry = A[(size_t)n * DR] * carry + Hh[(size_t)n * DR]; }
        }
    }
}

__device__ __forceinline__ void ph5_passC(Frame& F, int cn_rot = 0) {
    const bf16* PJ = (const bf16*)(F.ws + WS_PROJ); const bf16* GZ = PJ + 4 * PROJ_S;
    const bf16* SST = (const bf16*)F.dsb + (size_t)BATCH * NH * NCH * HD * HD; bf16* O = (bf16*)(F.ws + WS_H);
    const int tid = F.tid, lane = F.lane, w = F.wave, fr = lane & 15, fq = lane >> 4, kp = tid & 63;
    LAS bf16* QTL = (LAS bf16*)(F.lds + L_QTL); LAS bf16* QH = (LAS bf16*)(F.lds + L_QH); LAS bf16* KH = (LAS bf16*)(F.lds + L_KH);
    LAS bf16* VT = (LAS bf16*)(F.lds + L_VT); LAS bf16* Pm = (LAS bf16*)(F.lds + L_P); LAS float* SSQ = (LAS float*)(F.lds + L_SSQ); LAS float* RSTD = (LAS float*)(F.lds + L_RSTD);
    { const int cn = (F.vcu + cn_rot) & 255;
        const int b = cn / NCH, n = cn % NCH, t0 = b * SEQ + 64 * n;
        {
            LAS float* SSQ = (LAS float*)(F.lds + X_GTAB); LAS float* RSTD = SSQ + 512;
            unsigned valpk[32];
            for (int rrg = 0; rrg < PROBE_RG5; ++rrg) rg_wave_task<true>(F, b, n, w, valpk);
#pragma unroll
            for (int tt = 0; tt < 4; ++tt) { float s[4] = {0.f, 0.f, 0.f, 0.f};
#pragma unroll
                for (int ct = 0; ct < 4; ++ct) { const unsigned p0 = valpk[(tt * 4 + ct) * 2], p1 = valpk[(tt * 4 + ct) * 2 + 1]; const float v0 = bf2f(p0 & 0xffffu), v1 = bf2f(p0 >> 16), v2 = bf2f(p1 & 0xffffu), v3 = bf2f(p1 >> 16);
                    s[0] += v0 * v0; s[1] += v1 * v1; s[2] += v2 * v2; s[3] += v3 * v3; }
#pragma unroll
                for (int r = 0; r < 4; ++r) { float x = s[r]; x += __shfl_xor(x, 1); x += __shfl_xor(x, 2); x += __shfl_xor(x, 4); x += __shfl_xor(x, 8); if (fr == 0) SSQ[(16 * tt + 4 * fq + r) * 8 + w] = x; } }
            __syncthreads();
            if (tid < 64) { float s = 0.f;
#pragma unroll
                for (int i = 0; i < 8; ++i) s += SSQ[tid * 8 + i];
                RSTD[tid] = rsqrtf(s * (1.f / DR) + EPS); }
            __syncthreads();
            { LAS bf16* VL = (LAS bf16*)(F.lds + w * 16384);
#pragma unroll
              for (int tt = 0; tt < 4; ++tt)
#pragma unroll
                  for (int ct = 0; ct < 4; ++ct) { const unsigned p0 = valpk[(tt * 4 + ct) * 2], p1 = valpk[(tt * 4 + ct) * 2 + 1]; const int tb = 16 * tt + 4 * fq, ch = 16 * ct + fr;
                      VL[(tb + 0) * 72 + ch] = (bf16)(p0 & 0xffffu); VL[(tb + 1) * 72 + ch] = (bf16)(p0 >> 16); VL[(tb + 2) * 72 + ch] = (bf16)(p1 & 0xffffu); VL[(tb + 3) * 72 + ch] = (bf16)(p1 >> 16); }
              LDS_WAIT();
              const int pc = lane & 7; const f32x4 g0 = *(const f32x4*)(F.in[18] + 64 * w + 8 * pc), g1 = *(const f32x4*)(F.in[18] + 64 * w + 8 * pc + 4);
#pragma unroll
              for (int p = 0; p < 8; ++p) { const int row = 8 * p + (lane >> 3); const v4u vv = *(const LAS v4u*)(VL + row * 72 + 8 * pc); const float rs = RSTD[row];
                  v4u o; o.x = pk2(bf2f(vv.x & 0xffffu) * rs * g0[0], bf2f(vv.x >> 16) * rs * g0[1]); o.y = pk2(bf2f(vv.y & 0xffffu) * rs * g0[2], bf2f(vv.y >> 16) * rs * g0[3]);
                  o.z = pk2(bf2f(vv.z & 0xffffu) * rs * g1[0], bf2f(vv.z >> 16) * rs * g1[1]); o.w = pk2(bf2f(vv.w & 0xffffu) * rs * g1[2], bf2f(vv.w >> 16) * rs * g1[3]);
                  *(v4u*)(O + (size_t)(t0 + row) * D + DH + 64 * w + 8 * pc) = o; } }
            __syncthreads();
        }
        HgLoad L; hg_load<true>(F, t0, 0, L);
        LAS bf16* OT = (LAS bf16*)(F.lds + L_OT);
#pragma unroll 1
        for (int hx = 0; hx < NH * PROBE_H5; ++hx) { const int h = hx & (NH - 1);
            const int task = (b * NH + h) * NCH + n;
            const int pr0 = tid >> 4, pc0 = (tid & 15) * 8;
            const v4u gz0 = *(const v4u*)(GZ + (size_t)(t0 + pr0) * DH + h * HD + pc0), gz1 = *(const v4u*)(GZ + (size_t)(t0 + pr0 + 32) * DH + h * HD + pc0);
            bf16x8 bS[4];
#pragma unroll
            for (int ks = 0; ks < 4; ++ks) bS[ks] = *(const bf16x8*)(SST + (size_t)task * (HD * HD) + (size_t)(16 * w + fr) * HD + 8 * fq + 32 * ks);
            float c0[8], c1[8], off[2], bmid[2], blast[2]; hg_cumsum(F, L, c0, c1, off, bmid, blast);
#pragma unroll
            for (int i = 0; i < 8; ++i) { const int tl = 8 * w + i; const float b0 = off[0] + c0[i], b1 = off[1] + c1[i];
                const float q0 = bf2f(L.q[i] & 0xffffu), q1 = bf2f(L.q[i] >> 16), k0 = bf2f(L.ki[i] & 0xffffu), k1 = bf2f(L.ki[i] >> 16);
                const float eq0 = __expf(fminf(b0 - bmid[0], 80.f)), eq1 = __expf(fminf(b1 - bmid[1], 80.f)), ek0 = __expf(fminf(bmid[0] - b0, 80.f)), ek1 = __expf(fminf(bmid[1] - b1, 80.f));
                *(LAS unsigned*)(QH + tl * 136 + 2 * kp) = pk2(q0 * eq0, q1 * eq1); *(LAS unsigned*)(KH + tl * 136 + 2 * kp) = pk2(k0 * ek0, k1 * ek1);
                *(LAS unsigned*)(QTL + tl * 136 + 2 * kp) = pk2(q0 * __expf(b0), q1 * __expf(b1)); }
            hg_store_vt(F, L, VT);
            if (hx + 1 < NH * PROBE_H5) hg_load<true>(F, t0, (hx + 1) & (NH - 1), L);
            __syncthreads();
#pragma unroll
            for (int pp = 0; pp < 2; ++pp) { const int pi = 2 * w + pp, iq = pi >> 2, jk = pi & 3; f32x4 acc = {0.f, 0.f, 0.f, 0.f};
                if (jk <= iq) {
#pragma unroll
                    for (int ks = 0; ks < 4; ++ks) { const bf16x8 a = *(const LAS bf16x8*)(KH + (16 * jk + fr) * 136 + 8 * fq + 32 * ks); const bf16x8 bq = *(const LAS bf16x8*)(QH + (16 * iq + fr) * 136 + 8 * fq + 32 * ks);
                        acc = __builtin_amdgcn_mfma_f32_16x16x32_bf16(a, bq, acc, 0, 0, 0); }
                    if (jk == iq) {
#pragma unroll
                        for (int r = 0; r < 4; ++r) if (4 * fq + r > fr) acc[r] = 0.f; }
                }
                *(LAS v2u*)(Pm + (16 * iq + fr) * 72 + 16 * jk + 4 * fq) = (v2u){pk2m(acc[0], acc[1]), pk2m(acc[2], acc[3])}; }
            __syncthreads();
            f32x4 oacc[4];
            { bf16x8 bV[2];
#pragma unroll
              for (int ss = 0; ss < 2; ++ss) bV[ss] = *(const LAS bf16x8*)(VT + (16 * w + fr) * 72 + 8 * fq + 32 * ss);
#pragma unroll
              for (int tt = 0; tt < 4; ++tt) { f32x4 acc = {0.f, 0.f, 0.f, 0.f};
#pragma unroll
                  for (int ss = 0; ss < 2; ++ss) { const bf16x8 a = *(const LAS bf16x8*)(Pm + (16 * tt + fr) * 72 + 8 * fq + 32 * ss); acc = __builtin_amdgcn_mfma_f32_16x16x32_bf16(a, bV[ss], acc, 0, 0, 0); }
#pragma unroll
                  for (int ks = 0; ks < 4; ++ks) { const bf16x8 a = *(const LAS bf16x8*)(QTL + (16 * tt + fr) * 136 + 8 * fq + 32 * ks); acc = __builtin_amdgcn_mfma_f32_16x16x32_bf16(a, bS[ks], acc, 0, 0, 0); }
                  oacc[tt] = acc; } }
            const float gh = F.in[10][h * HD + 16 * w + fr];
#pragma unroll
            for (int tt = 0; tt < 4; ++tt)
#pragma unroll
                for (int r = 0; r < 4; ++r) { const float ov = oacc[tt][r]; float x = ov * ov; x += __shfl_xor(x, 1); x += __shfl_xor(x, 2); x += __shfl_xor(x, 4); x += __shfl_xor(x, 8);
                    const int tl = 16 * tt + 4 * fq + r; if (fr == 0) SSQ[tl * 8 + w] = x; OT[tl * 136 + 16 * w + fr] = (bf16)f2bf(ov * gh); }
            __syncthreads();
            if (tid < 64) { float s = 0.f;
#pragma unroll
                for (int i = 0; i < 8; ++i) s += SSQ[tid * 8 + i];
                RSTD[tid] = rsqrtf(s * (1.f / HD) + EPS); }
            __syncthreads();
#pragma unroll
            for (int pz = 0; pz < 2; ++pz) { const int row = pr0 + 32 * pz; const v4u ot = *(const LAS v4u*)(OT + row * 136 + pc0), gz = pz ? gz1 : gz0; const float rs = RSTD[row];
                v4u o;
                o.x = pk2(bf2f(ot.x & 0xffffu) * rs * bf2f(gz.x & 0xffffu), bf2f(ot.x >> 16) * rs * bf2f(gz.x >> 16)); o.y = pk2(bf2f(ot.y & 0xffffu) * rs * bf2f(gz.y & 0xffffu), bf2f(ot.y >> 16) * rs * bf2f(gz.y >> 16));
                o.z = pk2(bf2f(ot.z & 0xffffu) * rs * bf2f(gz.z & 0xffffu), bf2f(ot.z >> 16) * rs * bf2f(gz.z >> 16)); o.w = pk2(bf2f(ot.w & 0xffffu) * rs * bf2f(gz.w & 0xffffu), bf2f(ot.w >> 16) * rs * bf2f(gz.w >> 16));
                *(v4u*)(O + (size_t)(t0 + row) * D + h * HD + pc0) = o; }
            __syncthreads();
        }
    }
}

constexpr int L7_HI = 0, L7_LO = 32768, L7_PART = 65536, L7_LG = L7_PART + 24576, L7_ROUT = L7_LG + 2304;
__device__ __forceinline__ void ph7_rows(Frame& F) {
    const float* x = F.in[0]; const float* mod = (const float*)(F.ws + WS_MOD); const bf16* mix = (const bf16*)(F.ws + WS_MIX);
    const float *gpm = F.in[5], *gpf = F.in[6], *brg = F.in[21], *bre = F.in[23];
    const bf16* RRH = (const bf16*)(F.ws + WS_RRH); const bf16* RRL = (const bf16*)(F.ws + WS_RRL);
    bf16* H = (bf16*)(F.ws + WS_H); float* wgt = (float*)(F.ws + WS_WGT);
    unsigned* cnt = (unsigned*)(F.ws + WS_CTL) + CW_CNT; int* list = (int*)(F.ws + WS_LIST);
    LAS float* PART = (LAS float*)(F.lds + L7_PART); LAS float* LG = (LAS float*)(F.lds + L7_LG); LAS float* ROUT = (LAS float*)(F.lds + L7_ROUT);
    const int w = F.wave, fr = F.lane & 15, fq = F.lane >> 4, row0 = 64 * F.vcu;
    bf16x8 bh[4][3], bl[4][3];
#pragma unroll
    for (int ks = 0; ks < 4; ++ks)
#pragma unroll
        for (int nt = 0; nt < 3; ++nt) { const size_t wo = (size_t)(16 * nt + fr) * D + 128 * w + 32 * ks + 8 * fq; bh[ks][nt] = *(const bf16x8*)(RRH + wo); bl[ks][nt] = *(const bf16x8*)(RRL + wo); }
    v2u mv[2][4]; f32x4 xv[2][4];
#define P7_LOAD(it_) do { _Pragma("unroll") for (int rr = 0; rr < 2; ++rr) { const int m_ = row0 + 16 * (it_) + 2 * w + rr; _Pragma("unroll") for (int j = 0; j < 4; ++j) { \
        mv[rr][j] = ((const GAS v2u*)(mix + (size_t)m_ * D) + lane)[64 * j]; xv[rr][j] = ((const GAS f32x4*)(x + (size_t)m_ * D) + lane)[64 * j]; } } } while (0)
    { const int lane = F.lane; P7_LOAD(0); }
#pragma unroll 1
    for (int it = 0; it < 4; ++it) {
        int lane = F.lane; asm volatile("" : "+v"(lane));
#pragma unroll
        for (int rr = 0; rr < 2; ++rr) {
            const int rl = 2 * w + rr, m = row0 + 16 * it + rl, b = m / SEQ; const float* mb = mod + b * 6144; const float *gt1 = mb + 2048, *sh2 = mb + 3072, *sc2 = mb + 4096;
            f32x4 v[4], xr_[4]; float s = 0.f;
#pragma unroll
            for (int j = 0; j < 4; ++j) { v[j] = (f32x4){bf2f(mv[rr][j].x & 0xffffu), bf2f(mv[rr][j].x >> 16), bf2f(mv[rr][j].y & 0xffffu), bf2f(mv[rr][j].y >> 16)}; xr_[j] = xv[rr][j];
                s += v[j].x * v[j].x + v[j].y * v[j].y + v[j].z * v[j].z + v[j].w * v[j].w; }
            const float rs1 = rsqrtf(wave_sum(s) * (1.f / D) + EPS); float s2 = 0.f;
#pragma unroll
            for (int j = 0; j < 4; ++j) { const int c0 = 4 * lane + 256 * j; const f32x4 gg = *(const f32x4*)(gpm + c0), gt = *(const f32x4*)(gt1 + c0);
                xr_[j].x += gt.x * (v[j].x * rs1 * gg.x); xr_[j].y += gt.y * (v[j].y * rs1 * gg.y); xr_[j].z += gt.z * (v[j].z * rs1 * gg.z); xr_[j].w += gt.w * (v[j].w * rs1 * gg.w);
                ((GAS unsigned long long*)((bf16*)(F.ws + WS_X1B) + (size_t)m * D) + lane)[64 * j] = (unsigned long long)pk2(xr_[j].x, xr_[j].y) | ((unsigned long long)pk2(xr_[j].z, xr_[j].w) << 32);
                s2 += xr_[j].x * xr_[j].x + xr_[j].y * xr_[j].y + xr_[j].z * xr_[j].z + xr_[j].w * xr_[j].w; }
            const float rs2 = rsqrtf(wave_sum(s2) * (1.f / D) + EPS);
#pragma unroll
            for (int j = 0; j < 4; ++j) { const int c0 = 4 * lane + 256 * j; const f32x4 gg = *(const f32x4*)(gpf + c0), sc = *(const f32x4*)(sc2 + c0), sh = *(const f32x4*)(sh2 + c0);
                const float h0 = xr_[j].x * rs2 * gg.x * (1.f + sc.x) + sh.x, h1 = xr_[j].y * rs2 * gg.y * (1.f + sc.y) + sh.y, h2 = xr_[j].z * rs2 * gg.z * (1.f + sc.z) + sh.z, h3 = xr_[j].w * rs2 * gg.w * (1.f + sc.w) + sh.w;
                const unsigned p01 = pk2(h0, h1), p23 = pk2(h2, h3);
                ((GAS unsigned long long*)(H + (size_t)m * D) + lane)[64 * j] = (unsigned long long)p01 | ((unsigned long long)p23 << 32);
                const unsigned q01 = pk2(h0 - bf2f(p01 & 0xffffu), h1 - bf2f(p01 >> 16)), q23 = pk2(h2 - bf2f(p23 & 0xffffu), h3 - bf2f(p23 >> 16));
                const int so = rl * 2048 + ((((lane >> 1) + 32 * j) ^ rl) << 4) + (lane & 1) * 8;
                *(LAS v2u*)(F.lds + L7_HI + so) = (v2u){p01, p23}; *(LAS v2u*)(F.lds + L7_LO + so) = (v2u){q01, q23}; }
        }
        if (it < 3) P7_LOAD(it + 1);
        __syncthreads();
        f32x4 acc[3] = {{0.f, 0.f, 0.f, 0.f}, {0.f, 0.f, 0.f, 0.f}, {0.f, 0.f, 0.f, 0.f}};
#pragma unroll
        for (int ks = 0; ks < 4; ++ks) { const int slot = 16 * w + 4 * ks + fq, so = fr * 2048 + ((slot ^ fr) << 4);
            const bf16x8 ah = *(const LAS bf16x8*)(F.lds + L7_HI + so), al = *(const LAS bf16x8*)(F.lds + L7_LO + so);
#pragma unroll
            for (int nt = 0; nt < 3; ++nt) {
                acc[nt] = __builtin_amdgcn_mfma_f32_16x16x32_bf16(ah, bh[ks][nt], acc[nt], 0, 0, 0); acc[nt] = __builtin_amdgcn_mfma_f32_16x16x32_bf16(ah, bl[ks][nt], acc[nt], 0, 0, 0); acc[nt] = __builtin_amdgcn_mfma_f32_16x16x32_bf16(al, bh[ks][nt], acc[nt], 0, 0, 0); } }
#pragma unroll
        for (int nt = 0; nt < 3; ++nt)
#pragma unroll
            for (int r = 0; r < 4; ++r) PART[(w * 16 + 4 * fq + r) * 48 + 16 * nt + fr] = acc[nt][r];
        __syncthreads();
        int tid16 = F.tid; asm volatile("" : "+v"(tid16));
        for (int e = tid16; e < 16 * 36; e += NTHR) { const int row = e / 36, o = e - row * 36; float a = o < 4 ? brg[o] : bre[o - 4];
#pragma unroll
            for (int ww = 0; ww < 8; ++ww) a += PART[(ww * 16 + row) * 48 + o];
            LG[e] = a; }
        __syncthreads();
        if (tid16 < 16) {
            const LAS float* lgl = LG + tid16 * 36;
            int gs = 0; float gm = lgl[0];
#pragma unroll
            for (int o = 1; o < NG; ++o) if (lgl[o] > gm) { gm = lgl[o]; gs = o; }
            float den = 0.f;
#pragma unroll
            for (int o = 0; o < NG; ++o) den += __expf(lgl[o] - gm);
            const float gate = 1.f / den;
            float sel[EPG];
#pragma unroll
            for (int o = 0; o < EPG; ++o) sel[o] = lgl[4 + 8 * gs + o];
            int i1 = 0; float m1 = sel[0];
#pragma unroll
            for (int o = 1; o < EPG; ++o) if (sel[o] > m1) { m1 = sel[o]; i1 = o; }
            int i2 = -1; float m2 = -3.0e38f;
#pragma unroll
            for (int o = 0; o < EPG; ++o) if (o != i1 && sel[o] > m2) { m2 = sel[o]; i2 = o; }
            if (i2 < 0) i2 = (i1 + 1) & 7;
            const float e2 = __expf(m2 - m1);
            *(LAS f32x4*)(ROUT + (16 * it + tid16) * 4) = (f32x4){__int_as_float(gs * EPG + i1), __int_as_float(gs * EPG + i2), gate / (1.f + e2), gate * e2 / (1.f + e2)};
        }
    }
#undef P7_LOAD
    LAS unsigned* HIST = (LAS unsigned*)(F.lds + L7_ROUT + 1024); LAS unsigned* BASE = HIST + 32;
    if (F.tid < 32) HIST[F.tid] = 0u;
    __syncthreads();
    int e_ = 0; unsigned rank_ = 0u;
    if (F.tid < 128) { const int rl = F.tid >> 1, kx = F.tid & 1; e_ = __float_as_int(ROUT[rl * 4 + kx]); rank_ = atomicAdd((unsigned*)(HIST + e_), 1u); wgt[2 * (row0 + rl) + kx] = ROUT[rl * 4 + 2 + kx]; }
    __syncthreads();
    if (F.tid < 32) { const unsigned c = HIST[F.tid]; BASE[F.tid] = c ? atomicAdd(&cnt[64 * F.tid], c) : 0u; }
    __syncthreads();
    if (F.tid < 128) list[e_ * 32768 + BASE[e_] + rank_] = 2 * row0 + F.tid;
    __syncthreads();
}

__device__ __forceinline__ int moe_tables(Frame& F) {
    LAS int* MBE = (LAS int*)(F.lds + X_MBE); LAS int* MBS = MBE + MAXMB; LAS int* NMB = MBS + 33;
    LAS int* CNTL = NMB + 1;
    if (F.tid < NE) CNTL[F.tid] = (int)__hip_atomic_load(F.ctl + CW_CNT + 64 * F.tid, RLX_AGENT);
    __syncthreads();
    if (F.tid == 0) { int mb = 0;
        for (int e = 0; e < NE; ++e) { const int c = CNTL[e]; MBS[e] = mb; const int nb = (c + 255) >> 8; for (int j = 0; j < nb && mb < MAXMB; ++j) MBE[mb++] = e; }
        MBS[NE] = mb; NMB[0] = mb; }
    __syncthreads();
    return NMB[0];
}
template <bool FOR_A>
__device__ __forceinline__ void moe_fill_tab(Frame& F, const pg8::MoeOrder& S) {
    LAS int* MBE = (LAS int*)(F.lds + X_MBE); LAS int* MBS = MBE + MAXMB; LAS int* tab = (LAS int*)(F.lds + X_GTAB); const int* list = (const int*)(F.ws + WS_LIST);
    pg8::Unit u;
    for (int i = 0; i < 8 && S.next(i, u) && u.slot == i; ++i) {
        if (F.tid < 256) { const int e = MBE[u.pm], pos = (u.pm - MBS[e]) * 256 + F.tid, c = (MBS + 34)[e];
            const int aid = pos < c ? list[e * 32768 + pos] : -1;
            tab[i * 256 + F.tid] = FOR_A ? (aid >= 0 ? (aid >> 1) * (D * 2) : 0) : aid; }
    }
    __syncthreads();
}

__device__ __forceinline__ void ph10_final(Frame& F) {
    const float* mod = (const float*)(F.ws + WS_MOD); const bf16* YA = (const bf16*)(F.ws + WS_YA); const bf16* X1 = (const bf16*)(F.ws + WS_X1B); const float* gp = F.in[7];
    const int gw = F.vcu * NWAVES + F.wave, NGW = F.G * NWAVES;
    for (int rep10 = 0; rep10 < PROBE_R10; ++rep10)
    for (int m0 = gw; m0 < T / 2; m0 += NGW) {
        int lane = F.lane; asm volatile("" : "+v"(lane));
        v2u ya[2][4], yb[2][4], xb[2][4];
#pragma unroll
        for (int r = 0; r < 2; ++r) { const int m = m0 + r * (T / 2);
#pragma unroll
            for (int j = 0; j < 4; ++j) { ya[r][j] = ((const GAS v2u*)(YA + (size_t)(2 * m) * D) + lane)[64 * j]; yb[r][j] = ((const GAS v2u*)(YA + (size_t)(2 * m + 1) * D) + lane)[64 * j]; xb[r][j] = ((const GAS v2u*)(X1 + (size_t)m * D) + lane)[64 * j]; } }
#pragma unroll
        for (int r = 0; r < 2; ++r) { const int m = m0 + r * (T / 2); const float* gt2 = mod + r * 6144 + 5120;
            float y[4][4]; float s = 0.f;
#pragma unroll
            for (int j = 0; j < 4; ++j) { const v2u a = ya[r][j], c = yb[r][j];
                y[j][0] = bf2f(a.x & 0xffffu) + bf2f(c.x & 0xffffu); y[j][1] = bf2f(a.x >> 16) + bf2f(c.x >> 16); y[j][2] = bf2f(a.y & 0xffffu) + bf2f(c.y & 0xffffu); y[j][3] = bf2f(a.y >> 16) + bf2f(c.y >> 16);
#pragma unroll
                for (int i = 0; i < 4; ++i) s += y[j][i] * y[j][i]; }
            const float rs = rsqrtf(wave_sum(s) * (1.f / D) + EPS);
#pragma unroll
            for (int j = 0; j < 4; ++j) { const int c0 = 4 * lane + 256 * j; const f32x4 gg = *(const f32x4*)(gp + c0), gt = *(const f32x4*)(gt2 + c0); const v2u xq = xb[r][j];
                f32x4 xv = {bf2f(xq.x & 0xffffu), bf2f(xq.x >> 16), bf2f(xq.y & 0xffffu), bf2f(xq.y >> 16)};
                xv.x += gt.x * (y[j][0] * rs * gg.x); xv.y += gt.y * (y[j][1] * rs * gg.y); xv.z += gt.z * (y[j][2] * rs * gg.z); xv.w += gt.w * (y[j][3] * rs * gg.w);
                if (rep10 == PROBE_R10 - 1) ((GAS f32x4*)(F.out + (size_t)m * D) + lane)[64 * j] = xv; else *((GAS f32x4*)(F.ws + WS_H + (size_t)(m >> 1) * D * 4) + lane + 64 * j) = xv; } }
    }
}

constexpr int NPH = 11;
__global__ void __launch_bounds__(NTHR, 2) skel_fwd(Args args) {
    extern __shared__ __attribute__((aligned(16))) unsigned char lds[];
    Frame F;
    F.lds = (LAS unsigned char*)lds; F.MISC = (volatile LAS unsigned*)(F.lds + X_MISC);
    F.tid = threadIdx.x; F.lane = F.tid & 63; F.wave = __builtin_amdgcn_readfirstlane(F.tid >> 6);
    F.G = gridDim.x; { const int bx = blockIdx.x; F.vcu = (F.G % 8 == 0) ? (bx % 8) * (F.G / 8) + bx / 8 : bx; }
    F.in = args.in; F.out = args.out; F.ws = args.ws; F.dsb = args.dsb; F.ctl = (gu32*)(args.ws + WS_CTL);
    if (F.tid < 32) F.MISC[F.tid] = 0u;
    __syncthreads();
    XcdBarrier bar; bar.bar = (unsigned*)(F.ctl + CW_BAR); bar.x = 0; bar.st = nullptr;
    const int lo = args.ph_lo, hi = args.ph_hi;
    const bool one = (hi - lo) > 1;
    if (one) bar = xcd_barrier_post((unsigned*)(F.ctl + CW_BAR), F.MISC + 8);
#ifndef PHMASK
#define PHMASK 0x7FF
#endif
#define IN(k) (((PHMASK >> (k)) & 1) && lo <= (k) && (k) < hi)
#define SEAM(k) do { if (IN(k) && IN((k) + 1)) for (int sb_ = 0; sb_ < PROBE_SEAM; ++sb_) xcd_barrier(bar); } while (0)
#ifndef REPMASK
#define REPMASK 0
#endif
#define REP(k) (((REPMASK >> (k)) & 1) != 0)

    if (IN(0)) { ph0_prologue(F); if (REP(0)) { xcd_barrier(bar); ph0_prologue(F); } } if (IN(0) && IN(2)) xcd_barrier(bar);
    if (IN(2)) for (int rep_ = 0; rep_ < (REP(2) ? 2 : 1); ++rep_) {
        if (rep_) xcd_barrier(bar);
        pg8::Gemm g{(const bf16*)(F.ws + WS_H), (const bf16*)(F.ws + WS_WIN), D}; pg8::StaticOrder S; S.init(T, DIN, D, F.G, (int)blockIdx.x, PROBE_G2);
        pg8::EpiProj E{(bf16*)(F.ws + WS_PROJ), (const float*)(F.ws + WS_LB)};
        pg8::gemm_phase<pg8::EpiProj, pg8::StaticOrder, false>(F.lds, g, S, E, nullptr);
    } SEAM(2);
    if (IN(3)) { ph3_passA(F); if (REP(3)) { xcd_barrier(bar); ph3_passA(F); } if (PROBE_ROTA > 1) { xcd_barrier(bar); ph3_passA(F, 77); } } SEAM(3);
    if (IN(4)) { ph4_passB(F); if (REP(4)) { xcd_barrier(bar); ph4_passB(F); } } SEAM(4);
    for (int xb_ = 1; xb_ < PROBE_BAR; ++xb_) xcd_barrier(bar);
    if (IN(5)) { ph5_passC(F); if (REP(5)) { xcd_barrier(bar); ph5_passC(F); } if (PROBE_ROTC > 1) { xcd_barrier(bar); ph5_passC(F, 77); } } SEAM(5);
    if (IN(6)) for (int rep_ = 0; rep_ < (REP(6) ? 2 : 1); ++rep_) {
        if (rep_) xcd_barrier(bar);
        pg8::Gemm g{(const bf16*)(F.ws + WS_H), (const bf16*)(F.ws + WS_WOUT), D}; pg8::StaticOrder S; S.init(T, D, D, F.G, (int)blockIdx.x);
        pg8::EpiMixB E{(bf16*)(F.ws + WS_MIX), D};
        pg8::gemm_phase<pg8::EpiMixB, pg8::StaticOrder, false>(F.lds, g, S, E, nullptr);
    } SEAM(6);
    if (IN(7)) { ph7_rows(F); } SEAM(7);
    if (IN(8)) {
        const int nmb = moe_tables(F);
        unsigned* mbc = (unsigned*)(F.ctl + CW_MB);
        { pg8::MoeOrder S{4 * nmb, F.G, (int)blockIdx.x, D, (const LAS int*)(F.lds + X_MBE), (size_t)D * D * 2, PROBE_M8, 0, mbc};
          moe_fill_tab<true>(F, S);
          pg8::Gemm g{(const bf16*)(F.ws + WS_H), (const bf16*)(F.ws + WS_W13), D}; pg8::EpiAct E{(bf16*)(F.ws + WS_ACT)};
          pg8::gemm_phase<pg8::EpiAct, pg8::MoeOrder, true>(F.lds, g, S, E, (const LAS unsigned*)(F.lds + X_GTAB)); }
        { pg8::MoeOrder S{4 * nmb, F.G, (int)blockIdx.x, DE, (const LAS int*)(F.lds + X_MBE), (size_t)D * DE * 2, PROBE_M9, 1, nullptr};
          moe_fill_tab<false>(F, S);
          if (F.tid < 64) { pg8::Unit u; unsigned sp = 0;
              for (int i = 0; i < 8 && S.next(i, u) && u.slot == i; ++i)
                  while ((unsigned)__builtin_amdgcn_readfirstlane(__hip_atomic_load(F.ctl + CW_MB + 64 * u.pm, RLX_AGENT)) < 32u) { __builtin_amdgcn_s_sleep(2); if (++sp > (1u << 22)) break; }
              __builtin_amdgcn_fence(__ATOMIC_ACQUIRE, "agent"); VM_WAIT(); }
          __syncthreads();
          pg8::Gemm g{(const bf16*)(F.ws + WS_ACT), (const bf16*)(F.ws + WS_W2), DE}; pg8::EpiYa E{(bf16*)(F.ws + WS_YA), (const float*)(F.ws + WS_WGT), (const LAS int*)(F.lds + X_GTAB)};
          pg8::gemm_phase<pg8::EpiYa, pg8::MoeOrder, false>(F.lds, g, S, E, nullptr); }
    } if (IN(8) && IN(10)) xcd_barrier(bar);
    if (IN(10)) { ph10_final(F); }
#undef IN
#undef SEAM
}


extern "C" void kernel_launch(void* const* d_in, const int* in_sizes, int n_in, void* d_out, int out_size, void* d_ws, size_t ws_size, hipStream_t stream) {
    static int grid = 0;
    if (grid == 0) {
        if (n_in != 27 || out_size != T * D || ws_size < WS_END) { fprintf(stderr, "kernel_launch: unexpected n_in %d / out %d / ws %zu\n", n_in, out_size, ws_size); grid = -1; return; }
        int dev = 0, cus = 0, per_cu = 0;
        if (hipGetDevice(&dev) != hipSuccess || hipDeviceGetAttribute(&cus, hipDeviceAttributeMultiprocessorCount, dev) != hipSuccess) { grid = -1; return; }
        if (hipFuncSetAttribute((const void*)skel_fwd, hipFuncAttributeMaxDynamicSharedMemorySize, LDS_BYTES) != hipSuccess) { fprintf(stderr, "kernel_launch: hipFuncSetAttribute failed\n"); grid = -1; return; }
        if (hipOccupancyMaxActiveBlocksPerMultiprocessor(&per_cu, (const void*)skel_fwd, NTHR, LDS_BYTES) != hipSuccess || per_cu < 1) { fprintf(stderr, "kernel_launch: occupancy query says %d blocks per CU\n", per_cu); per_cu = 1; }
        (void)hipGetLastError();
        if (cus < 256) { fprintf(stderr, "kernel_launch: needs 256 CUs (one resident workgroup per chunk), device has %d\n", cus); grid = -1; return; }
        grid = 256;
        fprintf(stderr, "kernel_launch: grid %d, occupancy query %d per CU, ws %zu MiB\n", grid, per_cu, ws_size >> 20);
    }
    if (grid < 0) return;
    (void)hipMemsetAsync((char*)d_ws + WS_CTL, 0, CTL_ZERO_BYTES, stream);
    Args a{};
    for (int i = 0; i < 27; ++i) a.in[i] = (const float*)d_in[i];
    a.out = (float*)d_out; a.ws = (unsigned char*)d_ws; a.dsb = (unsigned char*)d_out;
#if MK_N_LAUNCHES == 1
    a.ph_lo = 0; a.ph_hi = NPH;
    hipLaunchKernelGGL(skel_fwd, dim3(grid), dim3(NTHR), LDS_BYTES, stream, a);
    if (PROBE_TAIL > 1) { a.dsb = (unsigned char*)d_ws + WS_W13; a.ph_lo = 0; a.ph_hi = PROBE_TAIL; (void)hipMemsetAsync((char*)d_ws + WS_CTL, 0, CTL_ZERO_BYTES, stream); hipLaunchKernelGGL(skel_fwd, dim3(grid), dim3(NTHR), LDS_BYTES, stream, a); }
    if (PROBE_TAIL67 > 1) { a.out = (float*)((unsigned char*)d_ws + WS_W13); a.ph_lo = 6; a.ph_hi = 6 + PROBE_TAIL67 - 1; (void)hipMemsetAsync((char*)d_ws + WS_CTL, 0, CTL_ZERO_BYTES, stream); hipLaunchKernelGGL(skel_fwd, dim3(grid), dim3(NTHR), LDS_BYTES, stream, a); }
    if (PROBE_TAIL8 > 1) { a.ph_lo = 8; a.ph_hi = 9; hipLaunchKernelGGL(skel_fwd, dim3(grid), dim3(NTHR), LDS_BYTES, stream, a); }
    if (PROBE_TAIL10 > 1) { a.out = (float*)((unsigned char*)d_ws + WS_W13); a.ph_lo = 10; a.ph_hi = 11; hipLaunchKernelGGL(skel_fwd, dim3(grid), dim3(NTHR), LDS_BYTES, stream, a); }
    for (int all_ = 1; all_ < PROBE_ALL; ++all_) { (void)hipMemsetAsync((char*)d_ws + WS_CTL, 0, CTL_ZERO_BYTES, stream); hipLaunchKernelGGL(skel_fwd, dim3(grid), dim3(NTHR), LDS_BYTES, stream, a); }
#else
    for (int ph = 0; ph < NPH; ++ph) { a.ph_lo = ph; a.ph_hi = ph + 1; hipLaunchKernelGGL(skel_fwd, dim3(grid), dim3(NTHR), LDS_BYTES, stream, a); }
#endif
}
```

```cpp
#include <hip/hip_runtime.h>
#include <cstdio>
#include <cstdint>

constexpr int BATCH = 2, SEQ = 8192, D = 1024, T = BATCH * SEQ;
constexpr int DH = 512, HD = 128, NH = 4, CHK = 64, NCH = SEQ / CHK;
constexpr int DR = 512, RBD = 64;
constexpr int DIN = 3072;
constexpr int NG = 4, EPG = 8, NE = 32, DE = 512;
constexpr int MAXMB = 160;
constexpr float EPS = 1e-6f;
constexpr int NWAVES = 8, NTHR = 512;

#define GAS __attribute__((address_space(1)))
#define LAS __attribute__((address_space(3)))
typedef unsigned short bf16;
typedef unsigned v4u __attribute__((ext_vector_type(4)));
typedef unsigned v2u __attribute__((ext_vector_type(2)));
typedef float f32x4 __attribute__((ext_vector_type(4)));
typedef short bf16x8 __attribute__((ext_vector_type(8)));
typedef GAS unsigned gu32;
#define RLX_AGENT __ATOMIC_RELAXED, __HIP_MEMORY_SCOPE_AGENT
#define LDS_WAIT() asm volatile("s_waitcnt lgkmcnt(0)" ::: "memory")
#define VM_WAIT() asm volatile("s_waitcnt vmcnt(0)" ::: "memory")
#define LDS_BAR() do { asm volatile("s_waitcnt lgkmcnt(0)" ::: "memory"); __builtin_amdgcn_s_barrier(); asm volatile("" ::: "memory"); } while (0)

__device__ __forceinline__ unsigned f2bf(float f) { unsigned u = __builtin_bit_cast(unsigned, f); return (u + 0x7fffu + ((u >> 16) & 1u)) >> 16; }
__device__ __forceinline__ float bf2f(unsigned h) { return __builtin_bit_cast(float, h << 16); }
typedef float f32x2_t __attribute__((ext_vector_type(2))); typedef __bf16 bf16x2_t __attribute__((ext_vector_type(2)));
__device__ __forceinline__ unsigned pk2m(float lo, float hi) { f32x2_t v = {lo, hi}; bf16x2_t b = __builtin_convertvector(v, bf16x2_t); return __builtin_bit_cast(unsigned, b); }
__device__ __forceinline__ unsigned pk2(float lo, float hi) { unsigned r; asm volatile("v_cvt_pk_bf16_f32 %0, %1, %2" : "=v"(r) : "v"(lo), "v"(hi)); return r; }
__device__ __forceinline__ float frcp(float v) { return __builtin_amdgcn_rcpf(v); }
__device__ __forceinline__ float sigmoidf_(float v) { return frcp(1.f + __expf(-v)); }
__device__ __forceinline__ float siluf_(float v) { return v * frcp(1.f + __expf(-v)); }
__device__ __forceinline__ float gelu_tanh_(float v) { const float u = 1.5957691216057308f * (v + 0.044715f * v * v * v); return v * frcp(1.f + __expf(-u)); }
template <int CTRL> __device__ __forceinline__ float dpp_f(float x) { return __builtin_bit_cast(float, __builtin_amdgcn_update_dpp(0, __builtin_bit_cast(int, x), CTRL, 0xF, 0xF, false)); }
__device__ __forceinline__ float row_sum16(float x) {
    x += dpp_f<0x121>(x); x += dpp_f<0x122>(x); x += dpp_f<0x124>(x); x += dpp_f<0x128>(x); return x; }
__device__ __forceinline__ float wave_sum(float v) {
    v = row_sum16(v);
    const int vi = __builtin_bit_cast(int, v);
    return (__builtin_bit_cast(float, __builtin_amdgcn_readlane(vi, 0)) + __builtin_bit_cast(float, __builtin_amdgcn_readlane(vi, 16))) + (__builtin_bit_cast(float, __builtin_amdgcn_readlane(vi, 32)) + __builtin_bit_cast(float, __builtin_amdgcn_readlane(vi, 48)));
}

__device__ __forceinline__ float partner_row16(float x, bool odd_row) { float a = x, b = x; asm volatile("s_nop 1\n\tv_permlane16_swap_b32 %0, %1" : "+v"(a), "+v"(b)); return odd_row ? a : b; }
__device__ __forceinline__ float partner_half32(float x, bool upper) { float a = x, b = x; asm volatile("s_nop 1\n\tv_permlane32_swap_b32 %0, %1" : "+v"(a), "+v"(b)); return upper ? a : b; }

constexpr size_t MiB = 1u << 20, KiB = 1u << 10;
constexpr size_t WS_CTL = 0, CTL_ZERO_BYTES = 160 * KiB;
constexpr size_t WS_MOD = 1 * MiB;
constexpr size_t WS_LB = WS_MOD + 64 * KiB;
constexpr size_t WS_WRT = WS_MOD + 128 * KiB;
constexpr size_t WS_WIT = WS_WRT + 64 * KiB;
constexpr size_t WS_RRH = WS_WIT + 64 * KiB;
constexpr size_t WS_RRL = WS_RRH + 96 * KiB;
constexpr size_t WS_RGA = 2 * MiB;
constexpr size_t WS_RGH = WS_RGA + 512 * KiB;
constexpr size_t WS_CARRY = WS_RGH + 512 * KiB;
constexpr size_t WS_DD = WS_CARRY + 512 * KiB;
constexpr size_t WS_WGT = 4 * MiB;
constexpr size_t WS_LIST = 5 * MiB;
constexpr size_t WS_WIN = 10 * MiB;
constexpr size_t WS_WOUT = 16 * MiB;
constexpr size_t WS_W13 = 18 * MiB;
constexpr size_t WS_W2 = 82 * MiB;
constexpr size_t WS_H = 114 * MiB;
constexpr size_t WS_PROJ = 146 * MiB;
constexpr size_t WS_MIX = WS_PROJ;
constexpr size_t WS_YA = WS_PROJ;
constexpr size_t WS_ACT = WS_PROJ + 64 * MiB;
constexpr size_t WS_X1B = 258 * MiB;
constexpr size_t WS_END = 290 * MiB;
constexpr size_t PROJ_S = (size_t)T * DH;
constexpr int CW_CNT = 32768;
constexpr int CW_MODCNT = 128;
constexpr int CW_BAR = 4096;
constexpr int CW_MB = 16384;

constexpr int RING_BYTES = 131072;
constexpr int RTAB_BYTES = 1024 * 36 * 4;
constexpr int X_OFF = RTAB_BYTES;
constexpr int X_GTAB = X_OFF;
constexpr int X_MBE = X_OFF + 8192;
constexpr int X_MISC = X_OFF + 10240;
constexpr int LDS_BYTES = X_OFF + 12288;

namespace pg8 {
constexpr int BM = 256, BK = 64, HALF = 128, HTB = HALF * BK * 2, NXCD = 8, WGM = 8;
__host__ __device__ __forceinline__ int lds_byte(int r, int c) { const int st = (r >> 4) * 2 + (c >> 5), rr = r & 15, cc = c & 31, ob = rr * 64 + cc * 2; return st * 1024 + (ob ^ (((ob >> 9) & 1) << 5)); }
__host__ __device__ __forceinline__ void stage_rc(int b, int& R, int& C) { const int st = b / 1024, sb = b % 1024, swz = sb ^ (((sb >> 9) & 1) << 5); R = (st >> 1) * 16 + swz / 64; C = (st & 1) * 32 + (swz % 64) / 2; }
__host__ __device__ __forceinline__ int perm32(int rho) { const int n = rho >> 4, i = rho & 15; return 8 * (i >> 2) + 4 * n + (i & 3); }

struct Unit { int pm, pn, slot; };
struct Gemm { const bf16* A; const bf16* Bt; int K; };

struct StaticOrder {
    int nM, nN, nwg, G, c, K, rep;
    __device__ __forceinline__ void init(int M, int N, int K_, int G_, int c_, int rep_ = 1) { nM = M / BM; nN = N / BM; nwg = nM * nN; G = G_; c = c_; K = K_; rep = rep_; }
    __device__ __forceinline__ bool next(int i, Unit& u) const {
        long L = (long)i * G + c; if (L >= (long)nwg * rep) return false; L %= nwg;
        int wgid = (int)L; { const int q = nwg / NXCD, r = nwg % NXCD, xcd = wgid % NXCD, off = wgid / NXCD; wgid = (xcd < r ? xcd * (q + 1) : r * (q + 1) + (xcd - r) * q) + off; }
        const int nig = WGM * nN, gid = wgid / nig, fm = gid * WGM, gsz = (nM - fm) < WGM ? (nM - fm) : WGM;
        u.pm = fm + ((wgid % nig) % gsz); u.pn = (wgid % nig) / gsz; u.slot = i; return true;
    }
    __device__ __forceinline__ size_t aoff(const Unit& u) const { return (size_t)u.pm * BM * K * 2; }
    __device__ __forceinline__ size_t boff(const Unit& u) const { return (size_t)u.pn * BM * K * 2; }
    __device__ __forceinline__ void done(const Unit&) const {}
};
struct MoeOrder {
    int nunits, G, c, K; const LAS int* mbe; size_t estride; int rep;
    int rev; unsigned* done_cnt;
    __device__ __forceinline__ bool next(int i, Unit& u) const {
        const int x = c & 7, ci = c >> 3; const int lo = (int)(((long)nunits * x) >> 3), hi = (int)(((long)nunits * (x + 1)) >> 3);
        int mine; long L0; int stride;
        if (!rev) { mine = (hi - lo - ci + 31) >> 5; L0 = lo + ci; stride = 32; }
        else {
            const int U = hi - lo, base = U >> 5, rem = U & 31, Tc = (3 * U + 31) >> 5;
            int dhi = Tc - 2 * (base + 1); dhi = dhi > 0 ? dhi : 0; int dlo = Tc - 2 * base; dlo = dlo > 0 ? dlo : 0;
            int tailn = rem * dhi; tailn = tailn < U ? tailn : U; const int headn = U - tailn;
            int s0, s1;
            if (ci < rem) { s1 = U - ci * dhi; s0 = s1 - dhi; s0 = s0 > headn ? s0 : headn; s1 = s1 > headn ? s1 : headn; }
            else { s0 = (ci - rem) * dlo; s1 = s0 + dlo; s0 = s0 < headn ? s0 : headn; s1 = s1 < headn ? s1 : headn; }
            mine = s1 - s0; L0 = lo + s0; stride = 1; }
        if (mine <= 0 || i >= mine * rep) return false;
        const int ii = i % mine; const long L = L0 + (long)stride * ii;
        u.pm = (int)(L >> 2); u.pn = (int)(L & 3); u.slot = ii; return true;
    }
    __device__ __forceinline__ size_t aoff(const Unit& u) const { return (size_t)u.pm * BM * K * 2; }
    __device__ __forceinline__ size_t boff(const Unit& u) const { return (size_t)mbe[u.pm] * estride + (size_t)u.pn * BM * K * 2; }
    __device__ __forceinline__ void done(const Unit& u) const {
        if (done_cnt) { asm volatile("s_waitcnt vmcnt(0)" ::: "memory"); if ((threadIdx.x & 63) == 0) __hip_atomic_fetch_add(done_cnt + 64 * u.pm, 1u, __ATOMIC_RELAXED, __HIP_MEMORY_SCOPE_AGENT); }
    }
};

struct EpiProj {
    static constexpr bool PERM = true;
    bf16* base; const float* lb;
    __device__ __forceinline__ void operator()(const f32x4 (&acc)[2][2][4][2], const Unit& u, int wr, int wc, int fr, int fq) const {
        const int grp = u.pn >> 1, c0 = (u.pn & 1) * 256 + wc * 32 + 8 * fq, row0 = u.pm * BM + wr * 64 + fr;
        bf16* ob = base + (grp == 0 ? 0 : grp == 1 ? PROJ_S : (size_t)(grp + 1) * PROJ_S);
        float lbv[2][8];
        if (grp == 1) {
#pragma unroll
            for (int bj = 0; bj < 2; ++bj) { const f32x4 a = *(const f32x4*)(lb + c0 + bj * HALF), b = *(const f32x4*)(lb + c0 + bj * HALF + 4);
                lbv[bj][0] = a[0]; lbv[bj][1] = a[1]; lbv[bj][2] = a[2]; lbv[bj][3] = a[3]; lbv[bj][4] = b[0]; lbv[bj][5] = b[1]; lbv[bj][6] = b[2]; lbv[bj][7] = b[3]; }
        }
#pragma unroll
        for (int ai = 0; ai < 2; ++ai)
#pragma unroll
            for (int m = 0; m < 4; ++m) { bf16* rowp = ob + (size_t)(row0 + ai * HALF + m * 16) * DH + c0;
#pragma unroll
                for (int bj = 0; bj < 2; ++bj) {
                    float v[8];
#pragma unroll
                    for (int j = 0; j < 4; ++j) { v[j] = acc[ai][bj][m][0][j]; v[4 + j] = acc[ai][bj][m][1][j]; }
                    if (grp == 1) {
                        float kv[8];
#pragma unroll
                        for (int j = 0; j < 8; ++j) { const float l = lbv[bj][j], sg = sigmoidf_(v[j]); kv[j] = (1.f - l) * (1.f - sg); v[j] = __logf(l + (1.f - l) * sg); }
                        v4u w; w.x = pk2(kv[0], kv[1]); w.y = pk2(kv[2], kv[3]); w.z = pk2(kv[4], kv[5]); w.w = pk2(kv[6], kv[7]);
                        *(v4u*)(rowp + PROJ_S + bj * HALF) = w;
                    } else if (grp == 0 || grp == 3) {
#pragma unroll
                        for (int j = 0; j < 8; ++j) v[j] = siluf_(v[j]);
                    } else if (grp == 5) {
#pragma unroll
                        for (int j = 0; j < 8; ++j) v[j] = gelu_tanh_(v[j]);
                    }
                    v4u w; w.x = pk2m(v[0], v[1]); w.y = pk2m(v[2], v[3]); w.z = pk2m(v[4], v[5]); w.w = pk2m(v[6], v[7]);
                    *(v4u*)(rowp + bj * HALF) = w;
                } }
    }
};
struct EpiF32 {
    static constexpr bool PERM = false;
    float* C; int ldc;
    __device__ __forceinline__ void operator()(const f32x4 (&acc)[2][2][4][2], const Unit& u, int wr, int wc, int fr, int fq) const {
        const int row0 = u.pm * BM + wr * 64 + fr, col0 = u.pn * BM + wc * 32 + 4 * fq;
#pragma unroll
        for (int ai = 0; ai < 2; ++ai)
#pragma unroll
            for (int m = 0; m < 4; ++m) { float* rowp = C + (size_t)(row0 + ai * HALF + m * 16) * ldc + col0;
#pragma unroll
                for (int bj = 0; bj < 2; ++bj)
#pragma unroll
                    for (int n = 0; n < 2; ++n) *(f32x4*)(rowp + bj * HALF + n * 16) = acc[ai][bj][m][n]; }
    }
};
struct EpiMixB {
    static constexpr bool PERM = true;
    bf16* C; int ldc;
    __device__ __forceinline__ void operator()(const f32x4 (&acc)[2][2][4][2], const Unit& u, int wr, int wc, int fr, int fq) const {
        const int row0 = u.pm * BM + wr * 64 + fr, col0 = u.pn * BM + wc * 32 + 8 * fq;
#pragma unroll
        for (int ai = 0; ai < 2; ++ai)
#pragma unroll
            for (int m = 0; m < 4; ++m) { bf16* rowp = C + (size_t)(row0 + ai * HALF + m * 16) * ldc + col0;
#pragma unroll
                for (int bj = 0; bj < 2; ++bj) { const f32x4 a = acc[ai][bj][m][0], b = acc[ai][bj][m][1];
                    v4u w; w.x = pk2m(a[0], a[1]); w.y = pk2m(a[2], a[3]); w.z = pk2m(b[0], b[1]); w.w = pk2m(b[2], b[3]);
                    *(v4u*)(rowp + bj * HALF) = w; } }
    }
};
struct EpiAct {
    static constexpr bool PERM = true;
    bf16* act;
    __device__ __forceinline__ void operator()(const f32x4 (&acc)[2][2][4][2], const Unit& u, int wr, int wc, int fr, int fq) const {
        const int row0 = u.pm * BM + wr * 64 + fr, col0 = u.pn * HALF + wc * 32 + 8 * fq;
#pragma unroll
        for (int ai = 0; ai < 2; ++ai)
#pragma unroll
            for (int m = 0; m < 4; ++m) {
                float v[8];
#pragma unroll
                for (int j = 0; j < 4; ++j) { v[j] = siluf_(acc[ai][0][m][0][j]) * acc[ai][1][m][0][j]; v[4 + j] = siluf_(acc[ai][0][m][1][j]) * acc[ai][1][m][1][j]; }
                v4u w; w.x = pk2(v[0], v[1]); w.y = pk2(v[2], v[3]); w.z = pk2(v[4], v[5]); w.w = pk2(v[6], v[7]);
                bf16* dst = act + (size_t)(row0 + ai * HALF + m * 16) * DE + col0;
                asm volatile("global_store_dwordx4 %0, %1, off sc1\n\ts_nop 1" :: "v"(dst), "v"(w) : "memory"); }
    }
};
struct EpiYa {
    static constexpr bool PERM = true;
    bf16* ya; const float* wgt; const LAS int* tab;
    __device__ __forceinline__ void operator()(const f32x4 (&acc)[2][2][4][2], const Unit& u, int wr, int wc, int fr, int fq) const {
        const int col0 = u.pn * BM + wc * 32 + 8 * fq;
#pragma unroll
        for (int ai = 0; ai < 2; ++ai)
#pragma unroll
            for (int m = 0; m < 4; ++m) { const int aid = tab[u.slot * 256 + ai * HALF + wr * 64 + m * 16 + fr];
                if (aid >= 0) { const float w8 = wgt[aid]; bf16* rowp = ya + (size_t)aid * D + col0;
#pragma unroll
                    for (int bj = 0; bj < 2; ++bj) { const f32x4 a = acc[ai][bj][m][0] * w8, b = acc[ai][bj][m][1] * w8;
                        v4u w; w.x = pk2(a[0], a[1]); w.y = pk2(a[2], a[3]); w.z = pk2(b[0], b[1]); w.w = pk2(b[2], b[3]);
                        *(v4u*)(rowp + bj * HALF) = w; } } }
    }
};

template <class Epi, class Sched, bool GATHER, bool ALIGN_EPI = true>
__device__ __forceinline__ void gemm_phase(LAS unsigned char* lds, const Gemm g, const Sched& S, const Epi& E, const LAS unsigned* gtab) {
    const int tid = threadIdx.x, wid = __builtin_amdgcn_readfirstlane(tid >> 6), lane = tid & 63, wr = wid >> 2, wc = wid & 3, fr = lane & 15, fq = lane >> 4;
    const int K = g.K, nt = K / BK;
    unsigned voffA[2], voffB[2]; int rowA[2];
#pragma unroll
    for (int i = 0; i < 2; ++i) { int R, C; stage_rc(tid * 16 + i * 8192, R, C); const int Rb = Epi::PERM ? ((R & ~31) + perm32(R & 31)) : R;
        voffA[i] = GATHER ? (unsigned)(C * 2) : (unsigned)(R * K + C) * 2u; voffB[i] = (unsigned)(Rb * K + C) * 2u; rowA[i] = R; }
    const size_t kstep = (size_t)(BK * 2);
    const size_t hstep = (size_t)HALF * K * 2;
    const unsigned ldsw = (unsigned)wid * 1024u;
    const int aoff = lds_byte(wr * 64 + fr, fq * 8), boff = lds_byte(wc * 32 + fr, fq * 8);
#define PG8_SA(b, h) (((b) * 2 + (h)) * HTB)
#define PG8_SB(b, h) ((4 + (b) * 2 + (h)) * HTB)
#define PG8_STAGE(bufoff, gbase, voff) do { _Pragma("unroll") for (int _i = 0; _i < 2; ++_i) \
        __builtin_amdgcn_global_load_lds((const unsigned*)((const char*)(gbase) + (voff)[_i]), (LAS unsigned*)(lds + (bufoff) + ldsw + _i * 8192), 16, 0, 0); } while (0)
#define PG8_STAGE_A(bufoff, gbase, slot, h) do { if constexpr (GATHER) { _Pragma("unroll") for (int _i = 0; _i < 2; ++_i) { const unsigned _ro = gtab[(slot) * 256 + (h) * HALF + rowA[_i]]; \
        __builtin_amdgcn_global_load_lds((const unsigned*)((const char*)(gbase) + _ro + voffA[_i]), (LAS unsigned*)(lds + (bufoff) + ldsw + _i * 8192), 16, 0, 0); } } \
        else { PG8_STAGE(bufoff, (const char*)(gbase) + (h) * hstep, voffA); } } while (0)
#define PG8_LDA(dst, b, h) do { _Pragma("unroll") for (int m = 0; m < 4; ++m) _Pragma("unroll") for (int k = 0; k < 2; ++k) dst[m][k] = *(const LAS bf16x8*)(lds + PG8_SA(b, h) + aoff + m * 2048 + k * 1024); } while (0)
#define PG8_LDB(dst, b, h) do { _Pragma("unroll") for (int n = 0; n < 2; ++n) _Pragma("unroll") for (int k = 0; k < 2; ++k) dst[n][k] = *(const LAS bf16x8*)(lds + PG8_SB(b, h) + boff + n * 2048 + k * 1024); } while (0)
#define PG8_MMA(ai, bj, At, Bt) do { __builtin_amdgcn_s_setprio(1); _Pragma("unroll") for (int m = 0; m < 4; ++m) _Pragma("unroll") for (int n = 0; n < 2; ++n) _Pragma("unroll") for (int k = 0; k < 2; ++k) \
        acc[ai][bj][m][n] = __builtin_amdgcn_mfma_f32_16x16x32_bf16(Bt[n][k], At[m][k], acc[ai][bj][m][n], 0, 0, 0); __builtin_amdgcn_s_setprio(0); } while (0)
#define PG8_WAIT_V(n) asm volatile("s_waitcnt vmcnt(" #n ")" ::: "memory")
#define PG8_WAIT_L(n) asm volatile("s_waitcnt lgkmcnt(" #n ")" ::: "memory")
#define PG8_BAR __builtin_amdgcn_s_barrier()
#define PG8_SCHED __builtin_amdgcn_sched_barrier(0)
    Unit cur, nxt; int ui = 0;
    if (!S.next(0, cur)) return;
    f32x4 acc[2][2][4][2];
#pragma unroll
    for (int a = 0; a < 2; ++a)
#pragma unroll
        for (int b = 0; b < 2; ++b)
#pragma unroll
            for (int m = 0; m < 4; ++m)
#pragma unroll
                for (int n = 0; n < 2; ++n) acc[a][b][m][n] = (f32x4){0.f, 0.f, 0.f, 0.f};
    bf16x8 At[4][2], B0[2][2], B1[2][2];
    const char* cA = (const char*)g.A + (GATHER ? (size_t)0 : S.aoff(cur)); const char* cB = (const char*)g.Bt + S.boff(cur);
    PG8_STAGE(PG8_SB(0, 0), cB, voffB); PG8_STAGE(PG8_SB(0, 1), cB + hstep, voffB); PG8_STAGE_A(PG8_SA(0, 0), cA, 0, 0); PG8_STAGE_A(PG8_SA(0, 1), cA, 0, 1);
    if (wr == 1) PG8_BAR;
    PG8_WAIT_V(2); PG8_BAR;
    PG8_STAGE(PG8_SB(1, 0), cB + kstep, voffB); PG8_STAGE_A(PG8_SA(1, 0), cA + kstep, 0, 0); PG8_STAGE(PG8_SB(1, 1), cB + hstep + kstep, voffB);
    PG8_WAIT_V(6); PG8_BAR;
    for (;;) {
        const bool has_next = S.next(ui + 1, nxt);
        const char* nA = has_next ? (const char*)g.A + (GATHER ? (size_t)0 : S.aoff(nxt)) : cA; const char* nB = has_next ? (const char*)g.Bt + S.boff(nxt) : cB;
        const int nslot = has_next ? nxt.slot : cur.slot, cslot = cur.slot;
        for (int t = 0; t < nt; t += 2) {
            const bool last = (t == nt - 2);
            const char* a1 = cA + (size_t)(t + 1) * kstep;
            const char* a2 = last ? nA : cA + (size_t)(t + 2) * kstep; const char* b2 = last ? nB : cB + (size_t)(t + 2) * kstep;
            const char* a3 = a2 + kstep; const char* b3 = b2 + kstep;
            const int s2 = last ? nslot : cslot;
            PG8_LDB(B0, 0, 0); PG8_LDB(B1, 0, 1); PG8_SCHED; PG8_LDA(At, 0, 0); PG8_STAGE_A(PG8_SA(1, 1), a1, cslot, 1);
            PG8_WAIT_V(8); PG8_WAIT_L(0); PG8_BAR; PG8_MMA(0, 0, At, B0); PG8_MMA(0, 1, At, B1); PG8_BAR; PG8_SCHED;
            PG8_LDA(At, 0, 1); PG8_STAGE(PG8_SB(0, 0), b2, voffB); PG8_STAGE(PG8_SB(0, 1), b2 + hstep, voffB); PG8_STAGE_A(PG8_SA(0, 0), a2, s2, 0);
            PG8_WAIT_V(8); PG8_WAIT_L(0); PG8_BAR; PG8_MMA(1, 0, At, B0); PG8_MMA(1, 1, At, B1); PG8_BAR; PG8_SCHED;
            PG8_LDB(B0, 1, 0); PG8_LDB(B1, 1, 1); PG8_SCHED; PG8_LDA(At, 1, 0); PG8_STAGE_A(PG8_SA(0, 1), a2, s2, 1);
            PG8_WAIT_V(8); PG8_WAIT_L(0); PG8_BAR; PG8_MMA(0, 0, At, B0); PG8_MMA(0, 1, At, B1); PG8_BAR; PG8_SCHED;
            PG8_LDA(At, 1, 1); PG8_STAGE(PG8_SB(1, 0), b3, voffB); PG8_STAGE(PG8_SB(1, 1), b3 + hstep, voffB); PG8_STAGE_A(PG8_SA(1, 0), a3, s2, 0);
            PG8_WAIT_V(8); PG8_WAIT_L(0); PG8_BAR; PG8_MMA(1, 0, At, B0); PG8_MMA(1, 1, At, B1); PG8_BAR; PG8_SCHED;
        }
        if constexpr (ALIGN_EPI) { if (wr == 0) PG8_BAR; }
        E(acc, cur, wr, wc, fr, fq); S.done(cur);
        if (!has_next) break;
#pragma unroll
        for (int a = 0; a < 2; ++a)
#pragma unroll
            for (int b = 0; b < 2; ++b)
#pragma unroll
                for (int m = 0; m < 4; ++m)
#pragma unroll
                    for (int n = 0; n < 2; ++n) acc[a][b][m][n] = (f32x4){0.f, 0.f, 0.f, 0.f};
        cur = nxt; cA = nA; cB = nB; ++ui;
        if constexpr (ALIGN_EPI) { if (wr == 1) PG8_BAR; }
    }
    PG8_WAIT_V(0);
    if constexpr (!ALIGN_EPI) { if (wr == 0) PG8_BAR; }
    PG8_BAR;
#undef PG8_SA
#undef PG8_SB
#undef PG8_STAGE
#undef PG8_STAGE_A
#undef PG8_LDA
#undef PG8_LDB
#undef PG8_MMA
#undef PG8_WAIT_V
#undef PG8_WAIT_L
#undef PG8_BAR
#undef PG8_SCHED
}
}

#define XB_TMO      128
#define XB_XCNT(j)  (256  + 64 * (j))
#define XB_XSUB(j)  (1280 + 64 * (j))
#define XB_XGEN(j)  (2304 + 64 * (j))
#define XB_TOP      3328
#define XB_TOPGEN   3392
#define XCD_BAR_WORDS 3456
#define XB_SPIN_CAP (1u << 18)
__device__ __forceinline__ unsigned xb_ld(unsigned* p)              { return __hip_atomic_load(p, __ATOMIC_RELAXED, __HIP_MEMORY_SCOPE_AGENT); }
__device__ __forceinline__ unsigned xb_add(unsigned* p, unsigned v) { return __hip_atomic_fetch_add(p, v, __ATOMIC_RELAXED, __HIP_MEMORY_SCOPE_AGENT); }
__device__ __forceinline__ unsigned xb_xcc_id() { return (unsigned)__builtin_amdgcn_s_getreg((3 << 11) | 20) & 0xFu; }
#define XB_SPIN(cond, bar) do { unsigned _sp = 0; while (cond) { __builtin_amdgcn_s_sleep(1); \
    if ((++_sp & 255u) == 0u) { if (xb_ld(&(bar)[XB_TMO])) break; if (_sp > XB_SPIN_CAP) { atomicAdd(&(bar)[XB_TMO], 1u); break; } } } } while (0)
struct XcdBarrier { unsigned* bar; unsigned x; volatile LAS unsigned* st; };
__device__ __forceinline__ XcdBarrier xcd_barrier_post(unsigned* bar, volatile LAS unsigned* st) {
    XcdBarrier b; b.bar = bar; b.x = xb_xcc_id(); b.st = st;
    if (threadIdx.x == 0) (void)xb_add(&bar[XB_XCNT(b.x)], 1u);
    return b;
}
__device__ __forceinline__ void xcd_barrier_complete(unsigned* bar, unsigned x, unsigned& nloc, unsigned& nx) {
    const unsigned G = gridDim.x * gridDim.y * gridDim.z;
    unsigned sum, cnt, mine, sp = 0u;
    for (;;) {
        sum = 0u; cnt = 0u; mine = 0u;
#pragma unroll
        for (unsigned j = 0; j < 16; ++j) { const unsigned c = xb_ld(&bar[XB_XCNT(j)]); sum += c; cnt += (c > 0u) ? 1u : 0u; mine = (j == x) ? c : mine; }
        if (sum == G) break;
        __builtin_amdgcn_s_sleep(1);
        if ((++sp & 255u) == 0u) { if (xb_ld(&bar[XB_TMO])) break; if (sp > XB_SPIN_CAP) { atomicAdd(&bar[XB_TMO], 1u); break; } }
    }
    nloc = mine > 0u ? mine : 1u; nx = cnt > 0u ? cnt : 1u;
}
__device__ __forceinline__ void xcd_barrier(const XcdBarrier& b) {
    asm volatile("s_waitcnt vmcnt(0)" ::: "memory");
    __syncthreads();
    if (threadIdx.x == 0) {
        unsigned* bar = b.bar;
        __builtin_amdgcn_s_waitcnt(0);
        unsigned nloc = b.st[0], nx = b.st[1];
        if (nloc == 0u) { xcd_barrier_complete(bar, b.x, nloc, nx); b.st[0] = nloc; b.st[1] = nx; }
        const unsigned old = xb_add(&bar[XB_XSUB(b.x)], 1u);
        const unsigned gen = old / nloc;
        if (old + 1u == (gen + 1u) * nloc) {
            __builtin_amdgcn_fence(__ATOMIC_RELEASE, "agent");
            asm volatile("s_waitcnt vmcnt(0)" ::: "memory");
            const unsigned og = xb_add(&bar[XB_TOP], 1u);
            const unsigned tg = og / nx;
            if (og + 1u == (tg + 1u) * nx) xb_add(&bar[XB_TOPGEN], 1u);
            else XB_SPIN(xb_ld(&bar[XB_TOPGEN]) == tg, bar);
            __builtin_amdgcn_fence(__ATOMIC_ACQUIRE, "agent");
            xb_add(&bar[XB_XGEN(b.x)], 1u);
            asm volatile("s_waitcnt vmcnt(0)" ::: "memory");
        } else {
            XB_SPIN(xb_ld(&bar[XB_XGEN(b.x)]) == gen, bar);
            __builtin_amdgcn_fence(__ATOMIC_ACQUIRE, "agent");
            asm volatile("s_waitcnt vmcnt(0)" ::: "memory");
        }
    }
    __syncthreads();
}

struct Args { const float* in[27]; float* out; unsigned char* ws; int ph_lo, ph_hi; };
struct Frame {
    LAS unsigned char* lds; volatile LAS unsigned* MISC; gu32* ctl;
    int tid, lane, wave, vcu, G;
    const float* const* in; float* out; unsigned char* ws; unsigned char* dsb;
};

__device__ __forceinline__ void p0_transpose_item(const float* W, int N, bf16* WT, int ldt, int k0, int n0, int drow0, LAS unsigned* Tl, int lane) {
    const int kq = lane >> 3, c4 = lane & 7;
    f32x4 a[4], b[4];
#pragma unroll
    for (int i = 0; i < 4; ++i) { const float* p = W + (size_t)(k0 + 16 * i + 2 * kq) * N + n0 + 4 * c4; a[i] = *(const f32x4*)p; b[i] = *(const f32x4*)(p + N); }
#pragma unroll
    for (int i = 0; i < 4; ++i)
#pragma unroll
        for (int j = 0; j < 4; ++j) Tl[(4 * c4 + j) * 32 + ((8 * i + kq) ^ (4 * c4))] = pk2(a[i][j], b[i][j]);
    LDS_WAIT(); asm volatile("" ::: "memory");
#pragma unroll
    for (int jj = 0; jj < 4; ++jj) { const int n = (lane >> 3) + 8 * jj, c = lane & 7;
        const v4u o = *(const LAS v4u*)(Tl + n * 32 + 4 * (c ^ (n >> 2)));
        *(GAS v4u*)(WT + (size_t)(drow0 + n) * ldt + k0 + 8 * c) = o; }
    LDS_WAIT(); asm volatile("" ::: "memory");
}
__device__ __forceinline__ void ph1_hrows(Frame& F);
__device__ __forceinline__ void ph0_prologue(Frame& F) {
    const float* c = F.in[1]; const float* wada = F.in[2]; const float* bada = F.in[3];
    float* mod = (float*)(F.ws + WS_MOD);
    LAS float* sc = (LAS float*)(F.lds);
    LAS float* red = (LAS float*)(F.lds + 8192);
    for (int i = F.tid; i < 2 * D; i += NTHR) sc[i] = siluf_(c[i]);
    __syncthreads();
    for (int slab = F.vcu; slab < 256; slab += F.G) {
        const int n0 = slab * 24;
        if (F.tid < 510) {
            const int kq = F.tid / 6, c4 = F.tid % 6; float a[2][4];
#pragma unroll
            for (int b = 0; b < 2; ++b)
#pragma unroll
                for (int j = 0; j < 4; ++j) a[b][j] = 0.f;
            for (int k = kq; k < D; k += 85) { const f32x4 w = *(const f32x4*)(wada + (size_t)k * 6144 + n0 + 4 * c4); const float s0 = sc[k], s1 = sc[D + k];
#pragma unroll
                for (int j = 0; j < 4; ++j) { a[0][j] += s0 * w[j]; a[1][j] += s1 * w[j]; } }
#pragma unroll
            for (int b = 0; b < 2; ++b)
#pragma unroll
                for (int j = 0; j < 4; ++j) red[(kq * 6 + c4) * 8 + b * 4 + j] = a[b][j];
        }
        __syncthreads();
        if (F.tid < 48) { const int b = F.tid / 24, col = F.tid % 24, c4 = col >> 2, j = col & 3; float s = 0.f;
            for (int kq = 0; kq < 85; ++kq) s += red[(kq * 6 + c4) * 8 + b * 4 + j];
            mod[b * 6144 + n0 + col] = s + bada[n0 + col]; }
        __syncthreads();
    }
    VM_WAIT(); __syncthreads();
    if (F.tid == 0) { __builtin_amdgcn_fence(__ATOMIC_RELEASE, "agent"); VM_WAIT(); __hip_atomic_fetch_add(F.ctl + CW_MODCNT, 1u, RLX_AGENT); }
    const int gt = F.vcu * NTHR + F.tid, NGT = F.G * NTHR;
    if (gt < DH) { const float* g = F.in[9]; ((float*)(F.ws + WS_LB))[gt] = 1.f / (1.f + __expf(g[DH + gt] - g[gt])); }
    for (int e = gt; e < 48 * D; e += NGT) { const int n = e >> 10, kk = e & 1023; const float wv = n < NG ? F.in[20][kk * NG + n] : n < NG + NE ? F.in[22][kk * NE + n - NG] : 0.f;
        const unsigned hi = f2bf(wv); ((bf16*)(F.ws + WS_RRH))[e] = (bf16)hi; ((bf16*)(F.ws + WS_RRL))[e] = (bf16)f2bf(wv - bf2f(hi)); }
    for (int e = gt; e < 2 * 8 * 64 * 64; e += NGT) { const int which = e >> 15, r = e & 32767, blk = r >> 12, j = (r >> 6) & 63, i = r & 63;
        const float* w = which ? F.in[15] : F.in[13]; ((bf16*)(F.ws + (which ? WS_WIT : WS_WRT)))[r] = (bf16)f2bf(w[(size_t)(blk * 64 + i) * 64 + j]); }
    LAS unsigned* scr = (LAS unsigned*)(F.lds + 32768 + F.wave * 4096);
    const int gw = F.vcu * NWAVES + F.wave, NGW = F.G * NWAVES;
    constexpr int I_IN = 16 * 96, I_OUT = 16 * 32, I_E = 256 + 256 + 256, NITEMS = I_IN + I_OUT + NE * I_E;
    for (int it = gw; it < NITEMS; it += NGW) {
        int r = it;
        if (r < I_IN) { const int kb = r / 96, nb = r % 96; p0_transpose_item(F.in[8], DIN, (bf16*)(F.ws + WS_WIN), D, 64 * kb, 32 * nb, 32 * nb, scr, F.lane); continue; } r -= I_IN;
        if (r < I_OUT) { const int kb = r / 32, nb = r % 32; p0_transpose_item(F.in[19], D, (bf16*)(F.ws + WS_WOUT), D, 64 * kb, 32 * nb, 32 * nb, scr, F.lane); continue; } r -= I_OUT;
        const int e = r / I_E; r -= e * I_E;
        if (r < 512) { const int w3 = r >> 8, q = r & 255, kb = q >> 4, nb = q & 15, n0 = 32 * nb;
            p0_transpose_item((w3 ? F.in[25] : F.in[24]) + (size_t)e * D * DE, DE, (bf16*)(F.ws + WS_W13) + (size_t)e * D * D, D, 64 * kb, n0, (n0 >> 7) * 256 + (n0 & 127) + 128 * w3, scr, F.lane); }
        else { const int q = r - 512, kb = q >> 5, nb = q & 31;
            p0_transpose_item(F.in[26] + (size_t)e * DE * D, D, (bf16*)(F.ws + WS_W2) + (size_t)e * D * DE, DE, 64 * kb, 32 * nb, 32 * nb, scr, F.lane); }
    }
    if (F.tid < 64) { unsigned sp = 0;
        while ((unsigned)__builtin_amdgcn_readfirstlane(__hip_atomic_load(F.ctl + CW_MODCNT, RLX_AGENT)) < (unsigned)F.G) { __builtin_amdgcn_s_sleep(2); if (++sp > (1u << 20)) break; }
        __builtin_amdgcn_fence(__ATOMIC_ACQUIRE, "agent"); VM_WAIT(); }
    __syncthreads();
    ph1_hrows(F);
}

__device__ __forceinline__ void ph1_hrows(Frame& F) {
    const float* x = F.in[0]; const float* g = F.in[4]; const float* mod = (const float*)(F.ws + WS_MOD); bf16* H = (bf16*)(F.ws + WS_H);
    LAS float* PA = (LAS float*)F.lds; LAS float* PB = PA + 2 * D;
    for (int i = F.tid; i < 2 * D; i += NTHR) { const int b = i >> 10, c = i & 1023; PA[i] = g[c] * (1.f + mod[b * 6144 + 1024 + c]); PB[i] = mod[b * 6144 + c]; }
    __syncthreads();
    const int gw = F.vcu * NWAVES + F.wave, NGW = F.G * NWAVES;
    f32x4 v[2][4], v2[2][4];
#define P1_LOAD(V_, m0_) do { _Pragma("unroll") for (int r = 0; r < 2; ++r) _Pragma("unroll") for (int j = 0; j < 4; ++j) V_[r][j] = ((const GAS f32x4*)(x + (size_t)((m0_) + r * (T / 2)) * D) + lane)[64 * j]; } while (0)
#define P1_ROWS(V_, m0_) do { _Pragma("unroll") for (int r = 0; r < 2; ++r) { const int m = (m0_) + r * (T / 2); float s = 0.f; \
        _Pragma("unroll") for (int j = 0; j < 4; ++j) s += V_[r][j].x * V_[r][j].x + V_[r][j].y * V_[r][j].y + V_[r][j].z * V_[r][j].z + V_[r][j].w * V_[r][j].w; \
        const float rstd = rsqrtf(wave_sum(s) * (1.f / D) + EPS); \
        GAS unsigned long long* o8 = (GAS unsigned long long*)(H + (size_t)m * D) + lane; \
        _Pragma("unroll") for (int j = 0; j < 4; ++j) { const int c0 = r * D + 4 * lane + 256 * j; const f32x4 pa = *(const LAS f32x4*)(PA + c0), pb = *(const LAS f32x4*)(PB + c0); \
            const float a0 = V_[r][j].x * rstd * pa.x + pb.x, a1 = V_[r][j].y * rstd * pa.y + pb.y, a2 = V_[r][j].z * rstd * pa.z + pb.z, a3 = V_[r][j].w * rstd * pa.w + pb.w; \
            o8[64 * j] = (unsigned long long)pk2(a0, a1) | ((unsigned long long)pk2(a2, a3) << 32); } } } while (0)
    { const int lane = F.lane; if (gw < T / 2) P1_LOAD(v, gw); }
    for (int m0 = gw; m0 < T / 2; m0 += 2 * NGW) {
        int lane = F.lane; asm volatile("" : "+v"(lane));
        const bool has2 = m0 + NGW < T / 2, has3 = m0 + 2 * NGW < T / 2;
        if (has2) P1_LOAD(v2, m0 + NGW);
        P1_ROWS(v, m0);
        if (has3) P1_LOAD(v, m0 + 2 * NGW);
        if (has2) P1_ROWS(v2, m0 + NGW);
    }
#undef P1_LOAD
#undef P1_ROWS
}

constexpr int L_GT = 0;
constexpr int L_QTL = 4096;
constexpr int L_QH = L_QTL + 17408;
constexpr int L_KH = L_QH + 17408;
constexpr int L_VT = L_KH + 17408;
constexpr int L_P = L_VT + 18432;
constexpr int L_SSQ = L_P + 9216;
constexpr int L_RSTD = L_SSQ + 2048;
constexpr int L_OT = L_RSTD + 256;
constexpr int L_KT = L_QTL;
static_assert(L_OT + 17408 <= RING_BYTES, "mixer LDS map");

struct HgLoad { unsigned lf[8], ki[8], vv[8], q[8]; };
template <bool NEEDQ>
__device__ __forceinline__ void hg_load(Frame& F, int t0, int h, HgLoad& L) {
    const bf16* PJ = (const bf16*)(F.ws + WS_PROJ); const size_t base = (size_t)(t0 + 8 * F.wave) * DH + h * HD + 2 * (F.tid & 63);
#pragma unroll
    for (int i = 0; i < 8; ++i) { const size_t o = base + (size_t)i * DH; L.lf[i] = *(const unsigned*)(PJ + PROJ_S + o); L.ki[i] = *(const unsigned*)(PJ + 2 * PROJ_S + o); L.vv[i] = *(const unsigned*)(PJ + 3 * PROJ_S + o);
        if (NEEDQ) L.q[i] = *(const unsigned*)(PJ + o); }
}
__device__ __forceinline__ void hg_cumsum(Frame& F, const HgLoad& L, float (&c0)[8], float (&c1)[8], float (&off)[2], float (&bmid)[2], float (&blast)[2]) {
    LAS float* GT = (LAS float*)(F.lds + L_GT); const int kp = F.tid & 63, w = F.wave;
    float r0 = 0.f, r1 = 0.f;
#pragma unroll
    for (int i = 0; i < 8; ++i) { r0 += bf2f(L.lf[i] & 0xffffu); r1 += bf2f(L.lf[i] >> 16); c0[i] = r0; c1[i] = r1; }
    *(LAS f32x2_t*)(GT + w * 128 + 2 * kp) = (f32x2_t){r0, r1};
    LDS_BAR();
    float a0 = 0.f, a1 = 0.f; off[0] = 0.f; off[1] = 0.f; bmid[0] = 0.f; bmid[1] = 0.f;
#pragma unroll
    for (int g = 0; g < 8; ++g) { const f32x2_t v = *(const LAS f32x2_t*)(GT + g * 128 + 2 * kp); if (g == w) { off[0] = a0; off[1] = a1; } a0 += v.x; a1 += v.y; if (g == 3) { bmid[0] = a0; bmid[1] = a1; } }
    blast[0] = a0; blast[1] = a1;
}
__device__ __forceinline__ void hg_store_vt(Frame& F, const HgLoad& L, LAS bf16* VT) {
    const int kp = F.tid & 63, w = F.wave; v4u lo, hi;
    lo.x = (L.vv[0] & 0xffffu) | (L.vv[1] << 16); lo.y = (L.vv[2] & 0xffffu) | (L.vv[3] << 16); lo.z = (L.vv[4] & 0xffffu) | (L.vv[5] << 16); lo.w = (L.vv[6] & 0xffffu) | (L.vv[7] << 16);
    hi.x = (L.vv[0] >> 16) | (L.vv[1] & 0xffff0000u); hi.y = (L.vv[2] >> 16) | (L.vv[3] & 0xffff0000u); hi.z = (L.vv[4] >> 16) | (L.vv[5] & 0xffff0000u); hi.w = (L.vv[6] >> 16) | (L.vv[7] & 0xffff0000u);
    *(LAS v4u*)(VT + (2 * kp) * 72 + 8 * w) = lo; *(LAS v4u*)(VT + (2 * kp + 1) * 72 + 8 * w) = hi;
}

template <bool FINAL>
__device__ __forceinline__ void rg_wave_task(Frame& F, int b, int n, int cb, unsigned (&valpk)[32]) {
    const int lane = F.lane, fr = lane & 15, fq = lane >> 4, c0 = 64 * cb; const int t0 = b * SEQ + 64 * n;
    const bf16* XR = (const bf16*)(F.ws + WS_PROJ) + 5 * PROJ_S; const bf16* YR = (const bf16*)(F.ws + WS_PROJ) + 6 * PROJ_S;
    const bf16* WRT = (const bf16*)(F.ws + WS_WRT); const bf16* WIT = (const bf16*)(F.ws + WS_WIT);
    bf16x8 IDf[2][2];
    v4u xq[2][4], gq[2];
#define RG_LOAD_TILE(tt_) do { const int tl_ = 16 * (tt_) + fr, tp_ = 64 * n + tl_; _Pragma("unroll") for (int ks = 0; ks < 2; ++ks) { const int cc = c0 + 32 * ks + 8 * fq; \
        _Pragma("unroll") for (int tap = 0; tap < 4; ++tap) { const bool ok_ = (tp_ - 3 + tap >= 0); const v4u x_ = *(const v4u*)(XR + (size_t)(t0 + (ok_ ? tl_ - 3 + tap : 0)) * DH + cc); \
            xq[ks][tap] = (v4u){ok_ ? x_.x : 0u, ok_ ? x_.y : 0u, ok_ ? x_.z : 0u, ok_ ? x_.w : 0u}; } \
        if (FINAL) gq[ks] = *(const v4u*)(YR + (size_t)(t0 + tl_) * DH + cc); } } while (0)
    RG_LOAD_TILE(0);
    LAS unsigned char* wl = F.lds + F.wave * 16384; LAS float* cwl = (LAS float*)(F.lds + RING_BYTES + F.wave * 2048);
#pragma unroll
    for (int p = 0; p < 8; ++p) { const int pc = p * 64 + lane, j = pc >> 3, sl = pc & 7; const size_t o = (size_t)(c0 + j) * 64 + 8 * sl;
        *(LAS v4u*)(wl + j * 128 + ((sl ^ (j & 7)) << 4)) = *(const v4u*)(WRT + o); *(LAS v4u*)(wl + 8192 + j * 128 + ((sl ^ (j & 7)) << 4)) = *(const v4u*)(WIT + o); }
#pragma unroll
    for (int tap = 0; tap < 4; ++tap) cwl[tap * 64 + lane] = F.in[11][tap * DR + c0 + lane];
    cwl[256 + lane] = F.in[12][c0 + lane];
    LDS_WAIT();
#pragma unroll
    for (int ks = 0; ks < 2; ++ks)
#pragma unroll
        for (int c2 = 0; c2 < 2; ++c2) { bf16x8 v;
#pragma unroll
            for (int j = 0; j < 8; ++j) v[j] = (short)((8 * fq + j == 16 * c2 + fr) ? 0x3F80 : 0);
            IDf[ks][c2] = v; }
    float br[4], bi[4], ls8[4], hrun[4], arun[4];
#pragma unroll
    for (int ct = 0; ct < 4; ++ct) { const int c = c0 + 16 * ct + fr; br[ct] = F.in[14][c]; bi[ct] = F.in[16][c]; const float lam = F.in[17][c]; ls8[ct] = -8.f * log1pf(__expf(-lam));
        hrun[ct] = FINAL ? ((const float*)(F.ws + WS_CARRY))[(size_t)(b * NCH + n) * DR + c] : 0.f; arun[ct] = 1.f; }
#pragma unroll
    for (int tt = 0; tt < 4; ++tt) {
        bf16x8 AX[2], AG[2];
#pragma unroll
        for (int ks = 0; ks < 2; ++ks) { const int cl = 32 * ks + 8 * fq; float xc[8];
            { const f32x4 b0 = *(const LAS f32x4*)(cwl + 256 + cl), b1 = *(const LAS f32x4*)(cwl + 256 + cl + 4); xc[0] = b0[0]; xc[1] = b0[1]; xc[2] = b0[2]; xc[3] = b0[3]; xc[4] = b1[0]; xc[5] = b1[1]; xc[6] = b1[2]; xc[7] = b1[3]; }
#pragma unroll
            for (int tap = 0; tap < 4; ++tap) { const v4u xv = xq[ks][tap];
                const f32x4 w0 = *(const LAS f32x4*)(cwl + tap * 64 + cl), w1 = *(const LAS f32x4*)(cwl + tap * 64 + cl + 4);
                xc[0] += w0[0] * bf2f(xv.x & 0xffffu); xc[1] += w0[1] * bf2f(xv.x >> 16); xc[2] += w0[2] * bf2f(xv.y & 0xffffu); xc[3] += w0[3] * bf2f(xv.y >> 16);
                xc[4] += w1[0] * bf2f(xv.z & 0xffffu); xc[5] += w1[1] * bf2f(xv.z >> 16); xc[6] += w1[2] * bf2f(xv.w & 0xffffu); xc[7] += w1[3] * bf2f(xv.w >> 16); }
            v4u pk; pk.x = pk2(xc[0], xc[1]); pk.y = pk2(xc[2], xc[3]); pk.z = pk2(xc[4], xc[5]); pk.w = pk2(xc[6], xc[7]); AX[ks] = __builtin_bit_cast(bf16x8, pk);
            if (FINAL) AG[ks] = __builtin_bit_cast(bf16x8, gq[ks]);
        }
        if (tt < 3) RG_LOAD_TILE(tt + 1);
        asm volatile("" ::: "memory");
#pragma unroll
        for (int ct = 0; ct < 4; ++ct) {
            f32x4 aR = {0.f, 0.f, 0.f, 0.f}, aI = {0.f, 0.f, 0.f, 0.f}, aX = {0.f, 0.f, 0.f, 0.f}, aG = {0.f, 0.f, 0.f, 0.f};
#pragma unroll
            for (int ks = 0; ks < 2; ++ks) { const int jr = 16 * ct + fr, so = jr * 128 + (((4 * ks + fq) ^ (jr & 7)) << 4);
                const bf16x8 wr_ = *(const LAS bf16x8*)(wl + so), wi_ = *(const LAS bf16x8*)(wl + 8192 + so);
                aR = __builtin_amdgcn_mfma_f32_16x16x32_bf16(AX[ks], wr_, aR, 0, 0, 0); aI = __builtin_amdgcn_mfma_f32_16x16x32_bf16(AX[ks], wi_, aI, 0, 0, 0); }
            aX = __builtin_amdgcn_mfma_f32_16x16x32_bf16(AX[ct >> 1], IDf[ct >> 1][ct & 1], aX, 0, 0, 0);
            if (FINAL) aG = __builtin_amdgcn_mfma_f32_16x16x32_bf16(AG[ct >> 1], IDf[ct >> 1][ct & 1], aG, 0, 0, 0);
            float a[4], u[4];
#pragma unroll
            for (int r = 0; r < 4; ++r) { const float rr = sigmoidf_(aR[r] + br[ct]), ii = sigmoidf_(aI[r] + bi[ct]); const float la = rr * ls8[ct]; a[r] = __expf(la);
                const float x2 = 2.f * la; const float ep = -x2 * (1.f + x2 * (0.5f + x2 * (0.16666667f + x2 * 0.041666667f))), ed = 1.f - a[r] * a[r];
                u[r] = __builtin_amdgcn_sqrtf(x2 > -0.03f ? ep : ed) * (ii * aX[r]); }
            const float Af = a[0] * a[1] * a[2] * a[3], Hf = ((u[0] * a[1] + u[1]) * a[2] + u[2]) * a[3] + u[3];
            const bool oddr = (fq & 1) != 0, upper = fq >= 2;
            const float Ap = partner_row16(Af, oddr), Hp = partner_row16(Hf, oddr);
            const float At = Af * Ap, Ht = oddr ? (Af * Hp + Hf) : (Ap * Hf + Hp);
            const float Ao = partner_half32(At, upper), Ho = partner_half32(Ht, upper);
            const float Atot = At * Ao, Htot = upper ? (At * Ho + Ht) : (Ao * Ht + Ho);
            float Aex, Hex;
            if (!upper) { Aex = oddr ? Ap : 1.f; Hex = oddr ? Hp : 0.f; }
            else { Aex = oddr ? Ao * Ap : Ao; Hex = oddr ? (Ap * Ho + Hp) : Ho; }
            if (FINAL) { float h = Aex * hrun[ct] + Hex;
#pragma unroll
                for (int r = 0; r < 4; ++r) { h = a[r] * h + u[r]; u[r] = h * aG[r]; }
                valpk[(tt * 4 + ct) * 2] = pk2(u[0], u[1]); valpk[(tt * 4 + ct) * 2 + 1] = pk2(u[2], u[3]); }
            hrun[ct] = Atot * hrun[ct] + Htot; arun[ct] *= Atot;
        }
    }
#undef RG_LOAD_TILE
    if (!FINAL && fq == 0) {
#pragma unroll
        for (int ct = 0; ct < 4; ++ct) { const size_t o = (size_t)(b * NCH + n) * DR + c0 + 16 * ct + fr; ((float*)(F.ws + WS_RGA))[o] = arun[ct]; ((float*)(F.ws + WS_RGH))[o] = hrun[ct]; }
    }
}

__device__ __forceinline__ void ph3_passA(Frame& F) {
    bf16* DS = (bf16*)F.dsb; float* DDp = (float*)(F.ws + WS_DD);
    const int lane = F.lane, w = F.wave, fr = lane & 15, fq = lane >> 4, kp = F.tid & 63;
    LAS bf16* KT = (LAS bf16*)(F.lds + L_KT); LAS bf16* VT = (LAS bf16*)(F.lds + L_VT);
    { const int cn = F.vcu;
        const int b = cn / NCH, n = cn % NCH, t0 = b * SEQ + 64 * n;
        HgLoad L; hg_load<false>(F, t0, 0, L);
        { unsigned dummy[32]; rg_wave_task<false>(F, b, n, w, dummy); }
        LDS_BAR();
#pragma unroll
        for (int h = 0; h < NH; ++h) {
            const int task = (b * NH + h) * NCH + n;
            float c0[8], c1[8], off[2], bmid[2], blast[2]; hg_cumsum(F, L, c0, c1, off, bmid, blast);
            unsigned k0p[4], k1p[4];
#pragma unroll
            for (int i = 0; i < 8; i += 2) {
                const float a0 = bf2f(L.ki[i] & 0xffffu) * __expf(blast[0] - (off[0] + c0[i])), a1 = bf2f(L.ki[i + 1] & 0xffffu) * __expf(blast[0] - (off[0] + c0[i + 1]));
                const float d0 = bf2f(L.ki[i] >> 16) * __expf(blast[1] - (off[1] + c1[i])), d1 = bf2f(L.ki[i + 1] >> 16) * __expf(blast[1] - (off[1] + c1[i + 1]));
                k0p[i >> 1] = pk2(a0, a1); k1p[i >> 1] = pk2(d0, d1); }
            *(LAS v4u*)(KT + (2 * kp) * 72 + 8 * w) = (v4u){k0p[0], k0p[1], k0p[2], k0p[3]}; *(LAS v4u*)(KT + (2 * kp + 1) * 72 + 8 * w) = (v4u){k1p[0], k1p[1], k1p[2], k1p[3]};
            hg_store_vt(F, L, VT);
            if (w == 0) *(f32x2_t*)(DDp + (size_t)task * HD + 2 * kp) = (f32x2_t){__expf(blast[0]), __expf(blast[1])};
            if (h + 1 < NH) hg_load<false>(F, t0, h + 1, L);
            LDS_BAR();
            bf16x8 bV[2];
#pragma unroll
            for (int ss = 0; ss < 2; ++ss) bV[ss] = *(const LAS bf16x8*)(VT + (16 * w + fr) * 72 + 8 * fq + 32 * ss);
#pragma unroll
            for (int kt = 0; kt < 8; ++kt) { f32x4 acc = {0.f, 0.f, 0.f, 0.f};
#pragma unroll
                for (int ss = 0; ss < 2; ++ss) { const bf16x8 a = *(const LAS bf16x8*)(KT + (16 * kt + fr) * 72 + 8 * fq + 32 * ss); acc = __builtin_amdgcn_mfma_f32_16x16x32_bf16(a, bV[ss], acc, 0, 0, 0); }
                *(v2u*)(DS + (size_t)task * (HD * HD) + (size_t)(16 * w + fr) * HD + 16 * kt + 4 * fq) = (v2u){pk2m(acc[0], acc[1]), pk2m(acc[2], acc[3])}; }
            LDS_BAR();
        }
    }
}

__device__ __forceinline__ void ph4_passB(Frame& F) {
    const bf16* DS = (const bf16*)F.dsb; bf16* SST = (bf16*)F.dsb + (size_t)BATCH * NH * NCH * HD * HD; const float* DDp = (const float*)(F.ws + WS_DD);
    const int gt = F.vcu * NTHR + F.tid, NGT = F.G * NTHR;
    for (int idx = gt; idx < BATCH * NH * HD * HD / 2 + BATCH * DR; idx += NGT) {
        if (idx < BATCH * NH * HD * HD / 2) {
            const int bh = idx >> 13, pr = idx & 8191, e0 = 2 * pr, kk = e0 & 127;
            float s0 = 0.f, s1 = 0.f;
            const bf16* dsp = DS + (size_t)bh * NCH * (HD * HD) + e0; bf16* sp = SST + (size_t)bh * NCH * (HD * HD) + e0; const float* ddp = DDp + (size_t)bh * NCH * HD + kk;
            unsigned dA[8], dB[8]; f32x2_t eA[8], eB[8];
#define PB_LOAD(dv, ev, n0_) do { _Pragma("unroll") for (int j = 0; j < 8; ++j) { dv[j] = *(const unsigned*)(dsp + (size_t)((n0_) + j) * (HD * HD)); ev[j] = *(const f32x2_t*)(ddp + ((n0_) + j) * HD); } } while (0)
#define PB_STEP(dv, ev, n0_) do { _Pragma("unroll") for (int j = 0; j < 8; ++j) { *(unsigned*)(sp + (size_t)((n0_) + j) * (HD * HD)) = pk2(s0, s1); s0 = ev[j].x * s0 + bf2f(dv[j] & 0xffffu); s1 = ev[j].y * s1 + bf2f(dv[j] >> 16); } } while (0)
            PB_LOAD(dA, eA, 0);
#pragma unroll 1
            for (int n0 = 0; n0 < NCH; n0 += 16) {
                PB_LOAD(dB, eB, n0 + 8);
                PB_STEP(dA, eA, n0);
                if (n0 + 16 < NCH) PB_LOAD(dA, eA, n0 + 16);
                PB_STEP(dB, eB, n0 + 8);
            }
#undef PB_LOAD
#undef PB_STEP
        } else {
            const int r = idx - BATCH * NH * HD * HD / 2, b = r / DR, c = r % DR;
            const float* A = (const float*)(F.ws + WS_RGA) + (size_t)b * NCH * DR + c; const float* Hh = (const float*)(F.ws + WS_RGH) + (size_t)b * NCH * DR + c; float* C = (float*)(F.ws + WS_CARRY) + (size_t)b * NCH * DR + c;
            float carry = 0.f;
#pragma unroll 4
            for (int n = 0; n < NCH; ++n) { C[(size_t)n * DR] = carry; carry = A[(size_t)n * DR] * carry + Hh[(size_t)n * DR]; }
        }
    }
}

__device__ __forceinline__ void ph5_passC(Frame& F) {
    const bf16* PJ = (const bf16*)(F.ws + WS_PROJ); const bf16* GZ = PJ + 4 * PROJ_S;
    const bf16* SST = (const bf16*)F.dsb + (size_t)BATCH * NH * NCH * HD * HD; bf16* O = (bf16*)(F.ws + WS_H);
    const int tid = F.tid, lane = F.lane, w = F.wave, fr = lane & 15, fq = lane >> 4, kp = tid & 63;
    LAS bf16* QTL = (LAS bf16*)(F.lds + L_QTL); LAS bf16* QH = (LAS bf16*)(F.lds + L_QH); LAS bf16* KH = (LAS bf16*)(F.lds + L_KH);
    LAS bf16* VT = (LAS bf16*)(F.lds + L_VT); LAS bf16* Pm = (LAS bf16*)(F.lds + L_P); LAS float* SSQ = (LAS float*)(F.lds + L_SSQ); LAS float* RSTD = (LAS float*)(F.lds + L_RSTD);
    { const int cn = F.vcu;
        const int b = cn / NCH, n = cn % NCH, t0 = b * SEQ + 64 * n;
        {
            LAS float* SSQ = (LAS float*)(F.lds + X_GTAB); LAS float* RSTD = SSQ + 512;
            unsigned valpk[32];
            rg_wave_task<true>(F, b, n, w, valpk);
#pragma unroll
            for (int tt = 0; tt < 4; ++tt) { float s[4] = {0.f, 0.f, 0.f, 0.f};
#pragma unroll
                for (int ct = 0; ct < 4; ++ct) { const unsigned p0 = valpk[(tt * 4 + ct) * 2], p1 = valpk[(tt * 4 + ct) * 2 + 1]; const float v0 = bf2f(p0 & 0xffffu), v1 = bf2f(p0 >> 16), v2 = bf2f(p1 & 0xffffu), v3 = bf2f(p1 >> 16);
                    s[0] += v0 * v0; s[1] += v1 * v1; s[2] += v2 * v2; s[3] += v3 * v3; }
#pragma unroll
                for (int r = 0; r < 4; ++r) { float x = row_sum16(s[r]); if (fr == 0) SSQ[(16 * tt + 4 * fq + r) * 8 + w] = x; } }
            LDS_BAR();
            if (tid < 64) { float s = 0.f;
#pragma unroll
                for (int i = 0; i < 8; ++i) s += SSQ[tid * 8 + i];
                RSTD[tid] = rsqrtf(s * (1.f / DR) + EPS); }
            LDS_BAR();
            { LAS bf16* VL = (LAS bf16*)(F.lds + w * 16384);
#pragma unroll
              for (int tt = 0; tt < 4; ++tt)
#pragma unroll
                  for (int ct = 0; ct < 4; ++ct) { const unsigned p0 = valpk[(tt * 4 + ct) * 2], p1 = valpk[(tt * 4 + ct) * 2 + 1]; const int tb = 16 * tt + 4 * fq, ch = 16 * ct + fr;
                      VL[(tb + 0) * 72 + ch] = (bf16)(p0 & 0xffffu); VL[(tb + 1) * 72 + ch] = (bf16)(p0 >> 16); VL[(tb + 2) * 72 + ch] = (bf16)(p1 & 0xffffu); VL[(tb + 3) * 72 + ch] = (bf16)(p1 >> 16); }
              LDS_WAIT();
              const int pc = lane & 7; const f32x4 g0 = *(const f32x4*)(F.in[18] + 64 * w + 8 * pc), g1 = *(const f32x4*)(F.in[18] + 64 * w + 8 * pc + 4);
#pragma unroll
              for (int p = 0; p < 8; ++p) { const int row = 8 * p + (lane >> 3); const v4u vv = *(const LAS v4u*)(VL + row * 72 + 8 * pc); const float rs = RSTD[row];
                  v4u o; o.x = pk2(bf2f(vv.x & 0xffffu) * rs * g0[0], bf2f(vv.x >> 16) * rs * g0[1]); o.y = pk2(bf2f(vv.y & 0xffffu) * rs * g0[2], bf2f(vv.y >> 16) * rs * g0[3]);
                  o.z = pk2(bf2f(vv.z & 0xffffu) * rs * g1[0], bf2f(vv.z >> 16) * rs * g1[1]); o.w = pk2(bf2f(vv.w & 0xffffu) * rs * g1[2], bf2f(vv.w >> 16) * rs * g1[3]);
                  *(v4u*)(O + (size_t)(t0 + row) * D + DH + 64 * w + 8 * pc) = o; } }
            LDS_BAR();
        }
        HgLoad L; hg_load<true>(F, t0, 0, L);
        LAS bf16* OT = (LAS bf16*)(F.lds + L_OT);
#pragma unroll 1
        for (int h = 0; h < NH; ++h) {
            const int task = (b * NH + h) * NCH + n;
            const int pr0 = tid >> 4, pc0 = (tid & 15) * 8;
            const v4u gz0 = *(const v4u*)(GZ + (size_t)(t0 + pr0) * DH + h * HD + pc0), gz1 = *(const v4u*)(GZ + (size_t)(t0 + pr0 + 32) * DH + h * HD + pc0);
            bf16x8 bS[4];
#pragma unroll
            for (int ks = 0; ks < 4; ++ks) bS[ks] = *(const bf16x8*)(SST + (size_t)task * (HD * HD) + (size_t)(16 * w + fr) * HD + 8 * fq + 32 * ks);
            float c0[8], c1[8], off[2], bmid[2], blast[2]; hg_cumsum(F, L, c0, c1, off, bmid, blast);
#pragma unroll
            for (int i = 0; i < 8; ++i) { const int tl = 8 * w + i; const float b0 = off[0] + c0[i], b1 = off[1] + c1[i];
                const float q0 = bf2f(L.q[i] & 0xffffu), q1 = bf2f(L.q[i] >> 16), k0 = bf2f(L.ki[i] & 0xffffu), k1 = bf2f(L.ki[i] >> 16);
                const float eq0 = __expf(fminf(b0 - bmid[0], 80.f)), eq1 = __expf(fminf(b1 - bmid[1], 80.f)), ek0 = __expf(fminf(bmid[0] - b0, 80.f)), ek1 = __expf(fminf(bmid[1] - b1, 80.f));
                *(LAS unsigned*)(QH + tl * 136 + 2 * kp) = pk2(q0 * eq0, q1 * eq1); *(LAS unsigned*)(KH + tl * 136 + 2 * kp) = pk2(k0 * ek0, k1 * ek1);
                *(LAS unsigned*)(QTL + tl * 136 + 2 * kp) = pk2(q0 * __expf(b0), q1 * __expf(b1)); }
            hg_store_vt(F, L, VT);
            if (h + 1 < NH) hg_load<true>(F, t0, h + 1, L);
            LDS_BAR();
#pragma unroll
            for (int pp = 0; pp < 2; ++pp) { const int pi = 2 * w + pp, iq = pi >> 2, jk = pi & 3; f32x4 acc = {0.f, 0.f, 0.f, 0.f};
                if (jk <= iq) {
#pragma unroll
                    for (int ks = 0; ks < 4; ++ks) { const bf16x8 a = *(const LAS bf16x8*)(KH + (16 * jk + fr) * 136 + 8 * fq + 32 * ks); const bf16x8 bq = *(const LAS bf16x8*)(QH + (16 * iq + fr) * 136 + 8 * fq + 32 * ks);
                        acc = __builtin_amdgcn_mfma_f32_16x16x32_bf16(a, bq, acc, 0, 0, 0); }
                    if (jk == iq) {
#pragma unroll
                        for (int r = 0; r < 4; ++r) if (4 * fq + r > fr) acc[r] = 0.f; }
                }
                *(LAS v2u*)(Pm + (16 * iq + fr) * 72 + 16 * jk + 4 * fq) = (v2u){pk2m(acc[0], acc[1]), pk2m(acc[2], acc[3])}; }
            LDS_BAR();
            f32x4 oacc[4];
            { bf16x8 bV[2];
#pragma unroll
              for (int ss = 0; ss < 2; ++ss) bV[ss] = *(const LAS bf16x8*)(VT + (16 * w + fr) * 72 + 8 * fq + 32 * ss);
#pragma unroll
              for (int tt = 0; tt < 4; ++tt) { f32x4 acc = {0.f, 0.f, 0.f, 0.f};
#pragma unroll
                  for (int ss = 0; ss < 2; ++ss) { const bf16x8 a = *(const LAS bf16x8*)(Pm + (16 * tt + fr) * 72 + 8 * fq + 32 * ss); acc = __builtin_amdgcn_mfma_f32_16x16x32_bf16(a, bV[ss], acc, 0, 0, 0); }
#pragma unroll
                  for (int ks = 0; ks < 4; ++ks) { const bf16x8 a = *(const LAS bf16x8*)(QTL + (16 * tt + fr) * 136 + 8 * fq + 32 * ks); acc = __builtin_amdgcn_mfma_f32_16x16x32_bf16(a, bS[ks], acc, 0, 0, 0); }
                  oacc[tt] = acc; } }
            const float gh = F.in[10][h * HD + 16 * w + fr];
#pragma unroll
            for (int tt = 0; tt < 4; ++tt)
#pragma unroll
                for (int r = 0; r < 4; ++r) { const float ov = oacc[tt][r]; float x = row_sum16(ov * ov);
                    const int tl = 16 * tt + 4 * fq + r; if (fr == 0) SSQ[tl * 8 + w] = x; OT[tl * 136 + 16 * w + fr] = (bf16)f2bf(ov * gh); }
            LDS_BAR();
            if (tid < 64) { float s = 0.f;
#pragma unroll
                for (int i = 0; i < 8; ++i) s += SSQ[tid * 8 + i];
                RSTD[tid] = rsqrtf(s * (1.f / HD) + EPS); }
            LDS_BAR();
#pragma unroll
            for (int pz = 0; pz < 2; ++pz) { const int row = pr0 + 32 * pz; const v4u ot = *(const LAS v4u*)(OT + row * 136 + pc0), gz = pz ? gz1 : gz0; const float rs = RSTD[row];
                v4u o;
                o.x = pk2(bf2f(ot.x & 0xffffu) * rs * bf2f(gz.x & 0xffffu), bf2f(ot.x >> 16) * rs * bf2f(gz.x >> 16)); o.y = pk2(bf2f(ot.y & 0xffffu) * rs * bf2f(gz.y & 0xffffu), bf2f(ot.y >> 16) * rs * bf2f(gz.y >> 16));
                o.z = pk2(bf2f(ot.z & 0xffffu) * rs * bf2f(gz.z & 0xffffu), bf2f(ot.z >> 16) * rs * bf2f(gz.z >> 16)); o.w = pk2(bf2f(ot.w & 0xffffu) * rs * bf2f(gz.w & 0xffffu), bf2f(ot.w >> 16) * rs * bf2f(gz.w >> 16));
                *(v4u*)(O + (size_t)(t0 + row) * D + h * HD + pc0) = o; }
            LDS_BAR();
        }
    }
}

constexpr int L7_HI = 0, L7_LO = 32768, L7_PART = 65536, L7_LG = L7_PART + 24576, L7_ROUT = L7_LG + 2304;
__device__ __forceinline__ void ph7_rows(Frame& F) {
    const float* x = F.in[0]; const float* mod = (const float*)(F.ws + WS_MOD); const bf16* mix = (const bf16*)(F.ws + WS_MIX);
    const float *gpm = F.in[5], *gpf = F.in[6], *brg = F.in[21], *bre = F.in[23];
    const bf16* RRH = (const bf16*)(F.ws + WS_RRH); const bf16* RRL = (const bf16*)(F.ws + WS_RRL);
    bf16* H = (bf16*)(F.ws + WS_H); float* wgt = (float*)(F.ws + WS_WGT);
    unsigned* cnt = (unsigned*)(F.ws + WS_CTL) + CW_CNT; int* list = (int*)(F.ws + WS_LIST);
    LAS float* PART = (LAS float*)(F.lds + L7_PART); LAS float* LG = (LAS float*)(F.lds + L7_LG); LAS float* ROUT = (LAS float*)(F.lds + L7_ROUT);
    const int w = F.wave, fr = F.lane & 15, fq = F.lane >> 4, row0 = 64 * F.vcu;
    LAS float* C1 = (LAS float*)(F.lds + 98304); LAS float* C2 = C1 + D; LAS float* C3 = C2 + D;
    { const float* mb = mod + (row0 / SEQ) * 6144;
      for (int c = F.tid; c < D; c += NTHR) { C1[c] = mb[2048 + c] * gpm[c]; C2[c] = gpf[c] * (1.f + mb[4096 + c]); C3[c] = mb[3072 + c]; } }
    __syncthreads();
    bf16x8 bh[4][3], bl[4][3];
#pragma unroll
    for (int ks = 0; ks < 4; ++ks)
#pragma unroll
        for (int nt = 0; nt < 3; ++nt) { const size_t wo = (size_t)(16 * nt + fr) * D + 128 * w + 32 * ks + 8 * fq; bh[ks][nt] = *(const bf16x8*)(RRH + wo); bl[ks][nt] = *(const bf16x8*)(RRL + wo); }
    v2u mv[2][4]; f32x4 xv[2][4];
#define P7_LOAD(it_) do { _Pragma("unroll") for (int rr = 0; rr < 2; ++rr) { const int m_ = row0 + 16 * (it_) + 2 * w + rr; _Pragma("unroll") for (int j = 0; j < 4; ++j) { \
        mv[rr][j] = ((const GAS v2u*)(mix + (size_t)m_ * D) + lane)[64 * j]; xv[rr][j] = ((const GAS f32x4*)(x + (size_t)m_ * D) + lane)[64 * j]; } } } while (0)
    { const int lane = F.lane; P7_LOAD(0); }
#pragma unroll 1
    for (int it = 0; it < 4; ++it) {
        int lane = F.lane; asm volatile("" : "+v"(lane));
#pragma unroll
        for (int rr = 0; rr < 2; ++rr) {
            const int rl = 2 * w + rr, m = row0 + 16 * it + rl;
            f32x4 v[4], xr_[4]; float s = 0.f;
#pragma unroll
            for (int j = 0; j < 4; ++j) { v[j] = (f32x4){bf2f(mv[rr][j].x & 0xffffu), bf2f(mv[rr][j].x >> 16), bf2f(mv[rr][j].y & 0xffffu), bf2f(mv[rr][j].y >> 16)}; xr_[j] = xv[rr][j];
                s += v[j].x * v[j].x + v[j].y * v[j].y + v[j].z * v[j].z + v[j].w * v[j].w; }
            const float rs1 = rsqrtf(wave_sum(s) * (1.f / D) + EPS); float s2 = 0.f;
#pragma unroll
            for (int j = 0; j < 4; ++j) { const int c0 = 4 * lane + 256 * j; const f32x4 k1 = *(const LAS f32x4*)(C1 + c0);
                xr_[j].x += k1.x * (v[j].x * rs1); xr_[j].y += k1.y * (v[j].y * rs1); xr_[j].z += k1.z * (v[j].z * rs1); xr_[j].w += k1.w * (v[j].w * rs1);
                ((GAS unsigned long long*)((bf16*)(F.ws + WS_X1B) + (size_t)m * D) + lane)[64 * j] = (unsigned long long)pk2(xr_[j].x, xr_[j].y) | ((unsigned long long)pk2(xr_[j].z, xr_[j].w) << 32);
                s2 += xr_[j].x * xr_[j].x + xr_[j].y * xr_[j].y + xr_[j].z * xr_[j].z + xr_[j].w * xr_[j].w; }
            const float rs2 = rsqrtf(wave_sum(s2) * (1.f / D) + EPS);
#pragma unroll
            for (int j = 0; j < 4; ++j) { const int c0 = 4 * lane + 256 * j; const f32x4 k2 = *(const LAS f32x4*)(C2 + c0), k3 = *(const LAS f32x4*)(C3 + c0);
                const float h0 = xr_[j].x * rs2 * k2.x + k3.x, h1 = xr_[j].y * rs2 * k2.y + k3.y, h2 = xr_[j].z * rs2 * k2.z + k3.z, h3 = xr_[j].w * rs2 * k2.w + k3.w;
                const unsigned p01 = pk2(h0, h1), p23 = pk2(h2, h3);
                ((GAS unsigned long long*)(H + (size_t)m * D) + lane)[64 * j] = (unsigned long long)p01 | ((unsigned long long)p23 << 32);
                const unsigned q01 = pk2(h0 - bf2f(p01 & 0xffffu), h1 - bf2f(p01 >> 16)), q23 = pk2(h2 - bf2f(p23 & 0xffffu), h3 - bf2f(p23 >> 16));
                const int so = rl * 2048 + ((((lane >> 1) + 32 * j) ^ rl) << 4) + (lane & 1) * 8;
                *(LAS v2u*)(F.lds + L7_HI + so) = (v2u){p01, p23}; *(LAS v2u*)(F.lds + L7_LO + so) = (v2u){q01, q23}; }
        }
        if (it < 3) P7_LOAD(it + 1);
        LDS_BAR();
        f32x4 acc[3] = {{0.f, 0.f, 0.f, 0.f}, {0.f, 0.f, 0.f, 0.f}, {0.f, 0.f, 0.f, 0.f}};
#pragma unroll
        for (int ks = 0; ks < 4; ++ks) { const int slot = 16 * w + 4 * ks + fq, so = fr * 2048 + ((slot ^ fr) << 4);
            const bf16x8 ah = *(const LAS bf16x8*)(F.lds + L7_HI + so), al = *(const LAS bf16x8*)(F.lds + L7_LO + so);
#pragma unroll
            for (int nt = 0; nt < 3; ++nt) {
                acc[nt] = __builtin_amdgcn_mfma_f32_16x16x32_bf16(ah, bh[ks][nt], acc[nt], 0, 0, 0); acc[nt] = __builtin_amdgcn_mfma_f32_16x16x32_bf16(ah, bl[ks][nt], acc[nt], 0, 0, 0); acc[nt] = __builtin_amdgcn_mfma_f32_16x16x32_bf16(al, bh[ks][nt], acc[nt], 0, 0, 0); } }
#pragma unroll
        for (int nt = 0; nt < 3; ++nt)
#pragma unroll
            for (int r = 0; r < 4; ++r) PART[(w * 16 + 4 * fq + r) * 48 + 16 * nt + fr] = acc[nt][r];
        LDS_BAR();
        int tid16 = F.tid; asm volatile("" : "+v"(tid16));
        for (int e = tid16; e < 16 * 36; e += NTHR) { const int row = e / 36, o = e - row * 36; float a = o < 4 ? brg[o] : bre[o - 4];
#pragma unroll
            for (int ww = 0; ww < 8; ++ww) a += PART[(ww * 16 + row) * 48 + o];
            LG[e] = a; }
        LDS_BAR();
        if (tid16 < 16) {
            const LAS float* lgl = LG + tid16 * 36;
            int gs = 0; float gm = lgl[0];
#pragma unroll
            for (int o = 1; o < NG; ++o) if (lgl[o] > gm) { gm = lgl[o]; gs = o; }
            float den = 0.f;
#pragma unroll
            for (int o = 0; o < NG; ++o) den += __expf(lgl[o] - gm);
            const float gate = 1.f / den;
            float sel[EPG];
#pragma unroll
            for (int o = 0; o < EPG; ++o) sel[o] = lgl[4 + 8 * gs + o];
            int i1 = 0; float m1 = sel[0];
#pragma unroll
            for (int o = 1; o < EPG; ++o) if (sel[o] > m1) { m1 = sel[o]; i1 = o; }
            int i2 = -1; float m2 = -3.0e38f;
#pragma unroll
            for (int o = 0; o < EPG; ++o) if (o != i1 && sel[o] > m2) { m2 = sel[o]; i2 = o; }
            if (i2 < 0) i2 = (i1 + 1) & 7;
            const float e2 = __expf(m2 - m1);
            *(LAS f32x4*)(ROUT + (16 * it + tid16) * 4) = (f32x4){__int_as_float(gs * EPG + i1), __int_as_float(gs * EPG + i2), gate / (1.f + e2), gate * e2 / (1.f + e2)};
        }
    }
#undef P7_LOAD
    LAS unsigned* HIST = (LAS unsigned*)(F.lds + L7_ROUT + 1024); LAS unsigned* BASE = HIST + 32;
    if (F.tid < 32) HIST[F.tid] = 0u;
    __syncthreads();
    int e_ = 0; unsigned rank_ = 0u;
    if (F.tid < 128) { const int rl = F.tid >> 1, kx = F.tid & 1; e_ = __float_as_int(ROUT[rl * 4 + kx]); rank_ = atomicAdd((unsigned*)(HIST + e_), 1u); wgt[2 * (row0 + rl) + kx] = ROUT[rl * 4 + 2 + kx]; }
    __syncthreads();
    if (F.tid < 32) { const unsigned c = HIST[F.tid]; BASE[F.tid] = c ? atomicAdd(&cnt[64 * F.tid], c) : 0u; }
    __syncthreads();
    if (F.tid < 128) list[e_ * 32768 + BASE[e_] + rank_] = 2 * row0 + F.tid;
    __syncthreads();
}

__device__ __forceinline__ int moe_tables(Frame& F) {
    LAS int* MBE = (LAS int*)(F.lds + X_MBE); LAS int* MBS = MBE + MAXMB; LAS int* NMB = MBS + 33;
    LAS int* CNTL = NMB + 1;
    if (F.tid < NE) CNTL[F.tid] = (int)__hip_atomic_load(F.ctl + CW_CNT + 64 * F.tid, RLX_AGENT);
    __syncthreads();
    if (F.tid < NE) { int mb = 0;
        for (int e = 0; e < F.tid; ++e) mb += (CNTL[e] + 255) >> 8;
        const int nb = (CNTL[F.tid] + 255) >> 8; MBS[F.tid] = mb;
        for (int j = 0; j < nb && mb + j < MAXMB; ++j) MBE[mb + j] = F.tid;
        if (F.tid == NE - 1) { MBS[NE] = mb + nb; NMB[0] = mb + nb; } }
    __syncthreads();
    return NMB[0];
}
__device__ __forceinline__ void moe_fill_tabs(Frame& F, const pg8::MoeOrder& Sup, const pg8::MoeOrder& Sdn) {
    LAS int* MBE = (LAS int*)(F.lds + X_MBE); LAS int* MBS = MBE + MAXMB; LAS int* tab = (LAS int*)(F.lds + X_GTAB); const int* list = (const int*)(F.ws + WS_LIST);
    const bool dn = F.tid >= 256; const int r = F.tid & 255; const pg8::MoeOrder& S = dn ? Sdn : Sup;
    int aid[4]; bool val[4];
#pragma unroll
    for (int i = 0; i < 4; ++i) { pg8::Unit u; val[i] = S.next(i, u) && u.slot == i; aid[i] = -1;
        if (val[i]) { const int e = MBE[u.pm], pos = (u.pm - MBS[e]) * 256 + r, c = (MBS + 34)[e]; if (pos < c) aid[i] = list[e * 32768 + pos]; } }
#pragma unroll
    for (int i = 0; i < 4; ++i) if (val[i]) tab[((dn ? 4 : 0) + i) * 256 + r] = dn ? aid[i] : (aid[i] >= 0 ? (aid[i] >> 1) * (D * 2) : 0);
    __syncthreads();
}

__device__ __forceinline__ void ph10_final(Frame& F) {
    const float* mod = (const float*)(F.ws + WS_MOD); const bf16* YA = (const bf16*)(F.ws + WS_YA); const bf16* X1 = (const bf16*)(F.ws + WS_X1B); const float* gp = F.in[7];
    LAS float* CG = (LAS float*)F.lds;
    for (int i = F.tid; i < 2 * D; i += NTHR) { const int b = i >> 10, c = i & 1023; CG[i] = mod[b * 6144 + 5120 + c] * gp[c]; }
    __syncthreads();
    const int gw = F.vcu * NWAVES + F.wave, NGW = F.G * NWAVES;
    v2u ya[2][4], yb[2][4], xb[2][4], ya2[2][4], yb2[2][4], xb2[2][4];
#define P10_LOAD(YA_, YB_, XB_, m0_) do { _Pragma("unroll") for (int r = 0; r < 2; ++r) { const int m_ = (m0_) + r * (T / 2); _Pragma("unroll") for (int j = 0; j < 4; ++j) { \
        YA_[r][j] = ((const GAS v2u*)(YA + (size_t)(2 * m_) * D) + lane)[64 * j]; YB_[r][j] = ((const GAS v2u*)(YA + (size_t)(2 * m_ + 1) * D) + lane)[64 * j]; XB_[r][j] = ((const GAS v2u*)(X1 + (size_t)m_ * D) + lane)[64 * j]; } } } while (0)
#define P10_ROWS(YA_, YB_, XB_, m0_) do { _Pragma("unroll") for (int r = 0; r < 2; ++r) { const int m = (m0_) + r * (T / 2); float y[4][4]; float s = 0.f; \
        _Pragma("unroll") for (int j = 0; j < 4; ++j) { const v2u a = YA_[r][j], c = YB_[r][j]; \
            y[j][0] = bf2f(a.x & 0xffffu) + bf2f(c.x & 0xffffu); y[j][1] = bf2f(a.x >> 16) + bf2f(c.x >> 16); y[j][2] = bf2f(a.y & 0xffffu) + bf2f(c.y & 0xffffu); y[j][3] = bf2f(a.y >> 16) + bf2f(c.y >> 16); \
            _Pragma("unroll") for (int i = 0; i < 4; ++i) s += y[j][i] * y[j][i]; } \
        const float rs = rsqrtf(wave_sum(s) * (1.f / D) + EPS); \
        _Pragma("unroll") for (int j = 0; j < 4; ++j) { const int c0 = r * D + 4 * lane + 256 * j; const f32x4 cg = *(const LAS f32x4*)(CG + c0); const v2u xq = XB_[r][j]; \
            f32x4 xv = {bf2f(xq.x & 0xffffu), bf2f(xq.x >> 16), bf2f(xq.y & 0xffffu), bf2f(xq.y >> 16)}; \
            xv.x += cg.x * (y[j][0] * rs); xv.y += cg.y * (y[j][1] * rs); xv.z += cg.z * (y[j][2] * rs); xv.w += cg.w * (y[j][3] * rs); \
            ((GAS f32x4*)(F.out + (size_t)m * D) + lane)[64 * j] = xv; } } } while (0)
    { const int lane = F.lane; if (gw < T / 2) P10_LOAD(ya, yb, xb, gw); }
    for (int m0 = gw; m0 < T / 2; m0 += 2 * NGW) {
        int lane = F.lane; asm volatile("" : "+v"(lane));
        const bool has2 = m0 + NGW < T / 2, has3 = m0 + 2 * NGW < T / 2;
        if (has2) P10_LOAD(ya2, yb2, xb2, m0 + NGW);
        P10_ROWS(ya, yb, xb, m0);
        if (has3) P10_LOAD(ya, yb, xb, m0 + 2 * NGW);
        if (has2) P10_ROWS(ya2, yb2, xb2, m0 + NGW);
    }
#undef P10_LOAD
#undef P10_ROWS
}

__global__ void __launch_bounds__(NTHR, 2) skel_fwd(Args args) {
    extern __shared__ __attribute__((aligned(16))) unsigned char lds[];
    Frame F;
    F.lds = (LAS unsigned char*)lds; F.MISC = (volatile LAS unsigned*)(F.lds + X_MISC);
    F.tid = threadIdx.x; F.lane = F.tid & 63; F.wave = __builtin_amdgcn_readfirstlane(F.tid >> 6);
    F.G = gridDim.x; { const int bx = blockIdx.x; F.vcu = (F.G % 8 == 0) ? (bx % 8) * (F.G / 8) + bx / 8 : bx; }
    F.in = args.in; F.out = args.out; F.ws = args.ws; F.dsb = (unsigned char*)args.out; F.ctl = (gu32*)(args.ws + WS_CTL);
    if (F.tid < 32) F.MISC[F.tid] = 0u;
    __syncthreads();
    const XcdBarrier bar = xcd_barrier_post((unsigned*)(F.ctl + CW_BAR), F.MISC + 8);

    const int lo = args.ph_lo, hi = args.ph_hi;
#define IN(k) (lo <= (k) && (k) < hi)
    if (IN(0)) ph0_prologue(F);
    xcd_barrier(bar);
    if (IN(2)) {
        pg8::Gemm g{(const bf16*)(F.ws + WS_H), (const bf16*)(F.ws + WS_WIN), D}; pg8::StaticOrder S; S.init(T, DIN, D, F.G, (int)blockIdx.x);
        pg8::EpiProj E{(bf16*)(F.ws + WS_PROJ), (const float*)(F.ws + WS_LB)};
        pg8::gemm_phase<pg8::EpiProj, pg8::StaticOrder, false>(F.lds, g, S, E, nullptr);
    }
    xcd_barrier(bar);
    if (IN(3)) ph3_passA(F);
    xcd_barrier(bar);
    if (IN(4)) ph4_passB(F);
    xcd_barrier(bar);
    if (IN(5)) ph5_passC(F);
    xcd_barrier(bar);
    if (IN(6)) {
        pg8::Gemm g{(const bf16*)(F.ws + WS_H), (const bf16*)(F.ws + WS_WOUT), D}; pg8::StaticOrder S; S.init(T, D, D, F.G, (int)blockIdx.x);
        pg8::EpiMixB E{(bf16*)(F.ws + WS_MIX), D};
        pg8::gemm_phase<pg8::EpiMixB, pg8::StaticOrder, false>(F.lds, g, S, E, nullptr);
    }
    xcd_barrier(bar);
    if (IN(7)) ph7_rows(F);
    xcd_barrier(bar);
    if (IN(8)) {
        const int nmb = moe_tables(F);
        unsigned* mbc = (unsigned*)(F.ctl + CW_MB);
        pg8::MoeOrder Sup{4 * nmb, F.G, (int)blockIdx.x, D, (const LAS int*)(F.lds + X_MBE), (size_t)D * D * 2, 1, 0, mbc};
        pg8::MoeOrder Sdn{4 * nmb, F.G, (int)blockIdx.x, DE, (const LAS int*)(F.lds + X_MBE), (size_t)D * DE * 2, 1, 1, nullptr};
        moe_fill_tabs(F, Sup, Sdn);
        { pg8::Gemm g{(const bf16*)(F.ws + WS_H), (const bf16*)(F.ws + WS_W13), D}; pg8::EpiAct E{(bf16*)(F.ws + WS_ACT)};
          pg8::gemm_phase<pg8::EpiAct, pg8::MoeOrder, true>(F.lds, g, Sup, E, (const LAS unsigned*)(F.lds + X_GTAB)); }
        {
          if (F.tid < 64) { pg8::Unit u; const bool mine = F.tid < 4 && Sdn.next(F.tid, u) && u.slot == F.tid; unsigned sp = 0;
              while (__any(mine && __hip_atomic_load(F.ctl + CW_MB + 64 * u.pm, RLX_AGENT) < 32u)) { __builtin_amdgcn_s_sleep(2); if (++sp > (1u << 22)) break; }
              __builtin_amdgcn_fence(__ATOMIC_ACQUIRE, "agent"); VM_WAIT(); }
          __syncthreads();
          pg8::Gemm g{(const bf16*)(F.ws + WS_ACT), (const bf16*)(F.ws + WS_W2), DE}; pg8::EpiYa E{(bf16*)(F.ws + WS_YA), (const float*)(F.ws + WS_WGT), (const LAS int*)(F.lds + X_GTAB + 4096)};
          pg8::gemm_phase<pg8::EpiYa, pg8::MoeOrder, false>(F.lds, g, Sdn, E, nullptr); }
    }
    xcd_barrier(bar);
    if (IN(10)) ph10_final(F);
#undef IN
}

extern "C" void kernel_launch(void* const* d_in, const int* in_sizes, int n_in, void* d_out, int out_size, void* d_ws, size_t ws_size, hipStream_t stream) {
    static int grid = 0;
    if (grid == 0) {
        if (n_in != 27 || out_size != T * D || ws_size < WS_END) { fprintf(stderr, "kernel_launch: unexpected n_in %d / out %d / ws %zu\n", n_in, out_size, ws_size); grid = -1; return; }
        int dev = 0, cus = 0, per_cu = 0;
        if (hipGetDevice(&dev) != hipSuccess || hipDeviceGetAttribute(&cus, hipDeviceAttributeMultiprocessorCount, dev) != hipSuccess) { grid = -1; return; }
        if (hipFuncSetAttribute((const void*)skel_fwd, hipFuncAttributeMaxDynamicSharedMemorySize, LDS_BYTES) != hipSuccess) { fprintf(stderr, "kernel_launch: hipFuncSetAttribute failed\n"); grid = -1; return; }
        if (hipOccupancyMaxActiveBlocksPerMultiprocessor(&per_cu, (const void*)skel_fwd, NTHR, LDS_BYTES) != hipSuccess || per_cu < 1) { fprintf(stderr, "kernel_launch: the occupancy query reports %d workgroups per CU; nothing launched\n", per_cu); (void)hipGetLastError(); grid = -1; return; }
        (void)hipGetLastError();
        if (cus * per_cu < 256) { fprintf(stderr, "kernel_launch: needs 256 co-resident workgroups (one per 64-token chunk), device admits %d\n", cus * per_cu); grid = -1; return; }
        grid = 256;
    }
    if (grid < 0) return;
    (void)hipMemsetAsync((char*)d_ws + WS_CTL, 0, CTL_ZERO_BYTES, stream);
    Args a{};
    for (int i = 0; i < 27; ++i) a.in[i] = (const float*)d_in[i];
    a.out = (float*)d_out; a.ws = (unsigned char*)d_ws; a.ph_lo = 0; a.ph_hi = 11;
    hipLaunchKernelGGL(skel_fwd, dim3(grid), dim3(NTHR), LDS_BYTES, stream, a);
}
```

```cpp
#include <hip/hip_runtime.h>
#include <cstdio>
#include <cstdint>

constexpr int BATCH = 2, SEQ = 8192, D = 1024, T = BATCH * SEQ;
constexpr int DH = 512, HD = 128, NH = 4, CHK = 64, NCH = SEQ / CHK;
constexpr int DR = 512, RBD = 64;
constexpr int DIN = 3072;
constexpr int NG = 4, EPG = 8, NE = 32, DE = 512;
constexpr int MAXMB = 160;
constexpr float EPS = 1e-6f;
constexpr int NWAVES = 8, NTHR = 512;

#define GAS __attribute__((address_space(1)))
#define LAS __attribute__((address_space(3)))
typedef unsigned short bf16;
typedef unsigned v4u __attribute__((ext_vector_type(4)));
typedef unsigned v2u __attribute__((ext_vector_type(2)));
typedef float f32x4 __attribute__((ext_vector_type(4)));
typedef short bf16x8 __attribute__((ext_vector_type(8)));
typedef GAS unsigned gu32;
#define RLX_AGENT __ATOMIC_RELAXED, __HIP_MEMORY_SCOPE_AGENT
#define LDS_WAIT() asm volatile("s_waitcnt lgkmcnt(0)" ::: "memory")
#define VM_WAIT() asm volatile("s_waitcnt vmcnt(0)" ::: "memory")
#define LDS_BAR() do { asm volatile("s_waitcnt lgkmcnt(0)" ::: "memory"); __builtin_amdgcn_s_barrier(); asm volatile("" ::: "memory"); } while (0)

__device__ __forceinline__ unsigned f2bf(float f) { unsigned u = __builtin_bit_cast(unsigned, f); return (u + 0x7fffu + ((u >> 16) & 1u)) >> 16; }
__device__ __forceinline__ float bf2f(unsigned h) { return __builtin_bit_cast(float, h << 16); }
typedef float f32x2_t __attribute__((ext_vector_type(2))); typedef __bf16 bf16x2_t __attribute__((ext_vector_type(2)));
__device__ __forceinline__ unsigned pk2m(float lo, float hi) { f32x2_t v = {lo, hi}; bf16x2_t b = __builtin_convertvector(v, bf16x2_t); return __builtin_bit_cast(unsigned, b); }
__device__ __forceinline__ unsigned pk2(float lo, float hi) { unsigned r; asm volatile("v_cvt_pk_bf16_f32 %0, %1, %2" : "=v"(r) : "v"(lo), "v"(hi)); return r; }
__device__ __forceinline__ float frcp(float v) { return __builtin_amdgcn_rcpf(v); }
__device__ __forceinline__ float sigmoidf_(float v) { return frcp(1.f + __expf(-v)); }
__device__ __forceinline__ float siluf_(float v) { return v * frcp(1.f + __expf(-v)); }
__device__ __forceinline__ float gelu_tanh_(float v) { const float u = 1.5957691216057308f * (v + 0.044715f * v * v * v); return v * frcp(1.f + __expf(-u)); }
template <int CTRL> __device__ __forceinline__ float dpp_f(float x) { return __builtin_bit_cast(float, __builtin_amdgcn_update_dpp(0, __builtin_bit_cast(int, x), CTRL, 0xF, 0xF, false)); }
__device__ __forceinline__ float row_sum16(float x) {
    x += dpp_f<0x121>(x); x += dpp_f<0x122>(x); x += dpp_f<0x124>(x); x += dpp_f<0x128>(x); return x; }
__device__ __forceinline__ float wave_sum(float v) {
    v = row_sum16(v);
    const int vi = __builtin_bit_cast(int, v);
    return (__builtin_bit_cast(float, __builtin_amdgcn_readlane(vi, 0)) + __builtin_bit_cast(float, __builtin_amdgcn_readlane(vi, 16))) + (__builtin_bit_cast(float, __builtin_amdgcn_readlane(vi, 32)) + __builtin_bit_cast(float, __builtin_amdgcn_readlane(vi, 48)));
}

__device__ __forceinline__ float partner_row16(float x, bool odd_row) { float a = x, b = x; asm volatile("s_nop 1\n\tv_permlane16_swap_b32 %0, %1" : "+v"(a), "+v"(b)); return odd_row ? a : b; }
__device__ __forceinline__ float partner_half32(float x, bool upper) { float a = x, b = x; asm volatile("s_nop 1\n\tv_permlane32_swap_b32 %0, %1" : "+v"(a), "+v"(b)); return upper ? a : b; }

constexpr size_t MiB = 1u << 20, KiB = 1u << 10;
constexpr size_t WS_CTL = 0, CTL_ZERO_BYTES = 160 * KiB;
constexpr size_t WS_MOD = 1 * MiB;
constexpr size_t WS_LB = WS_MOD + 64 * KiB;
constexpr size_t WS_WRT = WS_MOD + 128 * KiB;
constexpr size_t WS_WIT = WS_WRT + 64 * KiB;
constexpr size_t WS_RRH = WS_WIT + 64 * KiB;
constexpr size_t WS_RRL = WS_RRH + 96 * KiB;
constexpr size_t WS_RGA = 2 * MiB;
constexpr size_t WS_RGH = WS_RGA + 512 * KiB;
constexpr size_t WS_CARRY = WS_RGH + 512 * KiB;
constexpr size_t WS_DD = WS_CARRY + 512 * KiB;
constexpr size_t WS_WGT = 4 * MiB;
constexpr size_t WS_LIST = 5 * MiB;
constexpr size_t WS_WIN = 10 * MiB;
constexpr size_t WS_WOUT = 16 * MiB;
constexpr size_t WS_W13 = 18 * MiB;
constexpr size_t WS_W2 = 82 * MiB;
constexpr size_t WS_H = 114 * MiB;
constexpr size_t WS_PROJ = 146 * MiB;
constexpr size_t WS_MIX = WS_PROJ;
constexpr size_t WS_YA = WS_PROJ;
constexpr size_t WS_ACT = WS_PROJ + 64 * MiB;
constexpr size_t WS_X1B = 258 * MiB;
constexpr size_t WS_END = 290 * MiB;
constexpr size_t PROJ_S = (size_t)T * DH;
constexpr int CW_CNT = 32768;
constexpr int CW_MODCNT = 128;
constexpr int CW_BAR = 4096;
constexpr int CW_MB = 16384;

constexpr int RING_BYTES = 131072;
constexpr int RTAB_BYTES = 1024 * 36 * 4;
constexpr int X_OFF = RTAB_BYTES;
constexpr int X_GTAB = X_OFF;
constexpr int X_MBE = X_OFF + 8192;
constexpr int X_MISC = X_OFF + 10240;
constexpr int LDS_BYTES = X_OFF + 12288;

namespace pg8 {
constexpr int BM = 256, BK = 64, HALF = 128, HTB = HALF * BK * 2, NXCD = 8, WGM = 8;
__host__ __device__ __forceinline__ int lds_byte(int r, int c) { const int st = (r >> 4) * 2 + (c >> 5), rr = r & 15, cc = c & 31, ob = rr * 64 + cc * 2; return st * 1024 + (ob ^ (((ob >> 9) & 1) << 5)); }
__host__ __device__ __forceinline__ void stage_rc(int b, int& R, int& C) { const int st = b / 1024, sb = b % 1024, swz = sb ^ (((sb >> 9) & 1) << 5); R = (st >> 1) * 16 + swz / 64; C = (st & 1) * 32 + (swz % 64) / 2; }
__host__ __device__ __forceinline__ int perm32(int rho) { const int n = rho >> 4, i = rho & 15; return 8 * (i >> 2) + 4 * n + (i & 3); }

struct Unit { int pm, pn, slot; };
struct Gemm { const bf16* A; const bf16* Bt; int K; };

struct StaticOrder {
    int nM, nN, nwg, G, c, K, rep;
    __device__ __forceinline__ void init(int M, int N, int K_, int G_, int c_, int rep_ = 1) { nM = M / BM; nN = N / BM; nwg = nM * nN; G = G_; c = c_; K = K_; rep = rep_; }
    __device__ __forceinline__ bool next(int i, Unit& u) const {
        long L = (long)i * G + c; if (L >= (long)nwg * rep) return false; L %= nwg;
        int wgid = (int)L; { const int q = nwg / NXCD, r = nwg % NXCD, xcd = wgid % NXCD, off = wgid / NXCD; wgid = (xcd < r ? xcd * (q + 1) : r * (q + 1) + (xcd - r) * q) + off; }
        const int nig = WGM * nN, gid = wgid / nig, fm = gid * WGM, gsz = (nM - fm) < WGM ? (nM - fm) : WGM;
        u.pm = fm + ((wgid % nig) % gsz); u.pn = (wgid % nig) / gsz; u.slot = i; return true;
    }
    __device__ __forceinline__ size_t aoff(const Unit& u) const { return (size_t)u.pm * BM * K * 2; }
    __device__ __forceinline__ size_t boff(const Unit& u) const { return (size_t)u.pn * BM * K * 2; }
    __device__ __forceinline__ void done(const Unit&) const {}
};
struct MoeOrder {
    int nunits, G, c, K; const LAS int* mbe; size_t estride; int rep;
    int rev; unsigned* done_cnt;
    __device__ __forceinline__ bool next(int i, Unit& u) const {
        const int x = c & 7, ci = c >> 3; const int lo = (int)(((long)nunits * x) >> 3), hi = (int)(((long)nunits * (x + 1)) >> 3);
        int mine; long L0; int stride;
        if (!rev) { mine = (hi - lo - ci + 31) >> 5; L0 = lo + ci; stride = 32; }
        else {
            const int U = hi - lo, base = U >> 5, rem = U & 31, Tc = (3 * U + 31) >> 5;
            int dhi = Tc - 2 * (base + 1); dhi = dhi > 0 ? dhi : 0; int dlo = Tc - 2 * base; dlo = dlo > 0 ? dlo : 0;
            int tailn = rem * dhi; tailn = tailn < U ? tailn : U; const int headn = U - tailn;
            int s0, s1;
            if (ci < rem) { s1 = U - ci * dhi; s0 = s1 - dhi; s0 = s0 > headn ? s0 : headn; s1 = s1 > headn ? s1 : headn; }
            else { s0 = (ci - rem) * dlo; s1 = s0 + dlo; s0 = s0 < headn ? s0 : headn; s1 = s1 < headn ? s1 : headn; }
            mine = s1 - s0; L0 = lo + s0; stride = 1; }
        if (mine <= 0 || i >= mine * rep) return false;
        const int ii = i % mine; const long L = L0 + (long)stride * ii;
        u.pm = (int)(L >> 2); u.pn = (int)(L & 3); u.slot = ii; return true;
    }
    __device__ __forceinline__ size_t aoff(const Unit& u) const { return (size_t)u.pm * BM * K * 2; }
    __device__ __forceinline__ size_t boff(const Unit& u) const { return (size_t)mbe[u.pm] * estride + (size_t)u.pn * BM * K * 2; }
    __device__ __forceinline__ void done(const Unit& u) const {
        if (done_cnt) { asm volatile("s_waitcnt vmcnt(0)" ::: "memory"); if ((threadIdx.x & 63) == 0) __hip_atomic_fetch_add(done_cnt + 64 * u.pm, 1u, __ATOMIC_RELAXED, __HIP_MEMORY_SCOPE_AGENT); }
    }
};

struct EpiProj {
    static constexpr bool PERM = true;
    bf16* base; const float* lb;
    __device__ __forceinline__ void operator()(const f32x4 (&acc)[2][2][4][2], const Unit& u, int wr, int wc, int fr, int fq) const {
        const int grp = u.pn >> 1, c0 = (u.pn & 1) * 256 + wc * 32 + 8 * fq, row0 = u.pm * BM + wr * 64 + fr;
        bf16* ob = base + (grp == 0 ? 0 : grp == 1 ? PROJ_S : (size_t)(grp + 1) * PROJ_S);
        float lbv[2][8];
        if (grp == 1) {
#pragma unroll
            for (int bj = 0; bj < 2; ++bj) { const f32x4 a = *(const f32x4*)(lb + c0 + bj * HALF), b = *(const f32x4*)(lb + c0 + bj * HALF + 4);
                lbv[bj][0] = a[0]; lbv[bj][1] = a[1]; lbv[bj][2] = a[2]; lbv[bj][3] = a[3]; lbv[bj][4] = b[0]; lbv[bj][5] = b[1]; lbv[bj][6] = b[2]; lbv[bj][7] = b[3]; }
        }
#pragma unroll
        for (int ai = 0; ai < 2; ++ai)
#pragma unroll
            for (int m = 0; m < 4; ++m) { bf16* rowp = ob + (size_t)(row0 + ai * HALF + m * 16) * DH + c0;
#pragma unroll
                for (int bj = 0; bj < 2; ++bj) {
                    float v[8];
#pragma unroll
                    for (int j = 0; j < 4; ++j) { v[j] = acc[ai][bj][m][0][j]; v[4 + j] = acc[ai][bj][m][1][j]; }
                    if (grp == 1) {
                        float kv[8];
#pragma unroll
                        for (int j = 0; j < 8; ++j) { const float l = lbv[bj][j], sg = sigmoidf_(v[j]); kv[j] = (1.f - l) * (1.f - sg); v[j] = __logf(l + (1.f - l) * sg); }
                        v4u w; w.x = pk2(kv[0], kv[1]); w.y = pk2(kv[2], kv[3]); w.z = pk2(kv[4], kv[5]); w.w = pk2(kv[6], kv[7]);
                        *(v4u*)(rowp + PROJ_S + bj * HALF) = w;
                    } else if (grp == 0 || grp == 3) {
#pragma unroll
                        for (int j = 0; j < 8; ++j) v[j] = siluf_(v[j]);
                    } else if (grp == 5) {
#pragma unroll
                        for (int j = 0; j < 8; ++j) v[j] = gelu_tanh_(v[j]);
                    }
                    v4u w; w.x = pk2m(v[0], v[1]); w.y = pk2m(v[2], v[3]); w.z = pk2m(v[4], v[5]); w.w = pk2m(v[6], v[7]);
                    *(v4u*)(rowp + bj * HALF) = w;
                } }
    }
};
struct EpiF32 {
    static constexpr bool PERM = false;
    float* C; int ldc;
    __device__ __forceinline__ void operator()(const f32x4 (&acc)[2][2][4][2], const Unit& u, int wr, int wc, int fr, int fq) const {
        const int row0 = u.pm * BM + wr * 64 + fr, col0 = u.pn * BM + wc * 32 + 4 * fq;
#pragma unroll
        for (int ai = 0; ai < 2; ++ai)
#pragma unroll
            for (int m = 0; m < 4; ++m) { float* rowp = C + (size_t)(row0 + ai * HALF + m * 16) * ldc + col0;
#pragma unroll
                for (int bj = 0; bj < 2; ++bj)
#pragma unroll
                    for (int n = 0; n < 2; ++n) *(f32x4*)(rowp + bj * HALF + n * 16) = acc[ai][bj][m][n]; }
    }
};
struct EpiMixB {
    static constexpr bool PERM = true;
    bf16* C; int ldc;
    __device__ __forceinline__ void operator()(const f32x4 (&acc)[2][2][4][2], const Unit& u, int wr, int wc, int fr, int fq) const {
        const int row0 = u.pm * BM + wr * 64 + fr, col0 = u.pn * BM + wc * 32 + 8 * fq;
#pragma unroll
        for (int ai = 0; ai < 2; ++ai)
#pragma unroll
            for (int m = 0; m < 4; ++m) { bf16* rowp = C + (size_t)(row0 + ai * HALF + m * 16) * ldc + col0;
#pragma unroll
                for (int bj = 0; bj < 2; ++bj) { const f32x4 a = acc[ai][bj][m][0], b = acc[ai][bj][m][1];
                    v4u w; w.x = pk2m(a[0], a[1]); w.y = pk2m(a[2], a[3]); w.z = pk2m(b[0], b[1]); w.w = pk2m(b[2], b[3]);
                    *(v4u*)(rowp + bj * HALF) = w; } }
    }
};
struct EpiAct {
    static constexpr bool PERM = true;
    bf16* act;
    __device__ __forceinline__ void operator()(const f32x4 (&acc)[2][2][4][2], const Unit& u, int wr, int wc, int fr, int fq) const {
        const int row0 = u.pm * BM + wr * 64 + fr, col0 = u.pn * HALF + wc * 32 + 8 * fq;
#pragma unroll
        for (int ai = 0; ai < 2; ++ai)
#pragma unroll
            for (int m = 0; m < 4; ++m) {
                float v[8];
#pragma unroll
                for (int j = 0; j < 4; ++j) { v[j] = siluf_(acc[ai][0][m][0][j]) * acc[ai][1][m][0][j]; v[4 + j] = siluf_(acc[ai][0][m][1][j]) * acc[ai][1][m][1][j]; }
                v4u w; w.x = pk2(v[0], v[1]); w.y = pk2(v[2], v[3]); w.z = pk2(v[4], v[5]); w.w = pk2(v[6], v[7]);
                bf16* dst = act + (size_t)(row0 + ai * HALF + m * 16) * DE + col0;
                asm volatile("global_store_dwordx4 %0, %1, off sc1\n\ts_nop 1" :: "v"(dst), "v"(w) : "memory"); }
    }
};
struct EpiYa {
    static constexpr bool PERM = true;
    bf16* ya; const float* wgt; const LAS int* tab;
    __device__ __forceinline__ void operator()(const f32x4 (&acc)[2][2][4][2], const Unit& u, int wr, int wc, int fr, int fq) const {
        const int col0 = u.pn * BM + wc * 32 + 8 * fq;
#pragma unroll
        for (int ai = 0; ai < 2; ++ai)
#pragma unroll
            for (int m = 0; m < 4; ++m) { const int aid = tab[u.slot * 256 + ai * HALF + wr * 64 + m * 16 + fr];
                if (aid >= 0) { const float w8 = wgt[aid]; bf16* rowp = ya + (size_t)aid * D + col0;
#pragma unroll
                    for (int bj = 0; bj < 2; ++bj) { const f32x4 a = acc[ai][bj][m][0] * w8, b = acc[ai][bj][m][1] * w8;
                        v4u w; w.x = pk2(a[0], a[1]); w.y = pk2(a[2], a[3]); w.z = pk2(b[0], b[1]); w.w = pk2(b[2], b[3]);
                        *(v4u*)(rowp + bj * HALF) = w; } } }
    }
};

template <class Epi, class Sched, bool GATHER, bool ALIGN_EPI = true>
__device__ __forceinline__ void gemm_phase(LAS unsigned char* lds, const Gemm g, const Sched& S, const Epi& E, const LAS unsigned* gtab) {
    const int tid = threadIdx.x, wid = __builtin_amdgcn_readfirstlane(tid >> 6), lane = tid & 63, wr = wid >> 2, wc = wid & 3, fr = lane & 15, fq = lane >> 4;
    const int K = g.K, nt = K / BK;
    unsigned voffA[2], voffB[2]; int rowA[2];
#pragma unroll
    for (int i = 0; i < 2; ++i) { int R, C; stage_rc(tid * 16 + i * 8192, R, C); const int Rb = Epi::PERM ? ((R & ~31) + perm32(R & 31)) : R;
        voffA[i] = GATHER ? (unsigned)(C * 2) : (unsigned)(R * K + C) * 2u; voffB[i] = (unsigned)(Rb * K + C) * 2u; rowA[i] = R; }
    const size_t kstep = (size_t)(BK * 2);
    const size_t hstep = (size_t)HALF * K * 2;
    const unsigned ldsw = (unsigned)wid * 1024u;
    const int aoff = lds_byte(wr * 64 + fr, fq * 8), boff = lds_byte(wc * 32 + fr, fq * 8);
#define PG8_SA(b, h) (((b) * 2 + (h)) * HTB)
#define PG8_SB(b, h) ((4 + (b) * 2 + (h)) * HTB)
#define PG8_STAGE(bufoff, gbase, voff) do { _Pragma("unroll") for (int _i = 0; _i < 2; ++_i) \
        __builtin_amdgcn_global_load_lds((const unsigned*)((const char*)(gbase) + (voff)[_i]), (LAS unsigned*)(lds + (bufoff) + ldsw + _i * 8192), 16, 0, 0); } while (0)
#define PG8_STAGE_A(bufoff, gbase, slot, h) do { if constexpr (GATHER) { _Pragma("unroll") for (int _i = 0; _i < 2; ++_i) { const unsigned _ro = gtab[(slot) * 256 + (h) * HALF + rowA[_i]]; \
        __builtin_amdgcn_global_load_lds((const unsigned*)((const char*)(gbase) + _ro + voffA[_i]), (LAS unsigned*)(lds + (bufoff) + ldsw + _i * 8192), 16, 0, 0); } } \
        else { PG8_STAGE(bufoff, (const char*)(gbase) + (h) * hstep, voffA); } } while (0)
#define PG8_LDA(dst, b, h) do { _Pragma("unroll") for (int m = 0; m < 4; ++m) _Pragma("unroll") for (int k = 0; k < 2; ++k) dst[m][k] = *(const LAS bf16x8*)(lds + PG8_SA(b, h) + aoff + m * 2048 + k * 1024); } while (0)
#define PG8_LDB(dst, b, h) do { _Pragma("unroll") for (int n = 0; n < 2; ++n) _Pragma("unroll") for (int k = 0; k < 2; ++k) dst[n][k] = *(const LAS bf16x8*)(lds + PG8_SB(b, h) + boff + n * 2048 + k * 1024); } while (0)
#define PG8_MMA(ai, bj, At, Bt) do { __builtin_amdgcn_s_setprio(1); _Pragma("unroll") for (int m = 0; m < 4; ++m) _Pragma("unroll") for (int n = 0; n < 2; ++n) _Pragma("unroll") for (int k = 0; k < 2; ++k) \
        acc[ai][bj][m][n] = __builtin_amdgcn_mfma_f32_16x16x32_bf16(Bt[n][k], At[m][k], acc[ai][bj][m][n], 0, 0, 0); __builtin_amdgcn_s_setprio(0); } while (0)
#define PG8_WAIT_V(n) asm volatile("s_waitcnt vmcnt(" #n ")" ::: "memory")
#define PG8_WAIT_L(n) asm volatile("s_waitcnt lgkmcnt(" #n ")" ::: "memory")
#define PG8_BAR __builtin_amdgcn_s_barrier()
#define PG8_SCHED __builtin_amdgcn_sched_barrier(0)
    Unit cur, nxt; int ui = 0;
    if (!S.next(0, cur)) return;
    f32x4 acc[2][2][4][2];
#pragma unroll
    for (int a = 0; a < 2; ++a)
#pragma unroll
        for (int b = 0; b < 2; ++b)
#pragma unroll
            for (int m = 0; m < 4; ++m)
#pragma unroll
                for (int n = 0; n < 2; ++n) acc[a][b][m][n] = (f32x4){0.f, 0.f, 0.f, 0.f};
    bf16x8 At[4][2], B0[2][2], B1[2][2];
    const char* cA = (const char*)g.A + (GATHER ? (size_t)0 : S.aoff(cur)); const char* cB = (const char*)g.Bt + S.boff(cur);
    PG8_STAGE(PG8_SB(0, 0), cB, voffB); PG8_STAGE(PG8_SB(0, 1), cB + hstep, voffB); PG8_STAGE_A(PG8_SA(0, 0), cA, 0, 0); PG8_STAGE_A(PG8_SA(0, 1), cA, 0, 1);
    if (wr == 1) PG8_BAR;
    PG8_WAIT_V(2); PG8_BAR;
    PG8_STAGE(PG8_SB(1, 0), cB + kstep, voffB); PG8_STAGE_A(PG8_SA(1, 0), cA + kstep, 0, 0); PG8_STAGE(PG8_SB(1, 1), cB + hstep + kstep, voffB);
    PG8_WAIT_V(6); PG8_BAR;
    for (;;) {
        const bool has_next = S.next(ui + 1, nxt);
        const char* nA = has_next ? (const char*)g.A + (GATHER ? (size_t)0 : S.aoff(nxt)) : cA; const char* nB = has_next ? (const char*)g.Bt + S.boff(nxt) : cB;
        const int nslot = has_next ? nxt.slot : cur.slot, cslot = cur.slot;
        for (int t = 0; t < nt; t += 2) {
            const bool last = (t == nt - 2);
            const char* a1 = cA + (size_t)(t + 1) * kstep;
            const char* a2 = last ? nA : cA + (size_t)(t + 2) * kstep; const char* b2 = last ? nB : cB + (size_t)(t + 2) * kstep;
            const char* a3 = a2 + kstep; const char* b3 = b2 + kstep;
            const int s2 = last ? nslot : cslot;
            PG8_LDB(B0, 0, 0); PG8_LDB(B1, 0, 1); PG8_SCHED; PG8_LDA(At, 0, 0); PG8_STAGE_A(PG8_SA(1, 1), a1, cslot, 1);
            PG8_WAIT_V(8); PG8_WAIT_L(0); PG8_BAR; PG8_MMA(0, 0, At, B0); PG8_MMA(0, 1, At, B1); PG8_BAR; PG8_SCHED;
            PG8_LDA(At, 0, 1); PG8_STAGE(PG8_SB(0, 0), b2, voffB); PG8_STAGE(PG8_SB(0, 1), b2 + hstep, voffB); PG8_STAGE_A(PG8_SA(0, 0), a2, s2, 0);
            PG8_WAIT_V(8); PG8_WAIT_L(0); PG8_BAR; PG8_MMA(1, 0, At, B0); PG8_MMA(1, 1, At, B1); PG8_BAR; PG8_SCHED;
            PG8_LDB(B0, 1, 0); PG8_LDB(B1, 1, 1); PG8_SCHED; PG8_LDA(At, 1, 0); PG8_STAGE_A(PG8_SA(0, 1), a2, s2, 1);
            PG8_WAIT_V(8); PG8_WAIT_L(0); PG8_BAR; PG8_MMA(0, 0, At, B0); PG8_MMA(0, 1, At, B1); PG8_BAR; PG8_SCHED;
            PG8_LDA(At, 1, 1); PG8_STAGE(PG8_SB(1, 0), b3, voffB); PG8_STAGE(PG8_SB(1, 1), b3 + hstep, voffB); PG8_STAGE_A(PG8_SA(1, 0), a3, s2, 0);
            PG8_WAIT_V(8); PG8_WAIT_L(0); PG8_BAR; PG8_MMA(1, 0, At, B0); PG8_MMA(1, 1, At, B1); PG8_BAR; PG8_SCHED;
        }
        if constexpr (ALIGN_EPI) { if (wr == 0) PG8_BAR; }
        E(acc, cur, wr, wc, fr, fq); S.done(cur);
        if (!has_next) break;
#pragma unroll
        for (int a = 0; a < 2; ++a)
#pragma unroll
            for (int b = 0; b < 2; ++b)
#pragma unroll
                for (int m = 0; m < 4; ++m)
#pragma unroll
                    for (int n = 0; n < 2; ++n) acc[a][b][m][n] = (f32x4){0.f, 0.f, 0.f, 0.f};
        cur = nxt; cA = nA; cB = nB; ++ui;
        if constexpr (ALIGN_EPI) { if (wr == 1) PG8_BAR; }
    }
    PG8_WAIT_V(0);
    if constexpr (!ALIGN_EPI) { if (wr == 0) PG8_BAR; }
    PG8_BAR;
#undef PG8_SA
#undef PG8_SB
#undef PG8_STAGE
#undef PG8_STAGE_A
#undef PG8_LDA
#undef PG8_LDB
#undef PG8_MMA
#undef PG8_WAIT_V
#undef PG8_WAIT_L
#undef PG8_BAR
#undef PG8_SCHED
}
}

#define XB_TMO      128
#define XB_XCNT(j)  (256  + 64 * (j))
#define XB_XSUB(j)  (1280 + 64 * (j))
#define XB_XGEN(j)  (2304 + 64 * (j))
#define XB_TOP      3328
#define XB_TOPGEN   3392
#define XCD_BAR_WORDS 3456
#define XB_SPIN_CAP (1u << 18)
__device__ __forceinline__ unsigned xb_ld(unsigned* p)              { return __hip_atomic_load(p, __ATOMIC_RELAXED, __HIP_MEMORY_SCOPE_AGENT); }
__device__ __forceinline__ unsigned xb_add(unsigned* p, unsigned v) { return __hip_atomic_fetch_add(p, v, __ATOMIC_RELAXED, __HIP_MEMORY_SCOPE_AGENT); }
__device__ __forceinline__ unsigned xb_xcc_id() { return (unsigned)__builtin_amdgcn_s_getreg((3 << 11) | 20) & 0xFu; }
#define XB_SPIN(cond, bar) do { unsigned _sp = 0; while (cond) { __builtin_amdgcn_s_sleep(1); \
    if ((++_sp & 255u) == 0u) { if (xb_ld(&(bar)[XB_TMO])) break; if (_sp > XB_SPIN_CAP) { atomicAdd(&(bar)[XB_TMO], 1u); break; } } } } while (0)
struct XcdBarrier { unsigned* bar; unsigned x; volatile LAS unsigned* st; };
__device__ __forceinline__ XcdBarrier xcd_barrier_post(unsigned* bar, volatile LAS unsigned* st) {
    XcdBarrier b; b.bar = bar; b.x = xb_xcc_id(); b.st = st;
    if (threadIdx.x == 0) (void)xb_add(&bar[XB_XCNT(b.x)], 1u);
    return b;
}
__device__ __forceinline__ void xcd_barrier_complete(unsigned* bar, unsigned x, unsigned& nloc, unsigned& nx) {
    const unsigned G = gridDim.x * gridDim.y * gridDim.z;
    unsigned sum, cnt, mine, sp = 0u;
    for (;;) {
        sum = 0u; cnt = 0u; mine = 0u;
#pragma unroll
        for (unsigned j = 0; j < 16; ++j) { const unsigned c = xb_ld(&bar[XB_XCNT(j)]); sum += c; cnt += (c > 0u) ? 1u : 0u; mine = (j == x) ? c : mine; }
        if (sum == G) break;
        __builtin_amdgcn_s_sleep(1);
        if ((++sp & 255u) == 0u) { if (xb_ld(&bar[XB_TMO])) break; if (sp > XB_SPIN_CAP) { atomicAdd(&bar[XB_TMO], 1u); break; } }
    }
    nloc = mine > 0u ? mine : 1u; nx = cnt > 0u ? cnt : 1u;
}
__device__ __forceinline__ void xcd_barrier(const XcdBarrier& b) {
    asm volatile("s_waitcnt vmcnt(0)" ::: "memory");
    __syncthreads();
    if (threadIdx.x == 0) {
        unsigned* bar = b.bar;
        __builtin_amdgcn_s_waitcnt(0);
        unsigned nloc = b.st[0], nx = b.st[1];
        if (nloc == 0u) { xcd_barrier_complete(bar, b.x, nloc, nx); b.st[0] = nloc; b.st[1] = nx; }
        const unsigned old = xb_add(&bar[XB_XSUB(b.x)], 1u);
        const unsigned gen = old / nloc;
        if (old + 1u == (gen + 1u) * nloc) {
            __builtin_amdgcn_fence(__ATOMIC_RELEASE, "agent");
            asm volatile("s_waitcnt vmcnt(0)" ::: "memory");
            const unsigned og = xb_add(&bar[XB_TOP], 1u);
            const unsigned tg = og / nx;
            if (og + 1u == (tg + 1u) * nx) xb_add(&bar[XB_TOPGEN], 1u);
            else XB_SPIN(xb_ld(&bar[XB_TOPGEN]) == tg, bar);
            __builtin_amdgcn_fence(__ATOMIC_ACQUIRE, "agent");
            xb_add(&bar[XB_XGEN(b.x)], 1u);
            asm volatile("s_waitcnt vmcnt(0)" ::: "memory");
        } else {
            XB_SPIN(xb_ld(&bar[XB_XGEN(b.x)]) == gen, bar);
            __builtin_amdgcn_fence(__ATOMIC_ACQUIRE, "agent");
            asm volatile("s_waitcnt vmcnt(0)" ::: "memory");
        }
    }
    __syncthreads();
}

struct Args { const float* in[27]; float* out; unsigned char* ws; int ph_lo, ph_hi; };
struct Frame {
    LAS unsigned char* lds; volatile LAS unsigned* MISC; gu32* ctl;
    int tid, lane, wave, vcu, G;
    const float* const* in; float* out; unsigned char* ws; unsigned char* dsb;
};

__device__ __forceinline__ void p0_transpose_item(const float* W, int N, bf16* WT, int ldt, int k0, int n0, int drow0, LAS unsigned* Tl, int lane) {
    const int kq = lane >> 3, c4 = lane & 7;
    f32x4 a[4], b[4];
#pragma unroll
    for (int i = 0; i < 4; ++i) { const float* p = W + (size_t)(k0 + 16 * i + 2 * kq) * N + n0 + 4 * c4; a[i] = *(const f32x4*)p; b[i] = *(const f32x4*)(p + N); }
#pragma unroll
    for (int i = 0; i < 4; ++i)
#pragma unroll
        for (int j = 0; j < 4; ++j) Tl[(4 * c4 + j) * 32 + ((8 * i + kq) ^ (4 * c4))] = pk2(a[i][j], b[i][j]);
    LDS_WAIT(); asm volatile("" ::: "memory");
#pragma unroll
    for (int jj = 0; jj < 4; ++jj) { const int n = (lane >> 3) + 8 * jj, c = lane & 7;
        const v4u o = *(const LAS v4u*)(Tl + n * 32 + 4 * (c ^ (n >> 2)));
        *(GAS v4u*)(WT + (size_t)(drow0 + n) * ldt + k0 + 8 * c) = o; }
    LDS_WAIT(); asm volatile("" ::: "memory");
}
__device__ __forceinline__ void ph1_hrows(Frame& F);
__device__ __forceinline__ void ph0_prologue(Frame& F) {
    const float* c = F.in[1]; const float* wada = F.in[2]; const float* bada = F.in[3];
    float* mod = (float*)(F.ws + WS_MOD);
    LAS float* sc = (LAS float*)(F.lds);
    LAS float* red = (LAS float*)(F.lds + 8192);
    for (int i = F.tid; i < 2 * D; i += NTHR) sc[i] = siluf_(c[i]);
    __syncthreads();
    for (int slab = F.vcu; slab < 256; slab += F.G) {
        const int n0 = slab * 24;
        if (F.tid < 510) {
            const int kq = F.tid / 6, c4 = F.tid % 6; float a[2][4];
#pragma unroll
            for (int b = 0; b < 2; ++b)
#pragma unroll
                for (int j = 0; j < 4; ++j) a[b][j] = 0.f;
            for (int k = kq; k < D; k += 85) { const f32x4 w = *(const f32x4*)(wada + (size_t)k * 6144 + n0 + 4 * c4); const float s0 = sc[k], s1 = sc[D + k];
#pragma unroll
                for (int j = 0; j < 4; ++j) { a[0][j] += s0 * w[j]; a[1][j] += s1 * w[j]; } }
#pragma unroll
            for (int b = 0; b < 2; ++b)
#pragma unroll
                for (int j = 0; j < 4; ++j) red[(kq * 6 + c4) * 8 + b * 4 + j] = a[b][j];
        }
        __syncthreads();
        if (F.tid < 48) { const int b = F.tid / 24, col = F.tid % 24, c4 = col >> 2, j = col & 3; float s = 0.f;
            for (int kq = 0; kq < 85; ++kq) s += red[(kq * 6 + c4) * 8 + b * 4 + j];
            mod[b * 6144 + n0 + col] = s + bada[n0 + col]; }
        __syncthreads();
    }
    VM_WAIT(); __syncthreads();
    if (F.tid == 0) { __builtin_amdgcn_fence(__ATOMIC_RELEASE, "agent"); VM_WAIT(); __hip_atomic_fetch_add(F.ctl + CW_MODCNT, 1u, RLX_AGENT); }
    const int gt = F.vcu * NTHR + F.tid, NGT = F.G * NTHR;
    if (gt < DH) { const float* g = F.in[9]; ((float*)(F.ws + WS_LB))[gt] = 1.f / (1.f + __expf(g[DH + gt] - g[gt])); }
    for (int e = gt; e < 48 * D; e += NGT) { const int n = e >> 10, kk = e & 1023; const float wv = n < NG ? F.in[20][kk * NG + n] : n < NG + NE ? F.in[22][kk * NE + n - NG] : 0.f;
        const unsigned hi = f2bf(wv); ((bf16*)(F.ws + WS_RRH))[e] = (bf16)hi; ((bf16*)(F.ws + WS_RRL))[e] = (bf16)f2bf(wv - bf2f(hi)); }
    for (int e = gt; e < 2 * 8 * 64 * 64; e += NGT) { const int which = e >> 15, r = e & 32767, blk = r >> 12, j = (r >> 6) & 63, i = r & 63;
        const float* w = which ? F.in[15] : F.in[13]; ((bf16*)(F.ws + (which ? WS_WIT : WS_WRT)))[r] = (bf16)f2bf(w[(size_t)(blk * 64 + i) * 64 + j]); }
    LAS unsigned* scr = (LAS unsigned*)(F.lds + 32768 + F.wave * 4096);
    const int gw = F.vcu * NWAVES + F.wave, NGW = F.G * NWAVES;
    constexpr int I_IN = 16 * 96, I_OUT = 16 * 32, I_E = 256 + 256 + 256, NITEMS = I_IN + I_OUT + NE * I_E;
    for (int it = gw; it < NITEMS; it += NGW) {
        int r = it;
        if (r < I_IN) { const int kb = r / 96, nb = r % 96; p0_transpose_item(F.in[8], DIN, (bf16*)(F.ws + WS_WIN), D, 64 * kb, 32 * nb, 32 * nb, scr, F.lane); continue; } r -= I_IN;
        if (r < I_OUT) { const int kb = r / 32, nb = r % 32; p0_transpose_item(F.in[19], D, (bf16*)(F.ws + WS_WOUT), D, 64 * kb, 32 * nb, 32 * nb, scr, F.lane); continue; } r -= I_OUT;
        const int e = r / I_E; r -= e * I_E;
        if (r < 512) { const int w3 = r >> 8, q = r & 255, kb = q >> 4, nb = q & 15, n0 = 32 * nb;
            p0_transpose_item((w3 ? F.in[25] : F.in[24]) + (size_t)e * D * DE, DE, (bf16*)(F.ws + WS_W13) + (size_t)e * D * D, D, 64 * kb, n0, (n0 >> 7) * 256 + (n0 & 127) + 128 * w3, scr, F.lane); }
        else { const int q = r - 512, kb = q >> 5, nb = q & 31;
            p0_transpose_item(F.in[26] + (size_t)e * DE * D, D, (bf16*)(F.ws + WS_W2) + (size_t)e * D * DE, DE, 64 * kb, 32 * nb, 32 * nb, scr, F.lane); }
    }
    if (F.tid < 64) { unsigned sp = 0;
        while ((unsigned)__builtin_amdgcn_readfirstlane(__hip_atomic_load(F.ctl + CW_MODCNT, RLX_AGENT)) < (unsigned)F.G) { __builtin_amdgcn_s_sleep(2); if (++sp > (1u << 20)) break; }
        __builtin_amdgcn_fence(__ATOMIC_ACQUIRE, "agent"); VM_WAIT(); }
    __syncthreads();
    ph1_hrows(F);
}

__device__ __forceinline__ void ph1_hrows(Frame& F) {
    const float* x = F.in[0]; const float* g = F.in[4]; const float* mod = (const float*)(F.ws + WS_MOD); bf16* H = (bf16*)(F.ws + WS_H);
    LAS float* PA = (LAS float*)F.lds; LAS float* PB = PA + 2 * D;
    for (int i = F.tid; i < 2 * D; i += NTHR) { const int b = i >> 10, c = i & 1023; PA[i] = g[c] * (1.f + mod[b * 6144 + 1024 + c]); PB[i] = mod[b * 6144 + c]; }
    __syncthreads();
    const int gw = F.vcu * NWAVES + F.wave, NGW = F.G * NWAVES;
    f32x4 v[2][4], v2[2][4];
#define P1_LOAD(V_, m0_) do { _Pragma("unroll") for (int r = 0; r < 2; ++r) _Pragma("unroll") for (int j = 0; j < 4; ++j) V_[r][j] = ((const GAS f32x4*)(x + (size_t)((m0_) + r * (T / 2)) * D) + lane)[64 * j]; } while (0)
#define P1_ROWS(V_, m0_) do { _Pragma("unroll") for (int r = 0; r < 2; ++r) { const int m = (m0_) + r * (T / 2); float s = 0.f; \
        _Pragma("unroll") for (int j = 0; j < 4; ++j) s += V_[r][j].x * V_[r][j].x + V_[r][j].y * V_[r][j].y + V_[r][j].z * V_[r][j].z + V_[r][j].w * V_[r][j].w; \
        const float rstd = rsqrtf(wave_sum(s) * (1.f / D) + EPS); \
        GAS unsigned long long* o8 = (GAS unsigned long long*)(H + (size_t)m * D) + lane; \
        _Pragma("unroll") for (int j = 0; j < 4; ++j) { const int c0 = r * D + 4 * lane + 256 * j; const f32x4 pa = *(const LAS f32x4*)(PA + c0), pb = *(const LAS f32x4*)(PB + c0); \
            const float a0 = V_[r][j].x * rstd * pa.x + pb.x, a1 = V_[r][j].y * rstd * pa.y + pb.y, a2 = V_[r][j].z * rstd * pa.z + pb.z, a3 = V_[r][j].w * rstd * pa.w + pb.w; \
            o8[64 * j] = (unsigned long long)pk2(a0, a1) | ((unsigned long long)pk2(a2, a3) << 32); } } } while (0)
    { const int lane = F.lane; if (gw < T / 2) P1_LOAD(v, gw); }
    for (int m0 = gw; m0 < T / 2; m0 += 2 * NGW) {
        int lane = F.lane; asm volatile("" : "+v"(lane));
        const bool has2 = m0 + NGW < T / 2, has3 = m0 + 2 * NGW < T / 2;
        if (has2) P1_LOAD(v2, m0 + NGW);
        P1_ROWS(v, m0);
        if (has3) P1_LOAD(v, m0 + 2 * NGW);
        if (has2) P1_ROWS(v2, m0 + NGW);
    }
#undef P1_LOAD
#undef P1_ROWS
}

constexpr int L_GT = 0;
constexpr int L_QTL = 4096;
constexpr int L_QH = L_QTL + 17408;
constexpr int L_KH = L_QH + 17408;
constexpr int L_VT = L_KH + 17408;
constexpr int L_P = L_VT + 18432;
constexpr int L_SSQ = L_P + 9216;
constexpr int L_RSTD = L_SSQ + 2048;
constexpr int L_OT = L_RSTD + 256;
constexpr int L_KT = L_QTL;
static_assert(L_OT + 17408 <= RING_BYTES, "mixer LDS map");

struct HgLoad { unsigned lf[8], ki[8], vv[8], q[8]; };
template <bool NEEDQ>
__device__ __forceinline__ void hg_load(Frame& F, int t0, int h, HgLoad& L) {
    const bf16* PJ = (const bf16*)(F.ws + WS_PROJ); const size_t base = (size_t)(t0 + 8 * F.wave) * DH + h * HD + 2 * (F.tid & 63);
#pragma unroll
    for (int i = 0; i < 8; ++i) { const size_t o = base + (size_t)i * DH; L.lf[i] = *(const unsigned*)(PJ + PROJ_S + o); L.ki[i] = *(const unsigned*)(PJ + 2 * PROJ_S + o); L.vv[i] = *(const unsigned*)(PJ + 3 * PROJ_S + o);
        if (NEEDQ) L.q[i] = *(const unsigned*)(PJ + o); }
}
__device__ __forceinline__ void hg_cumsum(Frame& F, const HgLoad& L, float (&c0)[8], float (&c1)[8], float (&off)[2], float (&bmid)[2], float (&blast)[2]) {
    LAS float* GT = (LAS float*)(F.lds + L_GT); const int kp = F.tid & 63, w = F.wave;
    float r0 = 0.f, r1 = 0.f;
#pragma unroll
    for (int i = 0; i < 8; ++i) { r0 += bf2f(L.lf[i] & 0xffffu); r1 += bf2f(L.lf[i] >> 16); c0[i] = r0; c1[i] = r1; }
    *(LAS f32x2_t*)(GT + w * 128 + 2 * kp) = (f32x2_t){r0, r1};
    LDS_BAR();
    float a0 = 0.f, a1 = 0.f; off[0] = 0.f; off[1] = 0.f; bmid[0] = 0.f; bmid[1] = 0.f;
#pragma unroll
    for (int g = 0; g < 8; ++g) { const f32x2_t v = *(const LAS f32x2_t*)(GT + g * 128 + 2 * kp); if (g == w) { off[0] = a0; off[1] = a1; } a0 += v.x; a1 += v.y; if (g == 3) { bmid[0] = a0; bmid[1] = a1; } }
    blast[0] = a0; blast[1] = a1;
}
__device__ __forceinline__ void hg_store_vt(Frame& F, const HgLoad& L, LAS bf16* VT) {
    const int kp = F.tid & 63, w = F.wave; v4u lo, hi;
    lo.x = (L.vv[0] & 0xffffu) | (L.vv[1] << 16); lo.y = (L.vv[2] & 0xffffu) | (L.vv[3] << 16); lo.z = (L.vv[4] & 0xffffu) | (L.vv[5] << 16); lo.w = (L.vv[6] & 0xffffu) | (L.vv[7] << 16);
    hi.x = (L.vv[0] >> 16) | (L.vv[1] & 0xffff0000u); hi.y = (L.vv[2] >> 16) | (L.vv[3] & 0xffff0000u); hi.z = (L.vv[4] >> 16) | (L.vv[5] & 0xffff0000u); hi.w = (L.vv[6] >> 16) | (L.vv[7] & 0xffff0000u);
    *(LAS v4u*)(VT + (2 * kp) * 72 + 8 * w) = lo; *(LAS v4u*)(VT + (2 * kp + 1) * 72 + 8 * w) = hi;
}

template <bool FINAL>
__device__ __forceinline__ void rg_wave_task(Frame& F, int b, int n, int cb, unsigned (&valpk)[32]) {
    const int lane = F.lane, fr = lane & 15, fq = lane >> 4, c0 = 64 * cb; const int t0 = b * SEQ + 64 * n;
    const bf16* XR = (const bf16*)(F.ws + WS_PROJ) + 5 * PROJ_S; const bf16* YR = (const bf16*)(F.ws + WS_PROJ) + 6 * PROJ_S;
    const bf16* WRT = (const bf16*)(F.ws + WS_WRT); const bf16* WIT = (const bf16*)(F.ws + WS_WIT);
    bf16x8 IDf[2][2];
    v4u xq[2][4], gq[2];
#define RG_LOAD_TILE(tt_) do { const int tl_ = 16 * (tt_) + fr, tp_ = 64 * n + tl_; _Pragma("unroll") for (int ks = 0; ks < 2; ++ks) { const int cc = c0 + 32 * ks + 8 * fq; \
        _Pragma("unroll") for (int tap = 0; tap < 4; ++tap) { const bool ok_ = (tp_ - 3 + tap >= 0); const v4u x_ = *(const v4u*)(XR + (size_t)(t0 + (ok_ ? tl_ - 3 + tap : 0)) * DH + cc); \
            xq[ks][tap] = (v4u){ok_ ? x_.x : 0u, ok_ ? x_.y : 0u, ok_ ? x_.z : 0u, ok_ ? x_.w : 0u}; } \
        if (FINAL) gq[ks] = *(const v4u*)(YR + (size_t)(t0 + tl_) * DH + cc); } } while (0)
    RG_LOAD_TILE(0);
    LAS unsigned char* wl = F.lds + F.wave * 16384; LAS float* cwl = (LAS float*)(F.lds + RING_BYTES + F.wave * 2048);
#pragma unroll
    for (int p = 0; p < 8; ++p) { const int pc = p * 64 + lane, j = pc >> 3, sl = pc & 7; const size_t o = (size_t)(c0 + j) * 64 + 8 * sl;
        *(LAS v4u*)(wl + j * 128 + ((sl ^ (j & 7)) << 4)) = *(const v4u*)(WRT + o); *(LAS v4u*)(wl + 8192 + j * 128 + ((sl ^ (j & 7)) << 4)) = *(const v4u*)(WIT + o); }
#pragma unroll
    for (int tap = 0; tap < 4; ++tap) cwl[tap * 64 + lane] = F.in[11][tap * DR + c0 + lane];
    cwl[256 + lane] = F.in[12][c0 + lane];
    LDS_WAIT();
#pragma unroll
    for (int ks = 0; ks < 2; ++ks)
#pragma unroll
        for (int c2 = 0; c2 < 2; ++c2) { bf16x8 v;
#pragma unroll
            for (int j = 0; j < 8; ++j) v[j] = (short)((8 * fq + j == 16 * c2 + fr) ? 0x3F80 : 0);
            IDf[ks][c2] = v; }
    float br[4], bi[4], ls8[4], hrun[4], arun[4];
#pragma unroll
    for (int ct = 0; ct < 4; ++ct) { const int c = c0 + 16 * ct + fr; br[ct] = F.in[14][c]; bi[ct] = F.in[16][c]; const float lam = F.in[17][c]; ls8[ct] = -8.f * log1pf(__expf(-lam));
        hrun[ct] = FINAL ? ((const float*)(F.ws + WS_CARRY))[(size_t)(b * NCH + n) * DR + c] : 0.f; arun[ct] = 1.f; }
#pragma unroll
    for (int tt = 0; tt < 4; ++tt) {
        bf16x8 AX[2], AG[2];
#pragma unroll
        for (int ks = 0; ks < 2; ++ks) { const int cl = 32 * ks + 8 * fq; float xc[8];
            { const f32x4 b0 = *(const LAS f32x4*)(cwl + 256 + cl), b1 = *(const LAS f32x4*)(cwl + 256 + cl + 4); xc[0] = b0[0]; xc[1] = b0[1]; xc[2] = b0[2]; xc[3] = b0[3]; xc[4] = b1[0]; xc[5] = b1[1]; xc[6] = b1[2]; xc[7] = b1[3]; }
#pragma unroll
            for (int tap = 0; tap < 4; ++tap) { const v4u xv = xq[ks][tap];
                const f32x4 w0 = *(const LAS f32x4*)(cwl + tap * 64 + cl), w1 = *(const LAS f32x4*)(cwl + tap * 64 + cl + 4);
                xc[0] += w0[0] * bf2f(xv.x & 0xffffu); xc[1] += w0[1] * bf2f(xv.x >> 16); xc[2] += w0[2] * bf2f(xv.y & 0xffffu); xc[3] += w0[3] * bf2f(xv.y >> 16);
                xc[4] += w1[0] * bf2f(xv.z & 0xffffu); xc[5] += w1[1] * bf2f(xv.z >> 16); xc[6] += w1[2] * bf2f(xv.w & 0xffffu); xc[7] += w1[3] * bf2f(xv.w >> 16); }
            v4u pk; pk.x = pk2(xc[0], xc[1]); pk.y = pk2(xc[2], xc[3]); pk.z = pk2(xc[4], xc[5]); pk.w = pk2(xc[6], xc[7]); AX[ks] = __builtin_bit_cast(bf16x8, pk);
            if (FINAL) AG[ks] = __builtin_bit_cast(bf16x8, gq[ks]);
        }
        if (tt < 3) RG_LOAD_TILE(tt + 1);
        asm volatile("" ::: "memory");
#pragma unroll
        for (int ct = 0; ct < 4; ++ct) {
            f32x4 aR = {0.f, 0.f, 0.f, 0.f}, aI = {0.f, 0.f, 0.f, 0.f}, aX = {0.f, 0.f, 0.f, 0.f}, aG = {0.f, 0.f, 0.f, 0.f};
#pragma unroll
            for (int ks = 0; ks < 2; ++ks) { const int jr = 16 * ct + fr, so = jr * 128 + (((4 * ks + fq) ^ (jr & 7)) << 4);
                const bf16x8 wr_ = *(const LAS bf16x8*)(wl + so), wi_ = *(const LAS bf16x8*)(wl + 8192 + so);
                aR = __builtin_amdgcn_mfma_f32_16x16x32_bf16(AX[ks], wr_, aR, 0, 0, 0); aI = __builtin_amdgcn_mfma_f32_16x16x32_bf16(AX[ks], wi_, aI, 0, 0, 0); }
            aX = __builtin_amdgcn_mfma_f32_16x16x32_bf16(AX[ct >> 1], IDf[ct >> 1][ct & 1], aX, 0, 0, 0);
            if (FINAL) aG = __builtin_amdgcn_mfma_f32_16x16x32_bf16(AG[ct >> 1], IDf[ct >> 1][ct & 1], aG, 0, 0, 0);
            float a[4], u[4];
#pragma unroll
            for (int r = 0; r < 4; ++r) { const float rr = sigmoidf_(aR[r] + br[ct]), ii = sigmoidf_(aI[r] + bi[ct]); const float la = rr * ls8[ct]; a[r] = __expf(la);
                const float x2 = 2.f * la; const float ep = -x2 * (1.f + x2 * (0.5f + x2 * (0.16666667f + x2 * 0.041666667f))), ed = 1.f - a[r] * a[r];
                u[r] = __builtin_amdgcn_sqrtf(x2 > -0.03f ? ep : ed) * (ii * aX[r]); }
            const float Af = a[0] * a[1] * a[2] * a[3], Hf = ((u[0] * a[1] + u[1]) * a[2] + u[2]) * a[3] + u[3];
            const bool oddr = (fq & 1) != 0, upper = fq >= 2;
            const float Ap = partner_row16(Af, oddr), Hp = partner_row16(Hf, oddr);
            const float At = Af * Ap, Ht = oddr ? (Af * Hp + Hf) : (Ap * Hf + Hp);
            const float Ao = partner_half32(At, upper), Ho = partner_half32(Ht, upper);
            const float Atot = At * Ao, Htot = upper ? (At * Ho + Ht) : (Ao * Ht + Ho);
            float Aex, Hex;
            if (!upper) { Aex = oddr ? Ap : 1.f; Hex = oddr ? Hp : 0.f; }
            else { Aex = oddr ? Ao * Ap : Ao; Hex = oddr ? (Ap * Ho + Hp) : Ho; }
            if (FINAL) { float h = Aex * hrun[ct] + Hex;
#pragma unroll
                for (int r = 0; r < 4; ++r) { h = a[r] * h + u[r]; u[r] = h * aG[r]; }
                valpk[(tt * 4 + ct) * 2] = pk2(u[0], u[1]); valpk[(tt * 4 + ct) * 2 + 1] = pk2(u[2], u[3]); }
            hrun[ct] = Atot * hrun[ct] + Htot; arun[ct] *= Atot;
        }
    }
#undef RG_LOAD_TILE
    if (!FINAL && fq == 0) {
#pragma unroll
        for (int ct = 0; ct < 4; ++ct) { const size_t o = (size_t)(b * NCH + n) * DR + c0 + 16 * ct + fr; ((float*)(F.ws + WS_RGA))[o] = arun[ct]; ((float*)(F.ws + WS_RGH))[o] = hrun[ct]; }
    }
}

__device__ __forceinline__ void ph3_passA(Frame& F) {
    bf16* DS = (bf16*)F.dsb; float* DDp = (float*)(F.ws + WS_DD);
    const int lane = F.lane, w = F.wave, fr = lane & 15, fq = lane >> 4, kp = F.tid & 63;
    LAS bf16* KT = (LAS bf16*)(F.lds + L_KT); LAS bf16* VT = (LAS bf16*)(F.lds + L_VT);
    { const int cn = F.vcu;
        const int b = cn / NCH, n = cn % NCH, t0 = b * SEQ + 64 * n;
        HgLoad L; hg_load<false>(F, t0, 0, L);
        { unsigned dummy[32]; rg_wave_task<false>(F, b, n, w, dummy); }
        LDS_BAR();
#pragma unroll
        for (int h = 0; h < NH; ++h) {
            const int task = (b * NH + h) * NCH + n;
            float c0[8], c1[8], off[2], bmid[2], blast[2]; hg_cumsum(F, L, c0, c1, off, bmid, blast);
            unsigned k0p[4], k1p[4];
#pragma unroll
            for (int i = 0; i < 8; i += 2) {
                const float a0 = bf2f(L.ki[i] & 0xffffu) * __expf(blast[0] - (off[0] + c0[i])), a1 = bf2f(L.ki[i + 1] & 0xffffu) * __expf(blast[0] - (off[0] + c0[i + 1]));
                const float d0 = bf2f(L.ki[i] >> 16) * __expf(blast[1] - (off[1] + c1[i])), d1 = bf2f(L.ki[i + 1] >> 16) * __expf(blast[1] - (off[1] + c1[i + 1]));
                k0p[i >> 1] = pk2(a0, a1); k1p[i >> 1] = pk2(d0, d1); }
            *(LAS v4u*)(KT + (2 * kp) * 72 + 8 * w) = (v4u){k0p[0], k0p[1], k0p[2], k0p[3]}; *(LAS v4u*)(KT + (2 * kp + 1) * 72 + 8 * w) = (v4u){k1p[0], k1p[1], k1p[2], k1p[3]};
            hg_store_vt(F, L, VT);
            if (w == 0) *(f32x2_t*)(DDp + (size_t)task * HD + 2 * kp) = (f32x2_t){__expf(blast[0]), __expf(blast[1])};
            if (h + 1 < NH) hg_load<false>(F, t0, h + 1, L);
            LDS_BAR();
            bf16x8 bV[2];
#pragma unroll
            for (int ss = 0; ss < 2; ++ss) bV[ss] = *(const LAS bf16x8*)(VT + (16 * w + fr) * 72 + 8 * fq + 32 * ss);
#pragma unroll
            for (int kt = 0; kt < 8; ++kt) { f32x4 acc = {0.f, 0.f, 0.f, 0.f};
#pragma unroll
                for (int ss = 0; ss < 2; ++ss) { const bf16x8 a = *(const LAS bf16x8*)(KT + (16 * kt + fr) * 72 + 8 * fq + 32 * ss); acc = __builtin_amdgcn_mfma_f32_16x16x32_bf16(a, bV[ss], acc, 0, 0, 0); }
                *(v2u*)(DS + (size_t)task * (HD * HD) + (size_t)(16 * w + fr) * HD + 16 * kt + 4 * fq) = (v2u){pk2m(acc[0], acc[1]), pk2m(acc[2], acc[3])}; }
        }
    }
}

__device__ __forceinline__ void ph4_passB(Frame& F) {
    const bf16* DS = (const bf16*)F.dsb; bf16* SST = (bf16*)F.dsb + (size_t)BATCH * NH * NCH * HD * HD; const float* DDp = (const float*)(F.ws + WS_DD);
    const int gt = F.vcu * NTHR + F.tid, NGT = F.G * NTHR;
    for (int idx = gt; idx < BATCH * NH * HD * HD / 2 + BATCH * DR; idx += NGT) {
        if (idx < BATCH * NH * HD * HD / 2) {
            const int bh = idx >> 13, pr = idx & 8191, e0 = 2 * pr, kk = e0 & 127;
            float s0 = 0.f, s1 = 0.f;
            const bf16* dsp = DS + (size_t)bh * NCH * (HD * HD) + e0; bf16* sp = SST + (size_t)bh * NCH * (HD * HD) + e0; const float* ddp = DDp + (size_t)bh * NCH * HD + kk;
            unsigned dA[8], dB[8]; f32x2_t eA[8], eB[8];
#define PB_LOAD(dv, ev, n0_) do { _Pragma("unroll") for (int j = 0; j < 8; ++j) { dv[j] = *(const unsigned*)(dsp + (size_t)((n0_) + j) * (HD * HD)); ev[j] = *(const f32x2_t*)(ddp + ((n0_) + j) * HD); } } while (0)
#define PB_STEP(dv, ev, n0_) do { _Pragma("unroll") for (int j = 0; j < 8; ++j) { *(unsigned*)(sp + (size_t)((n0_) + j) * (HD * HD)) = pk2(s0, s1); s0 = ev[j].x * s0 + bf2f(dv[j] & 0xffffu); s1 = ev[j].y * s1 + bf2f(dv[j] >> 16); } } while (0)
            PB_LOAD(dA, eA, 0);
#pragma unroll 1
            for (int n0 = 0; n0 < NCH; n0 += 16) {
                PB_LOAD(dB, eB, n0 + 8);
                PB_STEP(dA, eA, n0);
                if (n0 + 16 < NCH) PB_LOAD(dA, eA, n0 + 16);
                PB_STEP(dB, eB, n0 + 8);
            }
#undef PB_LOAD
#undef PB_STEP
        } else {
            const int r = idx - BATCH * NH * HD * HD / 2, b = r / DR, c = r % DR;
            const float* A = (const float*)(F.ws + WS_RGA) + (size_t)b * NCH * DR + c; const float* Hh = (const float*)(F.ws + WS_RGH) + (size_t)b * NCH * DR + c; float* C = (float*)(F.ws + WS_CARRY) + (size_t)b * NCH * DR + c;
            float carry = 0.f;
#pragma unroll 4
            for (int n = 0; n < NCH; ++n) { C[(size_t)n * DR] = carry; carry = A[(size_t)n * DR] * carry + Hh[(size_t)n * DR]; }
        }
    }
}

__device__ __forceinline__ void ph5_passC(Frame& F) {
    const bf16* PJ = (const bf16*)(F.ws + WS_PROJ); const bf16* GZ = PJ + 4 * PROJ_S;
    const bf16* SST = (const bf16*)F.dsb + (size_t)BATCH * NH * NCH * HD * HD; bf16* O = (bf16*)(F.ws + WS_H);
    const int tid = F.tid, lane = F.lane, w = F.wave, fr = lane & 15, fq = lane >> 4, kp = tid & 63;
    LAS bf16* QTL = (LAS bf16*)(F.lds + L_QTL); LAS bf16* QH = (LAS bf16*)(F.lds + L_QH); LAS bf16* KH = (LAS bf16*)(F.lds + L_KH);
    LAS bf16* VT = (LAS bf16*)(F.lds + L_VT); LAS bf16* Pm = (LAS bf16*)(F.lds + L_P); LAS float* SSQ = (LAS float*)(F.lds + L_SSQ); LAS float* RSTD = (LAS float*)(F.lds + L_RSTD);
    { const int cn = F.vcu;
        const int b = cn / NCH, n = cn % NCH, t0 = b * SEQ + 64 * n;
        {
            LAS float* SSQ = (LAS float*)(F.lds + X_GTAB); LAS float* RSTD = SSQ + 512;
            unsigned valpk[32];
            rg_wave_task<true>(F, b, n, w, valpk);
#pragma unroll
            for (int tt = 0; tt < 4; ++tt) { float s[4] = {0.f, 0.f, 0.f, 0.f};
#pragma unroll
                for (int ct = 0; ct < 4; ++ct) { const unsigned p0 = valpk[(tt * 4 + ct) * 2], p1 = valpk[(tt * 4 + ct) * 2 + 1]; const float v0 = bf2f(p0 & 0xffffu), v1 = bf2f(p0 >> 16), v2 = bf2f(p1 & 0xffffu), v3 = bf2f(p1 >> 16);
                    s[0] += v0 * v0; s[1] += v1 * v1; s[2] += v2 * v2; s[3] += v3 * v3; }
#pragma unroll
                for (int r = 0; r < 4; ++r) { float x = row_sum16(s[r]); if (fr == 0) SSQ[(16 * tt + 4 * fq + r) * 8 + w] = x; } }
            LDS_BAR();
            if (tid < 64) { float s = 0.f;
#pragma unroll
                for (int i = 0; i < 8; ++i) s += SSQ[tid * 8 + i];
                RSTD[tid] = rsqrtf(s * (1.f / DR) + EPS); }
            LDS_BAR();
            { LAS bf16* VL = (LAS bf16*)(F.lds + w * 16384);
#pragma unroll
              for (int tt = 0; tt < 4; ++tt)
#pragma unroll
                  for (int ct = 0; ct < 4; ++ct) { const unsigned p0 = valpk[(tt * 4 + ct) * 2], p1 = valpk[(tt * 4 + ct) * 2 + 1]; const int tb = 16 * tt + 4 * fq, ch = 16 * ct + fr;
                      VL[(tb + 0) * 72 + ch] = (bf16)(p0 & 0xffffu); VL[(tb + 1) * 72 + ch] = (bf16)(p0 >> 16); VL[(tb + 2) * 72 + ch] = (bf16)(p1 & 0xffffu); VL[(tb + 3) * 72 + ch] = (bf16)(p1 >> 16); }
              LDS_WAIT();
              const int pc = lane & 7; const f32x4 g0 = *(const f32x4*)(F.in[18] + 64 * w + 8 * pc), g1 = *(const f32x4*)(F.in[18] + 64 * w + 8 * pc + 4);
#pragma unroll
              for (int p = 0; p < 8; ++p) { const int row = 8 * p + (lane >> 3); const v4u vv = *(const LAS v4u*)(VL + row * 72 + 8 * pc); const float rs = RSTD[row];
                  v4u o; o.x = pk2(bf2f(vv.x & 0xffffu) * rs * g0[0], bf2f(vv.x >> 16) * rs * g0[1]); o.y = pk2(bf2f(vv.y & 0xffffu) * rs * g0[2], bf2f(vv.y >> 16) * rs * g0[3]);
                  o.z = pk2(bf2f(vv.z & 0xffffu) * rs * g1[0], bf2f(vv.z >> 16) * rs * g1[1]); o.w = pk2(bf2f(vv.w & 0xffffu) * rs * g1[2], bf2f(vv.w >> 16) * rs * g1[3]);
                  *(v4u*)(O + (size_t)(t0 + row) * D + DH + 64 * w + 8 * pc) = o; } }
            LDS_BAR();
        }
        HgLoad L; hg_load<true>(F, t0, 0, L);
        LAS bf16* OT = (LAS bf16*)(F.lds + L_OT);
#pragma unroll 1
        for (int h = 0; h < NH; ++h) {
            const int task = (b * NH + h) * NCH + n;
            const int pr0 = tid >> 4, pc0 = (tid & 15) * 8;
            const v4u gz0 = *(const v4u*)(GZ + (size_t)(t0 + pr0) * DH + h * HD + pc0), gz1 = *(const v4u*)(GZ + (size_t)(t0 + pr0 + 32) * DH + h * HD + pc0);
            bf16x8 bS[4];
#pragma unroll
            for (int ks = 0; ks < 4; ++ks) bS[ks] = *(const bf16x8*)(SST + (size_t)task * (HD * HD) + (size_t)(16 * w + fr) * HD + 8 * fq + 32 * ks);
            float c0[8], c1[8], off[2], bmid[2], blast[2]; hg_cumsum(F, L, c0, c1, off, bmid, blast);
#pragma unroll
            for (int i = 0; i < 8; ++i) { const int tl = 8 * w + i; const float b0 = off[0] + c0[i], b1 = off[1] + c1[i];
                const float q0 = bf2f(L.q[i] & 0xffffu), q1 = bf2f(L.q[i] >> 16), k0 = bf2f(L.ki[i] & 0xffffu), k1 = bf2f(L.ki[i] >> 16);
                const float eq0 = __expf(fminf(b0 - bmid[0], 80.f)), eq1 = __expf(fminf(b1 - bmid[1], 80.f)), ek0 = __expf(fminf(bmid[0] - b0, 80.f)), ek1 = __expf(fminf(bmid[1] - b1, 80.f));
                *(LAS unsigned*)(QH + tl * 136 + 2 * kp) = pk2(q0 * eq0, q1 * eq1); *(LAS unsigned*)(KH + tl * 136 + 2 * kp) = pk2(k0 * ek0, k1 * ek1);
                *(LAS unsigned*)(QTL + tl * 136 + 2 * kp) = pk2(q0 * __expf(b0), q1 * __expf(b1)); }
            hg_store_vt(F, L, VT);
            if (h + 1 < NH) hg_load<true>(F, t0, h + 1, L);
            LDS_BAR();
#pragma unroll
            for (int pp = 0; pp < 2; ++pp) { const int pi = 2 * w + pp, iq = pi >> 2, jk = pi & 3; f32x4 acc = {0.f, 0.f, 0.f, 0.f};
                if (jk <= iq) {
#pragma unroll
                    for (int ks = 0; ks < 4; ++ks) { const bf16x8 a = *(const LAS bf16x8*)(KH + (16 * jk + fr) * 136 + 8 * fq + 32 * ks); const bf16x8 bq = *(const LAS bf16x8*)(QH + (16 * iq + fr) * 136 + 8 * fq + 32 * ks);
                        acc = __builtin_amdgcn_mfma_f32_16x16x32_bf16(a, bq, acc, 0, 0, 0); }
                    if (jk == iq) {
#pragma unroll
                        for (int r = 0; r < 4; ++r) if (4 * fq + r > fr) acc[r] = 0.f; }
                }
                *(LAS v2u*)(Pm + (16 * iq + fr) * 72 + 16 * jk + 4 * fq) = (v2u){pk2m(acc[0], acc[1]), pk2m(acc[2], acc[3])}; }
            LDS_BAR();
            f32x4 oacc[4];
            { bf16x8 bV[2];
#pragma unroll
              for (int ss = 0; ss < 2; ++ss) bV[ss] = *(const LAS bf16x8*)(VT + (16 * w + fr) * 72 + 8 * fq + 32 * ss);
#pragma unroll
              for (int tt = 0; tt < 4; ++tt) { f32x4 acc = {0.f, 0.f, 0.f, 0.f};
#pragma unroll
                  for (int ss = 0; ss < 2; ++ss) { const bf16x8 a = *(const LAS bf16x8*)(Pm + (16 * tt + fr) * 72 + 8 * fq + 32 * ss); acc = __builtin_amdgcn_mfma_f32_16x16x32_bf16(a, bV[ss], acc, 0, 0, 0); }
#pragma unroll
                  for (int ks = 0; ks < 4; ++ks) { const bf16x8 a = *(const LAS bf16x8*)(QTL + (16 * tt + fr) * 136 + 8 * fq + 32 * ks); acc = __builtin_amdgcn_mfma_f32_16x16x32_bf16(a, bS[ks], acc, 0, 0, 0); }
                  oacc[tt] = acc; } }
            const float gh = F.in[10][h * HD + 16 * w + fr];
#pragma unroll
            for (int tt = 0; tt < 4; ++tt)
#pragma unroll
                for (int r = 0; r < 4; ++r) { const float ov = oacc[tt][r]; float x = row_sum16(ov * ov);
                    const int tl = 16 * tt + 4 * fq + r; if (fr == 0) SSQ[tl * 8 + w] = x; OT[tl * 136 + 16 * w + fr] = (bf16)f2bf(ov * gh); }
            LDS_BAR();
#pragma unroll
            for (int pz = 0; pz < 2; ++pz) { const int row = pr0 + 32 * pz; const v4u ot = *(const LAS v4u*)(OT + row * 136 + pc0), gz = pz ? gz1 : gz0;
                const f32x4 q0 = *(const LAS f32x4*)(SSQ + row * 8), q1 = *(const LAS f32x4*)(SSQ + row * 8 + 4); const float rs = rsqrtf((((q0[0] + q0[1]) + (q0[2] + q0[3])) + ((q1[0] + q1[1]) + (q1[2] + q1[3]))) * (1.f / HD) + EPS);
                v4u o;
                o.x = pk2(bf2f(ot.x & 0xffffu) * rs * bf2f(gz.x & 0xffffu), bf2f(ot.x >> 16) * rs * bf2f(gz.x >> 16)); o.y = pk2(bf2f(ot.y & 0xffffu) * rs * bf2f(gz.y & 0xffffu), bf2f(ot.y >> 16) * rs * bf2f(gz.y >> 16));
                o.z = pk2(bf2f(ot.z & 0xffffu) * rs * bf2f(gz.z & 0xffffu), bf2f(ot.z >> 16) * rs * bf2f(gz.z >> 16)); o.w = pk2(bf2f(ot.w & 0xffffu) * rs * bf2f(gz.w & 0xffffu), bf2f(ot.w >> 16) * rs * bf2f(gz.w >> 16));
                *(v4u*)(O + (size_t)(t0 + row) * D + h * HD + pc0) = o; }
        }
    }
}

constexpr int L7_HI = 0, L7_LO = 32768, L7_PART = 65536, L7_LG = L7_PART + 24576, L7_ROUT = L7_LG + 2304;
__device__ __forceinline__ void ph7_rows(Frame& F) {
    const float* x = F.in[0]; const float* mod = (const float*)(F.ws + WS_MOD); const bf16* mix = (const bf16*)(F.ws + WS_MIX);
    const float *gpm = F.in[5], *gpf = F.in[6], *brg = F.in[21], *bre = F.in[23];
    const bf16* RRH = (const bf16*)(F.ws + WS_RRH); const bf16* RRL = (const bf16*)(F.ws + WS_RRL);
    bf16* H = (bf16*)(F.ws + WS_H); float* wgt = (float*)(F.ws + WS_WGT);
    unsigned* cnt = (unsigned*)(F.ws + WS_CTL) + CW_CNT; int* list = (int*)(F.ws + WS_LIST);
    LAS float* PART = (LAS float*)(F.lds + L7_PART); LAS float* LG = (LAS float*)(F.lds + L7_LG); LAS float* ROUT = (LAS float*)(F.lds + L7_ROUT);
    const int w = F.wave, fr = F.lane & 15, fq = F.lane >> 4, row0 = 64 * F.vcu;
    LAS float* C1 = (LAS float*)(F.lds + 98304); LAS float* C2 = C1 + D; LAS float* C3 = C2 + D;
    { const float* mb = mod + (row0 / SEQ) * 6144;
      for (int c = F.tid; c < D; c += NTHR) { C1[c] = mb[2048 + c] * gpm[c]; C2[c] = gpf[c] * (1.f + mb[4096 + c]); C3[c] = mb[3072 + c]; } }
    __syncthreads();
    bf16x8 bh[4][3], bl[4][3];
#pragma unroll
    for (int ks = 0; ks < 4; ++ks)
#pragma unroll
        for (int nt = 0; nt < 3; ++nt) { const size_t wo = (size_t)(16 * nt + fr) * D + 128 * w + 32 * ks + 8 * fq; bh[ks][nt] = *(const bf16x8*)(RRH + wo); bl[ks][nt] = *(const bf16x8*)(RRL + wo); }
    v2u mv[2][4]; f32x4 xv[2][4];
#define P7_LOAD(it_) do { _Pragma("unroll") for (int rr = 0; rr < 2; ++rr) { const int m_ = row0 + 16 * (it_) + 2 * w + rr; _Pragma("unroll") for (int j = 0; j < 4; ++j) { \
        mv[rr][j] = ((const GAS v2u*)(mix + (size_t)m_ * D) + lane)[64 * j]; xv[rr][j] = ((const GAS f32x4*)(x + (size_t)m_ * D) + lane)[64 * j]; } } } while (0)
    { const int lane = F.lane; P7_LOAD(0); }
#pragma unroll 1
    for (int it = 0; it < 4; ++it) {
        int lane = F.lane; asm volatile("" : "+v"(lane));
#pragma unroll
        for (int rr = 0; rr < 2; ++rr) {
            const int rl = 2 * w + rr, m = row0 + 16 * it + rl;
            f32x4 v[4], xr_[4]; float s = 0.f;
#pragma unroll
            for (int j = 0; j < 4; ++j) { v[j] = (f32x4){bf2f(mv[rr][j].x & 0xffffu), bf2f(mv[rr][j].x >> 16), bf2f(mv[rr][j].y & 0xffffu), bf2f(mv[rr][j].y >> 16)}; xr_[j] = xv[rr][j];
                s += v[j].x * v[j].x + v[j].y * v[j].y + v[j].z * v[j].z + v[j].w * v[j].w; }
            const float rs1 = rsqrtf(wave_sum(s) * (1.f / D) + EPS); float s2 = 0.f;
#pragma unroll
            for (int j = 0; j < 4; ++j) { const int c0 = 4 * lane + 256 * j; const f32x4 k1 = *(const LAS f32x4*)(C1 + c0);
                xr_[j].x += k1.x * (v[j].x * rs1); xr_[j].y += k1.y * (v[j].y * rs1); xr_[j].z += k1.z * (v[j].z * rs1); xr_[j].w += k1.w * (v[j].w * rs1);
                ((GAS unsigned long long*)((bf16*)(F.ws + WS_X1B) + (size_t)m * D) + lane)[64 * j] = (unsigned long long)pk2(xr_[j].x, xr_[j].y) | ((unsigned long long)pk2(xr_[j].z, xr_[j].w) << 32);
                s2 += xr_[j].x * xr_[j].x + xr_[j].y * xr_[j].y + xr_[j].z * xr_[j].z + xr_[j].w * xr_[j].w; }
            const float rs2 = rsqrtf(wave_sum(s2) * (1.f / D) + EPS);
#pragma unroll
            for (int j = 0; j < 4; ++j) { const int c0 = 4 * lane + 256 * j; const f32x4 k2 = *(const LAS f32x4*)(C2 + c0), k3 = *(const LAS f32x4*)(C3 + c0);
                const float h0 = xr_[j].x * rs2 * k2.x + k3.x, h1 = xr_[j].y * rs2 * k2.y + k3.y, h2 = xr_[j].z * rs2 * k2.z + k3.z, h3 = xr_[j].w * rs2 * k2.w + k3.w;
                const unsigned p01 = pk2(h0, h1), p23 = pk2(h2, h3);
                ((GAS unsigned long long*)(H + (size_t)m * D) + lane)[64 * j] = (unsigned long long)p01 | ((unsigned long long)p23 << 32);
                const unsigned q01 = pk2(h0 - bf2f(p01 & 0xffffu), h1 - bf2f(p01 >> 16)), q23 = pk2(h2 - bf2f(p23 & 0xffffu), h3 - bf2f(p23 >> 16));
                const int so = rl * 2048 + ((((lane >> 1) + 32 * j) ^ rl) << 4) + (lane & 1) * 8;
                *(LAS v2u*)(F.lds + L7_HI + so) = (v2u){p01, p23}; *(LAS v2u*)(F.lds + L7_LO + so) = (v2u){q01, q23}; }
        }
        if (it < 3) P7_LOAD(it + 1);
        LDS_BAR();
        f32x4 acc[3] = {{0.f, 0.f, 0.f, 0.f}, {0.f, 0.f, 0.f, 0.f}, {0.f, 0.f, 0.f, 0.f}};
#pragma unroll
        for (int ks = 0; ks < 4; ++ks) { const int slot = 16 * w + 4 * ks + fq, so = fr * 2048 + ((slot ^ fr) << 4);
            const bf16x8 ah = *(const LAS bf16x8*)(F.lds + L7_HI + so), al = *(const LAS bf16x8*)(F.lds + L7_LO + so);
#pragma unroll
            for (int nt = 0; nt < 3; ++nt) {
                acc[nt] = __builtin_amdgcn_mfma_f32_16x16x32_bf16(ah, bh[ks][nt], acc[nt], 0, 0, 0); acc[nt] = __builtin_amdgcn_mfma_f32_16x16x32_bf16(ah, bl[ks][nt], acc[nt], 0, 0, 0); acc[nt] = __builtin_amdgcn_mfma_f32_16x16x32_bf16(al, bh[ks][nt], acc[nt], 0, 0, 0); } }
#pragma unroll
        for (int nt = 0; nt < 3; ++nt)
#pragma unroll
            for (int r = 0; r < 4; ++r) PART[(w * 16 + 4 * fq + r) * 48 + 16 * nt + fr] = acc[nt][r];
        LDS_BAR();
        int tid16 = F.tid; asm volatile("" : "+v"(tid16));
        for (int e = tid16; e < 16 * 36; e += NTHR) { const int row = e / 36, o = e - row * 36; float a = o < 4 ? brg[o] : bre[o - 4];
#pragma unroll
            for (int ww = 0; ww < 8; ++ww) a += PART[(ww * 16 + row) * 48 + o];
            LG[e] = a; }
        LDS_BAR();
        if (tid16 < 16) {
            const LAS float* lgl = LG + tid16 * 36;
            int gs = 0; float gm = lgl[0];
#pragma unroll
            for (int o = 1; o < NG; ++o) if (lgl[o] > gm) { gm = lgl[o]; gs = o; }
            float den = 0.f;
#pragma unroll
            for (int o = 0; o < NG; ++o) den += __expf(lgl[o] - gm);
            const float gate = 1.f / den;
            float sel[EPG];
#pragma unroll
            for (int o = 0; o < EPG; ++o) sel[o] = lgl[4 + 8 * gs + o];
            int i1 = 0; float m1 = sel[0];
#pragma unroll
            for (int o = 1; o < EPG; ++o) if (sel[o] > m1) { m1 = sel[o]; i1 = o; }
            int i2 = -1; float m2 = -3.0e38f;
#pragma unroll
            for (int o = 0; o < EPG; ++o) if (o != i1 && sel[o] > m2) { m2 = sel[o]; i2 = o; }
            if (i2 < 0) i2 = (i1 + 1) & 7;
            const float e2 = __expf(m2 - m1);
            *(LAS f32x4*)(ROUT + (16 * it + tid16) * 4) = (f32x4){__int_as_float(gs * EPG + i1), __int_as_float(gs * EPG + i2), gate / (1.f + e2), gate * e2 / (1.f + e2)};
        }
    }
#undef P7_LOAD
    LAS unsigned* HIST = (LAS unsigned*)(F.lds + L7_ROUT + 1024); LAS unsigned* BASE = HIST + 32;
    if (F.tid < 32) HIST[F.tid] = 0u;
    __syncthreads();
    int e_ = 0; unsigned rank_ = 0u;
    if (F.tid < 128) { const int rl = F.tid >> 1, kx = F.tid & 1; e_ = __float_as_int(ROUT[rl * 4 + kx]); rank_ = atomicAdd((unsigned*)(HIST + e_), 1u); wgt[2 * (row0 + rl) + kx] = ROUT[rl * 4 + 2 + kx]; }
    __syncthreads();
    if (F.tid < 32) { const unsigned c = HIST[F.tid]; BASE[F.tid] = c ? atomicAdd(&cnt[64 * F.tid], c) : 0u; }
    __syncthreads();
    if (F.tid < 128) list[e_ * 32768 + BASE[e_] + rank_] = 2 * row0 + F.tid;
    __syncthreads();
}

__device__ __forceinline__ int moe_tables(Frame& F) {
    LAS int* MBE = (LAS int*)(F.lds + X_MBE); LAS int* MBS = MBE + MAXMB; LAS int* NMB = MBS + 33;
    LAS int* CNTL = NMB + 1;
    if (F.tid < NE) CNTL[F.tid] = (int)__hip_atomic_load(F.ctl + CW_CNT + 64 * F.tid, RLX_AGENT);
    __syncthreads();
    if (F.tid < NE) { int mb = 0;
        for (int e = 0; e < F.tid; ++e) mb += (CNTL[e] + 255) >> 8;
        const int nb = (CNTL[F.tid] + 255) >> 8; MBS[F.tid] = mb;
        for (int j = 0; j < nb && mb + j < MAXMB; ++j) MBE[mb + j] = F.tid;
        if (F.tid == NE - 1) { MBS[NE] = mb + nb; NMB[0] = mb + nb; } }
    __syncthreads();
    return NMB[0];
}
__device__ __forceinline__ void moe_fill_tabs(Frame& F, const pg8::MoeOrder& Sup, const pg8::MoeOrder& Sdn) {
    LAS int* MBE = (LAS int*)(F.lds + X_MBE); LAS int* MBS = MBE + MAXMB; LAS int* tab = (LAS int*)(F.lds + X_GTAB); const int* list = (const int*)(F.ws + WS_LIST);
    const bool dn = F.tid >= 256; const int r = F.tid & 255; const pg8::MoeOrder& S = dn ? Sdn : Sup;
    int aid[4]; bool val[4];
#pragma unroll
    for (int i = 0; i < 4; ++i) { pg8::Unit u; val[i] = S.next(i, u) && u.slot == i; aid[i] = -1;
        if (val[i]) { const int e = MBE[u.pm], pos = (u.pm - MBS[e]) * 256 + r, c = (MBS + 34)[e]; if (pos < c) aid[i] = list[e * 32768 + pos]; } }
#pragma unroll
    for (int i = 0; i < 4; ++i) if (val[i]) tab[((dn ? 4 : 0) + i) * 256 + r] = dn ? aid[i] : (aid[i] >= 0 ? (aid[i] >> 1) * (D * 2) : 0);
    __syncthreads();
}

__device__ __forceinline__ void ph10_final(Frame& F) {
    const float* mod = (const float*)(F.ws + WS_MOD); const bf16* YA = (const bf16*)(F.ws + WS_YA); const bf16* X1 = (const bf16*)(F.ws + WS_X1B); const float* gp = F.in[7];
    LAS float* CG = (LAS float*)F.lds;
    for (int i = F.tid; i < 2 * D; i += NTHR) { const int b = i >> 10, c = i & 1023; CG[i] = mod[b * 6144 + 5120 + c] * gp[c]; }
    __syncthreads();
    const int gw = F.vcu * NWAVES + F.wave, NGW = F.G * NWAVES;
    v2u ya[2][4], yb[2][4], xb[2][4], ya2[2][4], yb2[2][4], xb2[2][4];
#define P10_LOAD(YA_, YB_, XB_, m0_) do { _Pragma("unroll") for (int r = 0; r < 2; ++r) { const int m_ = (m0_) + r * (T / 2); _Pragma("unroll") for (int j = 0; j < 4; ++j) { \
        YA_[r][j] = ((const GAS v2u*)(YA + (size_t)(2 * m_) * D) + lane)[64 * j]; YB_[r][j] = ((const GAS v2u*)(YA + (size_t)(2 * m_ + 1) * D) + lane)[64 * j]; XB_[r][j] = ((const GAS v2u*)(X1 + (size_t)m_ * D) + lane)[64 * j]; } } } while (0)
#define P10_ROWS(YA_, YB_, XB_, m0_) do { _Pragma("unroll") for (int r = 0; r < 2; ++r) { const int m = (m0_) + r * (T / 2); float y[4][4]; float s = 0.f; \
        _Pragma("unroll") for (int j = 0; j < 4; ++j) { const v2u a = YA_[r][j], c = YB_[r][j]; \
            y[j][0] = bf2f(a.x & 0xffffu) + bf2f(c.x & 0xffffu); y[j][1] = bf2f(a.x >> 16) + bf2f(c.x >> 16); y[j][2] = bf2f(a.y & 0xffffu) + bf2f(c.y & 0xffffu); y[j][3] = bf2f(a.y >> 16) + bf2f(c.y >> 16); \
            _Pragma("unroll") for (int i = 0; i < 4; ++i) s += y[j][i] * y[j][i]; } \
        const float rs = rsqrtf(wave_sum(s) * (1.f / D) + EPS); \
        _Pragma("unroll") for (int j = 0; j < 4; ++j) { const int c0 = r * D + 4 * lane + 256 * j; const f32x4 cg = *(const LAS f32x4*)(CG + c0); const v2u xq = XB_[r][j]; \
            f32x4 xv = {bf2f(xq.x & 0xffffu), bf2f(xq.x >> 16), bf2f(xq.y & 0xffffu), bf2f(xq.y >> 16)}; \
            xv.x += cg.x * (y[j][0] * rs); xv.y += cg.y * (y[j][1] * rs); xv.z += cg.z * (y[j][2] * rs); xv.w += cg.w * (y[j][3] * rs); \
            ((GAS f32x4*)(F.out + (size_t)m * D) + lane)[64 * j] = xv; } } } while (0)
    { const int lane = F.lane; if (gw < T / 2) P10_LOAD(ya, yb, xb, gw); }
    for (int m0 = gw; m0 < T / 2; m0 += 2 * NGW) {
        int lane = F.lane; asm volatile("" : "+v"(lane));
        const bool has2 = m0 + NGW < T / 2, has3 = m0 + 2 * NGW < T / 2;
        if (has2) P10_LOAD(ya2, yb2, xb2, m0 + NGW);
        P10_ROWS(ya, yb, xb, m0);
        if (has3) P10_LOAD(ya, yb, xb, m0 + 2 * NGW);
        if (has2) P10_ROWS(ya2, yb2, xb2, m0 + NGW);
    }
#undef P10_LOAD
#undef P10_ROWS
}

__global__ void __launch_bounds__(NTHR, 2) skel_fwd(Args args) {
    extern __shared__ __attribute__((aligned(16))) unsigned char lds[];
    Frame F;
    F.lds = (LAS unsigned char*)lds; F.MISC = (volatile LAS unsigned*)(F.lds + X_MISC);
    F.tid = threadIdx.x; F.lane = F.tid & 63; F.wave = __builtin_amdgcn_readfirstlane(F.tid >> 6);
    F.G = gridDim.x; { const int bx = blockIdx.x; F.vcu = (F.G % 8 == 0) ? (bx % 8) * (F.G / 8) + bx / 8 : bx; }
    F.in = args.in; F.out = args.out; F.ws = args.ws; F.dsb = (unsigned char*)args.out; F.ctl = (gu32*)(args.ws + WS_CTL);
    if (F.tid < 32) F.MISC[F.tid] = 0u;
    __syncthreads();
    const XcdBarrier bar = xcd_barrier_post((unsigned*)(F.ctl + CW_BAR), F.MISC + 8);

    const int lo = args.ph_lo, hi = args.ph_hi;
#define IN(k) (lo <= (k) && (k) < hi)
    if (IN(0)) ph0_prologue(F);
    xcd_barrier(bar);
    if (IN(2)) {
        pg8::Gemm g{(const bf16*)(F.ws + WS_H), (const bf16*)(F.ws + WS_WIN), D}; pg8::StaticOrder S; S.init(T, DIN, D, F.G, (int)blockIdx.x);
        pg8::EpiProj E{(bf16*)(F.ws + WS_PROJ), (const float*)(F.ws + WS_LB)};
        pg8::gemm_phase<pg8::EpiProj, pg8::StaticOrder, false>(F.lds, g, S, E, nullptr);
    }
    xcd_barrier(bar);
    if (IN(3)) ph3_passA(F);
    xcd_barrier(bar);
    if (IN(4)) ph4_passB(F);
    xcd_barrier(bar);
    if (IN(5)) ph5_passC(F);
    xcd_barrier(bar);
    if (IN(6)) {
        pg8::Gemm g{(const bf16*)(F.ws + WS_H), (const bf16*)(F.ws + WS_WOUT), D}; pg8::StaticOrder S; S.init(T, D, D, F.G, (int)blockIdx.x);
        pg8::EpiMixB E{(bf16*)(F.ws + WS_MIX), D};
        pg8::gemm_phase<pg8::EpiMixB, pg8::StaticOrder, false>(F.lds, g, S, E, nullptr);
    }
    xcd_barrier(bar);
    if (IN(7)) ph7_rows(F);
    xcd_barrier(bar);
    if (IN(8)) {
        const int nmb = moe_tables(F);
        unsigned* mbc = (unsigned*)(F.ctl + CW_MB);
        pg8::MoeOrder Sup{4 * nmb, F.G, (int)blockIdx.x, D, (const LAS int*)(F.lds + X_MBE), (size_t)D * D * 2, 1, 0, mbc};
        pg8::MoeOrder Sdn{4 * nmb, F.G, (int)blockIdx.x, DE, (const LAS int*)(F.lds + X_MBE), (size_t)D * DE * 2, 1, 1, nullptr};
        moe_fill_tabs(F, Sup, Sdn);
        { pg8::Gemm g{(const bf16*)(F.ws + WS_H), (const bf16*)(F.ws + WS_W13), D}; pg8::EpiAct E{(bf16*)(F.ws + WS_ACT)};
          pg8::gemm_phase<pg8::EpiAct, pg8::MoeOrder, true>(F.lds, g, Sup, E, (const LAS unsigned*)(F.lds + X_GTAB)); }
        {
          if (F.tid < 64) { pg8::Unit u; const bool mine = F.tid < 4 && Sdn.next(F.tid, u) && u.slot == F.tid; unsigned sp = 0;
              while (__any(mine && __hip_atomic_load(F.ctl + CW_MB + 64 * u.pm, RLX_AGENT) < 32u)) { __builtin_amdgcn_s_sleep(2); if (++sp > (1u << 22)) break; }
              __builtin_amdgcn_fence(__ATOMIC_ACQUIRE, "agent"); VM_WAIT(); }
          __syncthreads();
          pg8::Gemm g{(const bf16*)(F.ws + WS_ACT), (const bf16*)(F.ws + WS_W2), DE}; pg8::EpiYa E{(bf16*)(F.ws + WS_YA), (const float*)(F.ws + WS_WGT), (const LAS int*)(F.lds + X_GTAB + 4096)};
          pg8::gemm_phase<pg8::EpiYa, pg8::MoeOrder, false>(F.lds, g, Sdn, E, nullptr); }
    }
    xcd_barrier(bar);
    if (IN(10)) ph10_final(F);
#undef IN
}

extern "C" void kernel_launch(void* const* d_in, const int* in_sizes, int n_in, void* d_out, int out_size, void* d_ws, size_t ws_size, hipStream_t stream) {
    static int grid = 0;
    if (grid == 0) {
        if (n_in != 27 || out_size != T * D || ws_size < WS_END) { fprintf(stderr, "kernel_launch: unexpected n_in %d / out %d / ws %zu\n", n_in, out_size, ws_size); grid = -1; return; }
        int dev = 0, cus = 0, per_cu = 0;
        if (hipGetDevice(&dev) != hipSuccess || hipDeviceGetAttribute(&cus, hipDeviceAttributeMultiprocessorCount, dev) != hipSuccess) { grid = -1; return; }
        if (hipFuncSetAttribute((const void*)skel_fwd, hipFuncAttributeMaxDynamicSharedMemorySize, LDS_BYTES) != hipSuccess) { fprintf(stderr, "kernel_launch: hipFuncSetAttribute failed\n"); grid = -1; return; }
        if (hipOccupancyMaxActiveBlocksPerMultiprocessor(&per_cu, (const void*)skel_fwd, NTHR, LDS_BYTES) != hipSuccess || per_cu < 1) { fprintf(stderr, "kernel_launch: the occupancy query reports %d workgroups per CU; nothing launched\n", per_cu); (void)hipGetLastError(); grid = -1; return; }
        (void)hipGetLastError();
        if (cus * per_cu < 256) { fprintf(stderr, "kernel_launch: needs 256 co-resident workgroups (one per 64-token chunk), device admits %d\n", cus * per_cu); grid = -1; return; }
        grid = 256;
    }
    if (grid < 0) return;
    (void)hipMemsetAsync((char*)d_ws + WS_CTL, 0, CTL_ZERO_BYTES, stream);
    Args a{};
    for (int i = 0; i < 27; ++i) a.in[i] = (const float*)d_in[i];
    a.out = (float*)d_out; a.ws = (unsigned char*)d_ws; a.ph_lo = 0; a.ph_hi = 11;
    hipLaunchKernelGGL(skel_fwd, dim3(grid), dim3(NTHR), LDS_BYTES, stream, a);
}
```

```cpp
#include <hip/hip_runtime.h>
#include <cstdio>
#include <cstdint>

constexpr int BATCH = 2, SEQ = 8192, D = 1024, T = BATCH * SEQ;
constexpr int DH = 512, HD = 128, NH = 4, CHK = 64, NCH = SEQ / CHK;
constexpr int DR = 512, RBD = 64;
constexpr int DIN = 3072;
constexpr int NG = 4, EPG = 8, NE = 32, DE = 512;
constexpr int MAXMB = 160;
constexpr float EPS = 1e-6f;
constexpr int NWAVES = 8, NTHR = 512;

#define GAS __attribute__((address_space(1)))
#define LAS __attribute__((address_space(3)))
typedef unsigned short bf16;
typedef unsigned v4u __attribute__((ext_vector_type(4)));
typedef unsigned v2u __attribute__((ext_vector_type(2)));
typedef float f32x4 __attribute__((ext_vector_type(4)));
typedef short bf16x8 __attribute__((ext_vector_type(8)));
typedef GAS unsigned gu32;
#define RLX_AGENT __ATOMIC_RELAXED, __HIP_MEMORY_SCOPE_AGENT
#define LDS_WAIT() asm volatile("s_waitcnt lgkmcnt(0)" ::: "memory")
#define VM_WAIT() asm volatile("s_waitcnt vmcnt(0)" ::: "memory")
#define LDS_BAR() do { asm volatile("s_waitcnt lgkmcnt(0)" ::: "memory"); __builtin_amdgcn_s_barrier(); asm volatile("" ::: "memory"); } while (0)

__device__ __forceinline__ unsigned f2bf(float f) { unsigned u = __builtin_bit_cast(unsigned, f); return (u + 0x7fffu + ((u >> 16) & 1u)) >> 16; }
__device__ __forceinline__ float bf2f(unsigned h) { return __builtin_bit_cast(float, h << 16); }
typedef float f32x2_t __attribute__((ext_vector_type(2))); typedef __bf16 bf16x2_t __attribute__((ext_vector_type(2)));
__device__ __forceinline__ unsigned pk2m(float lo, float hi) { f32x2_t v = {lo, hi}; bf16x2_t b = __builtin_convertvector(v, bf16x2_t); return __builtin_bit_cast(unsigned, b); }
__device__ __forceinline__ unsigned pk2(float lo, float hi) { unsigned r; asm volatile("v_cvt_pk_bf16_f32 %0, %1, %2" : "=v"(r) : "v"(lo), "v"(hi)); return r; }
__device__ __forceinline__ float frcp(float v) { return __builtin_amdgcn_rcpf(v); }
__device__ __forceinline__ float sigmoidf_(float v) { return frcp(1.f + __expf(-v)); }
__device__ __forceinline__ float siluf_(float v) { return v * frcp(1.f + __expf(-v)); }
__device__ __forceinline__ float gelu_tanh_(float v) { const float u = 1.5957691216057308f * (v + 0.044715f * v * v * v); return v * frcp(1.f + __expf(-u)); }
template <int CTRL> __device__ __forceinline__ float dpp_f(float x) { return __builtin_bit_cast(float, __builtin_amdgcn_update_dpp(0, __builtin_bit_cast(int, x), CTRL, 0xF, 0xF, false)); }
__device__ __forceinline__ float row_sum16(float x) {
    x += dpp_f<0x121>(x); x += dpp_f<0x122>(x); x += dpp_f<0x124>(x); x += dpp_f<0x128>(x); return x; }
__device__ __forceinline__ float wave_sum(float v) {
    v = row_sum16(v);
    const int vi = __builtin_bit_cast(int, v);
    return (__builtin_bit_cast(float, __builtin_amdgcn_readlane(vi, 0)) + __builtin_bit_cast(float, __builtin_amdgcn_readlane(vi, 16))) + (__builtin_bit_cast(float, __builtin_amdgcn_readlane(vi, 32)) + __builtin_bit_cast(float, __builtin_amdgcn_readlane(vi, 48)));
}

__device__ __forceinline__ float partner_row16(float x, bool odd_row) { float a = x, b = x; asm volatile("s_nop 1\n\tv_permlane16_swap_b32 %0, %1" : "+v"(a), "+v"(b)); return odd_row ? a : b; }
__device__ __forceinline__ float partner_half32(float x, bool upper) { float a = x, b = x; asm volatile("s_nop 1\n\tv_permlane32_swap_b32 %0, %1" : "+v"(a), "+v"(b)); return upper ? a : b; }

constexpr size_t MiB = 1u << 20, KiB = 1u << 10;
constexpr size_t WS_CTL = 0, CTL_ZERO_BYTES = 160 * KiB;
constexpr size_t WS_MOD = 1 * MiB;
constexpr size_t WS_LB = WS_MOD + 64 * KiB;
constexpr size_t WS_WRT = WS_MOD + 128 * KiB;
constexpr size_t WS_WIT = WS_WRT + 64 * KiB;
constexpr size_t WS_RRH = WS_WIT + 64 * KiB;
constexpr size_t WS_RRL = WS_RRH + 96 * KiB;
constexpr size_t WS_RGA = 2 * MiB;
constexpr size_t WS_RGH = WS_RGA + 512 * KiB;
constexpr size_t WS_CARRY = WS_RGH + 512 * KiB;
constexpr size_t WS_DD = WS_CARRY + 512 * KiB;
constexpr size_t WS_WGT = 4 * MiB;
constexpr size_t WS_LIST = 5 * MiB;
constexpr size_t WS_WIN = 10 * MiB;
constexpr size_t WS_WOUT = 16 * MiB;
constexpr size_t WS_W13 = 18 * MiB;
constexpr size_t WS_W2 = 82 * MiB;
constexpr size_t WS_H = 114 * MiB;
constexpr size_t WS_PROJ = 146 * MiB;
constexpr size_t WS_MIX = WS_PROJ;
constexpr size_t WS_YA = WS_PROJ;
constexpr size_t WS_ACT = WS_PROJ + 64 * MiB;
constexpr size_t WS_X1B = 258 * MiB;
constexpr size_t WS_END = 290 * MiB;
constexpr size_t PROJ_S = (size_t)T * DH;
constexpr int CW_CNT = 32768;
constexpr int CW_MODCNT = 128;
constexpr int CW_BAR = 4096;
constexpr int CW_MB = 16384;

constexpr int RING_BYTES = 131072;
constexpr int RTAB_BYTES = 1024 * 36 * 4;
constexpr int X_OFF = RTAB_BYTES;
constexpr int X_GTAB = X_OFF;
constexpr int X_MBE = X_OFF + 8192;
constexpr int X_MISC = X_OFF + 10240;
constexpr int LDS_BYTES = X_OFF + 12288;

namespace pg8 {
constexpr int BM = 256, BK = 64, HALF = 128, HTB = HALF * BK * 2, NXCD = 8, WGM = 8;
__host__ __device__ __forceinline__ int lds_byte(int r, int c) { const int st = (r >> 4) * 2 + (c >> 5), rr = r & 15, cc = c & 31, ob = rr * 64 + cc * 2; return st * 1024 + (ob ^ (((ob >> 9) & 1) << 5)); }
__host__ __device__ __forceinline__ void stage_rc(int b, int& R, int& C) { const int st = b / 1024, sb = b % 1024, swz = sb ^ (((sb >> 9) & 1) << 5); R = (st >> 1) * 16 + swz / 64; C = (st & 1) * 32 + (swz % 64) / 2; }
__host__ __device__ __forceinline__ int perm32(int rho) { const int n = rho >> 4, i = rho & 15; return 8 * (i >> 2) + 4 * n + (i & 3); }

struct Unit { int pm, pn, slot; };
struct Gemm { const bf16* A; const bf16* Bt; int K; };

struct StaticOrder {
    int nM, nN, nwg, G, c, K, rep;
    __device__ __forceinline__ void init(int M, int N, int K_, int G_, int c_, int rep_ = 1) { nM = M / BM; nN = N / BM; nwg = nM * nN; G = G_; c = c_; K = K_; rep = rep_; }
    __device__ __forceinline__ bool next(int i, Unit& u) const {
        long L = (long)i * G + c; if (L >= (long)nwg * rep) return false; L %= nwg;
        int wgid = (int)L; { const int q = nwg / NXCD, r = nwg % NXCD, xcd = wgid % NXCD, off = wgid / NXCD; wgid = (xcd < r ? xcd * (q + 1) : r * (q + 1) + (xcd - r) * q) + off; }
        const int nig = WGM * nN, gid = wgid / nig, fm = gid * WGM, gsz = (nM - fm) < WGM ? (nM - fm) : WGM;
        u.pm = fm + ((wgid % nig) % gsz); u.pn = (wgid % nig) / gsz; u.slot = i; return true;
    }
    __device__ __forceinline__ size_t aoff(const Unit& u) const { return (size_t)u.pm * BM * K * 2; }
    __device__ __forceinline__ size_t boff(const Unit& u) const { return (size_t)u.pn * BM * K * 2; }
    __device__ __forceinline__ void done(const Unit&) const {}
};
struct MoeOrder {
    int nunits, G, c, K; const LAS int* mbe; size_t estride; int rep;
    int rev; unsigned* done_cnt;
    __device__ __forceinline__ bool next(int i, Unit& u) const {
        const int x = c & 7, ci = c >> 3; const int lo = (int)(((long)nunits * x) >> 3), hi = (int)(((long)nunits * (x + 1)) >> 3);
        int mine; long L0; int stride;
        if (!rev) { mine = (hi - lo - ci + 31) >> 5; L0 = lo + ci; stride = 32; }
        else {
            const int U = hi - lo, base = U >> 5, rem = U & 31, Tc = (3 * U + 31) >> 5;
            int dhi = Tc - 2 * (base + 1); dhi = dhi > 0 ? dhi : 0; int dlo = Tc - 2 * base; dlo = dlo > 0 ? dlo : 0;
            int tailn = rem * dhi; tailn = tailn < U ? tailn : U; const int headn = U - tailn;
            int s0, s1;
            if (ci < rem) { s1 = U - ci * dhi; s0 = s1 - dhi; s0 = s0 > headn ? s0 : headn; s1 = s1 > headn ? s1 : headn; }
            else { s0 = (ci - rem) * dlo; s1 = s0 + dlo; s0 = s0 < headn ? s0 : headn; s1 = s1 < headn ? s1 : headn; }
            mine = s1 - s0; L0 = lo + s0; stride = 1; }
        if (mine <= 0 || i >= mine * rep) return false;
        const int ii = i % mine; const long L = L0 + (long)stride * ii;
        u.pm = (int)(L >> 2); u.pn = (int)(L & 3); u.slot = ii; return true;
    }
    __device__ __forceinline__ size_t aoff(const Unit& u) const { return (size_t)u.pm * BM * K * 2; }
    __device__ __forceinline__ size_t boff(const Unit& u) const { return (size_t)mbe[u.pm] * estride + (size_t)u.pn * BM * K * 2; }
    __device__ __forceinline__ void done(const Unit& u) const {
        if (done_cnt) { asm volatile("s_waitcnt vmcnt(0)" ::: "memory"); if ((threadIdx.x & 63) == 0) __hip_atomic_fetch_add(done_cnt + 64 * u.pm, 1u, __ATOMIC_RELAXED, __HIP_MEMORY_SCOPE_AGENT); }
    }
};

struct EpiProj {
    static constexpr bool PERM = true;
    bf16* base; const float* lb;
    __device__ __forceinline__ void operator()(const f32x4 (&acc)[2][2][4][2], const Unit& u, int wr, int wc, int fr, int fq) const {
        const int grp = u.pn >> 1, c0 = (u.pn & 1) * 256 + wc * 32 + 8 * fq, row0 = u.pm * BM + wr * 64 + fr;
        bf16* ob = base + (grp == 0 ? 0 : grp == 1 ? PROJ_S : (size_t)(grp + 1) * PROJ_S);
        float lbv[2][8];
        if (grp == 1) {
#pragma unroll
            for (int bj = 0; bj < 2; ++bj) { const f32x4 a = *(const f32x4*)(lb + c0 + bj * HALF), b = *(const f32x4*)(lb + c0 + bj * HALF + 4);
                lbv[bj][0] = a[0]; lbv[bj][1] = a[1]; lbv[bj][2] = a[2]; lbv[bj][3] = a[3]; lbv[bj][4] = b[0]; lbv[bj][5] = b[1]; lbv[bj][6] = b[2]; lbv[bj][7] = b[3]; }
        }
#pragma unroll
        for (int ai = 0; ai < 2; ++ai)
#pragma unroll
            for (int m = 0; m < 4; ++m) { bf16* rowp = ob + (size_t)(row0 + ai * HALF + m * 16) * DH + c0;
#pragma unroll
                for (int bj = 0; bj < 2; ++bj) {
                    float v[8];
#pragma unroll
                    for (int j = 0; j < 4; ++j) { v[j] = acc[ai][bj][m][0][j]; v[4 + j] = acc[ai][bj][m][1][j]; }
                    if (grp == 1) {
                        float kv[8];
#pragma unroll
                        for (int j = 0; j < 8; ++j) { const float l = lbv[bj][j], sg = sigmoidf_(v[j]); kv[j] = (1.f - l) * (1.f - sg); v[j] = __logf(l + (1.f - l) * sg); }
                        v4u w; w.x = pk2(kv[0], kv[1]); w.y = pk2(kv[2], kv[3]); w.z = pk2(kv[4], kv[5]); w.w = pk2(kv[6], kv[7]);
                        *(v4u*)(rowp + PROJ_S + bj * HALF) = w;
                    } else if (grp == 0 || grp == 3) {
#pragma unroll
                        for (int j = 0; j < 8; ++j) v[j] = siluf_(v[j]);
                    } else if (grp == 5) {
#pragma unroll
                        for (int j = 0; j < 8; ++j) v[j] = gelu_tanh_(v[j]);
                    }
                    v4u w; w.x = pk2m(v[0], v[1]); w.y = pk2m(v[2], v[3]); w.z = pk2m(v[4], v[5]); w.w = pk2m(v[6], v[7]);
                    *(v4u*)(rowp + bj * HALF) = w;
                } }
    }
};
struct EpiF32 {
    static constexpr bool PERM = false;
    float* C; int ldc;
    __device__ __forceinline__ void operator()(const f32x4 (&acc)[2][2][4][2], const Unit& u, int wr, int wc, int fr, int fq) const {
        const int row0 = u.pm * BM + wr * 64 + fr, col0 = u.pn * BM + wc * 32 + 4 * fq;
#pragma unroll
        for (int ai = 0; ai < 2; ++ai)
#pragma unroll
            for (int m = 0; m < 4; ++m) { float* rowp = C + (size_t)(row0 + ai * HALF + m * 16) * ldc + col0;
#pragma unroll
                for (int bj = 0; bj < 2; ++bj)
#pragma unroll
                    for (int n = 0; n < 2; ++n) *(f32x4*)(rowp + bj * HALF + n * 16) = acc[ai][bj][m][n]; }
    }
};
struct EpiMixB {
    static constexpr bool PERM = true;
    bf16* C; int ldc;
    __device__ __forceinline__ void operator()(const f32x4 (&acc)[2][2][4][2], const Unit& u, int wr, int wc, int fr, int fq) const {
        const int row0 = u.pm * BM + wr * 64 + fr, col0 = u.pn * BM + wc * 32 + 8 * fq;
#pragma unroll
        for (int ai = 0; ai < 2; ++ai)
#pragma unroll
            for (int m = 0; m < 4; ++m) { bf16* rowp = C + (size_t)(row0 + ai * HALF + m * 16) * ldc + col0;
#pragma unroll
                for (int bj = 0; bj < 2; ++bj) { const f32x4 a = acc[ai][bj][m][0], b = acc[ai][bj][m][1];
                    v4u w; w.x = pk2m(a[0], a[1]); w.y = pk2m(a[2], a[3]); w.z = pk2m(b[0], b[1]); w.w = pk2m(b[2], b[3]);
                    *(v4u*)(rowp + bj * HALF) = w; } }
    }
};
struct EpiAct {
    static constexpr bool PERM = true;
    bf16* act;
    __device__ __forceinline__ void operator()(const f32x4 (&acc)[2][2][4][2], const Unit& u, int wr, int wc, int fr, int fq) const {
        const int row0 = u.pm * BM + wr * 64 + fr, col0 = u.pn * HALF + wc * 32 + 8 * fq;
#pragma unroll
        for (int ai = 0; ai < 2; ++ai)
#pragma unroll
            for (int m = 0; m < 4; ++m) {
                float v[8];
#pragma unroll
                for (int j = 0; j < 4; ++j) { v[j] = siluf_(acc[ai][0][m][0][j]) * acc[ai][1][m][0][j]; v[4 + j] = siluf_(acc[ai][0][m][1][j]) * acc[ai][1][m][1][j]; }
                v4u w; w.x = pk2(v[0], v[1]); w.y = pk2(v[2], v[3]); w.z = pk2(v[4], v[5]); w.w = pk2(v[6], v[7]);
                bf16* dst = act + (size_t)(row0 + ai * HALF + m * 16) * DE + col0;
                asm volatile("global_store_dwordx4 %0, %1, off sc1\n\ts_nop 1" :: "v"(dst), "v"(w) : "memory"); }
    }
};
struct EpiYa {
    static constexpr bool PERM = true;
    bf16* ya; const float* wgt; const LAS int* tab;
    __device__ __forceinline__ void operator()(const f32x4 (&acc)[2][2][4][2], const Unit& u, int wr, int wc, int fr, int fq) const {
        const int col0 = u.pn * BM + wc * 32 + 8 * fq;
#pragma unroll
        for (int ai = 0; ai < 2; ++ai)
#pragma unroll
            for (int m = 0; m < 4; ++m) { const int aid = tab[u.slot * 256 + ai * HALF + wr * 64 + m * 16 + fr];
                if (aid >= 0) { const float w8 = wgt[aid]; bf16* rowp = ya + (size_t)aid * D + col0;
#pragma unroll
                    for (int bj = 0; bj < 2; ++bj) { const f32x4 a = acc[ai][bj][m][0] * w8, b = acc[ai][bj][m][1] * w8;
                        v4u w; w.x = pk2(a[0], a[1]); w.y = pk2(a[2], a[3]); w.z = pk2(b[0], b[1]); w.w = pk2(b[2], b[3]);
                        *(v4u*)(rowp + bj * HALF) = w; } } }
    }
};

template <class Epi, class Sched, bool GATHER, bool ALIGN_EPI = true>
__device__ __forceinline__ void gemm_phase(LAS unsigned char* lds, const Gemm g, const Sched& S, const Epi& E, const LAS unsigned* gtab) {
    const int tid = threadIdx.x, wid = __builtin_amdgcn_readfirstlane(tid >> 6), lane = tid & 63, wr = wid >> 2, wc = wid & 3, fr = lane & 15, fq = lane >> 4;
    const int K = g.K, nt = K / BK;
    unsigned voffA[2], voffB[2]; int rowA[2];
#pragma unroll
    for (int i = 0; i < 2; ++i) { int R, C; stage_rc(tid * 16 + i * 8192, R, C); const int Rb = Epi::PERM ? ((R & ~31) + perm32(R & 31)) : R;
        voffA[i] = GATHER ? (unsigned)(C * 2) : (unsigned)(R * K + C) * 2u; voffB[i] = (unsigned)(Rb * K + C) * 2u; rowA[i] = R; }
    const size_t kstep = (size_t)(BK * 2);
    const size_t hstep = (size_t)HALF * K * 2;
    const unsigned ldsw = (unsigned)wid * 1024u;
    const int aoff = lds_byte(wr * 64 + fr, fq * 8), boff = lds_byte(wc * 32 + fr, fq * 8);
#define PG8_SA(b, h) (((b) * 2 + (h)) * HTB)
#define PG8_SB(b, h) ((4 + (b) * 2 + (h)) * HTB)
#define PG8_STAGE(bufoff, gbase, voff) do { _Pragma("unroll") for (int _i = 0; _i < 2; ++_i) \
        __builtin_amdgcn_global_load_lds((const unsigned*)((const char*)(gbase) + (voff)[_i]), (LAS unsigned*)(lds + (bufoff) + ldsw + _i * 8192), 16, 0, 0); } while (0)
#define PG8_STAGE_A(bufoff, gbase, slot, h) do { if constexpr (GATHER) { _Pragma("unroll") for (int _i = 0; _i < 2; ++_i) { const unsigned _ro = gtab[(slot) * 256 + (h) * HALF + rowA[_i]]; \
        __builtin_amdgcn_global_load_lds((const unsigned*)((const char*)(gbase) + _ro + voffA[_i]), (LAS unsigned*)(lds + (bufoff) + ldsw + _i * 8192), 16, 0, 0); } } \
        else { PG8_STAGE(bufoff, (const char*)(gbase) + (h) * hstep, voffA); } } while (0)
#define PG8_LDA(dst, b, h) do { _Pragma("unroll") for (int m = 0; m < 4; ++m) _Pragma("unroll") for (int k = 0; k < 2; ++k) dst[m][k] = *(const LAS bf16x8*)(lds + PG8_SA(b, h) + aoff + m * 2048 + k * 1024); } while (0)
#define PG8_LDB(dst, b, h) do { _Pragma("unroll") for (int n = 0; n < 2; ++n) _Pragma("unroll") for (int k = 0; k < 2; ++k) dst[n][k] = *(const LAS bf16x8*)(lds + PG8_SB(b, h) + boff + n * 2048 + k * 1024); } while (0)
#define PG8_MMA(ai, bj, At, Bt) do { __builtin_amdgcn_s_setprio(1); _Pragma("unroll") for (int m = 0; m < 4; ++m) _Pragma("unroll") for (int n = 0; n < 2; ++n) _Pragma("unroll") for (int k = 0; k < 2; ++k) \
        acc[ai][bj][m][n] = __builtin_amdgcn_mfma_f32_16x16x32_bf16(Bt[n][k], At[m][k], acc[ai][bj][m][n], 0, 0, 0); __builtin_amdgcn_s_setprio(0); } while (0)
#define PG8_WAIT_V(n) asm volatile("s_waitcnt vmcnt(" #n ")" ::: "memory")
#define PG8_WAIT_L(n) asm volatile("s_waitcnt lgkmcnt(" #n ")" ::: "memory")
#define PG8_BAR __builtin_amdgcn_s_barrier()
#define PG8_SCHED __builtin_amdgcn_sched_barrier(0)
    Unit cur, nxt; int ui = 0;
    if (!S.next(0, cur)) return;
    f32x4 acc[2][2][4][2];
#pragma unroll
    for (int a = 0; a < 2; ++a)
#pragma unroll
        for (int b = 0; b < 2; ++b)
#pragma unroll
            for (int m = 0; m < 4; ++m)
#pragma unroll
                for (int n = 0; n < 2; ++n) acc[a][b][m][n] = (f32x4){0.f, 0.f, 0.f, 0.f};
    bf16x8 At[4][2], B0[2][2], B1[2][2];
    const char* cA = (const char*)g.A + (GATHER ? (size_t)0 : S.aoff(cur)); const char* cB = (const char*)g.Bt + S.boff(cur);
    PG8_STAGE(PG8_SB(0, 0), cB, voffB); PG8_STAGE(PG8_SB(0, 1), cB + hstep, voffB); PG8_STAGE_A(PG8_SA(0, 0), cA, 0, 0); PG8_STAGE_A(PG8_SA(0, 1), cA, 0, 1);
    if (wr == 1) PG8_BAR;
    PG8_WAIT_V(2); PG8_BAR;
    PG8_STAGE(PG8_SB(1, 0), cB + kstep, voffB); PG8_STAGE_A(PG8_SA(1, 0), cA + kstep, 0, 0); PG8_STAGE(PG8_SB(1, 1), cB + hstep + kstep, voffB);
    PG8_WAIT_V(6); PG8_BAR;
    for (;;) {
        const bool has_next = S.next(ui + 1, nxt);
        const char* nA = has_next ? (const char*)g.A + (GATHER ? (size_t)0 : S.aoff(nxt)) : cA; const char* nB = has_next ? (const char*)g.Bt + S.boff(nxt) : cB;
        const int nslot = has_next ? nxt.slot : cur.slot, cslot = cur.slot;
        for (int t = 0; t < nt; t += 2) {
            const bool last = (t == nt - 2);
            const char* a1 = cA + (size_t)(t + 1) * kstep;
            const char* a2 = last ? nA : cA + (size_t)(t + 2) * kstep; const char* b2 = last ? nB : cB + (size_t)(t + 2) * kstep;
            const char* a3 = a2 + kstep; const char* b3 = b2 + kstep;
            const int s2 = last ? nslot : cslot;
            PG8_LDB(B0, 0, 0); PG8_LDB(B1, 0, 1); PG8_SCHED; PG8_LDA(At, 0, 0); PG8_STAGE_A(PG8_SA(1, 1), a1, cslot, 1);
            PG8_WAIT_V(8); PG8_WAIT_L(0); PG8_BAR; PG8_MMA(0, 0, At, B0); PG8_MMA(0, 1, At, B1); PG8_BAR; PG8_SCHED;
            PG8_LDA(At, 0, 1); PG8_STAGE(PG8_SB(0, 0), b2, voffB); PG8_STAGE(PG8_SB(0, 1), b2 + hstep, voffB); PG8_STAGE_A(PG8_SA(0, 0), a2, s2, 0);
            PG8_WAIT_V(8); PG8_WAIT_L(0); PG8_BAR; PG8_MMA(1, 0, At, B0); PG8_MMA(1, 1, At, B1); PG8_BAR; PG8_SCHED;
            PG8_LDB(B0, 1, 0); PG8_LDB(B1, 1, 1); PG8_SCHED; PG8_LDA(At, 1, 0); PG8_STAGE_A(PG8_SA(0, 1), a2, s2, 1);
            PG8_WAIT_V(8); PG8_WAIT_L(0); PG8_BAR; PG8_MMA(0, 0, At, B0); PG8_MMA(0, 1, At, B1); PG8_BAR; PG8_SCHED;
            PG8_LDA(At, 1, 1); PG8_STAGE(PG8_SB(1, 0), b3, voffB); PG8_STAGE(PG8_SB(1, 1), b3 + hstep, voffB); PG8_STAGE_A(PG8_SA(1, 0), a3, s2, 0);
            PG8_WAIT_V(8); PG8_WAIT_L(0); PG8_BAR; PG8_MMA(1, 0, At, B0); PG8_MMA(1, 1, At, B1); PG8_BAR; PG8_SCHED;
        }
        if constexpr (ALIGN_EPI) { if (wr == 0) PG8_BAR; }
        E(acc, cur, wr, wc, fr, fq); S.done(cur);
        if (!has_next) break;
#pragma unroll
        for (int a = 0; a < 2; ++a)
#pragma unroll
            for (int b = 0; b < 2; ++b)
#pragma unroll
                for (int m = 0; m < 4; ++m)
#pragma unroll
                    for (int n = 0; n < 2; ++n) acc[a][b][m][n] = (f32x4){0.f, 0.f, 0.f, 0.f};
        cur = nxt; cA = nA; cB = nB; ++ui;
        if constexpr (ALIGN_EPI) { if (wr == 1) PG8_BAR; }
    }
    PG8_WAIT_V(0);
    if constexpr (!ALIGN_EPI) { if (wr == 0) PG8_BAR; }
    PG8_BAR;
#undef PG8_SA
#undef PG8_SB
#undef PG8_STAGE
#undef PG8_STAGE_A
#undef PG8_LDA
#undef PG8_LDB
#undef PG8_MMA
#undef PG8_WAIT_V
#undef PG8_WAIT_L
#undef PG8_BAR
#undef PG8_SCHED
}
}

#define XB_TMO      128
#define XB_XCNT(j)  (256  + 64 * (j))
#define XB_XSUB(j)  (1280 + 64 * (j))
#define XB_XGEN(j)  (2304 + 64 * (j))
#define XB_TOP      3328
#define XB_TOPGEN   3392
#define XCD_BAR_WORDS 3456
#define XB_SPIN_CAP (1u << 18)
__device__ __forceinline__ unsigned xb_ld(unsigned* p)              { return __hip_atomic_load(p, __ATOMIC_RELAXED, __HIP_MEMORY_SCOPE_AGENT); }
__device__ __forceinline__ unsigned xb_add(unsigned* p, unsigned v) { return __hip_atomic_fetch_add(p, v, __ATOMIC_RELAXED, __HIP_MEMORY_SCOPE_AGENT); }
__device__ __forceinline__ unsigned xb_xcc_id() { return (unsigned)__builtin_amdgcn_s_getreg((3 << 11) | 20) & 0xFu; }
#define XB_SPIN(cond, bar) do { unsigned _sp = 0; while (cond) { __builtin_amdgcn_s_sleep(1); \
    if ((++_sp & 255u) == 0u) { if (xb_ld(&(bar)[XB_TMO])) break; if (_sp > XB_SPIN_CAP) { atomicAdd(&(bar)[XB_TMO], 1u); break; } } } } while (0)
struct XcdBarrier { unsigned* bar; unsigned x; volatile LAS unsigned* st; };
__device__ __forceinline__ XcdBarrier xcd_barrier_post(unsigned* bar, volatile LAS unsigned* st) {
    XcdBarrier b; b.bar = bar; b.x = xb_xcc_id(); b.st = st;
    if (threadIdx.x == 0) (void)xb_add(&bar[XB_XCNT(b.x)], 1u);
    return b;
}
__device__ __forceinline__ void xcd_barrier_complete(unsigned* bar, unsigned x, unsigned& nloc, unsigned& nx) {
    const unsigned G = gridDim.x * gridDim.y * gridDim.z;
    unsigned sum, cnt, mine, sp = 0u;
    for (;;) {
        sum = 0u; cnt = 0u; mine = 0u;
#pragma unroll
        for (unsigned j = 0; j < 16; ++j) { const unsigned c = xb_ld(&bar[XB_XCNT(j)]); sum += c; cnt += (c > 0u) ? 1u : 0u; mine = (j == x) ? c : mine; }
        if (sum == G) break;
        __builtin_amdgcn_s_sleep(1);
        if ((++sp & 255u) == 0u) { if (xb_ld(&bar[XB_TMO])) break; if (sp > XB_SPIN_CAP) { atomicAdd(&bar[XB_TMO], 1u); break; } }
    }
    nloc = mine > 0u ? mine : 1u; nx = cnt > 0u ? cnt : 1u;
}
__device__ __forceinline__ void xcd_barrier(const XcdBarrier& b) {
    asm volatile("s_waitcnt vmcnt(0)" ::: "memory");
    __syncthreads();
    if (threadIdx.x == 0) {
        unsigned* bar = b.bar;
        __builtin_amdgcn_s_waitcnt(0);
        unsigned nloc = b.st[0], nx = b.st[1];
        if (nloc == 0u) { xcd_barrier_complete(bar, b.x, nloc, nx); b.st[0] = nloc; b.st[1] = nx; }
        const unsigned old = xb_add(&bar[XB_XSUB(b.x)], 1u);
        const unsigned gen = old / nloc;
        if (old + 1u == (gen + 1u) * nloc) {
            __builtin_amdgcn_fence(__ATOMIC_RELEASE, "agent");
            asm volatile("s_waitcnt vmcnt(0)" ::: "memory");
            const unsigned og = xb_add(&bar[XB_TOP], 1u);
            const unsigned tg = og / nx;
            if (og + 1u == (tg + 1u) * nx) xb_add(&bar[XB_TOPGEN], 1u);
            else XB_SPIN(xb_ld(&bar[XB_TOPGEN]) == tg, bar);
            __builtin_amdgcn_fence(__ATOMIC_ACQUIRE, "agent");
            xb_add(&bar[XB_XGEN(b.x)], 1u);
            asm volatile("s_waitcnt vmcnt(0)" ::: "memory");
        } else {
            XB_SPIN(xb_ld(&bar[XB_XGEN(b.x)]) == gen, bar);
            __builtin_amdgcn_fence(__ATOMIC_ACQUIRE, "agent");
            asm volatile("s_waitcnt vmcnt(0)" ::: "memory");
        }
    }
    __syncthreads();
}

struct Args { const float* in[27]; float* out; unsigned char* ws; int ph_lo, ph_hi; };
struct Frame {
    LAS unsigned char* lds; volatile LAS unsigned* MISC; gu32* ctl;
    int tid, lane, wave, vcu, G;
    const float* const* in; float* out; unsigned char* ws; unsigned char* dsb;
};

__device__ __forceinline__ void p0_transpose_item(const float* W, int N, bf16* WT, int ldt, int k0, int n0, int drow0, LAS unsigned* Tl, int lane, bool nt_store = false) {
    const int kq = lane >> 3, c4 = lane & 7;
    f32x4 a[4], b[4];
#pragma unroll
    for (int i = 0; i < 4; ++i) { const float* p = W + (size_t)(k0 + 16 * i + 2 * kq) * N + n0 + 4 * c4; a[i] = __builtin_nontemporal_load((const f32x4*)p); b[i] = __builtin_nontemporal_load((const f32x4*)(p + N));   }
#pragma unroll
    for (int i = 0; i < 4; ++i)
#pragma unroll
        for (int j = 0; j < 4; ++j) Tl[(4 * c4 + j) * 32 + ((8 * i + kq) ^ (4 * c4))] = pk2(a[i][j], b[i][j]);
    LDS_WAIT(); asm volatile("" ::: "memory");
#pragma unroll
    for (int jj = 0; jj < 4; ++jj) { const int n = (lane >> 3) + 8 * jj, c = lane & 7;
        const v4u o = *(const LAS v4u*)(Tl + n * 32 + 4 * (c ^ (n >> 2)));
        if (nt_store) __builtin_nontemporal_store(o, (GAS v4u*)(WT + (size_t)(drow0 + n) * ldt + k0 + 8 * c)); else *(GAS v4u*)(WT + (size_t)(drow0 + n) * ldt + k0 + 8 * c) = o; }
    LDS_WAIT(); asm volatile("" ::: "memory");
}
__device__ __forceinline__ void ph1_hrows(Frame& F);
__device__ __forceinline__ void ph0_prologue(Frame& F) {
    const float* c = F.in[1]; const float* wada = F.in[2]; const float* bada = F.in[3];
    float* mod = (float*)(F.ws + WS_MOD);
    LAS float* sc = (LAS float*)(F.lds);
    LAS float* red = (LAS float*)(F.lds + 8192);
    for (int i = F.tid; i < 2 * D; i += NTHR) sc[i] = siluf_(c[i]);
    __syncthreads();
    for (int slab = F.vcu; slab < 256; slab += F.G) {
        const int n0 = slab * 24;
        if (F.tid < 510) {
            const int kq = F.tid / 6, c4 = F.tid % 6; float a[2][4];
#pragma unroll
            for (int b = 0; b < 2; ++b)
#pragma unroll
                for (int j = 0; j < 4; ++j) a[b][j] = 0.f;
            for (int k = kq; k < D; k += 85) { const f32x4 w = __builtin_nontemporal_load((const f32x4*)(wada + (size_t)k * 6144 + n0 + 4 * c4)); const float s0 = sc[k], s1 = sc[D + k];
#pragma unroll
                for (int j = 0; j < 4; ++j) { a[0][j] += s0 * w[j]; a[1][j] += s1 * w[j]; } }
#pragma unroll
            for (int b = 0; b < 2; ++b)
#pragma unroll
                for (int j = 0; j < 4; ++j) red[(kq * 6 + c4) * 8 + b * 4 + j] = a[b][j];
        }
        __syncthreads();
        if (F.tid < 48) { const int b = F.tid / 24, col = F.tid % 24, c4 = col >> 2, j = col & 3; float s = 0.f;
            for (int kq = 0; kq < 85; ++kq) s += red[(kq * 6 + c4) * 8 + b * 4 + j];
            mod[b * 6144 + n0 + col] = s + bada[n0 + col]; }
        __syncthreads();
    }
    VM_WAIT(); __syncthreads();
    if (F.tid == 0) { __builtin_amdgcn_fence(__ATOMIC_RELEASE, "agent"); VM_WAIT(); __hip_atomic_fetch_add(F.ctl + CW_MODCNT, 1u, RLX_AGENT); }
    const int gt = F.vcu * NTHR + F.tid, NGT = F.G * NTHR;
    if (gt < DH) { const float* g = F.in[9]; ((float*)(F.ws + WS_LB))[gt] = 1.f / (1.f + __expf(g[DH + gt] - g[gt])); }
    for (int e = gt; e < 48 * D; e += NGT) { const int n = e >> 10, kk = e & 1023; const float wv = n < NG ? F.in[20][kk * NG + n] : n < NG + NE ? F.in[22][kk * NE + n - NG] : 0.f;
        const unsigned hi = f2bf(wv); ((bf16*)(F.ws + WS_RRH))[e] = (bf16)hi; ((bf16*)(F.ws + WS_RRL))[e] = (bf16)f2bf(wv - bf2f(hi)); }
    for (int e = gt; e < 2 * 8 * 64 * 64; e += NGT) { const int which = e >> 15, r = e & 32767, blk = r >> 12, j = (r >> 6) & 63, i = r & 63;
        const float* w = which ? F.in[15] : F.in[13]; ((bf16*)(F.ws + (which ? WS_WIT : WS_WRT)))[r] = (bf16)f2bf(w[(size_t)(blk * 64 + i) * 64 + j]); }
    LAS unsigned* scr = (LAS unsigned*)(F.lds + 32768 + F.wave * 4096);
    const int gw = F.vcu * NWAVES + F.wave, NGW = F.G * NWAVES;
    constexpr int I_IN = 16 * 96, I_OUT = 16 * 32, I_E = 256 + 256 + 256, NITEMS = I_IN + I_OUT + NE * I_E;
    for (int it = gw; it < NITEMS; it += NGW) {
        int r = it;
        if (r < I_IN) { const int kb = r / 96, nb = r % 96; p0_transpose_item(F.in[8], DIN, (bf16*)(F.ws + WS_WIN), D, 64 * kb, 32 * nb, 32 * nb, scr, F.lane); continue; } r -= I_IN;
        if (r < I_OUT) { const int kb = r / 32, nb = r % 32; p0_transpose_item(F.in[19], D, (bf16*)(F.ws + WS_WOUT), D, 64 * kb, 32 * nb, 32 * nb, scr, F.lane); continue; } r -= I_OUT;
        const int e = r / I_E; r -= e * I_E;
        if (r < 512) { const int w3 = r >> 8, q = r & 255, kb = q >> 4, nb = q & 15, n0 = 32 * nb;
            p0_transpose_item((w3 ? F.in[25] : F.in[24]) + (size_t)e * D * DE, DE, (bf16*)(F.ws + WS_W13) + (size_t)e * D * D, D, 64 * kb, n0, (n0 >> 7) * 256 + (n0 & 127) + 128 * w3, scr, F.lane, true); }
        else { const int q = r - 512, kb = q >> 5, nb = q & 31;
            p0_transpose_item(F.in[26] + (size_t)e * DE * D, D, (bf16*)(F.ws + WS_W2) + (size_t)e * D * DE, DE, 64 * kb, 32 * nb, 32 * nb, scr, F.lane, true); }
    }
    if (F.tid < 64) { unsigned sp = 0;
        while ((unsigned)__builtin_amdgcn_readfirstlane(__hip_atomic_load(F.ctl + CW_MODCNT, RLX_AGENT)) < (unsigned)F.G) { __builtin_amdgcn_s_sleep(2); if (++sp > (1u << 20)) break; }
        __builtin_amdgcn_fence(__ATOMIC_ACQUIRE, "agent"); VM_WAIT(); }
    __syncthreads();
    ph1_hrows(F);
}

__device__ __forceinline__ void ph1_hrows(Frame& F) {
    const float* x = F.in[0]; const float* g = F.in[4]; const float* mod = (const float*)(F.ws + WS_MOD); bf16* H = (bf16*)(F.ws + WS_H);
    LAS float* PA = (LAS float*)F.lds; LAS float* PB = PA + 2 * D;
    for (int i = F.tid; i < 2 * D; i += NTHR) { const int b = i >> 10, c = i & 1023; PA[i] = g[c] * (1.f + mod[b * 6144 + 1024 + c]); PB[i] = mod[b * 6144 + c]; }
    __syncthreads();
    const int gw = F.vcu * NWAVES + F.wave, NGW = F.G * NWAVES;
    f32x4 v[2][4], v2[2][4];
#define P1_LOAD(V_, m0_) do { _Pragma("unroll") for (int r = 0; r < 2; ++r) _Pragma("unroll") for (int j = 0; j < 4; ++j) V_[r][j] = __builtin_nontemporal_load(((const GAS f32x4*)(x + (size_t)((m0_) + r * (T / 2)) * D) + lane) + 64 * j); } while (0)
#define P1_ROWS(V_, m0_) do { _Pragma("unroll") for (int r = 0; r < 2; ++r) { const int m = (m0_) + r * (T / 2); float s = 0.f; \
        _Pragma("unroll") for (int j = 0; j < 4; ++j) s += V_[r][j].x * V_[r][j].x + V_[r][j].y * V_[r][j].y + V_[r][j].z * V_[r][j].z + V_[r][j].w * V_[r][j].w; \
        const float rstd = rsqrtf(wave_sum(s) * (1.f / D) + EPS); \
        GAS unsigned long long* o8 = (GAS unsigned long long*)(H + (size_t)m * D) + lane; \
        _Pragma("unroll") for (int j = 0; j < 4; ++j) { const int c0 = r * D + 4 * lane + 256 * j; const f32x4 pa = *(const LAS f32x4*)(PA + c0), pb = *(const LAS f32x4*)(PB + c0); \
            const float a0 = V_[r][j].x * rstd * pa.x + pb.x, a1 = V_[r][j].y * rstd * pa.y + pb.y, a2 = V_[r][j].z * rstd * pa.z + pb.z, a3 = V_[r][j].w * rstd * pa.w + pb.w; \
            o8[64 * j] = (unsigned long long)pk2(a0, a1) | ((unsigned long long)pk2(a2, a3) << 32); } } } while (0)
    { const int lane = F.lane; if (gw < T / 2) P1_LOAD(v, gw); }
    for (int m0 = gw; m0 < T / 2; m0 += 2 * NGW) {
        int lane = F.lane; asm volatile("" : "+v"(lane));
        const bool has2 = m0 + NGW < T / 2, has3 = m0 + 2 * NGW < T / 2;
        if (has2) P1_LOAD(v2, m0 + NGW);
        P1_ROWS(v, m0);
        if (has3) P1_LOAD(v, m0 + 2 * NGW);
        if (has2) P1_ROWS(v2, m0 + NGW);
    }
#undef P1_LOAD
#undef P1_ROWS
}

constexpr int L_GT = 0;
constexpr int L_QTL = 4096;
constexpr int L_QH = L_QTL + 17408;
constexpr int L_KH = L_QH + 17408;
constexpr int L_VT = L_KH + 17408;
constexpr int L_P = L_VT + 18432;
constexpr int L_SSQ = L_P + 9216;
constexpr int L_RSTD = L_SSQ + 2048;
constexpr int L_OT = L_RSTD + 256;
constexpr int L_KT = L_QTL;
static_assert(L_OT + 17408 <= RING_BYTES, "mixer LDS map");

struct HgLoad { unsigned lf[8], ki[8], vv[8], q[8]; };
template <bool NEEDQ>
__device__ __forceinline__ void hg_load(Frame& F, int t0, int h, HgLoad& L) {
    const bf16* PJ = (const bf16*)(F.ws + WS_PROJ); const size_t base = (size_t)(t0 + 8 * F.wave) * DH + h * HD + 2 * (F.tid & 63);
#pragma unroll
    for (int i = 0; i < 8; ++i) { const size_t o = base + (size_t)i * DH;
        if (NEEDQ) { L.lf[i] = __builtin_nontemporal_load((const unsigned*)(PJ + PROJ_S + o)); L.ki[i] = __builtin_nontemporal_load((const unsigned*)(PJ + 2 * PROJ_S + o)); L.vv[i] = __builtin_nontemporal_load((const unsigned*)(PJ + 3 * PROJ_S + o)); L.q[i] = __builtin_nontemporal_load((const unsigned*)(PJ + o)); }
        else { L.lf[i] = *(const unsigned*)(PJ + PROJ_S + o); L.ki[i] = *(const unsigned*)(PJ + 2 * PROJ_S + o); L.vv[i] = *(const unsigned*)(PJ + 3 * PROJ_S + o); } }
}
__device__ __forceinline__ void hg_cumsum(Frame& F, const HgLoad& L, float (&c0)[8], float (&c1)[8], float (&off)[2], float (&bmid)[2], float (&blast)[2]) {
    LAS float* GT = (LAS float*)(F.lds + L_GT); const int kp = F.tid & 63, w = F.wave;
    float r0 = 0.f, r1 = 0.f;
#pragma unroll
    for (int i = 0; i < 8; ++i) { r0 += bf2f(L.lf[i] & 0xffffu); r1 += bf2f(L.lf[i] >> 16); c0[i] = r0; c1[i] = r1; }
    *(LAS f32x2_t*)(GT + w * 128 + 2 * kp) = (f32x2_t){r0, r1};
    LDS_BAR();
    float a0 = 0.f, a1 = 0.f; off[0] = 0.f; off[1] = 0.f; bmid[0] = 0.f; bmid[1] = 0.f;
#pragma unroll
    for (int g = 0; g < 8; ++g) { const f32x2_t v = *(const LAS f32x2_t*)(GT + g * 128 + 2 * kp); if (g == w) { off[0] = a0; off[1] = a1; } a0 += v.x; a1 += v.y; if (g == 3) { bmid[0] = a0; bmid[1] = a1; } }
    blast[0] = a0; blast[1] = a1;
}
__device__ __forceinline__ void hg_store_vt(Frame& F, const HgLoad& L, LAS bf16* VT) {
    const int kp = F.tid & 63, w = F.wave; v4u lo, hi;
    lo.x = (L.vv[0] & 0xffffu) | (L.vv[1] << 16); lo.y = (L.vv[2] & 0xffffu) | (L.vv[3] << 16); lo.z = (L.vv[4] & 0xffffu) | (L.vv[5] << 16); lo.w = (L.vv[6] & 0xffffu) | (L.vv[7] << 16);
    hi.x = (L.vv[0] >> 16) | (L.vv[1] & 0xffff0000u); hi.y = (L.vv[2] >> 16) | (L.vv[3] & 0xffff0000u); hi.z = (L.vv[4] >> 16) | (L.vv[5] & 0xffff0000u); hi.w = (L.vv[6] >> 16) | (L.vv[7] & 0xffff0000u);
    *(LAS v4u*)(VT + (2 * kp) * 72 + 8 * w) = lo; *(LAS v4u*)(VT + (2 * kp + 1) * 72 + 8 * w) = hi;
}

template <bool FINAL>
__device__ __forceinline__ void rg_wave_task(Frame& F, int b, int n, int cb, unsigned (&valpk)[32]) {
    const int lane = F.lane, fr = lane & 15, fq = lane >> 4, c0 = 64 * cb; const int t0 = b * SEQ + 64 * n;
    const bf16* XR = (const bf16*)(F.ws + WS_PROJ) + 5 * PROJ_S; const bf16* YR = (const bf16*)(F.ws + WS_PROJ) + 6 * PROJ_S;
    const bf16* WRT = (const bf16*)(F.ws + WS_WRT); const bf16* WIT = (const bf16*)(F.ws + WS_WIT);
    bf16x8 IDf[2][2];
    v4u xq[2][4], gq[2];
#define RG_LOAD_TILE(tt_) do { const int tl_ = 16 * (tt_) + fr, tp_ = 64 * n + tl_; _Pragma("unroll") for (int ks = 0; ks < 2; ++ks) { const int cc = c0 + 32 * ks + 8 * fq; \
        _Pragma("unroll") for (int tap = 0; tap < 4; ++tap) { const bool ok_ = (tp_ - 3 + tap >= 0); const v4u x_ = FINAL ? __builtin_nontemporal_load((const v4u*)(XR + (size_t)(t0 + (ok_ ? tl_ - 3 + tap : 0)) * DH + cc)) : *(const v4u*)(XR + (size_t)(t0 + (ok_ ? tl_ - 3 + tap : 0)) * DH + cc); \
            xq[ks][tap] = (v4u){ok_ ? x_.x : 0u, ok_ ? x_.y : 0u, ok_ ? x_.z : 0u, ok_ ? x_.w : 0u}; } \
        if (FINAL) gq[ks] = __builtin_nontemporal_load((const v4u*)(YR + (size_t)(t0 + tl_) * DH + cc)); } } while (0)
    RG_LOAD_TILE(0);
    LAS unsigned char* wl = F.lds + F.wave * 16384; LAS float* cwl = (LAS float*)(F.lds + RING_BYTES + F.wave * 2048);
#pragma unroll
    for (int p = 0; p < 8; ++p) { const int pc = p * 64 + lane, j = pc >> 3, sl = pc & 7; const size_t o = (size_t)(c0 + j) * 64 + 8 * sl;
        *(LAS v4u*)(wl + j * 128 + ((sl ^ (j & 7)) << 4)) = *(const v4u*)(WRT + o); *(LAS v4u*)(wl + 8192 + j * 128 + ((sl ^ (j & 7)) << 4)) = *(const v4u*)(WIT + o); }
#pragma unroll
    for (int tap = 0; tap < 4; ++tap) cwl[tap * 64 + lane] = F.in[11][tap * DR + c0 + lane];
    cwl[256 + lane] = F.in[12][c0 + lane];
    LDS_WAIT();
#pragma unroll
    for (int ks = 0; ks < 2; ++ks)
#pragma unroll
        for (int c2 = 0; c2 < 2; ++c2) { bf16x8 v;
#pragma unroll
            for (int j = 0; j < 8; ++j) v[j] = (short)((8 * fq + j == 16 * c2 + fr) ? 0x3F80 : 0);
            IDf[ks][c2] = v; }
    float br[4], bi[4], ls8[4], hrun[4], arun[4];
#pragma unroll
    for (int ct = 0; ct < 4; ++ct) { const int c = c0 + 16 * ct + fr; br[ct] = F.in[14][c]; bi[ct] = F.in[16][c]; const float lam = F.in[17][c]; ls8[ct] = -8.f * log1pf(__expf(-lam));
        hrun[ct] = FINAL ? ((const float*)(F.ws + WS_CARRY))[(size_t)(b * NCH + n) * DR + c] : 0.f; arun[ct] = 1.f; }
#pragma unroll
    for (int tt = 0; tt < 4; ++tt) {
        bf16x8 AX[2], AG[2];
#pragma unroll
        for (int ks = 0; ks < 2; ++ks) { const int cl = 32 * ks + 8 * fq; float xc[8];
            { const f32x4 b0 = *(const LAS f32x4*)(cwl + 256 + cl), b1 = *(const LAS f32x4*)(cwl + 256 + cl + 4); xc[0] = b0[0]; xc[1] = b0[1]; xc[2] = b0[2]; xc[3] = b0[3]; xc[4] = b1[0]; xc[5] = b1[1]; xc[6] = b1[2]; xc[7] = b1[3]; }
#pragma unroll
            for (int tap = 0; tap < 4; ++tap) { const v4u xv = xq[ks][tap];
                const f32x4 w0 = *(const LAS f32x4*)(cwl + tap * 64 + cl), w1 = *(const LAS f32x4*)(cwl + tap * 64 + cl + 4);
                xc[0] += w0[0] * bf2f(xv.x & 0xffffu); xc[1] += w0[1] * bf2f(xv.x >> 16); xc[2] += w0[2] * bf2f(xv.y & 0xffffu); xc[3] += w0[3] * bf2f(xv.y >> 16);
                xc[4] += w1[0] * bf2f(xv.z & 0xffffu); xc[5] += w1[1] * bf2f(xv.z >> 16); xc[6] += w1[2] * bf2f(xv.w & 0xffffu); xc[7] += w1[3] * bf2f(xv.w >> 16); }
            v4u pk; pk.x = pk2(xc[0], xc[1]); pk.y = pk2(xc[2], xc[3]); pk.z = pk2(xc[4], xc[5]); pk.w = pk2(xc[6], xc[7]); AX[ks] = __builtin_bit_cast(bf16x8, pk);
            if (FINAL) AG[ks] = __builtin_bit_cast(bf16x8, gq[ks]);
        }
        if (tt < 3) RG_LOAD_TILE(tt + 1);
        asm volatile("" ::: "memory");
#pragma unroll
        for (int ct = 0; ct < 4; ++ct) {
            f32x4 aR = {0.f, 0.f, 0.f, 0.f}, aI = {0.f, 0.f, 0.f, 0.f}, aX = {0.f, 0.f, 0.f, 0.f}, aG = {0.f, 0.f, 0.f, 0.f};
#pragma unroll
            for (int ks = 0; ks < 2; ++ks) { const int jr = 16 * ct + fr, so = jr * 128 + (((4 * ks + fq) ^ (jr & 7)) << 4);
                const bf16x8 wr_ = *(const LAS bf16x8*)(wl + so), wi_ = *(const LAS bf16x8*)(wl + 8192 + so);
                aR = __builtin_amdgcn_mfma_f32_16x16x32_bf16(AX[ks], wr_, aR, 0, 0, 0); aI = __builtin_amdgcn_mfma_f32_16x16x32_bf16(AX[ks], wi_, aI, 0, 0, 0); }
            aX = __builtin_amdgcn_mfma_f32_16x16x32_bf16(AX[ct >> 1], IDf[ct >> 1][ct & 1], aX, 0, 0, 0);
            if (FINAL) aG = __builtin_amdgcn_mfma_f32_16x16x32_bf16(AG[ct >> 1], IDf[ct >> 1][ct & 1], aG, 0, 0, 0);
            float a[4], u[4];
#pragma unroll
            for (int r = 0; r < 4; ++r) { const float rr = sigmoidf_(aR[r] + br[ct]), ii = sigmoidf_(aI[r] + bi[ct]); const float la = rr * ls8[ct]; a[r] = __expf(la);
                const float x2 = 2.f * la; const float ep = -x2 * (1.f + x2 * (0.5f + x2 * (0.16666667f + x2 * 0.041666667f))), ed = 1.f - a[r] * a[r];
                u[r] = __builtin_amdgcn_sqrtf(x2 > -0.03f ? ep : ed) * (ii * aX[r]); }
            const float Af = a[0] * a[1] * a[2] * a[3], Hf = ((u[0] * a[1] + u[1]) * a[2] + u[2]) * a[3] + u[3];
            const bool oddr = (fq & 1) != 0, upper = fq >= 2;
            const float Ap = partner_row16(Af, oddr), Hp = partner_row16(Hf, oddr);
            const float At = Af * Ap, Ht = oddr ? (Af * Hp + Hf) : (Ap * Hf + Hp);
            const float Ao = partner_half32(At, upper), Ho = partner_half32(Ht, upper);
            const float Atot = At * Ao, Htot = upper ? (At * Ho + Ht) : (Ao * Ht + Ho);
            float Aex, Hex;
            if (!upper) { Aex = oddr ? Ap : 1.f; Hex = oddr ? Hp : 0.f; }
            else { Aex = oddr ? Ao * Ap : Ao; Hex = oddr ? (Ap * Ho + Hp) : Ho; }
            if (FINAL) { float h = Aex * hrun[ct] + Hex;
#pragma unroll
                for (int r = 0; r < 4; ++r) { h = a[r] * h + u[r]; u[r] = h * aG[r]; }
                valpk[(tt * 4 + ct) * 2] = pk2(u[0], u[1]); valpk[(tt * 4 + ct) * 2 + 1] = pk2(u[2], u[3]); }
            hrun[ct] = Atot * hrun[ct] + Htot; arun[ct] *= Atot;
        }
    }
#undef RG_LOAD_TILE
    if (!FINAL && fq == 0) {
#pragma unroll
        for (int ct = 0; ct < 4; ++ct) { const size_t o = (size_t)(b * NCH + n) * DR + c0 + 16 * ct + fr; ((float*)(F.ws + WS_RGA))[o] = arun[ct]; ((float*)(F.ws + WS_RGH))[o] = hrun[ct]; }
    }
}

__device__ __forceinline__ void ph3_passA(Frame& F) {
    bf16* DS = (bf16*)F.dsb; float* DDp = (float*)(F.ws + WS_DD);
    const int lane = F.lane, w = F.wave, fr = lane & 15, fq = lane >> 4, kp = F.tid & 63;
    LAS bf16* KT = (LAS bf16*)(F.lds + L_KT); LAS bf16* VT = (LAS bf16*)(F.lds + L_VT);
    { const int cn = F.vcu;
        const int b = cn / NCH, n = cn % NCH, t0 = b * SEQ + 64 * n;
        HgLoad L; hg_load<false>(F, t0, 0, L);
        { unsigned dummy[32]; rg_wave_task<false>(F, b, n, w, dummy); }
        LDS_BAR();
#pragma unroll
        for (int h = 0; h < NH; ++h) {
            const int task = (b * NH + h) * NCH + n;
            float c0[8], c1[8], off[2], bmid[2], blast[2]; hg_cumsum(F, L, c0, c1, off, bmid, blast);
            unsigned k0p[4], k1p[4];
#pragma unroll
            for (int i = 0; i < 8; i += 2) {
                const float a0 = bf2f(L.ki[i] & 0xffffu) * __expf(blast[0] - (off[0] + c0[i])), a1 = bf2f(L.ki[i + 1] & 0xffffu) * __expf(blast[0] - (off[0] + c0[i + 1]));
                const float d0 = bf2f(L.ki[i] >> 16) * __expf(blast[1] - (off[1] + c1[i])), d1 = bf2f(L.ki[i + 1] >> 16) * __expf(blast[1] - (off[1] + c1[i + 1]));
                k0p[i >> 1] = pk2(a0, a1); k1p[i >> 1] = pk2(d0, d1); }
            *(LAS v4u*)(KT + (2 * kp) * 72 + 8 * w) = (v4u){k0p[0], k0p[1], k0p[2], k0p[3]}; *(LAS v4u*)(KT + (2 * kp + 1) * 72 + 8 * w) = (v4u){k1p[0], k1p[1], k1p[2], k1p[3]};
            hg_store_vt(F, L, VT);
            if (w == 0) *(f32x2_t*)(DDp + (size_t)task * HD + 2 * kp) = (f32x2_t){__expf(blast[0]), __expf(blast[1])};
            if (h + 1 < NH) hg_load<false>(F, t0, h + 1, L);
            LDS_BAR();
            bf16x8 bV[2];
#pragma unroll
            for (int ss = 0; ss < 2; ++ss) bV[ss] = *(const LAS bf16x8*)(VT + (16 * w + fr) * 72 + 8 * fq + 32 * ss);
#pragma unroll
            for (int kt = 0; kt < 8; ++kt) { f32x4 acc = {0.f, 0.f, 0.f, 0.f};
#pragma unroll
                for (int ss = 0; ss < 2; ++ss) { const bf16x8 a = *(const LAS bf16x8*)(KT + (16 * kt + fr) * 72 + 8 * fq + 32 * ss); acc = __builtin_amdgcn_mfma_f32_16x16x32_bf16(a, bV[ss], acc, 0, 0, 0); }
                *(v2u*)(DS + (size_t)task * (HD * HD) + (size_t)(16 * w + fr) * HD + 16 * kt + 4 * fq) = (v2u){pk2m(acc[0], acc[1]), pk2m(acc[2], acc[3])}; }
        }
    }
}

__device__ __forceinline__ void ph4_passB(Frame& F) {
    const bf16* DS = (const bf16*)F.dsb; bf16* SST = (bf16*)F.dsb + (size_t)BATCH * NH * NCH * HD * HD; const float* DDp = (const float*)(F.ws + WS_DD);
    const int gt = F.vcu * NTHR + F.tid, NGT = F.G * NTHR;
    for (int idx = gt; idx < BATCH * NH * HD * HD / 2 + BATCH * DR; idx += NGT) {
        if (idx < BATCH * NH * HD * HD / 2) {
            const int bh = idx >> 13, pr = idx & 8191, e0 = 2 * pr, kk = e0 & 127;
            float s0 = 0.f, s1 = 0.f;
            const bf16* dsp = DS + (size_t)bh * NCH * (HD * HD) + e0; bf16* sp = SST + (size_t)bh * NCH * (HD * HD) + e0; const float* ddp = DDp + (size_t)bh * NCH * HD + kk;
            unsigned dA[8], dB[8]; f32x2_t eA[8], eB[8];
#define PB_LOAD(dv, ev, n0_) do { _Pragma("unroll") for (int j = 0; j < 8; ++j) { dv[j] = __builtin_nontemporal_load((const unsigned*)(dsp + (size_t)((n0_) + j) * (HD * HD))); ev[j] = *(const f32x2_t*)(ddp + ((n0_) + j) * HD); } } while (0)
#define PB_STEP(dv, ev, n0_) do { _Pragma("unroll") for (int j = 0; j < 8; ++j) { *(unsigned*)(sp + (size_t)((n0_) + j) * (HD * HD)) = pk2(s0, s1); s0 = ev[j].x * s0 + bf2f(dv[j] & 0xffffu); s1 = ev[j].y * s1 + bf2f(dv[j] >> 16); } } while (0)
            PB_LOAD(dA, eA, 0);
#pragma unroll 1
            for (int n0 = 0; n0 < NCH; n0 += 16) {
                PB_LOAD(dB, eB, n0 + 8);
                PB_STEP(dA, eA, n0);
                if (n0 + 16 < NCH) PB_LOAD(dA, eA, n0 + 16);
                PB_STEP(dB, eB, n0 + 8);
            }
#undef PB_LOAD
#undef PB_STEP
        } else {
            const int r = idx - BATCH * NH * HD * HD / 2, b = r / DR, c = r % DR;
            const float* A = (const float*)(F.ws + WS_RGA) + (size_t)b * NCH * DR + c; const float* Hh = (const float*)(F.ws + WS_RGH) + (size_t)b * NCH * DR + c; float* C = (float*)(F.ws + WS_CARRY) + (size_t)b * NCH * DR + c;
            float carry = 0.f;
#pragma unroll 4
            for (int n = 0; n < NCH; ++n) { C[(size_t)n * DR] = carry; carry = A[(size_t)n * DR] * carry + Hh[(size_t)n * DR]; }
        }
    }
}

__device__ __forceinline__ void ph5_passC(Frame& F) {
    const bf16* PJ = (const bf16*)(F.ws + WS_PROJ); const bf16* GZ = PJ + 4 * PROJ_S;
    const bf16* SST = (const bf16*)F.dsb + (size_t)BATCH * NH * NCH * HD * HD; bf16* O = (bf16*)(F.ws + WS_H);
    const int tid = F.tid, lane = F.lane, w = F.wave, fr = lane & 15, fq = lane >> 4, kp = tid & 63;
    LAS bf16* QTL = (LAS bf16*)(F.lds + L_QTL); LAS bf16* QH = (LAS bf16*)(F.lds + L_QH); LAS bf16* KH = (LAS bf16*)(F.lds + L_KH);
    LAS bf16* VT = (LAS bf16*)(F.lds + L_VT); LAS bf16* Pm = (LAS bf16*)(F.lds + L_P); LAS float* SSQ = (LAS float*)(F.lds + L_SSQ); LAS float* RSTD = (LAS float*)(F.lds + L_RSTD);
    { const int cn = F.vcu;
        const int b = cn / NCH, n = cn % NCH, t0 = b * SEQ + 64 * n;
        {
            LAS float* SSQ = (LAS float*)(F.lds + X_GTAB); LAS float* RSTD = SSQ + 512;
            unsigned valpk[32];
            rg_wave_task<true>(F, b, n, w, valpk);
#pragma unroll
            for (int tt = 0; tt < 4; ++tt) { float s[4] = {0.f, 0.f, 0.f, 0.f};
#pragma unroll
                for (int ct = 0; ct < 4; ++ct) { const unsigned p0 = valpk[(tt * 4 + ct) * 2], p1 = valpk[(tt * 4 + ct) * 2 + 1]; const float v0 = bf2f(p0 & 0xffffu), v1 = bf2f(p0 >> 16), v2 = bf2f(p1 & 0xffffu), v3 = bf2f(p1 >> 16);
                    s[0] += v0 * v0; s[1] += v1 * v1; s[2] += v2 * v2; s[3] += v3 * v3; }
#pragma unroll
                for (int r = 0; r < 4; ++r) { float x = row_sum16(s[r]); if (fr == 0) SSQ[(16 * tt + 4 * fq + r) * 8 + w] = x; } }
            LDS_BAR();
            if (tid < 64) { float s = 0.f;
#pragma unroll
                for (int i = 0; i < 8; ++i) s += SSQ[tid * 8 + i];
                RSTD[tid] = rsqrtf(s * (1.f / DR) + EPS); }
            LDS_BAR();
            { LAS bf16* VL = (LAS bf16*)(F.lds + w * 16384);
#pragma unroll
              for (int tt = 0; tt < 4; ++tt)
#pragma unroll
                  for (int ct = 0; ct < 4; ++ct) { const unsigned p0 = valpk[(tt * 4 + ct) * 2], p1 = valpk[(tt * 4 + ct) * 2 + 1]; const int tb = 16 * tt + 4 * fq, ch = 16 * ct + fr;
                      VL[(tb + 0) * 72 + ch] = (bf16)(p0 & 0xffffu); VL[(tb + 1) * 72 + ch] = (bf16)(p0 >> 16); VL[(tb + 2) * 72 + ch] = (bf16)(p1 & 0xffffu); VL[(tb + 3) * 72 + ch] = (bf16)(p1 >> 16); }
              LDS_WAIT();
              const int pc = lane & 7; const f32x4 g0 = *(const f32x4*)(F.in[18] + 64 * w + 8 * pc), g1 = *(const f32x4*)(F.in[18] + 64 * w + 8 * pc + 4);
#pragma unroll
              for (int p = 0; p < 8; ++p) { const int row = 8 * p + (lane >> 3); const v4u vv = *(const LAS v4u*)(VL + row * 72 + 8 * pc); const float rs = RSTD[row];
                  v4u o; o.x = pk2(bf2f(vv.x & 0xffffu) * rs * g0[0], bf2f(vv.x >> 16) * rs * g0[1]); o.y = pk2(bf2f(vv.y & 0xffffu) * rs * g0[2], bf2f(vv.y >> 16) * rs * g0[3]);
                  o.z = pk2(bf2f(vv.z & 0xffffu) * rs * g1[0], bf2f(vv.z >> 16) * rs * g1[1]); o.w = pk2(bf2f(vv.w & 0xffffu) * rs * g1[2], bf2f(vv.w >> 16) * rs * g1[3]);
                  *(v4u*)(O + (size_t)(t0 + row) * D + DH + 64 * w + 8 * pc) = o; } }
            LDS_BAR();
        }
        HgLoad L; hg_load<true>(F, t0, 0, L);
        LAS bf16* OT = (LAS bf16*)(F.lds + L_OT);
#pragma unroll 1
        for (int h = 0; h < NH; ++h) {
            const int task = (b * NH + h) * NCH + n;
            const int pr0 = tid >> 4, pc0 = (tid & 15) * 8;
            const v4u gz0 = __builtin_nontemporal_load((const v4u*)(GZ + (size_t)(t0 + pr0) * DH + h * HD + pc0)), gz1 = __builtin_nontemporal_load((const v4u*)(GZ + (size_t)(t0 + pr0 + 32) * DH + h * HD + pc0));
            bf16x8 bS[4];
#pragma unroll
            for (int ks = 0; ks < 4; ++ks) bS[ks] = __builtin_nontemporal_load((const bf16x8*)(SST + (size_t)task * (HD * HD) + (size_t)(16 * w + fr) * HD + 8 * fq + 32 * ks));
            float c0[8], c1[8], off[2], bmid[2], blast[2]; hg_cumsum(F, L, c0, c1, off, bmid, blast);
#pragma unroll
            for (int i = 0; i < 8; ++i) { const int tl = 8 * w + i; const float b0 = off[0] + c0[i], b1 = off[1] + c1[i];
                const float q0 = bf2f(L.q[i] & 0xffffu), q1 = bf2f(L.q[i] >> 16), k0 = bf2f(L.ki[i] & 0xffffu), k1 = bf2f(L.ki[i] >> 16);
                const float eq0 = __expf(fminf(b0 - bmid[0], 80.f)), eq1 = __expf(fminf(b1 - bmid[1], 80.f)), ek0 = __expf(fminf(bmid[0] - b0, 80.f)), ek1 = __expf(fminf(bmid[1] - b1, 80.f));
                *(LAS unsigned*)(QH + tl * 136 + 2 * kp) = pk2(q0 * eq0, q1 * eq1); *(LAS unsigned*)(KH + tl * 136 + 2 * kp) = pk2(k0 * ek0, k1 * ek1);
                *(LAS unsigned*)(QTL + tl * 136 + 2 * kp) = pk2(q0 * __expf(b0), q1 * __expf(b1)); }
            hg_store_vt(F, L, VT);
            if (h + 1 < NH) hg_load<true>(F, t0, h + 1, L);
            LDS_BAR();
#pragma unroll
            for (int pp = 0; pp < 2; ++pp) { const int pi = 2 * w + pp, iq = pi >> 2, jk = pi & 3; f32x4 acc = {0.f, 0.f, 0.f, 0.f};
                if (jk <= iq) {
#pragma unroll
                    for (int ks = 0; ks < 4; ++ks) { const bf16x8 a = *(const LAS bf16x8*)(KH + (16 * jk + fr) * 136 + 8 * fq + 32 * ks); const bf16x8 bq = *(const LAS bf16x8*)(QH + (16 * iq + fr) * 136 + 8 * fq + 32 * ks);
                        acc = __builtin_amdgcn_mfma_f32_16x16x32_bf16(a, bq, acc, 0, 0, 0); }
                    if (jk == iq) {
#pragma unroll
                        for (int r = 0; r < 4; ++r) if (4 * fq + r > fr) acc[r] = 0.f; }
                }
                *(LAS v2u*)(Pm + (16 * iq + fr) * 72 + 16 * jk + 4 * fq) = (v2u){pk2m(acc[0], acc[1]), pk2m(acc[2], acc[3])}; }
            LDS_BAR();
            f32x4 oacc[4];
            { bf16x8 bV[2];
#pragma unroll
              for (int ss = 0; ss < 2; ++ss) bV[ss] = *(const LAS bf16x8*)(VT + (16 * w + fr) * 72 + 8 * fq + 32 * ss);
#pragma unroll
              for (int tt = 0; tt < 4; ++tt) { f32x4 acc = {0.f, 0.f, 0.f, 0.f};
#pragma unroll
                  for (int ss = 0; ss < 2; ++ss) { const bf16x8 a = *(const LAS bf16x8*)(Pm + (16 * tt + fr) * 72 + 8 * fq + 32 * ss); acc = __builtin_amdgcn_mfma_f32_16x16x32_bf16(a, bV[ss], acc, 0, 0, 0); }
#pragma unroll
                  for (int ks = 0; ks < 4; ++ks) { const bf16x8 a = *(const LAS bf16x8*)(QTL + (16 * tt + fr) * 136 + 8 * fq + 32 * ks); acc = __builtin_amdgcn_mfma_f32_16x16x32_bf16(a, bS[ks], acc, 0, 0, 0); }
                  oacc[tt] = acc; } }
            const float gh = F.in[10][h * HD + 16 * w + fr];
#pragma unroll
            for (int tt = 0; tt < 4; ++tt)
#pragma unroll
                for (int r = 0; r < 4; ++r) { const float ov = oacc[tt][r]; float x = row_sum16(ov * ov);
                    const int tl = 16 * tt + 4 * fq + r; if (fr == 0) SSQ[tl * 8 + w] = x; OT[tl * 136 + 16 * w + fr] = (bf16)f2bf(ov * gh); }
            LDS_BAR();
#pragma unroll
            for (int pz = 0; pz < 2; ++pz) { const int row = pr0 + 32 * pz; const v4u ot = *(const LAS v4u*)(OT + row * 136 + pc0), gz = pz ? gz1 : gz0;
                const f32x4 q0 = *(const LAS f32x4*)(SSQ + row * 8), q1 = *(const LAS f32x4*)(SSQ + row * 8 + 4); const float rs = rsqrtf((((q0[0] + q0[1]) + (q0[2] + q0[3])) + ((q1[0] + q1[1]) + (q1[2] + q1[3]))) * (1.f / HD) + EPS);
                v4u o;
                o.x = pk2(bf2f(ot.x & 0xffffu) * rs * bf2f(gz.x & 0xffffu), bf2f(ot.x >> 16) * rs * bf2f(gz.x >> 16)); o.y = pk2(bf2f(ot.y & 0xffffu) * rs * bf2f(gz.y & 0xffffu), bf2f(ot.y >> 16) * rs * bf2f(gz.y >> 16));
                o.z = pk2(bf2f(ot.z & 0xffffu) * rs * bf2f(gz.z & 0xffffu), bf2f(ot.z >> 16) * rs * bf2f(gz.z >> 16)); o.w = pk2(bf2f(ot.w & 0xffffu) * rs * bf2f(gz.w & 0xffffu), bf2f(ot.w >> 16) * rs * bf2f(gz.w >> 16));
                *(v4u*)(O + (size_t)(t0 + row) * D + h * HD + pc0) = o; }
        }
    }
}

constexpr int L7_HI = 0, L7_LO = 32768, L7_PART = 65536, L7_LG = L7_PART + 24576, L7_ROUT = L7_LG + 2304;
__device__ __forceinline__ void ph7_rows(Frame& F) {
    const float* x = F.in[0]; const float* mod = (const float*)(F.ws + WS_MOD); const bf16* mix = (const bf16*)(F.ws + WS_MIX);
    const float *gpm = F.in[5], *gpf = F.in[6], *brg = F.in[21], *bre = F.in[23];
    const bf16* RRH = (const bf16*)(F.ws + WS_RRH); const bf16* RRL = (const bf16*)(F.ws + WS_RRL);
    bf16* H = (bf16*)(F.ws + WS_H); float* wgt = (float*)(F.ws + WS_WGT);
    unsigned* cnt = (unsigned*)(F.ws + WS_CTL) + CW_CNT; int* list = (int*)(F.ws + WS_LIST);
    LAS float* PART = (LAS float*)(F.lds + L7_PART); LAS float* LG = (LAS float*)(F.lds + L7_LG); LAS float* ROUT = (LAS float*)(F.lds + L7_ROUT);
    const int w = F.wave, fr = F.lane & 15, fq = F.lane >> 4, row0 = 64 * F.vcu;
    LAS float* C1 = (LAS float*)(F.lds + 98304); LAS float* C2 = C1 + D; LAS float* C3 = C2 + D;
    { const float* mb = mod + (row0 / SEQ) * 6144;
      for (int c = F.tid; c < D; c += NTHR) { C1[c] = mb[2048 + c] * gpm[c]; C2[c] = gpf[c] * (1.f + mb[4096 + c]); C3[c] = mb[3072 + c]; } }
    __syncthreads();
    bf16x8 bh[4][3], bl[4][3];
#pragma unroll
    for (int ks = 0; ks < 4; ++ks)
#pragma unroll
        for (int nt = 0; nt < 3; ++nt) { const size_t wo = (size_t)(16 * nt + fr) * D + 128 * w + 32 * ks + 8 * fq; bh[ks][nt] = *(const bf16x8*)(RRH + wo); bl[ks][nt] = *(const bf16x8*)(RRL + wo); }
    v2u mv[2][4]; f32x4 xv[2][4];
#define P7_LOAD(it_) do { _Pragma("unroll") for (int rr = 0; rr < 2; ++rr) { const int m_ = row0 + 16 * (it_) + 2 * w + rr; _Pragma("unroll") for (int j = 0; j < 4; ++j) { \
        mv[rr][j] = __builtin_nontemporal_load(((const GAS v2u*)(mix + (size_t)m_ * D) + lane) + 64 * j); xv[rr][j] = __builtin_nontemporal_load(((const GAS f32x4*)(x + (size_t)m_ * D) + lane) + 64 * j); } } } while (0)
    { const int lane = F.lane; P7_LOAD(0); }
#pragma unroll 1
    for (int it = 0; it < 4; ++it) {
        int lane = F.lane; asm volatile("" : "+v"(lane));
#pragma unroll
        for (int rr = 0; rr < 2; ++rr) {
            const int rl = 2 * w + rr, m = row0 + 16 * it + rl;
            f32x4 v[4], xr_[4]; float s = 0.f;
#pragma unroll
            for (int j = 0; j < 4; ++j) { v[j] = (f32x4){bf2f(mv[rr][j].x & 0xffffu), bf2f(mv[rr][j].x >> 16), bf2f(mv[rr][j].y & 0xffffu), bf2f(mv[rr][j].y >> 16)}; xr_[j] = xv[rr][j];
                s += v[j].x * v[j].x + v[j].y * v[j].y + v[j].z * v[j].z + v[j].w * v[j].w; }
            const float rs1 = rsqrtf(wave_sum(s) * (1.f / D) + EPS); float s2 = 0.f;
#pragma unroll
            for (int j = 0; j < 4; ++j) { const int c0 = 4 * lane + 256 * j; const f32x4 k1 = *(const LAS f32x4*)(C1 + c0);
                xr_[j].x += k1.x * (v[j].x * rs1); xr_[j].y += k1.y * (v[j].y * rs1); xr_[j].z += k1.z * (v[j].z * rs1); xr_[j].w += k1.w * (v[j].w * rs1);
                ((GAS unsigned long long*)((bf16*)(F.ws + WS_X1B) + (size_t)m * D) + lane)[64 * j] = (unsigned long long)pk2(xr_[j].x, xr_[j].y) | ((unsigned long long)pk2(xr_[j].z, xr_[j].w) << 32);
                s2 += xr_[j].x * xr_[j].x + xr_[j].y * xr_[j].y + xr_[j].z * xr_[j].z + xr_[j].w * xr_[j].w; }
            const float rs2 = rsqrtf(wave_sum(s2) * (1.f / D) + EPS);
#pragma unroll
            for (int j = 0; j < 4; ++j) { const int c0 = 4 * lane + 256 * j; const f32x4 k2 = *(const LAS f32x4*)(C2 + c0), k3 = *(const LAS f32x4*)(C3 + c0);
                const float h0 = xr_[j].x * rs2 * k2.x + k3.x, h1 = xr_[j].y * rs2 * k2.y + k3.y, h2 = xr_[j].z * rs2 * k2.z + k3.z, h3 = xr_[j].w * rs2 * k2.w + k3.w;
                const unsigned p01 = pk2(h0, h1), p23 = pk2(h2, h3);
                ((GAS unsigned long long*)(H + (size_t)m * D) + lane)[64 * j] = (unsigned long long)p01 | ((unsigned long long)p23 << 32);
                const unsigned q01 = pk2(h0 - bf2f(p01 & 0xffffu), h1 - bf2f(p01 >> 16)), q23 = pk2(h2 - bf2f(p23 & 0xffffu), h3 - bf2f(p23 >> 16));
                const int so = rl * 2048 + ((((lane >> 1) + 32 * j) ^ rl) << 4) + (lane & 1) * 8;
                *(LAS v2u*)(F.lds + L7_HI + so) = (v2u){p01, p23}; *(LAS v2u*)(F.lds + L7_LO + so) = (v2u){q01, q23}; }
        }
        if (it < 3) P7_LOAD(it + 1);
        LDS_BAR();
        f32x4 acc[3] = {{0.f, 0.f, 0.f, 0.f}, {0.f, 0.f, 0.f, 0.f}, {0.f, 0.f, 0.f, 0.f}};
#pragma unroll
        for (int ks = 0; ks < 4; ++ks) { const int slot = 16 * w + 4 * ks + fq, so = fr * 2048 + ((slot ^ fr) << 4);
            const bf16x8 ah = *(const LAS bf16x8*)(F.lds + L7_HI + so), al = *(const LAS bf16x8*)(F.lds + L7_LO + so);
#pragma unroll
            for (int nt = 0; nt < 3; ++nt) {
                acc[nt] = __builtin_amdgcn_mfma_f32_16x16x32_bf16(ah, bh[ks][nt], acc[nt], 0, 0, 0); acc[nt] = __builtin_amdgcn_mfma_f32_16x16x32_bf16(ah, bl[ks][nt], acc[nt], 0, 0, 0); acc[nt] = __builtin_amdgcn_mfma_f32_16x16x32_bf16(al, bh[ks][nt], acc[nt], 0, 0, 0); } }
#pragma unroll
        for (int nt = 0; nt < 3; ++nt)
#pragma unroll
            for (int r = 0; r < 4; ++r) PART[(w * 16 + 4 * fq + r) * 48 + 16 * nt + fr] = acc[nt][r];
        LDS_BAR();
        int tid16 = F.tid; asm volatile("" : "+v"(tid16));
        for (int e = tid16; e < 16 * 36; e += NTHR) { const int row = e / 36, o = e - row * 36; float a = o < 4 ? brg[o] : bre[o - 4];
#pragma unroll
            for (int ww = 0; ww < 8; ++ww) a += PART[(ww * 16 + row) * 48 + o];
            LG[e] = a; }
        LDS_BAR();
        if (tid16 < 16) {
            const LAS float* lgl = LG + tid16 * 36;
            int gs = 0; float gm = lgl[0];
#pragma unroll
            for (int o = 1; o < NG; ++o) if (lgl[o] > gm) { gm = lgl[o]; gs = o; }
            float den = 0.f;
#pragma unroll
            for (int o = 0; o < NG; ++o) den += __expf(lgl[o] - gm);
            const float gate = 1.f / den;
            float sel[EPG];
#pragma unroll
            for (int o = 0; o < EPG; ++o) sel[o] = lgl[4 + 8 * gs + o];
            int i1 = 0; float m1 = sel[0];
#pragma unroll
            for (int o = 1; o < EPG; ++o) if (sel[o] > m1) { m1 = sel[o]; i1 = o; }
            int i2 = -1; float m2 = -3.0e38f;
#pragma unroll
            for (int o = 0; o < EPG; ++o) if (o != i1 && sel[o] > m2) { m2 = sel[o]; i2 = o; }
            if (i2 < 0) i2 = (i1 + 1) & 7;
            const float e2 = __expf(m2 - m1);
            *(LAS f32x4*)(ROUT + (16 * it + tid16) * 4) = (f32x4){__int_as_float(gs * EPG + i1), __int_as_float(gs * EPG + i2), gate / (1.f + e2), gate * e2 / (1.f + e2)};
        }
    }
#undef P7_LOAD
    LAS unsigned* HIST = (LAS unsigned*)(F.lds + L7_ROUT + 1024); LAS unsigned* BASE = HIST + 32;
    if (F.tid < 32) HIST[F.tid] = 0u;
    __syncthreads();
    int e_ = 0; unsigned rank_ = 0u;
    if (F.tid < 128) { const int rl = F.tid >> 1, kx = F.tid & 1; e_ = __float_as_int(ROUT[rl * 4 + kx]); rank_ = atomicAdd((unsigned*)(HIST + e_), 1u); wgt[2 * (row0 + rl) + kx] = ROUT[rl * 4 + 2 + kx]; }
    __syncthreads();
    if (F.tid < 32) { const unsigned c = HIST[F.tid]; BASE[F.tid] = c ? atomicAdd(&cnt[64 * F.tid], c) : 0u; }
    __syncthreads();
    if (F.tid < 128) list[e_ * 32768 + BASE[e_] + rank_] = 2 * row0 + F.tid;
    __syncthreads();
}

__device__ __forceinline__ int moe_tables(Frame& F) {
    LAS int* MBE = (LAS int*)(F.lds + X_MBE); LAS int* MBS = MBE + MAXMB; LAS int* NMB = MBS + 33;
    LAS int* CNTL = NMB + 1;
    if (F.tid < NE) CNTL[F.tid] = (int)__hip_atomic_load(F.ctl + CW_CNT + 64 * F.tid, RLX_AGENT);
    __syncthreads();
    if (F.tid < NE) { int mb = 0;
        for (int e = 0; e < F.tid; ++e) mb += (CNTL[e] + 255) >> 8;
        const int nb = (CNTL[F.tid] + 255) >> 8; MBS[F.tid] = mb;
        for (int j = 0; j < nb && mb + j < MAXMB; ++j) MBE[mb + j] = F.tid;
        if (F.tid == NE - 1) { MBS[NE] = mb + nb; NMB[0] = mb + nb; } }
    __syncthreads();
    return NMB[0];
}
__device__ __forceinline__ void moe_fill_tabs(Frame& F, const pg8::MoeOrder& Sup, const pg8::MoeOrder& Sdn) {
    LAS int* MBE = (LAS int*)(F.lds + X_MBE); LAS int* MBS = MBE + MAXMB; LAS int* tab = (LAS int*)(F.lds + X_GTAB); const int* list = (const int*)(F.ws + WS_LIST);
    const bool dn = F.tid >= 256; const int r = F.tid & 255; const pg8::MoeOrder& S = dn ? Sdn : Sup;
    int aid[4]; bool val[4];
#pragma unroll
    for (int i = 0; i < 4; ++i) { pg8::Unit u; val[i] = S.next(i, u) && u.slot == i; aid[i] = -1;
        if (val[i]) { const int e = MBE[u.pm], pos = (u.pm - MBS[e]) * 256 + r, c = (MBS + 34)[e]; if (pos < c) aid[i] = list[e * 32768 + pos]; } }
#pragma unroll
    for (int i = 0; i < 4; ++i) if (val[i]) tab[((dn ? 4 : 0) + i) * 256 + r] = dn ? aid[i] : (aid[i] >= 0 ? (aid[i] >> 1) * (D * 2) : 0);
    __syncthreads();
}

__device__ __forceinline__ void ph10_final(Frame& F) {
    const float* mod = (const float*)(F.ws + WS_MOD); const bf16* YA = (const bf16*)(F.ws + WS_YA); const bf16* X1 = (const bf16*)(F.ws + WS_X1B); const float* gp = F.in[7];
    LAS float* CG = (LAS float*)F.lds;
    for (int i = F.tid; i < 2 * D; i += NTHR) { const int b = i >> 10, c = i & 1023; CG[i] = mod[b * 6144 + 5120 + c] * gp[c]; }
    __syncthreads();
    const int gw = F.vcu * NWAVES + F.wave, NGW = F.G * NWAVES;
    v2u ya[2][4], yb[2][4], xb[2][4], ya2[2][4], yb2[2][4], xb2[2][4];
#define P10_LOAD(YA_, YB_, XB_, m0_) do { _Pragma("unroll") for (int r = 0; r < 2; ++r) { const int m_ = (m0_) + r * (T / 2); _Pragma("unroll") for (int j = 0; j < 4; ++j) { \
        YA_[r][j] = __builtin_nontemporal_load(((const GAS v2u*)(YA + (size_t)(2 * m_) * D) + lane) + 64 * j); YB_[r][j] = __builtin_nontemporal_load(((const GAS v2u*)(YA + (size_t)(2 * m_ + 1) * D) + lane) + 64 * j); XB_[r][j] = __builtin_nontemporal_load(((const GAS v2u*)(X1 + (size_t)m_ * D) + lane) + 64 * j); } } } while (0)
#define P10_ROWS(YA_, YB_, XB_, m0_) do { _Pragma("unroll") for (int r = 0; r < 2; ++r) { const int m = (m0_) + r * (T / 2); float y[4][4]; float s = 0.f; \
        _Pragma("unroll") for (int j = 0; j < 4; ++j) { const v2u a = YA_[r][j], c = YB_[r][j]; \
            y[j][0] = bf2f(a.x & 0xffffu) + bf2f(c.x & 0xffffu); y[j][1] = bf2f(a.x >> 16) + bf2f(c.x >> 16); y[j][2] = bf2f(a.y & 0xffffu) + bf2f(c.y & 0xffffu); y[j][3] = bf2f(a.y >> 16) + bf2f(c.y >> 16); \
            _Pragma("unroll") for (int i = 0; i < 4; ++i) s += y[j][i] * y[j][i]; } \
        const float rs = rsqrtf(wave_sum(s) * (1.f / D) + EPS); \
        _Pragma("unroll") for (int j = 0; j < 4; ++j) { const int c0 = r * D + 4 * lane + 256 * j; const f32x4 cg = *(const LAS f32x4*)(CG + c0); const v2u xq = XB_[r][j]; \
            f32x4 xv = {bf2f(xq.x & 0xffffu), bf2f(xq.x >> 16), bf2f(xq.y & 0xffffu), bf2f(xq.y >> 16)}; \
            xv.x += cg.x * (y[j][0] * rs); xv.y += cg.y * (y[j][1] * rs); xv.z += cg.z * (y[j][2] * rs); xv.w += cg.w * (y[j][3] * rs); \
            __builtin_nontemporal_store(xv, ((GAS f32x4*)(F.out + (size_t)m * D) + lane) + 64 * j); } } } while (0)
    { const int lane = F.lane; if (gw < T / 2) P10_LOAD(ya, yb, xb, gw); }
    for (int m0 = gw; m0 < T / 2; m0 += 2 * NGW) {
        int lane = F.lane; asm volatile("" : "+v"(lane));
        const bool has2 = m0 + NGW < T / 2, has3 = m0 + 2 * NGW < T / 2;
        if (has2) P10_LOAD(ya2, yb2, xb2, m0 + NGW);
        P10_ROWS(ya, yb, xb, m0);
        if (has3) P10_LOAD(ya, yb, xb, m0 + 2 * NGW);
        if (has2) P10_ROWS(ya2, yb2, xb2, m0 + NGW);
    }
#undef P10_LOAD
#undef P10_ROWS
}

__global__ void __launch_bounds__(NTHR, 2) skel_fwd(Args args) {
    extern __shared__ __attribute__((aligned(16))) unsigned char lds[];
    Frame F;
    F.lds = (LAS unsigned char*)lds; F.MISC = (volatile LAS unsigned*)(F.lds + X_MISC);
    F.tid = threadIdx.x; F.lane = F.tid & 63; F.wave = __builtin_amdgcn_readfirstlane(F.tid >> 6);
    F.G = gridDim.x; { const int bx = blockIdx.x; F.vcu = (F.G % 8 == 0) ? (bx % 8) * (F.G / 8) + bx / 8 : bx; }
    F.in = args.in; F.out = args.out; F.ws = args.ws; F.dsb = (unsigned char*)args.out; F.ctl = (gu32*)(args.ws + WS_CTL);
    if (F.tid < 32) F.MISC[F.tid] = 0u;
    __syncthreads();
    const XcdBarrier bar = xcd_barrier_post((unsigned*)(F.ctl + CW_BAR), F.MISC + 8);

    const int lo = args.ph_lo, hi = args.ph_hi;
#define IN(k) (lo <= (k) && (k) < hi)
    if (IN(0)) ph0_prologue(F);
    xcd_barrier(bar);
    if (IN(2)) {
        pg8::Gemm g{(const bf16*)(F.ws + WS_H), (const bf16*)(F.ws + WS_WIN), D}; pg8::StaticOrder S; S.init(T, DIN, D, F.G, (int)blockIdx.x);
        pg8::EpiProj E{(bf16*)(F.ws + WS_PROJ), (const float*)(F.ws + WS_LB)};
        pg8::gemm_phase<pg8::EpiProj, pg8::StaticOrder, false>(F.lds, g, S, E, nullptr);
    }
    xcd_barrier(bar);
    if (IN(3)) ph3_passA(F);
    xcd_barrier(bar);
    if (IN(4)) ph4_passB(F);
    xcd_barrier(bar);
    if (IN(5)) ph5_passC(F);
    xcd_barrier(bar);
    if (IN(6)) {
        pg8::Gemm g{(const bf16*)(F.ws + WS_H), (const bf16*)(F.ws + WS_WOUT), D}; pg8::StaticOrder S; S.init(T, D, D, F.G, (int)blockIdx.x);
        pg8::EpiMixB E{(bf16*)(F.ws + WS_MIX), D};
        pg8::gemm_phase<pg8::EpiMixB, pg8::StaticOrder, false>(F.lds, g, S, E, nullptr);
    }
    xcd_barrier(bar);
    if (IN(7)) ph7_rows(F);
    xcd_barrier(bar);
    if (IN(8)) {
        const int nmb = moe_tables(F);
        unsigned* mbc = (unsigned*)(F.ctl + CW_MB);
        pg8::MoeOrder Sup{4 * nmb, F.G, (int)blockIdx.x, D, (const LAS int*)(F.lds + X_MBE), (size_t)D * D * 2, 1, 0, mbc};
        pg8::MoeOrder Sdn{4 * nmb, F.G, (int)blockIdx.x, DE, (const LAS int*)(F.lds + X_MBE), (size_t)D * DE * 2, 1, 1, nullptr};
        moe_fill_tabs(F, Sup, Sdn);
        { pg8::Gemm g{(const bf16*)(F.ws + WS_H), (const bf16*)(F.ws + WS_W13), D}; pg8::EpiAct E{(bf16*)(F.ws + WS_ACT)};
          pg8::gemm_phase<pg8::EpiAct, pg8::MoeOrder, true>(F.lds, g, Sup, E, (const LAS unsigned*)(F.lds + X_GTAB)); }
        {
          if (F.tid < 64) { pg8::Unit u; const bool mine = F.tid < 4 && Sdn.next(F.tid, u) && u.slot == F.tid; unsigned sp = 0;
              while (__any(mine && __hip_atomic_load(F.ctl + CW_MB + 64 * u.pm, RLX_AGENT) < 32u)) { __builtin_amdgcn_s_sleep(2); if (++sp > (1u << 22)) break; }
              __builtin_amdgcn_fence(__ATOMIC_ACQUIRE, "agent"); VM_WAIT(); }
          __syncthreads();
          pg8::Gemm g{(const bf16*)(F.ws + WS_ACT), (const bf16*)(F.ws + WS_W2), DE}; pg8::EpiYa E{(bf16*)(F.ws + WS_YA), (const float*)(F.ws + WS_WGT), (const LAS int*)(F.lds + X_GTAB + 4096)};
          pg8::gemm_phase<pg8::EpiYa, pg8::MoeOrder, false>(F.lds, g, Sdn, E, nullptr); }
    }
    xcd_barrier(bar);
    if (IN(10)) ph10_final(F);
#undef IN
}

extern "C" void kernel_launch(void* const* d_in, const int* in_sizes, int n_in, void* d_out, int out_size, void* d_ws, size_t ws_size, hipStream_t stream) {
    static int grid = 0;
    if (grid == 0) {
        if (n_in != 27 || out_size != T * D || ws_size < WS_END) { fprintf(stderr, "kernel_launch: unexpected n_in %d / out %d / ws %zu\n", n_in, out_size, ws_size); grid = -1; return; }
        int dev = 0, cus = 0, per_cu = 0;
        if (hipGetDevice(&dev) != hipSuccess || hipDeviceGetAttribute(&cus, hipDeviceAttributeMultiprocessorCount, dev) != hipSuccess) { grid = -1; return; }
        if (hipFuncSetAttribute((const void*)skel_fwd, hipFuncAttributeMaxDynamicSharedMemorySize, LDS_BYTES) != hipSuccess) { fprintf(stderr, "kernel_launch: hipFuncSetAttribute failed\n"); grid = -1; return; }
        if (hipOccupancyMaxActiveBlocksPerMultiprocessor(&per_cu, (const void*)skel_fwd, NTHR, LDS_BYTES) != hipSuccess || per_cu < 1) { fprintf(stderr, "kernel_launch: the occupancy query reports %d workgroups per CU; nothing launched\n", per_cu); (void)hipGetLastError(); grid = -1; return; }
        (void)hipGetLastError();
        if (cus * per_cu < 256) { fprintf(stderr, "kernel_launch: needs 256 co-resident workgroups (one per 64-token chunk), device admits %d\n", cus * per_cu); grid = -1; return; }
        grid = 256;
    }
    if (grid < 0) return;
    (void)hipMemsetAsync((char*)d_ws + WS_CTL, 0, CTL_ZERO_BYTES, stream);
    Args a{};
    for (int i = 0; i < 27; ++i) a.in[i] = (const float*)d_in[i];
    a.out = (float*)d_out; a.ws = (unsigned char*)d_ws; a.ph_lo = 0; a.ph_hi = 11;
    hipLaunchKernelGGL(skel_fwd, dim3(grid), dim3(NTHR), LDS_BYTES, stream, a);
}
```

```cpp
#include <hip/hip_runtime.h>
#include <cstdio>
#include <cstdint>

constexpr int BATCH = 2, SEQ = 8192, D = 1024, T = BATCH * SEQ;
constexpr int DH = 512, HD = 128, NH = 4, CHK = 64, NCH = SEQ / CHK;
constexpr int DR = 512, RBD = 64;
constexpr int DIN = 3072;
constexpr int NG = 4, EPG = 8, NE = 32, DE = 512;
constexpr int MAXMB = 160;
constexpr float EPS = 1e-6f;
constexpr int NWAVES = 8, NTHR = 512;

#define GAS __attribute__((address_space(1)))
#define LAS __attribute__((address_space(3)))
typedef unsigned short bf16;
typedef unsigned v4u __attribute__((ext_vector_type(4)));
typedef unsigned v2u __attribute__((ext_vector_type(2)));
typedef float f32x4 __attribute__((ext_vector_type(4)));
typedef short bf16x8 __attribute__((ext_vector_type(8)));
typedef GAS unsigned gu32;
#define RLX_AGENT __ATOMIC_RELAXED, __HIP_MEMORY_SCOPE_AGENT
#define LDS_WAIT() asm volatile("s_waitcnt lgkmcnt(0)" ::: "memory")
#define VM_WAIT() asm volatile("s_waitcnt vmcnt(0)" ::: "memory")
#define LDS_BAR() do { asm volatile("s_waitcnt lgkmcnt(0)" ::: "memory"); __builtin_amdgcn_s_barrier(); asm volatile("" ::: "memory"); } while (0)

__device__ __forceinline__ unsigned f2bf(float f) { unsigned u = __builtin_bit_cast(unsigned, f); return (u + 0x7fffu + ((u >> 16) & 1u)) >> 16; }
__device__ __forceinline__ float bf2f(unsigned h) { return __builtin_bit_cast(float, h << 16); }
typedef float f32x2_t __attribute__((ext_vector_type(2))); typedef __bf16 bf16x2_t __attribute__((ext_vector_type(2)));
__device__ __forceinline__ unsigned pk2m(float lo, float hi) { f32x2_t v = {lo, hi}; bf16x2_t b = __builtin_convertvector(v, bf16x2_t); return __builtin_bit_cast(unsigned, b); }
__device__ __forceinline__ unsigned pk2(float lo, float hi) { unsigned r; asm volatile("v_cvt_pk_bf16_f32 %0, %1, %2" : "=v"(r) : "v"(lo), "v"(hi)); return r; }
__device__ __forceinline__ float frcp(float v) { return __builtin_amdgcn_rcpf(v); }
__device__ __forceinline__ float sigmoidf_(float v) { return frcp(1.f + __expf(-v)); }
__device__ __forceinline__ float siluf_(float v) { return v * frcp(1.f + __expf(-v)); }
__device__ __forceinline__ float gelu_tanh_(float v) { const float u = 1.5957691216057308f * (v + 0.044715f * v * v * v); return v * frcp(1.f + __expf(-u)); }
template <int CTRL> __device__ __forceinline__ float dpp_f(float x) { return __builtin_bit_cast(float, __builtin_amdgcn_update_dpp(0, __builtin_bit_cast(int, x), CTRL, 0xF, 0xF, false)); }
__device__ __forceinline__ float row_sum16(float x) {
    x += dpp_f<0x121>(x); x += dpp_f<0x122>(x); x += dpp_f<0x124>(x); x += dpp_f<0x128>(x); return x; }
__device__ __forceinline__ float wave_sum(float v) {
    v = row_sum16(v);
    const int vi = __builtin_bit_cast(int, v);
    return (__builtin_bit_cast(float, __builtin_amdgcn_readlane(vi, 0)) + __builtin_bit_cast(float, __builtin_amdgcn_readlane(vi, 16))) + (__builtin_bit_cast(float, __builtin_amdgcn_readlane(vi, 32)) + __builtin_bit_cast(float, __builtin_amdgcn_readlane(vi, 48)));
}

__device__ __forceinline__ float partner_row16(float x, bool odd_row) { float a = x, b = x; asm volatile("s_nop 1\n\tv_permlane16_swap_b32 %0, %1" : "+v"(a), "+v"(b)); return odd_row ? a : b; }
__device__ __forceinline__ float partner_half32(float x, bool upper) { float a = x, b = x; asm volatile("s_nop 1\n\tv_permlane32_swap_b32 %0, %1" : "+v"(a), "+v"(b)); return upper ? a : b; }

constexpr size_t MiB = 1u << 20, KiB = 1u << 10;
constexpr size_t WS_CTL = 0, CTL_ZERO_BYTES = 160 * KiB;
constexpr size_t WS_MOD = 1 * MiB;
constexpr size_t WS_LB = WS_MOD + 64 * KiB;
constexpr size_t WS_WRT = WS_MOD + 128 * KiB;
constexpr size_t WS_WIT = WS_WRT + 64 * KiB;
constexpr size_t WS_RRH = WS_WIT + 64 * KiB;
constexpr size_t WS_RRL = WS_RRH + 96 * KiB;
constexpr size_t WS_RGA = 2 * MiB;
constexpr size_t WS_RGH = WS_RGA + 512 * KiB;
constexpr size_t WS_CARRY = WS_RGH + 512 * KiB;
constexpr size_t WS_DD = WS_CARRY + 512 * KiB;
constexpr size_t WS_WGT = 4 * MiB;
constexpr size_t WS_LIST = 5 * MiB;
constexpr size_t WS_WIN = 10 * MiB;
constexpr size_t WS_WOUT = 16 * MiB;
constexpr size_t WS_W13 = 18 * MiB;
constexpr size_t WS_W2 = 82 * MiB;
constexpr size_t WS_H = 114 * MiB;
constexpr size_t WS_PROJ = 146 * MiB;
constexpr size_t WS_MIX = WS_PROJ;
constexpr size_t WS_YA = WS_PROJ;
constexpr size_t WS_ACT = WS_PROJ + 64 * MiB;
constexpr size_t WS_X1B = 258 * MiB;
constexpr size_t WS_END = 290 * MiB;
constexpr size_t PROJ_S = (size_t)T * DH;
constexpr int CW_CNT = 32768;
constexpr int CW_MODCNT = 128;
constexpr int CW_BAR = 4096;
constexpr int CW_MB = 16384;

constexpr int RING_BYTES = 131072;
constexpr int RTAB_BYTES = 1024 * 36 * 4;
constexpr int X_OFF = RTAB_BYTES;
constexpr int X_GTAB = X_OFF;
constexpr int X_MBE = X_OFF + 8192;
constexpr int X_MISC = X_OFF + 10240;
constexpr int LDS_BYTES = X_OFF + 12288;

namespace pg8 {
constexpr int BM = 256, BK = 64, HALF = 128, HTB = HALF * BK * 2, NXCD = 8, WGM = 8;
__host__ __device__ __forceinline__ int lds_byte(int r, int c) { const int st = (r >> 4) * 2 + (c >> 5), rr = r & 15, cc = c & 31, ob = rr * 64 + cc * 2; return st * 1024 + (ob ^ (((ob >> 9) & 1) << 5)); }
__host__ __device__ __forceinline__ void stage_rc(int b, int& R, int& C) { const int st = b / 1024, sb = b % 1024, swz = sb ^ (((sb >> 9) & 1) << 5); R = (st >> 1) * 16 + swz / 64; C = (st & 1) * 32 + (swz % 64) / 2; }
__host__ __device__ __forceinline__ int perm32(int rho) { const int n = rho >> 4, i = rho & 15; return 8 * (i >> 2) + 4 * n + (i & 3); }

struct Unit { int pm, pn, slot; };
struct Gemm { const bf16* A; const bf16* Bt; int K; };

struct StaticOrder {
    int nM, nN, nwg, G, c, K, rep;
    __device__ __forceinline__ void init(int M, int N, int K_, int G_, int c_, int rep_ = 1) { nM = M / BM; nN = N / BM; nwg = nM * nN; G = G_; c = c_; K = K_; rep = rep_; }
    __device__ __forceinline__ bool next(int i, Unit& u) const {
        long L = (long)i * G + c; if (L >= (long)nwg * rep) return false; L %= nwg;
        int wgid = (int)L; { const int q = nwg / NXCD, r = nwg % NXCD, xcd = wgid % NXCD, off = wgid / NXCD; wgid = (xcd < r ? xcd * (q + 1) : r * (q + 1) + (xcd - r) * q) + off; }
        const int nig = WGM * nN, gid = wgid / nig, fm = gid * WGM, gsz = (nM - fm) < WGM ? (nM - fm) : WGM;
        u.pm = fm + ((wgid % nig) % gsz); u.pn = (wgid % nig) / gsz; u.slot = i; return true;
    }
    __device__ __forceinline__ size_t aoff(const Unit& u) const { return (size_t)u.pm * BM * K * 2; }
    __device__ __forceinline__ size_t boff(const Unit& u) const { return (size_t)u.pn * BM * K * 2; }
    __device__ __forceinline__ void done(const Unit&) const {}
};
struct ProjOrder {
    int c, K;
    __device__ __forceinline__ bool next(int i, Unit& u) const {
        if (i >= 4) return false;
        const int x = c & 7, gi = c >> 3, a = gi >> 3;
        const unsigned tab = a == 0 ? 0x0842u : a == 1 ? 0x1953u : 0xBA76u;
        u.pm = 8 * x + (gi & 7); u.pn = (int)((tab >> (4 * i)) & 15u); u.slot = i; return true;
    }
    __device__ __forceinline__ size_t aoff(const Unit& u) const { return (size_t)u.pm * BM * K * 2; }
    __device__ __forceinline__ size_t boff(const Unit& u) const { return (size_t)u.pn * BM * K * 2; }
    __device__ __forceinline__ void done(const Unit&) const {}
};
struct MoeOrder {
    int nunits, G, c, K; const LAS int* mbe; size_t estride; int rep;
    int rev; unsigned* done_cnt;
    __device__ __forceinline__ bool next(int i, Unit& u) const {
        const int x = c & 7, ci = c >> 3; const int lo = (int)(((long)nunits * x) >> 3), hi = (int)(((long)nunits * (x + 1)) >> 3);
        int mine; long L0; int stride;
        if (!rev) { mine = (hi - lo - ci + 31) >> 5; L0 = lo + ci; stride = 32; }
        else {
            const int U = hi - lo, base = U >> 5, rem = U & 31, Tc = (3 * U + 31) >> 5;
            int dhi = Tc - 2 * (base + 1); dhi = dhi > 0 ? dhi : 0; int dlo = Tc - 2 * base; dlo = dlo > 0 ? dlo : 0;
            int tailn = rem * dhi; tailn = tailn < U ? tailn : U; const int headn = U - tailn;
            int s0, s1;
            if (ci < rem) { s1 = U - ci * dhi; s0 = s1 - dhi; s0 = s0 > headn ? s0 : headn; s1 = s1 > headn ? s1 : headn; }
            else { s0 = (ci - rem) * dlo; s1 = s0 + dlo; s0 = s0 < headn ? s0 : headn; s1 = s1 < headn ? s1 : headn; }
            mine = s1 - s0; L0 = lo + s0; stride = 1; }
        if (mine <= 0 || i >= mine * rep) return false;
        const int ii = i % mine; const long L = L0 + (long)stride * ii;
        u.pm = (int)(L >> 2); u.pn = (int)(L & 3); u.slot = ii; return true;
    }
    __device__ __forceinline__ size_t aoff(const Unit& u) const { return (size_t)u.pm * BM * K * 2; }
    __device__ __forceinline__ size_t boff(const Unit& u) const { return (size_t)mbe[u.pm] * estride + (size_t)u.pn * BM * K * 2; }
    __device__ __forceinline__ void done(const Unit& u) const {
        if (done_cnt) { asm volatile("s_waitcnt vmcnt(0)" ::: "memory"); if ((threadIdx.x & 63) == 0) __hip_atomic_fetch_add(done_cnt + 64 * u.pm, 1u, __ATOMIC_RELAXED, __HIP_MEMORY_SCOPE_AGENT); }
    }
};

struct EpiProj {
    static constexpr bool PERM = true;
    bf16* base; const float* lb;
    __device__ __forceinline__ void operator()(const f32x4 (&acc)[2][2][4][2], const Unit& u, int wr, int wc, int fr, int fq) const {
        const int grp = u.pn >> 1, c0 = (u.pn & 1) * 256 + wc * 32 + 8 * fq, row0 = u.pm * BM + wr * 64 + fr; const bool late = grp == 0 || grp == 3 || grp == 5;
        bf16* ob = base + (grp == 0 ? 0 : grp == 1 ? PROJ_S : (size_t)(grp + 1) * PROJ_S);
        float lbv[2][8];
        if (grp == 1) {
#pragma unroll
            for (int bj = 0; bj < 2; ++bj) { const f32x4 a = *(const f32x4*)(lb + c0 + bj * HALF), b = *(const f32x4*)(lb + c0 + bj * HALF + 4);
                lbv[bj][0] = a[0]; lbv[bj][1] = a[1]; lbv[bj][2] = a[2]; lbv[bj][3] = a[3]; lbv[bj][4] = b[0]; lbv[bj][5] = b[1]; lbv[bj][6] = b[2]; lbv[bj][7] = b[3]; }
        }
#pragma unroll
        for (int ai = 0; ai < 2; ++ai)
#pragma unroll
            for (int m = 0; m < 4; ++m) { bf16* rowp = ob + (size_t)(row0 + ai * HALF + m * 16) * DH + c0;
#pragma unroll
                for (int bj = 0; bj < 2; ++bj) {
                    float v[8];
#pragma unroll
                    for (int j = 0; j < 4; ++j) { v[j] = acc[ai][bj][m][0][j]; v[4 + j] = acc[ai][bj][m][1][j]; }
                    if (grp == 1) {
                        float kv[8];
#pragma unroll
                        for (int j = 0; j < 8; ++j) { const float l = lbv[bj][j], sg = sigmoidf_(v[j]); kv[j] = (1.f - l) * (1.f - sg); v[j] = __logf(l + (1.f - l) * sg); }
                        v4u w; w.x = pk2(kv[0], kv[1]); w.y = pk2(kv[2], kv[3]); w.z = pk2(kv[4], kv[5]); w.w = pk2(kv[6], kv[7]);
                        *(v4u*)(rowp + PROJ_S + bj * HALF) = w;
                    } else if (grp == 0 || grp == 3) {
#pragma unroll
                        for (int j = 0; j < 8; ++j) v[j] = siluf_(v[j]);
                    } else if (grp == 5) {
#pragma unroll
                        for (int j = 0; j < 8; ++j) v[j] = gelu_tanh_(v[j]);
                    }
                    v4u w; w.x = pk2m(v[0], v[1]); w.y = pk2m(v[2], v[3]); w.z = pk2m(v[4], v[5]); w.w = pk2m(v[6], v[7]);
                    if (late) __builtin_nontemporal_store(w, (v4u*)(rowp + bj * HALF)); else *(v4u*)(rowp + bj * HALF) = w;
                } }
    }
};
struct EpiF32 {
    static constexpr bool PERM = false;
    float* C; int ldc;
    __device__ __forceinline__ void operator()(const f32x4 (&acc)[2][2][4][2], const Unit& u, int wr, int wc, int fr, int fq) const {
        const int row0 = u.pm * BM + wr * 64 + fr, col0 = u.pn * BM + wc * 32 + 4 * fq;
#pragma unroll
        for (int ai = 0; ai < 2; ++ai)
#pragma unroll
            for (int m = 0; m < 4; ++m) { float* rowp = C + (size_t)(row0 + ai * HALF + m * 16) * ldc + col0;
#pragma unroll
                for (int bj = 0; bj < 2; ++bj)
#pragma unroll
                    for (int n = 0; n < 2; ++n) *(f32x4*)(rowp + bj * HALF + n * 16) = acc[ai][bj][m][n]; }
    }
};
struct EpiMixB {
    static constexpr bool PERM = true;
    bf16* C; int ldc;
    __device__ __forceinline__ void operator()(const f32x4 (&acc)[2][2][4][2], const Unit& u, int wr, int wc, int fr, int fq) const {
        const int row0 = u.pm * BM + wr * 64 + fr, col0 = u.pn * BM + wc * 32 + 8 * fq;
#pragma unroll
        for (int ai = 0; ai < 2; ++ai)
#pragma unroll
            for (int m = 0; m < 4; ++m) { bf16* rowp = C + (size_t)(row0 + ai * HALF + m * 16) * ldc + col0;
#pragma unroll
                for (int bj = 0; bj < 2; ++bj) { const f32x4 a = acc[ai][bj][m][0], b = acc[ai][bj][m][1];
                    v4u w; w.x = pk2m(a[0], a[1]); w.y = pk2m(a[2], a[3]); w.z = pk2m(b[0], b[1]); w.w = pk2m(b[2], b[3]);
                    *(v4u*)(rowp + bj * HALF) = w; } }
    }
};
struct EpiAct {
    static constexpr bool PERM = true;
    bf16* act;
    __device__ __forceinline__ void operator()(const f32x4 (&acc)[2][2][4][2], const Unit& u, int wr, int wc, int fr, int fq) const {
        const int row0 = u.pm * BM + wr * 64 + fr, col0 = u.pn * HALF + wc * 32 + 8 * fq;
#pragma unroll
        for (int ai = 0; ai < 2; ++ai)
#pragma unroll
            for (int m = 0; m < 4; ++m) {
                float v[8];
#pragma unroll
                for (int j = 0; j < 4; ++j) { v[j] = siluf_(acc[ai][0][m][0][j]) * acc[ai][1][m][0][j]; v[4 + j] = siluf_(acc[ai][0][m][1][j]) * acc[ai][1][m][1][j]; }
                v4u w; w.x = pk2(v[0], v[1]); w.y = pk2(v[2], v[3]); w.z = pk2(v[4], v[5]); w.w = pk2(v[6], v[7]);
                bf16* dst = act + (size_t)(row0 + ai * HALF + m * 16) * DE + col0;
                asm volatile("global_store_dwordx4 %0, %1, off sc1\n\ts_nop 1" :: "v"(dst), "v"(w) : "memory"); }
    }
};
struct EpiYa {
    static constexpr bool PERM = true;
    bf16* ya; const float* wgt; const LAS int* tab;
    __device__ __forceinline__ void operator()(const f32x4 (&acc)[2][2][4][2], const Unit& u, int wr, int wc, int fr, int fq) const {
        const int col0 = u.pn * BM + wc * 32 + 8 * fq;
#pragma unroll
        for (int ai = 0; ai < 2; ++ai)
#pragma unroll
            for (int m = 0; m < 4; ++m) { const int aid = tab[u.slot * 256 + ai * HALF + wr * 64 + m * 16 + fr];
                if (aid >= 0) { const float w8 = wgt[aid]; bf16* rowp = ya + (size_t)aid * D + col0;
#pragma unroll
                    for (int bj = 0; bj < 2; ++bj) { const f32x4 a = acc[ai][bj][m][0] * w8, b = acc[ai][bj][m][1] * w8;
                        v4u w; w.x = pk2(a[0], a[1]); w.y = pk2(a[2], a[3]); w.z = pk2(b[0], b[1]); w.w = pk2(b[2], b[3]);
                        *(v4u*)(rowp + bj * HALF) = w; } } }
    }
};

template <class Epi, class Sched, bool GATHER, bool ALIGN_EPI = true>
__device__ __forceinline__ void gemm_phase(LAS unsigned char* lds, const Gemm g, const Sched& S, const Epi& E, const LAS unsigned* gtab) {
    const int tid = threadIdx.x, wid = __builtin_amdgcn_readfirstlane(tid >> 6), lane = tid & 63, wr = wid >> 2, wc = wid & 3, fr = lane & 15, fq = lane >> 4;
    const int K = g.K, nt = K / BK;
    unsigned voffA[2], voffB[2]; int rowA[2];
#pragma unroll
    for (int i = 0; i < 2; ++i) { int R, C; stage_rc(tid * 16 + i * 8192, R, C); const int Rb = Epi::PERM ? ((R & ~31) + perm32(R & 31)) : R;
        voffA[i] = GATHER ? (unsigned)(C * 2) : (unsigned)(R * K + C) * 2u; voffB[i] = (unsigned)(Rb * K + C) * 2u; rowA[i] = R; }
    const size_t kstep = (size_t)(BK * 2);
    const size_t hstep = (size_t)HALF * K * 2;
    const unsigned ldsw = (unsigned)wid * 1024u;
    const int aoff = lds_byte(wr * 64 + fr, fq * 8), boff = lds_byte(wc * 32 + fr, fq * 8);
#define PG8_SA(b, h) (((b) * 2 + (h)) * HTB)
#define PG8_SB(b, h) ((4 + (b) * 2 + (h)) * HTB)
#define PG8_STAGE(bufoff, gbase, voff) do { _Pragma("unroll") for (int _i = 0; _i < 2; ++_i) \
        __builtin_amdgcn_global_load_lds((const unsigned*)((const char*)(gbase) + (voff)[_i]), (LAS unsigned*)(lds + (bufoff) + ldsw + _i * 8192), 16, 0, 0); } while (0)
#define PG8_STAGE_A(bufoff, gbase, slot, h) do { if constexpr (GATHER) { _Pragma("unroll") for (int _i = 0; _i < 2; ++_i) { const unsigned _ro = gtab[(slot) * 256 + (h) * HALF + rowA[_i]]; \
        __builtin_amdgcn_global_load_lds((const unsigned*)((const char*)(gbase) + _ro + voffA[_i]), (LAS unsigned*)(lds + (bufoff) + ldsw + _i * 8192), 16, 0, 0); } } \
        else { PG8_STAGE(bufoff, (const char*)(gbase) + (h) * hstep, voffA); } } while (0)
#define PG8_LDA(dst, b, h) do { _Pragma("unroll") for (int m = 0; m < 4; ++m) _Pragma("unroll") for (int k = 0; k < 2; ++k) dst[m][k] = *(const LAS bf16x8*)(lds + PG8_SA(b, h) + aoff + m * 2048 + k * 1024); } while (0)
#define PG8_LDB(dst, b, h) do { _Pragma("unroll") for (int n = 0; n < 2; ++n) _Pragma("unroll") for (int k = 0; k < 2; ++k) dst[n][k] = *(const LAS bf16x8*)(lds + PG8_SB(b, h) + boff + n * 2048 + k * 1024); } while (0)
#define PG8_MMA(ai, bj, At, Bt) do { __builtin_amdgcn_s_setprio(1); _Pragma("unroll") for (int m = 0; m < 4; ++m) _Pragma("unroll") for (int n = 0; n < 2; ++n) _Pragma("unroll") for (int k = 0; k < 2; ++k) \
        acc[ai][bj][m][n] = __builtin_amdgcn_mfma_f32_16x16x32_bf16(Bt[n][k], At[m][k], acc[ai][bj][m][n], 0, 0, 0); __builtin_amdgcn_s_setprio(0); } while (0)
#define PG8_WAIT_V(n) asm volatile("s_waitcnt vmcnt(" #n ")" ::: "memory")
#define PG8_WAIT_L(n) asm volatile("s_waitcnt lgkmcnt(" #n ")" ::: "memory")
#define PG8_BAR __builtin_amdgcn_s_barrier()
#define PG8_SCHED __builtin_amdgcn_sched_barrier(0)
    Unit cur, nxt; int ui = 0;
    if (!S.next(0, cur)) return;
    f32x4 acc[2][2][4][2];
#pragma unroll
    for (int a = 0; a < 2; ++a)
#pragma unroll
        for (int b = 0; b < 2; ++b)
#pragma unroll
            for (int m = 0; m < 4; ++m)
#pragma unroll
                for (int n = 0; n < 2; ++n) acc[a][b][m][n] = (f32x4){0.f, 0.f, 0.f, 0.f};
    bf16x8 At[4][2], B0[2][2], B1[2][2];
    const char* cA = (const char*)g.A + (GATHER ? (size_t)0 : S.aoff(cur)); const char* cB = (const char*)g.Bt + S.boff(cur);
    PG8_STAGE(PG8_SB(0, 0), cB, voffB); PG8_STAGE(PG8_SB(0, 1), cB + hstep, voffB); PG8_STAGE_A(PG8_SA(0, 0), cA, 0, 0); PG8_STAGE_A(PG8_SA(0, 1), cA, 0, 1);
    if (wr == 1) PG8_BAR;
    PG8_WAIT_V(2); PG8_BAR;
    PG8_STAGE(PG8_SB(1, 0), cB + kstep, voffB); PG8_STAGE_A(PG8_SA(1, 0), cA + kstep, 0, 0); PG8_STAGE(PG8_SB(1, 1), cB + hstep + kstep, voffB);
    PG8_WAIT_V(6); PG8_BAR;
    for (;;) {
        const bool has_next = S.next(ui + 1, nxt);
        const char* nA = has_next ? (const char*)g.A + (GATHER ? (size_t)0 : S.aoff(nxt)) : cA; const char* nB = has_next ? (const char*)g.Bt + S.boff(nxt) : cB;
        const int nslot = has_next ? nxt.slot : cur.slot, cslot = cur.slot;
        for (int t = 0; t < nt; t += 2) {
            const bool last = (t == nt - 2);
            const char* a1 = cA + (size_t)(t + 1) * kstep;
            const char* a2 = last ? nA : cA + (size_t)(t + 2) * kstep; const char* b2 = last ? nB : cB + (size_t)(t + 2) * kstep;
            const char* a3 = a2 + kstep; const char* b3 = b2 + kstep;
            const int s2 = last ? nslot : cslot;
            PG8_LDB(B0, 0, 0); PG8_LDB(B1, 0, 1); PG8_SCHED; PG8_LDA(At, 0, 0); PG8_STAGE_A(PG8_SA(1, 1), a1, cslot, 1);
            PG8_WAIT_V(8); PG8_WAIT_L(0); PG8_BAR; PG8_MMA(0, 0, At, B0); PG8_MMA(0, 1, At, B1); PG8_BAR; PG8_SCHED;
            PG8_LDA(At, 0, 1); PG8_STAGE(PG8_SB(0, 0), b2, voffB); PG8_STAGE(PG8_SB(0, 1), b2 + hstep, voffB); PG8_STAGE_A(PG8_SA(0, 0), a2, s2, 0);
            PG8_WAIT_V(8); PG8_WAIT_L(0); PG8_BAR; PG8_MMA(1, 0, At, B0); PG8_MMA(1, 1, At, B1); PG8_BAR; PG8_SCHED;
            PG8_LDB(B0, 1, 0); PG8_LDB(B1, 1, 1); PG8_SCHED; PG8_LDA(At, 1, 0); PG8_STAGE_A(PG8_SA(0, 1), a2, s2, 1);
            PG8_WAIT_V(8); PG8_WAIT_L(0); PG8_BAR; PG8_MMA(0, 0, At, B0); PG8_MMA(0, 1, At, B1); PG8_BAR; PG8_SCHED;
            PG8_LDA(At, 1, 1); PG8_STAGE(PG8_SB(1, 0), b3, voffB); PG8_STAGE(PG8_SB(1, 1), b3 + hstep, voffB); PG8_STAGE_A(PG8_SA(1, 0), a3, s2, 0);
            PG8_WAIT_V(8); PG8_WAIT_L(0); PG8_BAR; PG8_MMA(1, 0, At, B0); PG8_MMA(1, 1, At, B1); PG8_BAR; PG8_SCHED;
        }
        if constexpr (ALIGN_EPI) { if (wr == 0) PG8_BAR; }
        E(acc, cur, wr, wc, fr, fq); S.done(cur);
        if (!has_next) break;
#pragma unroll
        for (int a = 0; a < 2; ++a)
#pragma unroll
            for (int b = 0; b < 2; ++b)
#pragma unroll
                for (int m = 0; m < 4; ++m)
#pragma unroll
                    for (int n = 0; n < 2; ++n) acc[a][b][m][n] = (f32x4){0.f, 0.f, 0.f, 0.f};
        cur = nxt; cA = nA; cB = nB; ++ui;
        if constexpr (ALIGN_EPI) { if (wr == 1) PG8_BAR; }
    }
    PG8_WAIT_V(0);
    if constexpr (!ALIGN_EPI) { if (wr == 0) PG8_BAR; }
    PG8_BAR;
#undef PG8_SA
#undef PG8_SB
#undef PG8_STAGE
#undef PG8_STAGE_A
#undef PG8_LDA
#undef PG8_LDB
#undef PG8_MMA
#undef PG8_WAIT_V
#undef PG8_WAIT_L
#undef PG8_BAR
#undef PG8_SCHED
}
}

#define XB_TMO      128
#define XB_XCNT(j)  (256  + 64 * (j))
#define XB_XSUB(j)  (1280 + 64 * (j))
#define XB_XGEN(j)  (2304 + 64 * (j))
#define XB_TOP      3328
#define XB_TOPGEN   3392
#define XCD_BAR_WORDS 3456
#define XB_SPIN_CAP (1u << 18)
__device__ __forceinline__ unsigned xb_ld(unsigned* p)              { return __hip_atomic_load(p, __ATOMIC_RELAXED, __HIP_MEMORY_SCOPE_AGENT); }
__device__ __forceinline__ unsigned xb_add(unsigned* p, unsigned v) { return __hip_atomic_fetch_add(p, v, __ATOMIC_RELAXED, __HIP_MEMORY_SCOPE_AGENT); }
__device__ __forceinline__ unsigned xb_xcc_id() { return (unsigned)__builtin_amdgcn_s_getreg((3 << 11) | 20) & 0xFu; }
#define XB_SPIN(cond, bar) do { unsigned _sp = 0; while (cond) { __builtin_amdgcn_s_sleep(1); \
    if ((++_sp & 255u) == 0u) { if (xb_ld(&(bar)[XB_TMO])) break; if (_sp > XB_SPIN_CAP) { atomicAdd(&(bar)[XB_TMO], 1u); break; } } } } while (0)
struct XcdBarrier { unsigned* bar; unsigned x; volatile LAS unsigned* st; };
__device__ __forceinline__ XcdBarrier xcd_barrier_post(unsigned* bar, volatile LAS unsigned* st) {
    XcdBarrier b; b.bar = bar; b.x = xb_xcc_id(); b.st = st;
    if (threadIdx.x == 0) (void)xb_add(&bar[XB_XCNT(b.x)], 1u);
    return b;
}
__device__ __forceinline__ void xcd_barrier_complete(unsigned* bar, unsigned x, unsigned& nloc, unsigned& nx) {
    const unsigned G = gridDim.x * gridDim.y * gridDim.z;
    unsigned sum, cnt, mine, sp = 0u;
    for (;;) {
        sum = 0u; cnt = 0u; mine = 0u;
#pragma unroll
        for (unsigned j = 0; j < 16; ++j) { const unsigned c = xb_ld(&bar[XB_XCNT(j)]); sum += c; cnt += (c > 0u) ? 1u : 0u; mine = (j == x) ? c : mine; }
        if (sum == G) break;
        __builtin_amdgcn_s_sleep(1);
        if ((++sp & 255u) == 0u) { if (xb_ld(&bar[XB_TMO])) break; if (sp > XB_SPIN_CAP) { atomicAdd(&bar[XB_TMO], 1u); break; } }
    }
    nloc = mine > 0u ? mine : 1u; nx = cnt > 0u ? cnt : 1u;
}
__device__ __forceinline__ void xcd_barrier(const XcdBarrier& b) {
    asm volatile("s_waitcnt vmcnt(0)" ::: "memory");
    __syncthreads();
    if (threadIdx.x == 0) {
        unsigned* bar = b.bar;
        __builtin_amdgcn_s_waitcnt(0);
        unsigned nloc = b.st[0], nx = b.st[1];
        if (nloc == 0u) { xcd_barrier_complete(bar, b.x, nloc, nx); b.st[0] = nloc; b.st[1] = nx; }
        const unsigned old = xb_add(&bar[XB_XSUB(b.x)], 1u);
        const unsigned gen = old / nloc;
        if (old + 1u == (gen + 1u) * nloc) {
            __builtin_amdgcn_fence(__ATOMIC_RELEASE, "agent");
            asm volatile("s_waitcnt vmcnt(0)" ::: "memory");
            const unsigned og = xb_add(&bar[XB_TOP], 1u);
            const unsigned tg = og / nx;
            if (og + 1u == (tg + 1u) * nx) xb_add(&bar[XB_TOPGEN], 1u);
            else XB_SPIN(xb_ld(&bar[XB_TOPGEN]) == tg, bar);
            __builtin_amdgcn_fence(__ATOMIC_ACQUIRE, "agent");
            xb_add(&bar[XB_XGEN(b.x)], 1u);
            asm volatile("s_waitcnt vmcnt(0)" ::: "memory");
        } else {
            XB_SPIN(xb_ld(&bar[XB_XGEN(b.x)]) == gen, bar);
            __builtin_amdgcn_fence(__ATOMIC_ACQUIRE, "agent");
            asm volatile("s_waitcnt vmcnt(0)" ::: "memory");
        }
    }
    __syncthreads();
}

struct Args { const float* in[27]; float* out; unsigned char* ws; int ph_lo, ph_hi; };
struct Frame {
    LAS unsigned char* lds; volatile LAS unsigned* MISC; gu32* ctl;
    int tid, lane, wave, vcu, G;
    const float* const* in; float* out; unsigned char* ws; unsigned char* dsb;
};

__device__ __forceinline__ void tr_load(const float* W, int N, int k0, int n0, int lane, f32x4 (&a)[4], f32x4 (&b)[4]) {
    const int kq = lane >> 3, c4 = lane & 7;
#pragma unroll
    for (int i = 0; i < 4; ++i) { const float* p = W + (size_t)(k0 + 16 * i + 2 * kq) * N + n0 + 4 * c4; a[i] = __builtin_nontemporal_load((const f32x4*)p); b[i] = __builtin_nontemporal_load((const f32x4*)(p + N));   }
}
__device__ __forceinline__ void tr_finish(const f32x4 (&a)[4], const f32x4 (&b)[4], bf16* WT, int ldt, int k0, int drow0, LAS unsigned* Tl, int lane, bool nt_store) {
    const int kq = lane >> 3, c4 = lane & 7;
#pragma unroll
    for (int i = 0; i < 4; ++i)
#pragma unroll
        for (int j = 0; j < 4; ++j) Tl[(4 * c4 + j) * 32 + ((8 * i + kq) ^ (4 * c4))] = pk2(a[i][j], b[i][j]);
    LDS_WAIT(); asm volatile("" ::: "memory");
#pragma unroll
    for (int jj = 0; jj < 4; ++jj) { const int n = (lane >> 3) + 8 * jj, c = lane & 7;
        const v4u o = *(const LAS v4u*)(Tl + n * 32 + 4 * (c ^ (n >> 2)));
        if (nt_store) __builtin_nontemporal_store(o, (GAS v4u*)(WT + (size_t)(drow0 + n) * ldt + k0 + 8 * c)); else *(GAS v4u*)(WT + (size_t)(drow0 + n) * ldt + k0 + 8 * c) = o; }
    LDS_WAIT(); asm volatile("" ::: "memory");
}
__device__ __forceinline__ void p0_transpose_item(const float* W, int N, bf16* WT, int ldt, int k0, int n0, int drow0, LAS unsigned* Tl, int lane, bool nt_store = false) {
    f32x4 a[4], b[4];
    tr_load(W, N, k0, n0, lane, a, b);
    tr_finish(a, b, WT, ldt, k0, drow0, Tl, lane, nt_store);
}
constexpr int MW_CONV_ROUNDS = 45;
struct MwItem { const float* W; bf16* WT; int N, ldt, k0, n0, drow0; };
__device__ __forceinline__ MwItem mw_decode(const Frame& F, int it) {
    it = (it & ~511) | ((it + 72 * (it >> 9)) & 511);
    MwItem m; const int e = it / 768; const int r = it - e * 768;
    const bool up = r < 512; const int w3 = (r >> 8) & 1, q = up ? (r & 255) : (r - 512);
    const int kb = up ? (q >> 4) : (q >> 5), nb = up ? (q & 15) : (q & 31), n0 = 32 * nb;
    const float* w13 = w3 ? F.in[25] : F.in[24];
    m.W = (up ? w13 : F.in[26]) + (size_t)e * D * DE; m.N = up ? DE : D;
    m.WT = (bf16*)(F.ws + (up ? WS_W13 : WS_W2)) + (size_t)e * (up ? D * D : D * DE); m.ldt = up ? D : DE;
    m.k0 = 64 * kb; m.n0 = n0; m.drow0 = up ? (n0 >> 7) * 256 + (n0 & 127) + 128 * w3 : n0;
    return m;
}
__device__ __forceinline__ void p2_moe_weight_copies(Frame& F, int cv) {
    LAS unsigned* scr = (LAS unsigned*)(F.lds + 32768 + F.wave * 4096);
    const int gw = cv * NWAVES + F.wave; constexpr int NGW = 64 * NWAVES, NPAIR = (MW_CONV_ROUNDS - 1) / 2;
    static_assert(MW_CONV_ROUNDS == 2 * NPAIR + 1 && (MW_CONV_ROUNDS + 3) * NGW == NE * 768, "rounds");
    f32x4 a[4], b[4], a2[4], b2[4];
    int it = gw;
    { const MwItem m = mw_decode(F, it); tr_load(m.W, m.N, m.k0, m.n0, F.lane, a, b); }
    for (int p = 0; p < NPAIR; ++p, it += 2 * NGW) {
        int lane = F.lane; asm volatile("" : "+v"(lane));
        { const MwItem m = mw_decode(F, it + NGW); tr_load(m.W, m.N, m.k0, m.n0, lane, a2, b2); }
        { const MwItem m = mw_decode(F, it); tr_finish(a, b, m.WT, m.ldt, m.k0, m.drow0, scr, lane, true); }
        { const MwItem m = mw_decode(F, it + 2 * NGW); tr_load(m.W, m.N, m.k0, m.n0, lane, a, b); }
        { const MwItem m = mw_decode(F, it + NGW); tr_finish(a2, b2, m.WT, m.ldt, m.k0, m.drow0, scr, lane, true); }
    }
    { int lane = F.lane; asm volatile("" : "+v"(lane));
      const MwItem m = mw_decode(F, it); tr_finish(a, b, m.WT, m.ldt, m.k0, m.drow0, scr, lane, true); }
}
__device__ __forceinline__ void p2_moe_weight_copy_tail(Frame& F, int gwave) {
    LAS unsigned* scr = (LAS unsigned*)(F.lds + 32768 + F.wave * 4096);
    const MwItem m = mw_decode(F, MW_CONV_ROUNDS * 512 + gwave);
    p0_transpose_item(m.W, m.N, m.WT, m.ldt, m.k0, m.n0, m.drow0, scr, F.lane, true);
}
__device__ __forceinline__ void ph1_hrows(Frame& F);
__device__ __forceinline__ void ph0_prologue(Frame& F) {
    const float* c = F.in[1]; const float* wada = F.in[2]; const float* bada = F.in[3];
    float* mod = (float*)(F.ws + WS_MOD);
    LAS float* sc = (LAS float*)(F.lds);
    LAS float* red = (LAS float*)(F.lds + 8192);
    for (int i = F.tid; i < 2 * D; i += NTHR) sc[i] = siluf_(c[i]);
    __syncthreads();
    for (int slab = F.vcu; slab < 256; slab += F.G) {
        const int n0 = slab * 24;
        if (F.tid < 510) {
            const int kq = F.tid / 6, c4 = F.tid % 6; float a[2][4];
#pragma unroll
            for (int b = 0; b < 2; ++b)
#pragma unroll
                for (int j = 0; j < 4; ++j) a[b][j] = 0.f;
            for (int k = kq; k < D; k += 85) { const f32x4 w = __builtin_nontemporal_load((const f32x4*)(wada + (size_t)k * 6144 + n0 + 4 * c4)); const float s0 = sc[k], s1 = sc[D + k];
#pragma unroll
                for (int j = 0; j < 4; ++j) { a[0][j] += s0 * w[j]; a[1][j] += s1 * w[j]; } }
#pragma unroll
            for (int b = 0; b < 2; ++b)
#pragma unroll
                for (int j = 0; j < 4; ++j) red[(kq * 6 + c4) * 8 + b * 4 + j] = a[b][j];
        }
        __syncthreads();
        if (F.tid < 48) { const int b = F.tid / 24, col = F.tid % 24, c4 = col >> 2, j = col & 3; float s = 0.f;
            for (int kq = 0; kq < 85; ++kq) s += red[(kq * 6 + c4) * 8 + b * 4 + j];
            mod[b * 6144 + n0 + col] = s + bada[n0 + col]; }
        __syncthreads();
    }
    VM_WAIT(); __syncthreads();
    if (F.tid == 0) { __builtin_amdgcn_fence(__ATOMIC_RELEASE, "agent"); VM_WAIT(); __hip_atomic_fetch_add(F.ctl + CW_MODCNT, 1u, RLX_AGENT); }
    const int gt = F.vcu * NTHR + F.tid, NGT = F.G * NTHR;
    if (gt < DH) { const float* g = F.in[9]; ((float*)(F.ws + WS_LB))[gt] = 1.f / (1.f + __expf(g[DH + gt] - g[gt])); }
    for (int e = gt; e < 48 * D; e += NGT) { const int n = e >> 10, kk = e & 1023; const float wv = n < NG ? F.in[20][kk * NG + n] : n < NG + NE ? F.in[22][kk * NE + n - NG] : 0.f;
        const unsigned hi = f2bf(wv); ((bf16*)(F.ws + WS_RRH))[e] = (bf16)hi; ((bf16*)(F.ws + WS_RRL))[e] = (bf16)f2bf(wv - bf2f(hi)); }
    for (int e = gt; e < 2 * 8 * 64 * 64; e += NGT) { const int which = e >> 15, r = e & 32767, blk = r >> 12, j = (r >> 6) & 63, i = r & 63;
        const float* w = which ? F.in[15] : F.in[13]; ((bf16*)(F.ws + (which ? WS_WIT : WS_WRT)))[r] = (bf16)f2bf(w[(size_t)(blk * 64 + i) * 64 + j]); }
    LAS unsigned* scr = (LAS unsigned*)(F.lds + 32768 + F.wave * 4096);
    const int gw = F.vcu * NWAVES + F.wave, NGW = F.G * NWAVES;
    constexpr int I_IN = 16 * 96, I_OUT = 16 * 32, NITEMS = I_IN + I_OUT;
    for (int it = gw; it < NITEMS; it += NGW) {
        int r = it;
        if (r < I_IN) { const int kb = r / 96, nb = r % 96; p0_transpose_item(F.in[8], DIN, (bf16*)(F.ws + WS_WIN), D, 64 * kb, 32 * nb, 32 * nb, scr, F.lane); continue; } r -= I_IN;
        { const int kb = r / 32, nb = r % 32; p0_transpose_item(F.in[19], D, (bf16*)(F.ws + WS_WOUT), D, 64 * kb, 32 * nb, 32 * nb, scr, F.lane); }
    }
    if (F.tid < 64) { unsigned sp = 0;
        while ((unsigned)__builtin_amdgcn_readfirstlane(__hip_atomic_load(F.ctl + CW_MODCNT, RLX_AGENT)) < (unsigned)F.G) { __builtin_amdgcn_s_sleep(2); if (++sp > (1u << 20)) break; }
        __builtin_amdgcn_fence(__ATOMIC_ACQUIRE, "agent"); VM_WAIT(); }
    __syncthreads();
    ph1_hrows(F);
}

__device__ __forceinline__ void ph1_hrows(Frame& F) {
    const float* x = F.in[0]; const float* g = F.in[4]; const float* mod = (const float*)(F.ws + WS_MOD); bf16* H = (bf16*)(F.ws + WS_H);
    LAS float* PA = (LAS float*)F.lds; LAS float* PB = PA + 2 * D;
    for (int i = F.tid; i < 2 * D; i += NTHR) { const int b = i >> 10, c = i & 1023; PA[i] = g[c] * (1.f + mod[b * 6144 + 1024 + c]); PB[i] = mod[b * 6144 + c]; }
    __syncthreads();
    const int gw = F.vcu * NWAVES + F.wave, NGW = F.G * NWAVES;
    f32x4 v[2][4], v2[2][4];
#define P1_LOAD(V_, m0_) do { _Pragma("unroll") for (int r = 0; r < 2; ++r) _Pragma("unroll") for (int j = 0; j < 4; ++j) V_[r][j] = __builtin_nontemporal_load(((const GAS f32x4*)(x + (size_t)((m0_) + r * (T / 2)) * D) + lane) + 64 * j); } while (0)
#define P1_ROWS(V_, m0_) do { _Pragma("unroll") for (int r = 0; r < 2; ++r) { const int m = (m0_) + r * (T / 2); float s = 0.f; \
        _Pragma("unroll") for (int j = 0; j < 4; ++j) s += V_[r][j].x * V_[r][j].x + V_[r][j].y * V_[r][j].y + V_[r][j].z * V_[r][j].z + V_[r][j].w * V_[r][j].w; \
        const float rstd = rsqrtf(wave_sum(s) * (1.f / D) + EPS); \
        GAS unsigned long long* o8 = (GAS unsigned long long*)(H + (size_t)m * D) + lane; \
        _Pragma("unroll") for (int j = 0; j < 4; ++j) { const int c0 = r * D + 4 * lane + 256 * j; const f32x4 pa = *(const LAS f32x4*)(PA + c0), pb = *(const LAS f32x4*)(PB + c0); \
            const float a0 = V_[r][j].x * rstd * pa.x + pb.x, a1 = V_[r][j].y * rstd * pa.y + pb.y, a2 = V_[r][j].z * rstd * pa.z + pb.z, a3 = V_[r][j].w * rstd * pa.w + pb.w; \
            o8[64 * j] = (unsigned long long)pk2(a0, a1) | ((unsigned long long)pk2(a2, a3) << 32); } } } while (0)
    static_assert(T / 2 == 4 * 256 * NWAVES, "row pairs per wave");
    int m0 = gw;
    { const int lane = F.lane; P1_LOAD(v, m0); }
    { int lane = F.lane; asm volatile("" : "+v"(lane));
      P1_LOAD(v2, m0 + NGW); P1_ROWS(v, m0); P1_LOAD(v, m0 + 2 * NGW); P1_ROWS(v2, m0 + NGW); }
    m0 += 2 * NGW;
    { int lane = F.lane; asm volatile("" : "+v"(lane));
      P1_LOAD(v2, m0 + NGW); P1_ROWS(v, m0); P1_ROWS(v2, m0 + NGW); }
#undef P1_LOAD
#undef P1_ROWS
}

constexpr int L_GT = 0;
constexpr int L_QTL = 4096;
constexpr int L_QH = L_QTL + 17408;
constexpr int L_KH = L_QH + 17408;
constexpr int L_VT = L_KH + 17408;
constexpr int L_P = L_VT + 18432;
constexpr int L_SSQ = L_P + 9216;
constexpr int L_RSTD = L_SSQ + 2048;
constexpr int L_OT = L_RSTD + 256;
constexpr int L_KT = L_QTL;
static_assert(L_OT + 17408 <= RING_BYTES, "mixer LDS map");

struct HgLoad { unsigned lf[8], ki[8], vv[8], q[8]; };
template <bool NEEDQ>
__device__ __forceinline__ void hg_load(Frame& F, int t0, int h, HgLoad& L) {
    const bf16* PJ = (const bf16*)(F.ws + WS_PROJ); const size_t base = (size_t)(t0 + 8 * F.wave) * DH + h * HD + 2 * (F.tid & 63);
#pragma unroll
    for (int i = 0; i < 8; ++i) { const size_t o = base + (size_t)i * DH;
        if (NEEDQ) { L.lf[i] = __builtin_nontemporal_load((const unsigned*)(PJ + PROJ_S + o)); L.ki[i] = __builtin_nontemporal_load((const unsigned*)(PJ + 2 * PROJ_S + o)); L.vv[i] = __builtin_nontemporal_load((const unsigned*)(PJ + 3 * PROJ_S + o)); L.q[i] = __builtin_nontemporal_load((const unsigned*)(PJ + o)); }
        else { L.lf[i] = *(const unsigned*)(PJ + PROJ_S + o); L.ki[i] = *(const unsigned*)(PJ + 2 * PROJ_S + o); L.vv[i] = *(const unsigned*)(PJ + 3 * PROJ_S + o); } }
}
__device__ __forceinline__ void hg_cumsum(Frame& F, const HgLoad& L, float (&c0)[8], float (&c1)[8], float (&off)[2], float (&bmid)[2], float (&blast)[2]) {
    LAS float* GT = (LAS float*)(F.lds + L_GT); const int kp = F.tid & 63, w = F.wave;
    float r0 = 0.f, r1 = 0.f;
#pragma unroll
    for (int i = 0; i < 8; ++i) { r0 += bf2f(L.lf[i] & 0xffffu); r1 += bf2f(L.lf[i] >> 16); c0[i] = r0; c1[i] = r1; }
    *(LAS f32x2_t*)(GT + w * 128 + 2 * kp) = (f32x2_t){r0, r1};
    LDS_BAR();
    float a0 = 0.f, a1 = 0.f; off[0] = 0.f; off[1] = 0.f; bmid[0] = 0.f; bmid[1] = 0.f;
#pragma unroll
    for (int g = 0; g < 8; ++g) { const f32x2_t v = *(const LAS f32x2_t*)(GT + g * 128 + 2 * kp); if (g == w) { off[0] = a0; off[1] = a1; } a0 += v.x; a1 += v.y; if (g == 3) { bmid[0] = a0; bmid[1] = a1; } }
    blast[0] = a0; blast[1] = a1;
}
__device__ __forceinline__ void hg_store_vt(Frame& F, const HgLoad& L, LAS bf16* VT) {
    const int kp = F.tid & 63, w = F.wave; v4u lo, hi;
    lo.x = (L.vv[0] & 0xffffu) | (L.vv[1] << 16); lo.y = (L.vv[2] & 0xffffu) | (L.vv[3] << 16); lo.z = (L.vv[4] & 0xffffu) | (L.vv[5] << 16); lo.w = (L.vv[6] & 0xffffu) | (L.vv[7] << 16);
    hi.x = (L.vv[0] >> 16) | (L.vv[1] & 0xffff0000u); hi.y = (L.vv[2] >> 16) | (L.vv[3] & 0xffff0000u); hi.z = (L.vv[4] >> 16) | (L.vv[5] & 0xffff0000u); hi.w = (L.vv[6] >> 16) | (L.vv[7] & 0xffff0000u);
    *(LAS v4u*)(VT + (2 * kp) * 72 + 8 * w) = lo; *(LAS v4u*)(VT + (2 * kp + 1) * 72 + 8 * w) = hi;
}

constexpr size_t WS_RGS = WS_X1B;
template <bool FINAL>
__device__ __forceinline__ void rg_wave_task(Frame& F, int b, int n, int cb, unsigned (&valpk)[32]) {
    const int lane = F.lane, fr = lane & 15, fq = lane >> 4, c0 = 64 * cb; const int t0 = b * SEQ + 64 * n;
    const bf16* XR = (const bf16*)(F.ws + WS_PROJ) + 5 * PROJ_S; const bf16* YR = (const bf16*)(F.ws + WS_PROJ) + 6 * PROJ_S;
    const bf16* WRT = (const bf16*)(F.ws + WS_WRT); const bf16* WIT = (const bf16*)(F.ws + WS_WIT);
    GAS v4u* rgs = (GAS v4u*)(F.ws + WS_RGS) + (size_t)((b * NCH + n) * 8 + cb) * (16 * 64) + lane;
    bf16x8 IDf[2][2];
    v4u xq[2][4], gqa[4][2], rqa[4][4];
#define RG_LOAD_TILE(tt_) do { const int tl_ = 16 * (tt_) + fr, tp_ = 64 * n + tl_; \
        if (!FINAL) { _Pragma("unroll") for (int ks = 0; ks < 2; ++ks) { const int cc = c0 + 32 * ks + 8 * fq; \
            _Pragma("unroll") for (int tap = 0; tap < 4; ++tap) { const bool ok_ = (tp_ - 3 + tap >= 0); const v4u x_ = __builtin_nontemporal_load((const v4u*)(XR + (size_t)(t0 + (ok_ ? tl_ - 3 + tap : 0)) * DH + cc));   \
                xq[ks][tap] = (v4u){ok_ ? x_.x : 0u, ok_ ? x_.y : 0u, ok_ ? x_.z : 0u, ok_ ? x_.w : 0u}; } } } \
        else { _Pragma("unroll") for (int ks = 0; ks < 2; ++ks) gqa[tt_][ks] = __builtin_nontemporal_load((const v4u*)(YR + (size_t)(t0 + tl_) * DH + c0 + 32 * ks + 8 * fq)); \
            _Pragma("unroll") for (int ct = 0; ct < 4; ++ct) rqa[tt_][ct] = __builtin_nontemporal_load(rgs + ((tt_) * 4 + ct) * 64); } } while (0)
    RG_LOAD_TILE(0);
    if (FINAL) { RG_LOAD_TILE(1); RG_LOAD_TILE(2); RG_LOAD_TILE(3); }
    LAS unsigned char* wl = F.lds + F.wave * 16384; LAS float* cwl = (LAS float*)(F.lds + RING_BYTES + F.wave * 2048);
    if (!FINAL) {
#pragma unroll
        for (int p = 0; p < 8; ++p) { const int pc = p * 64 + lane, j = pc >> 3, sl = pc & 7; const size_t o = (size_t)(c0 + j) * 64 + 8 * sl;
            *(LAS v4u*)(wl + j * 128 + ((sl ^ (j & 7)) << 4)) = *(const v4u*)(WRT + o); *(LAS v4u*)(wl + 8192 + j * 128 + ((sl ^ (j & 7)) << 4)) = *(const v4u*)(WIT + o); }
#pragma unroll
        for (int tap = 0; tap < 4; ++tap) cwl[tap * 64 + lane] = F.in[11][tap * DR + c0 + lane];
        cwl[256 + lane] = F.in[12][c0 + lane];
        LDS_WAIT();
    }
#pragma unroll
    for (int ks = 0; ks < 2; ++ks)
#pragma unroll
        for (int c2 = 0; c2 < 2; ++c2) { bf16x8 v;
#pragma unroll
            for (int j = 0; j < 8; ++j) v[j] = (short)((8 * fq + j == 16 * c2 + fr) ? 0x3F80 : 0);
            IDf[ks][c2] = v; }
    float br[4], bi[4], ls8[4], hrun[4], arun[4];
#pragma unroll
    for (int ct = 0; ct < 4; ++ct) { const int c = c0 + 16 * ct + fr;
        if (!FINAL) { br[ct] = F.in[14][c]; bi[ct] = F.in[16][c]; const float lam = F.in[17][c]; ls8[ct] = -8.f * log1pf(__expf(-lam)); } else { br[ct] = 0.f; bi[ct] = 0.f; ls8[ct] = 0.f; }
        hrun[ct] = FINAL ? ((const float*)(F.ws + WS_CARRY))[(size_t)(b * NCH + n) * DR + c] : 0.f; arun[ct] = 1.f; }
#pragma unroll
    for (int tt = 0; tt < 4; ++tt) {
        bf16x8 AX[2], AG[2]; v4u rc[4];
        if (!FINAL) {
#pragma unroll
            for (int ks = 0; ks < 2; ++ks) { const int cl = 32 * ks + 8 * fq; float xc[8];
                { const f32x4 b0 = *(const LAS f32x4*)(cwl + 256 + cl), b1 = *(const LAS f32x4*)(cwl + 256 + cl + 4); xc[0] = b0[0]; xc[1] = b0[1]; xc[2] = b0[2]; xc[3] = b0[3]; xc[4] = b1[0]; xc[5] = b1[1]; xc[6] = b1[2]; xc[7] = b1[3]; }
#pragma unroll
                for (int tap = 0; tap < 4; ++tap) { const v4u xv = xq[ks][tap];
                    const f32x4 w0 = *(const LAS f32x4*)(cwl + tap * 64 + cl), w1 = *(const LAS f32x4*)(cwl + tap * 64 + cl + 4);
                    xc[0] += w0[0] * bf2f(xv.x & 0xffffu); xc[1] += w0[1] * bf2f(xv.x >> 16); xc[2] += w0[2] * bf2f(xv.y & 0xffffu); xc[3] += w0[3] * bf2f(xv.y >> 16);
                    xc[4] += w1[0] * bf2f(xv.z & 0xffffu); xc[5] += w1[1] * bf2f(xv.z >> 16); xc[6] += w1[2] * bf2f(xv.w & 0xffffu); xc[7] += w1[3] * bf2f(xv.w >> 16); }
                v4u pk; pk.x = pk2(xc[0], xc[1]); pk.y = pk2(xc[2], xc[3]); pk.z = pk2(xc[4], xc[5]); pk.w = pk2(xc[6], xc[7]); AX[ks] = __builtin_bit_cast(bf16x8, pk); AG[ks] = AX[ks]; }
#pragma unroll
            for (int ct = 0; ct < 4; ++ct) rc[ct] = (v4u){0u, 0u, 0u, 0u};
        } else {
#pragma unroll
            for (int ks = 0; ks < 2; ++ks) { AG[ks] = __builtin_bit_cast(bf16x8, gqa[tt][ks]); AX[ks] = AG[ks]; }
#pragma unroll
            for (int ct = 0; ct < 4; ++ct) rc[ct] = rqa[tt][ct];
        }
        if (!FINAL && tt < 3) RG_LOAD_TILE(tt + 1);
        asm volatile("" ::: "memory");
#pragma unroll
        for (int ct = 0; ct < 4; ++ct) {
            float a[4], u[4]; f32x4 aG = {0.f, 0.f, 0.f, 0.f};
            if (!FINAL) {
                f32x4 aR = {0.f, 0.f, 0.f, 0.f}, aI = {0.f, 0.f, 0.f, 0.f}, aX = {0.f, 0.f, 0.f, 0.f};
#pragma unroll
                for (int ks = 0; ks < 2; ++ks) { const int jr = 16 * ct + fr, so = jr * 128 + (((4 * ks + fq) ^ (jr & 7)) << 4);
                    const bf16x8 wr_ = *(const LAS bf16x8*)(wl + so), wi_ = *(const LAS bf16x8*)(wl + 8192 + so);
                    aR = __builtin_amdgcn_mfma_f32_16x16x32_bf16(AX[ks], wr_, aR, 0, 0, 0); aI = __builtin_amdgcn_mfma_f32_16x16x32_bf16(AX[ks], wi_, aI, 0, 0, 0); }
                aX = __builtin_amdgcn_mfma_f32_16x16x32_bf16(AX[ct >> 1], IDf[ct >> 1][ct & 1], aX, 0, 0, 0);
                float la4[4];
#pragma unroll
                for (int r = 0; r < 4; ++r) { const float rr = sigmoidf_(aR[r] + br[ct]), ii = sigmoidf_(aI[r] + bi[ct]); const float la = rr * ls8[ct]; la4[r] = la; a[r] = __expf(la);
                    const float x2 = 2.f * la; const float ep = -x2 * (1.f + x2 * (0.5f + x2 * (0.16666667f + x2 * 0.041666667f))), ed = 1.f - a[r] * a[r];
                    u[r] = __builtin_amdgcn_sqrtf(x2 > -0.03f ? ep : ed) * (ii * aX[r]); }
                __builtin_nontemporal_store((v4u){pk2(la4[0], la4[1]), pk2(la4[2], la4[3]), pk2(u[0], u[1]), pk2(u[2], u[3])}, rgs + (tt * 4 + ct) * 64);
            } else {
                aG = __builtin_amdgcn_mfma_f32_16x16x32_bf16(AG[ct >> 1], IDf[ct >> 1][ct & 1], aG, 0, 0, 0);
                const v4u q = rc[ct];
                a[0] = __expf(bf2f(q.x & 0xffffu)); a[1] = __expf(bf2f(q.x >> 16)); a[2] = __expf(bf2f(q.y & 0xffffu)); a[3] = __expf(bf2f(q.y >> 16));
                u[0] = bf2f(q.z & 0xffffu); u[1] = bf2f(q.z >> 16); u[2] = bf2f(q.w & 0xffffu); u[3] = bf2f(q.w >> 16);
            }
            const float Af = a[0] * a[1] * a[2] * a[3], Hf = ((u[0] * a[1] + u[1]) * a[2] + u[2]) * a[3] + u[3];
            const bool oddr = (fq & 1) != 0, upper = fq >= 2;
            const float Ap = partner_row16(Af, oddr), Hp = partner_row16(Hf, oddr);
            const float At = Af * Ap, Ht = oddr ? (Af * Hp + Hf) : (Ap * Hf + Hp);
            const float Ao = partner_half32(At, upper), Ho = partner_half32(Ht, upper);
            const float Atot = At * Ao, Htot = upper ? (At * Ho + Ht) : (Ao * Ht + Ho);
            float Aex, Hex;
            if (!upper) { Aex = oddr ? Ap : 1.f; Hex = oddr ? Hp : 0.f; }
            else { Aex = oddr ? Ao * Ap : Ao; Hex = oddr ? (Ap * Ho + Hp) : Ho; }
            if (FINAL) { float h = Aex * hrun[ct] + Hex;
#pragma unroll
                for (int r = 0; r < 4; ++r) { h = a[r] * h + u[r]; u[r] = h * aG[r]; }
                valpk[(tt * 4 + ct) * 2] = pk2(u[0], u[1]); valpk[(tt * 4 + ct) * 2 + 1] = pk2(u[2], u[3]); }
            hrun[ct] = Atot * hrun[ct] + Htot; arun[ct] *= Atot;
        }
    }
#undef RG_LOAD_TILE
    if (!FINAL && fq == 0) {
#pragma unroll
        for (int ct = 0; ct < 4; ++ct) { const size_t o = (size_t)(b * NCH + n) * DR + c0 + 16 * ct + fr; ((float*)(F.ws + WS_RGA))[o] = arun[ct]; ((float*)(F.ws + WS_RGH))[o] = hrun[ct]; }
    }
}

__device__ __forceinline__ void ph3_passA(Frame& F) {
    bf16* DS = (bf16*)F.dsb; float* DDp = (float*)(F.ws + WS_DD);
    const int lane = F.lane, w = F.wave, fr = lane & 15, fq = lane >> 4, kp = F.tid & 63;
    LAS bf16* KT = (LAS bf16*)(F.lds + L_KT); LAS bf16* VT = (LAS bf16*)(F.lds + L_VT);
    { const int cn = F.vcu;
        const int b = cn / NCH, n = cn % NCH, t0 = b * SEQ + 64 * n;
        HgLoad LL[2]; hg_load<false>(F, t0, 0, LL[0]);
        { unsigned dummy[32]; rg_wave_task<false>(F, b, n, w, dummy); }
        hg_load<false>(F, t0, 1, LL[1]);
        LDS_BAR();
#pragma unroll
        for (int h = 0; h < NH; ++h) {
            const int task = (b * NH + h) * NCH + n; HgLoad& L = LL[h & 1];
            float c0[8], c1[8], off[2], bmid[2], blast[2]; hg_cumsum(F, L, c0, c1, off, bmid, blast);
            unsigned k0p[4], k1p[4];
#pragma unroll
            for (int i = 0; i < 8; i += 2) {
                const float a0 = bf2f(L.ki[i] & 0xffffu) * __expf(blast[0] - (off[0] + c0[i])), a1 = bf2f(L.ki[i + 1] & 0xffffu) * __expf(blast[0] - (off[0] + c0[i + 1]));
                const float d0 = bf2f(L.ki[i] >> 16) * __expf(blast[1] - (off[1] + c1[i])), d1 = bf2f(L.ki[i + 1] >> 16) * __expf(blast[1] - (off[1] + c1[i + 1]));
                k0p[i >> 1] = pk2(a0, a1); k1p[i >> 1] = pk2(d0, d1); }
            *(LAS v4u*)(KT + (2 * kp) * 72 + 8 * w) = (v4u){k0p[0], k0p[1], k0p[2], k0p[3]}; *(LAS v4u*)(KT + (2 * kp + 1) * 72 + 8 * w) = (v4u){k1p[0], k1p[1], k1p[2], k1p[3]};
            hg_store_vt(F, L, VT);
            if (w == 0) *(f32x2_t*)(DDp + (size_t)task * HD + 2 * kp) = (f32x2_t){__expf(blast[0]), __expf(blast[1])};
            if (h + 2 < NH) hg_load<false>(F, t0, h + 2, L);
            LDS_BAR();
            bf16x8 bV[2];
#pragma unroll
            for (int ss = 0; ss < 2; ++ss) bV[ss] = *(const LAS bf16x8*)(VT + (16 * w + fr) * 72 + 8 * fq + 32 * ss);
#pragma unroll
            for (int kt = 0; kt < 8; ++kt) { f32x4 acc = {0.f, 0.f, 0.f, 0.f};
#pragma unroll
                for (int ss = 0; ss < 2; ++ss) { const bf16x8 a = *(const LAS bf16x8*)(KT + (16 * kt + fr) * 72 + 8 * fq + 32 * ss); acc = __builtin_amdgcn_mfma_f32_16x16x32_bf16(a, bV[ss], acc, 0, 0, 0); }
                *(v2u*)(DS + (size_t)task * (HD * HD) + (size_t)(16 * w + fr) * HD + 16 * kt + 4 * fq) = (v2u){pk2m(acc[0], acc[1]), pk2m(acc[2], acc[3])}; }
        }
    }
}

__device__ __forceinline__ void ph4_passB(Frame& F) {
    const bf16* DS = (const bf16*)F.dsb; bf16* SST = (bf16*)F.dsb + (size_t)BATCH * NH * NCH * HD * HD; const float* DDp = (const float*)(F.ws + WS_DD);
    static_assert(BATCH * NH * HD * HD / 2 == 256 * 256 && BATCH * DR == 4 * 256, "pass B mapping");
    { const int idx = F.tid < 256 ? F.vcu * 256 + F.tid : (F.vcu < 4 ? BATCH * NH * HD * HD / 2 + F.vcu * 256 + (F.tid - 256) : -1);
        if (idx < 0) {}
        else if (idx < BATCH * NH * HD * HD / 2) {
            const int bh = idx >> 13, pr = idx & 8191, e0 = 2 * pr, kk = e0 & 127;
            float s0 = 0.f, s1 = 0.f;
            const bf16* dsp = DS + (size_t)bh * NCH * (HD * HD) + e0; bf16* sp = SST + (size_t)bh * NCH * (HD * HD) + e0; const float* ddp = DDp + (size_t)bh * NCH * HD + kk;
            unsigned dA[8], dB[8]; f32x2_t eA[8], eB[8];
#define PB_LOAD(dv, ev, n0_) do { _Pragma("unroll") for (int j = 0; j < 8; ++j) { dv[j] = __builtin_nontemporal_load((const unsigned*)(dsp + (size_t)((n0_) + j) * (HD * HD))); ev[j] = *(const f32x2_t*)(ddp + ((n0_) + j) * HD); } } while (0)
#define PB_STEP(dv, ev, n0_) do { _Pragma("unroll") for (int j = 0; j < 8; ++j) { *(unsigned*)(sp + (size_t)((n0_) + j) * (HD * HD)) = pk2(s0, s1); s0 = ev[j].x * s0 + bf2f(dv[j] & 0xffffu); s1 = ev[j].y * s1 + bf2f(dv[j] >> 16); } } while (0)
            PB_LOAD(dA, eA, 0);
#pragma unroll 1
            for (int n0 = 0; n0 < NCH - 16; n0 += 16) {
                PB_LOAD(dB, eB, n0 + 8);
                PB_STEP(dA, eA, n0);
                PB_LOAD(dA, eA, n0 + 16);
                PB_STEP(dB, eB, n0 + 8);
            }
            PB_LOAD(dB, eB, NCH - 8);
            PB_STEP(dA, eA, NCH - 16);
            PB_STEP(dB, eB, NCH - 8);
#undef PB_LOAD
#undef PB_STEP
        } else {
            const int r = idx - BATCH * NH * HD * HD / 2, b = r / DR, c = r % DR;
            const float* A = (const float*)(F.ws + WS_RGA) + (size_t)b * NCH * DR + c; const float* Hh = (const float*)(F.ws + WS_RGH) + (size_t)b * NCH * DR + c; float* C = (float*)(F.ws + WS_CARRY) + (size_t)b * NCH * DR + c;
            float carry = 0.f; float aA[16], hA[16], aB[16], hB[16];
#define RB_LOAD(av, hv, n0_) do { _Pragma("unroll") for (int j = 0; j < 16; ++j) { av[j] = A[(size_t)((n0_) + j) * DR]; hv[j] = Hh[(size_t)((n0_) + j) * DR]; } } while (0)
#define RB_STEP(av, hv, n0_) do { _Pragma("unroll") for (int j = 0; j < 16; ++j) { C[(size_t)((n0_) + j) * DR] = carry; carry = av[j] * carry + hv[j]; } } while (0)
            RB_LOAD(aA, hA, 0);
#pragma unroll 1
            for (int n0 = 0; n0 < NCH - 32; n0 += 32) {
                RB_LOAD(aB, hB, n0 + 16);
                RB_STEP(aA, hA, n0);
                RB_LOAD(aA, hA, n0 + 32);
                RB_STEP(aB, hB, n0 + 16);
            }
            RB_LOAD(aB, hB, NCH - 16);
            RB_STEP(aA, hA, NCH - 32);
            RB_STEP(aB, hB, NCH - 16);
#undef RB_LOAD
#undef RB_STEP
        }
    }
}

__device__ __forceinline__ void ph5_passC(Frame& F) {
    const bf16* PJ = (const bf16*)(F.ws + WS_PROJ); const bf16* GZ = PJ + 4 * PROJ_S;
    const bf16* SST = (const bf16*)F.dsb + (size_t)BATCH * NH * NCH * HD * HD; bf16* O = (bf16*)(F.ws + WS_H);
    const int tid = F.tid, lane = F.lane, w = F.wave, fr = lane & 15, fq = lane >> 4, kp = tid & 63;
    LAS bf16* QTL = (LAS bf16*)(F.lds + L_QTL); LAS bf16* QH = (LAS bf16*)(F.lds + L_QH); LAS bf16* KH = (LAS bf16*)(F.lds + L_KH);
    LAS bf16* VT = (LAS bf16*)(F.lds + L_VT); LAS bf16* Pm = (LAS bf16*)(F.lds + L_P); LAS float* SSQ = (LAS float*)(F.lds + L_SSQ); LAS float* RSTD = (LAS float*)(F.lds + L_RSTD);
    { const int cn = F.vcu;
        const int b = cn / NCH, n = cn % NCH, t0 = b * SEQ + 64 * n;
        HgLoad L;
        {
            LAS float* SSQ = (LAS float*)(F.lds + X_GTAB); LAS float* RSTD = SSQ + 512;
            unsigned valpk[32];
            hg_load<true>(F, t0, 0, L);
            rg_wave_task<true>(F, b, n, w, valpk);
#pragma unroll
            for (int tt = 0; tt < 4; ++tt) { float s[4] = {0.f, 0.f, 0.f, 0.f};
#pragma unroll
                for (int ct = 0; ct < 4; ++ct) { const unsigned p0 = valpk[(tt * 4 + ct) * 2], p1 = valpk[(tt * 4 + ct) * 2 + 1]; const float v0 = bf2f(p0 & 0xffffu), v1 = bf2f(p0 >> 16), v2 = bf2f(p1 & 0xffffu), v3 = bf2f(p1 >> 16);
                    s[0] += v0 * v0; s[1] += v1 * v1; s[2] += v2 * v2; s[3] += v3 * v3; }
#pragma unroll
                for (int r = 0; r < 4; ++r) { float x = row_sum16(s[r]); if (fr == 0) SSQ[(16 * tt + 4 * fq + r) * 8 + w] = x; } }
            LDS_BAR();
            if (tid < 64) { float s = 0.f;
#pragma unroll
                for (int i = 0; i < 8; ++i) s += SSQ[tid * 8 + i];
                RSTD[tid] = rsqrtf(s * (1.f / DR) + EPS); }
            LDS_BAR();
            { LAS bf16* VL = (LAS bf16*)(F.lds + w * 16384);
#pragma unroll
              for (int tt = 0; tt < 4; ++tt)
#pragma unroll
                  for (int ct = 0; ct < 4; ++ct) { const unsigned p0 = valpk[(tt * 4 + ct) * 2], p1 = valpk[(tt * 4 + ct) * 2 + 1]; const int tb = 16 * tt + 4 * fq, ch = 16 * ct + fr;
                      VL[(tb + 0) * 72 + ch] = (bf16)(p0 & 0xffffu); VL[(tb + 1) * 72 + ch] = (bf16)(p0 >> 16); VL[(tb + 2) * 72 + ch] = (bf16)(p1 & 0xffffu); VL[(tb + 3) * 72 + ch] = (bf16)(p1 >> 16); }
              LDS_WAIT();
              const int pc = lane & 7; const f32x4 g0 = *(const f32x4*)(F.in[18] + 64 * w + 8 * pc), g1 = *(const f32x4*)(F.in[18] + 64 * w + 8 * pc + 4);
#pragma unroll
              for (int p = 0; p < 8; ++p) { const int row = 8 * p + (lane >> 3); const v4u vv = *(const LAS v4u*)(VL + row * 72 + 8 * pc); const float rs = RSTD[row];
                  v4u o; o.x = pk2(bf2f(vv.x & 0xffffu) * rs * g0[0], bf2f(vv.x >> 16) * rs * g0[1]); o.y = pk2(bf2f(vv.y & 0xffffu) * rs * g0[2], bf2f(vv.y >> 16) * rs * g0[3]);
                  o.z = pk2(bf2f(vv.z & 0xffffu) * rs * g1[0], bf2f(vv.z >> 16) * rs * g1[1]); o.w = pk2(bf2f(vv.w & 0xffffu) * rs * g1[2], bf2f(vv.w >> 16) * rs * g1[3]);
                  *(v4u*)(O + (size_t)(t0 + row) * D + DH + 64 * w + 8 * pc) = o; } }
            LDS_BAR();
        }
        LAS bf16* OT = (LAS bf16*)(F.lds + L_OT);
#pragma unroll 1
        for (int h = 0; h < NH; ++h) {
            const int task = (b * NH + h) * NCH + n;
            const int pr0 = tid >> 4, pc0 = (tid & 15) * 8;
            const v4u gz0 = __builtin_nontemporal_load((const v4u*)(GZ + (size_t)(t0 + pr0) * DH + h * HD + pc0)), gz1 = __builtin_nontemporal_load((const v4u*)(GZ + (size_t)(t0 + pr0 + 32) * DH + h * HD + pc0));
            bf16x8 bS[4];
#pragma unroll
            for (int ks = 0; ks < 4; ++ks) bS[ks] = __builtin_nontemporal_load((const bf16x8*)(SST + (size_t)task * (HD * HD) + (size_t)(16 * w + fr) * HD + 8 * fq + 32 * ks));
            float c0[8], c1[8], off[2], bmid[2], blast[2]; hg_cumsum(F, L, c0, c1, off, bmid, blast);
#pragma unroll
            for (int i = 0; i < 8; ++i) { const int tl = 8 * w + i; const float b0 = off[0] + c0[i], b1 = off[1] + c1[i];
                const float q0 = bf2f(L.q[i] & 0xffffu), q1 = bf2f(L.q[i] >> 16), k0 = bf2f(L.ki[i] & 0xffffu), k1 = bf2f(L.ki[i] >> 16);
                const float eq0 = __expf(fminf(b0 - bmid[0], 80.f)), eq1 = __expf(fminf(b1 - bmid[1], 80.f)), ek0 = __expf(fminf(bmid[0] - b0, 80.f)), ek1 = __expf(fminf(bmid[1] - b1, 80.f));
                *(LAS unsigned*)(QH + tl * 136 + 2 * kp) = pk2(q0 * eq0, q1 * eq1); *(LAS unsigned*)(KH + tl * 136 + 2 * kp) = pk2(k0 * ek0, k1 * ek1);
                *(LAS unsigned*)(QTL + tl * 136 + 2 * kp) = pk2(q0 * __expf(b0), q1 * __expf(b1)); }
            hg_store_vt(F, L, VT);
            if (h + 1 < NH) hg_load<true>(F, t0, h + 1, L);
            LDS_BAR();
#pragma unroll
            for (int pp = 0; pp < 2; ++pp) { const int pi = 2 * w + pp, iq = pi >> 2, jk = pi & 3; f32x4 acc = {0.f, 0.f, 0.f, 0.f};
                if (jk <= iq) {
#pragma unroll
                    for (int ks = 0; ks < 4; ++ks) { const bf16x8 a = *(const LAS bf16x8*)(KH + (16 * jk + fr) * 136 + 8 * fq + 32 * ks); const bf16x8 bq = *(const LAS bf16x8*)(QH + (16 * iq + fr) * 136 + 8 * fq + 32 * ks);
                        acc = __builtin_amdgcn_mfma_f32_16x16x32_bf16(a, bq, acc, 0, 0, 0); }
                    if (jk == iq) {
#pragma unroll
                        for (int r = 0; r < 4; ++r) if (4 * fq + r > fr) acc[r] = 0.f; }
                }
                *(LAS v2u*)(Pm + (16 * iq + fr) * 72 + 16 * jk + 4 * fq) = (v2u){pk2m(acc[0], acc[1]), pk2m(acc[2], acc[3])}; }
            LDS_BAR();
            f32x4 oacc[4];
            { bf16x8 bV[2];
#pragma unroll
              for (int ss = 0; ss < 2; ++ss) bV[ss] = *(const LAS bf16x8*)(VT + (16 * w + fr) * 72 + 8 * fq + 32 * ss);
#pragma unroll
              for (int tt = 0; tt < 4; ++tt) { f32x4 acc = {0.f, 0.f, 0.f, 0.f};
#pragma unroll
                  for (int ss = 0; ss < 2; ++ss) { const bf16x8 a = *(const LAS bf16x8*)(Pm + (16 * tt + fr) * 72 + 8 * fq + 32 * ss); acc = __builtin_amdgcn_mfma_f32_16x16x32_bf16(a, bV[ss], acc, 0, 0, 0); }
#pragma unroll
                  for (int ks = 0; ks < 4; ++ks) { const bf16x8 a = *(const LAS bf16x8*)(QTL + (16 * tt + fr) * 136 + 8 * fq + 32 * ks); acc = __builtin_amdgcn_mfma_f32_16x16x32_bf16(a, bS[ks], acc, 0, 0, 0); }
                  oacc[tt] = acc; } }
            const float gh = F.in[10][h * HD + 16 * w + fr];
#pragma unroll
            for (int tt = 0; tt < 4; ++tt)
#pragma unroll
                for (int r = 0; r < 4; ++r) { const float ov = oacc[tt][r]; float x = row_sum16(ov * ov);
                    const int tl = 16 * tt + 4 * fq + r; if (fr == 0) SSQ[tl * 8 + w] = x; OT[tl * 136 + 16 * w + fr] = (bf16)f2bf(ov * gh); }
            LDS_BAR();
#pragma unroll
            for (int pz = 0; pz < 2; ++pz) { const int row = pr0 + 32 * pz; const v4u ot = *(const LAS v4u*)(OT + row * 136 + pc0), gz = pz ? gz1 : gz0;
                const f32x4 q0 = *(const LAS f32x4*)(SSQ + row * 8), q1 = *(const LAS f32x4*)(SSQ + row * 8 + 4); const float rs = rsqrtf((((q0[0] + q0[1]) + (q0[2] + q0[3])) + ((q1[0] + q1[1]) + (q1[2] + q1[3]))) * (1.f / HD) + EPS);
                v4u o;
                o.x = pk2(bf2f(ot.x & 0xffffu) * rs * bf2f(gz.x & 0xffffu), bf2f(ot.x >> 16) * rs * bf2f(gz.x >> 16)); o.y = pk2(bf2f(ot.y & 0xffffu) * rs * bf2f(gz.y & 0xffffu), bf2f(ot.y >> 16) * rs * bf2f(gz.y >> 16));
                o.z = pk2(bf2f(ot.z & 0xffffu) * rs * bf2f(gz.z & 0xffffu), bf2f(ot.z >> 16) * rs * bf2f(gz.z >> 16)); o.w = pk2(bf2f(ot.w & 0xffffu) * rs * bf2f(gz.w & 0xffffu), bf2f(ot.w >> 16) * rs * bf2f(gz.w >> 16));
                *(v4u*)(O + (size_t)(t0 + row) * D + h * HD + pc0) = o; }
        }
    }
}

constexpr int L7_HI = 0, L7_LO = 32768, L7_PART = 65536, L7_LG = L7_PART + 24576, L7_ROUT = L7_LG + 2304;
__device__ __forceinline__ void ph7_rows(Frame& F) {
    const float* x = F.in[0]; const float* mod = (const float*)(F.ws + WS_MOD); const bf16* mix = (const bf16*)(F.ws + WS_MIX);
    const float *gpm = F.in[5], *gpf = F.in[6], *brg = F.in[21], *bre = F.in[23];
    const bf16* RRH = (const bf16*)(F.ws + WS_RRH); const bf16* RRL = (const bf16*)(F.ws + WS_RRL);
    bf16* H = (bf16*)(F.ws + WS_H); float* wgt = (float*)(F.ws + WS_WGT);
    unsigned* cnt = (unsigned*)(F.ws + WS_CTL) + CW_CNT; int* list = (int*)(F.ws + WS_LIST);
    LAS float* PART = (LAS float*)(F.lds + L7_PART); LAS float* LG = (LAS float*)(F.lds + L7_LG); LAS float* ROUT = (LAS float*)(F.lds + L7_ROUT);
    const int w = F.wave, fr = F.lane & 15, fq = F.lane >> 4, row0 = 64 * F.vcu;
    LAS float* C1 = (LAS float*)(F.lds + 98304); LAS float* C2 = C1 + D; LAS float* C3 = C2 + D;
    v2u mv[2][4]; f32x4 xv[2][4];
#define P7_LOAD(it_) do { _Pragma("unroll") for (int rr = 0; rr < 2; ++rr) { const int m_ = row0 + 16 * (it_) + 2 * w + rr; _Pragma("unroll") for (int j = 0; j < 4; ++j) { \
        mv[rr][j] = __builtin_nontemporal_load(((const GAS v2u*)(mix + (size_t)m_ * D) + lane) + 64 * j); xv[rr][j] = __builtin_nontemporal_load(((const GAS f32x4*)(x + (size_t)m_ * D) + lane) + 64 * j); } } } while (0)
    { const int lane = F.lane; P7_LOAD(0); }
    { const float* mb = mod + (row0 / SEQ) * 6144;
      for (int c = F.tid; c < D; c += NTHR) { C1[c] = mb[2048 + c] * gpm[c]; C2[c] = gpf[c] * (1.f + mb[4096 + c]); C3[c] = mb[3072 + c]; } }
    __syncthreads();
    bf16x8 bh[4][3], bl[4][3];
#pragma unroll
    for (int ks = 0; ks < 4; ++ks)
#pragma unroll
        for (int nt = 0; nt < 3; ++nt) { const size_t wo = (size_t)(16 * nt + fr) * D + 128 * w + 32 * ks + 8 * fq; bh[ks][nt] = *(const bf16x8*)(RRH + wo); bl[ks][nt] = *(const bf16x8*)(RRL + wo); }
#pragma unroll 1
    for (int it = 0; it < 4; ++it) {
        int lane = F.lane; asm volatile("" : "+v"(lane));
#pragma unroll
        for (int rr = 0; rr < 2; ++rr) {
            const int rl = 2 * w + rr, m = row0 + 16 * it + rl;
            f32x4 v[4], xr_[4]; float s = 0.f;
#pragma unroll
            for (int j = 0; j < 4; ++j) { v[j] = (f32x4){bf2f(mv[rr][j].x & 0xffffu), bf2f(mv[rr][j].x >> 16), bf2f(mv[rr][j].y & 0xffffu), bf2f(mv[rr][j].y >> 16)}; xr_[j] = xv[rr][j];
                s += v[j].x * v[j].x + v[j].y * v[j].y + v[j].z * v[j].z + v[j].w * v[j].w; }
            const float rs1 = rsqrtf(wave_sum(s) * (1.f / D) + EPS); float s2 = 0.f;
#pragma unroll
            for (int j = 0; j < 4; ++j) { const int c0 = 4 * lane + 256 * j; const f32x4 k1 = *(const LAS f32x4*)(C1 + c0);
                xr_[j].x += k1.x * (v[j].x * rs1); xr_[j].y += k1.y * (v[j].y * rs1); xr_[j].z += k1.z * (v[j].z * rs1); xr_[j].w += k1.w * (v[j].w * rs1);
                ((GAS unsigned long long*)((bf16*)(F.ws + WS_X1B) + (size_t)m * D) + lane)[64 * j] = (unsigned long long)pk2(xr_[j].x, xr_[j].y) | ((unsigned long long)pk2(xr_[j].z, xr_[j].w) << 32);
                s2 += xr_[j].x * xr_[j].x + xr_[j].y * xr_[j].y + xr_[j].z * xr_[j].z + xr_[j].w * xr_[j].w; }
            const float rs2 = rsqrtf(wave_sum(s2) * (1.f / D) + EPS);
#pragma unroll
            for (int j = 0; j < 4; ++j) { const int c0 = 4 * lane + 256 * j; const f32x4 k2 = *(const LAS f32x4*)(C2 + c0), k3 = *(const LAS f32x4*)(C3 + c0);
                const float h0 = xr_[j].x * rs2 * k2.x + k3.x, h1 = xr_[j].y * rs2 * k2.y + k3.y, h2 = xr_[j].z * rs2 * k2.z + k3.z, h3 = xr_[j].w * rs2 * k2.w + k3.w;
                const unsigned p01 = pk2(h0, h1), p23 = pk2(h2, h3);
                ((GAS unsigned long long*)(H + (size_t)m * D) + lane)[64 * j] = (unsigned long long)p01 | ((unsigned long long)p23 << 32);
                const unsigned q01 = pk2(h0 - bf2f(p01 & 0xffffu), h1 - bf2f(p01 >> 16)), q23 = pk2(h2 - bf2f(p23 & 0xffffu), h3 - bf2f(p23 >> 16));
                const int so = rl * 2048 + ((((lane >> 1) + 32 * j) ^ rl) << 4) + (lane & 1) * 8;
                *(LAS v2u*)(F.lds + L7_HI + so) = (v2u){p01, p23}; *(LAS v2u*)(F.lds + L7_LO + so) = (v2u){q01, q23}; }
        }
        if (it < 3) P7_LOAD(it + 1);
        LDS_BAR();
        f32x4 acc[3] = {{0.f, 0.f, 0.f, 0.f}, {0.f, 0.f, 0.f, 0.f}, {0.f, 0.f, 0.f, 0.f}};
#pragma unroll
        for (int ks = 0; ks < 4; ++ks) { const int slot = 16 * w + 4 * ks + fq, so = fr * 2048 + ((slot ^ fr) << 4);
            const bf16x8 ah = *(const LAS bf16x8*)(F.lds + L7_HI + so), al = *(const LAS bf16x8*)(F.lds + L7_LO + so);
#pragma unroll
            for (int nt = 0; nt < 3; ++nt) {
                acc[nt] = __builtin_amdgcn_mfma_f32_16x16x32_bf16(ah, bh[ks][nt], acc[nt], 0, 0, 0); acc[nt] = __builtin_amdgcn_mfma_f32_16x16x32_bf16(ah, bl[ks][nt], acc[nt], 0, 0, 0); acc[nt] = __builtin_amdgcn_mfma_f32_16x16x32_bf16(al, bh[ks][nt], acc[nt], 0, 0, 0); } }
#pragma unroll
        for (int nt = 0; nt < 3; ++nt)
#pragma unroll
            for (int r = 0; r < 4; ++r) PART[(w * 16 + 4 * fq + r) * 48 + 16 * nt + fr] = acc[nt][r];
        LDS_BAR();
        int tid16 = F.tid; asm volatile("" : "+v"(tid16));
        for (int e = tid16; e < 16 * 36; e += NTHR) { const int row = e / 36, o = e - row * 36; float a = o < 4 ? brg[o] : bre[o - 4];
#pragma unroll
            for (int ww = 0; ww < 8; ++ww) a += PART[(ww * 16 + row) * 48 + o];
            LG[e] = a; }
        LDS_BAR();
        if (tid16 < 16) {
            const LAS float* lgl = LG + tid16 * 36;
            int gs = 0; float gm = lgl[0];
#pragma unroll
            for (int o = 1; o < NG; ++o) if (lgl[o] > gm) { gm = lgl[o]; gs = o; }
            float den = 0.f;
#pragma unroll
            for (int o = 0; o < NG; ++o) den += __expf(lgl[o] - gm);
            const float gate = 1.f / den;
            float sel[EPG];
#pragma unroll
            for (int o = 0; o < EPG; ++o) sel[o] = lgl[4 + 8 * gs + o];
            int i1 = 0; float m1 = sel[0];
#pragma unroll
            for (int o = 1; o < EPG; ++o) if (sel[o] > m1) { m1 = sel[o]; i1 = o; }
            int i2 = -1; float m2 = -3.0e38f;
#pragma unroll
            for (int o = 0; o < EPG; ++o) if (o != i1 && sel[o] > m2) { m2 = sel[o]; i2 = o; }
            if (i2 < 0) i2 = (i1 + 1) & 7;
            const float e2 = __expf(m2 - m1);
            *(LAS f32x4*)(ROUT + (16 * it + tid16) * 4) = (f32x4){__int_as_float(gs * EPG + i1), __int_as_float(gs * EPG + i2), gate / (1.f + e2), gate * e2 / (1.f + e2)};
        }
    }
#undef P7_LOAD
    LAS unsigned* HIST = (LAS unsigned*)(F.lds + L7_ROUT + 1024); LAS unsigned* BASE = HIST + 32;
    if (F.tid < 32) HIST[F.tid] = 0u;
    __syncthreads();
    int e_ = 0; unsigned rank_ = 0u;
    if (F.tid < 128) { const int rl = F.tid >> 1, kx = F.tid & 1; e_ = __float_as_int(ROUT[rl * 4 + kx]); rank_ = atomicAdd((unsigned*)(HIST + e_), 1u); wgt[2 * (row0 + rl) + kx] = ROUT[rl * 4 + 2 + kx]; }
    __syncthreads();
    if (F.tid < 32) { const unsigned c = HIST[F.tid]; BASE[F.tid] = c ? atomicAdd(&cnt[64 * F.tid], c) : 0u; }
    __syncthreads();
    if (F.tid < 128) list[e_ * 32768 + BASE[e_] + rank_] = 2 * row0 + F.tid;
    __syncthreads();
}

__device__ __forceinline__ int moe_tables(Frame& F) {
    LAS int* MBE = (LAS int*)(F.lds + X_MBE); LAS int* MBS = MBE + MAXMB; LAS int* NMB = MBS + 33;
    LAS int* CNTL = NMB + 1;
    if (F.tid < NE) CNTL[F.tid] = (int)__hip_atomic_load(F.ctl + CW_CNT + 64 * F.tid, RLX_AGENT);
    __syncthreads();
    if (F.tid < NE) { int mb = 0;
        for (int e = 0; e < F.tid; ++e) mb += (CNTL[e] + 255) >> 8;
        const int nb = (CNTL[F.tid] + 255) >> 8; MBS[F.tid] = mb;
        for (int j = 0; j < nb && mb + j < MAXMB; ++j) MBE[mb + j] = F.tid;
        if (F.tid == NE - 1) { MBS[NE] = mb + nb; NMB[0] = mb + nb; } }
    __syncthreads();
    return NMB[0];
}
__device__ __forceinline__ void moe_fill_tabs(Frame& F, const pg8::MoeOrder& Sup, const pg8::MoeOrder& Sdn) {
    LAS int* MBE = (LAS int*)(F.lds + X_MBE); LAS int* MBS = MBE + MAXMB; LAS int* tab = (LAS int*)(F.lds + X_GTAB); const int* list = (const int*)(F.ws + WS_LIST);
    const bool dn = F.tid >= 256; const int r = F.tid & 255; const pg8::MoeOrder& S = dn ? Sdn : Sup;
    int aid[4]; bool val[4];
#pragma unroll
    for (int i = 0; i < 4; ++i) { pg8::Unit u; val[i] = S.next(i, u) && u.slot == i; aid[i] = -1;
        if (val[i]) { const int e = MBE[u.pm], pos = (u.pm - MBS[e]) * 256 + r, c = (MBS + 34)[e]; if (pos < c) aid[i] = list[e * 32768 + pos]; } }
#pragma unroll
    for (int i = 0; i < 4; ++i) if (val[i]) tab[((dn ? 4 : 0) + i) * 256 + r] = dn ? aid[i] : (aid[i] >= 0 ? (aid[i] >> 1) * (D * 2) : 0);
    __syncthreads();
}

__device__ __forceinline__ void ph10_final(Frame& F) {
    const float* mod = (const float*)(F.ws + WS_MOD); const bf16* YA = (const bf16*)(F.ws + WS_YA); const bf16* X1 = (const bf16*)(F.ws + WS_X1B); const float* gp = F.in[7];
    LAS float* CG = (LAS float*)F.lds;
    const int gw = F.vcu * NWAVES + F.wave, NGW = F.G * NWAVES;
    v2u ya[2][4], yb[2][4], xb[2][4], ya2[2][4], yb2[2][4], xb2[2][4];
#define P10_LOAD(YA_, YB_, XB_, m0_) do { _Pragma("unroll") for (int r = 0; r < 2; ++r) { const int m_ = (m0_) + r * (T / 2); _Pragma("unroll") for (int j = 0; j < 4; ++j) { \
        YA_[r][j] = __builtin_nontemporal_load(((const GAS v2u*)(YA + (size_t)(2 * m_) * D) + lane) + 64 * j); YB_[r][j] = __builtin_nontemporal_load(((const GAS v2u*)(YA + (size_t)(2 * m_ + 1) * D) + lane) + 64 * j); XB_[r][j] = __builtin_nontemporal_load(((const GAS v2u*)(X1 + (size_t)m_ * D) + lane) + 64 * j); } } } while (0)
    int m0 = gw;
    { const int lane = F.lane; P10_LOAD(ya, yb, xb, m0); }
    for (int i = F.tid; i < 2 * D; i += NTHR) { const int b = i >> 10, c = i & 1023; CG[i] = mod[b * 6144 + 5120 + c] * gp[c]; }
    __syncthreads();
#define P10_ROWS(YA_, YB_, XB_, m0_) do { _Pragma("unroll") for (int r = 0; r < 2; ++r) { const int m = (m0_) + r * (T / 2); float y[4][4]; float s = 0.f; \
        _Pragma("unroll") for (int j = 0; j < 4; ++j) { const v2u a = YA_[r][j], c = YB_[r][j]; \
            y[j][0] = bf2f(a.x & 0xffffu) + bf2f(c.x & 0xffffu); y[j][1] = bf2f(a.x >> 16) + bf2f(c.x >> 16); y[j][2] = bf2f(a.y & 0xffffu) + bf2f(c.y & 0xffffu); y[j][3] = bf2f(a.y >> 16) + bf2f(c.y >> 16); \
            _Pragma("unroll") for (int i = 0; i < 4; ++i) s += y[j][i] * y[j][i]; } \
        const float rs = rsqrtf(wave_sum(s) * (1.f / D) + EPS); \
        _Pragma("unroll") for (int j = 0; j < 4; ++j) { const int c0 = r * D + 4 * lane + 256 * j; const f32x4 cg = *(const LAS f32x4*)(CG + c0); const v2u xq = XB_[r][j]; \
            f32x4 xv = {bf2f(xq.x & 0xffffu), bf2f(xq.x >> 16), bf2f(xq.y & 0xffffu), bf2f(xq.y >> 16)}; \
            xv.x += cg.x * (y[j][0] * rs); xv.y += cg.y * (y[j][1] * rs); xv.z += cg.z * (y[j][2] * rs); xv.w += cg.w * (y[j][3] * rs); \
            __builtin_nontemporal_store(xv, ((GAS f32x4*)(F.out + (size_t)m * D) + lane) + 64 * j); } } } while (0)
    static_assert(T / 2 == 4 * 256 * NWAVES, "row pairs per wave");
    { int lane = F.lane; asm volatile("" : "+v"(lane));
      P10_LOAD(ya2, yb2, xb2, m0 + NGW); P10_ROWS(ya, yb, xb, m0); P10_LOAD(ya, yb, xb, m0 + 2 * NGW); P10_ROWS(ya2, yb2, xb2, m0 + NGW); }
    m0 += 2 * NGW;
    { int lane = F.lane; asm volatile("" : "+v"(lane));
      P10_LOAD(ya2, yb2, xb2, m0 + NGW); P10_ROWS(ya, yb, xb, m0); P10_ROWS(ya2, yb2, xb2, m0 + NGW); }
#undef P10_LOAD
#undef P10_ROWS
}

__global__ void __launch_bounds__(NTHR, 2) skel_fwd(Args args) {
    extern __shared__ __attribute__((aligned(16))) unsigned char lds[];
    Frame F;
    F.lds = (LAS unsigned char*)lds; F.MISC = (volatile LAS unsigned*)(F.lds + X_MISC);
    F.tid = threadIdx.x; F.lane = F.tid & 63; F.wave = __builtin_amdgcn_readfirstlane(F.tid >> 6);
    F.G = gridDim.x; { const int bx = blockIdx.x; F.vcu = (F.G % 8 == 0) ? (bx % 8) * (F.G / 8) + bx / 8 : bx; }
    F.in = args.in; F.out = args.out; F.ws = args.ws; F.dsb = (unsigned char*)args.out; F.ctl = (gu32*)(args.ws + WS_CTL);
    if (F.tid < 32) F.MISC[F.tid] = 0u;
    __syncthreads();
    const XcdBarrier bar = xcd_barrier_post((unsigned*)(F.ctl + CW_BAR), F.MISC + 8);

    const int lo = args.ph_lo, hi = args.ph_hi;
#define IN(k) (lo <= (k) && (k) < hi)
#define PROBE_PH -1
#define PROBE_BLK 0
#define PROBE_OWN 0
#define PT0(k) unsigned long long t0_##k = 0; if (PROBE_PH == (k) && (int)blockIdx.x == PROBE_BLK) t0_##k = __builtin_amdgcn_s_memrealtime();
#define PT1(k) PT1X(k, 0)
#define PT1A(k) PT1X(k, 1)
#define PT1X(k, own) if (PROBE_PH == (k) && PROBE_OWN == (own) && (int)blockIdx.x == PROBE_BLK) { VM_WAIT(); __syncthreads(); const unsigned long long dt = __builtin_amdgcn_s_memrealtime() - t0_##k; while (__builtin_amdgcn_s_memrealtime() - t0_##k < 5 * dt) __builtin_amdgcn_s_sleep(8); }
    PT0(0) if (IN(0)) ph0_prologue(F); PT1A(0)
    xcd_barrier(bar); PT1(0)
    PT0(2) if (IN(2)) {
        const int bx = (int)blockIdx.x, x = bx & 7, ci = bx >> 3;
        if (ci < 8) p2_moe_weight_copies(F, x * 8 + ci);
        else {
            const int cg = x + 8 * (ci - 8);
            pg8::Gemm g{(const bf16*)(F.ws + WS_H), (const bf16*)(F.ws + WS_WIN), D}; pg8::ProjOrder S{cg, D};
            pg8::EpiProj E{(bf16*)(F.ws + WS_PROJ), (const float*)(F.ws + WS_LB)};
            pg8::gemm_phase<pg8::EpiProj, pg8::ProjOrder, false>(F.lds, g, S, E, nullptr);
            p2_moe_weight_copy_tail(F, cg * NWAVES + F.wave);
        }
    } PT1A(2)
    xcd_barrier(bar); PT1(2)
    PT0(3) if (IN(3)) ph3_passA(F); PT1A(3)
    xcd_barrier(bar); PT1(3)
    PT0(4) if (IN(4)) ph4_passB(F); PT1A(4)
    xcd_barrier(bar); PT1(4)
    PT0(5) if (IN(5)) ph5_passC(F); PT1A(5)
    xcd_barrier(bar); PT1(5)
    PT0(6) if (IN(6)) {
        pg8::Gemm g{(const bf16*)(F.ws + WS_H), (const bf16*)(F.ws + WS_WOUT), D}; pg8::StaticOrder S; S.init(T, D, D, F.G, (int)blockIdx.x);
        pg8::EpiMixB E{(bf16*)(F.ws + WS_MIX), D};
        pg8::gemm_phase<pg8::EpiMixB, pg8::StaticOrder, false>(F.lds, g, S, E, nullptr);
    } PT1A(6)
    xcd_barrier(bar); PT1(6)
    PT0(7) if (IN(7)) ph7_rows(F); PT1A(7)
    xcd_barrier(bar); PT1(7)
    PT0(8) if (IN(8)) {
        const int nmb = moe_tables(F);
        unsigned* mbc = (unsigned*)(F.ctl + CW_MB);
        pg8::MoeOrder Sup{4 * nmb, F.G, (int)blockIdx.x, D, (const LAS int*)(F.lds + X_MBE), (size_t)D * D * 2, 1, 0, mbc};
        pg8::MoeOrder Sdn{4 * nmb, F.G, (int)blockIdx.x, DE, (const LAS int*)(F.lds + X_MBE), (size_t)D * DE * 2, 1, 1, nullptr};
        moe_fill_tabs(F, Sup, Sdn);
        { pg8::Gemm g{(const bf16*)(F.ws + WS_H), (const bf16*)(F.ws + WS_W13), D}; pg8::EpiAct E{(bf16*)(F.ws + WS_ACT)};
          pg8::gemm_phase<pg8::EpiAct, pg8::MoeOrder, true>(F.lds, g, Sup, E, (const LAS unsigned*)(F.lds + X_GTAB)); }
        {
          if (F.tid < 64) { pg8::Unit u; const bool mine = F.tid < 4 && Sdn.next(F.tid, u) && u.slot == F.tid; unsigned sp = 0;
              while (__any(mine && __hip_atomic_load(F.ctl + CW_MB + 64 * u.pm, RLX_AGENT) < 32u)) { __builtin_amdgcn_s_sleep(2); if (++sp > (1u << 22)) break; }
              __builtin_amdgcn_fence(__ATOMIC_ACQUIRE, "agent"); VM_WAIT(); }
          __syncthreads();
          pg8::Gemm g{(const bf16*)(F.ws + WS_ACT), (const bf16*)(F.ws + WS_W2), DE}; pg8::EpiYa E{(bf16*)(F.ws + WS_YA), (const float*)(F.ws + WS_WGT), (const LAS int*)(F.lds + X_GTAB + 4096)};
          pg8::gemm_phase<pg8::EpiYa, pg8::MoeOrder, false>(F.lds, g, Sdn, E, nullptr); }
    } PT1A(8)
    xcd_barrier(bar); PT1(8)
    PT0(10) if (IN(10)) ph10_final(F); PT1(10)
#undef IN
#undef PT0
#undef PT1
#undef PT1X
#undef PT1A
}

extern "C" void kernel_launch(void* const* d_in, const int* in_sizes, int n_in, void* d_out, int out_size, void* d_ws, size_t ws_size, hipStream_t stream) {
    static int grid = 0;
    if (grid == 0) {
        if (n_in != 27 || out_size != T * D || ws_size < WS_END) { fprintf(stderr, "kernel_launch: unexpected n_in %d / out %d / ws %zu\n", n_in, out_size, ws_size); grid = -1; return; }
        int dev = 0, cus = 0, per_cu = 0;
        if (hipGetDevice(&dev) != hipSuccess || hipDeviceGetAttribute(&cus, hipDeviceAttributeMultiprocessorCount, dev) != hipSuccess) { grid = -1; return; }
        if (hipFuncSetAttribute((const void*)skel_fwd, hipFuncAttributeMaxDynamicSharedMemorySize, LDS_BYTES) != hipSuccess) { fprintf(stderr, "kernel_launch: hipFuncSetAttribute failed\n"); grid = -1; return; }
        if (hipOccupancyMaxActiveBlocksPerMultiprocessor(&per_cu, (const void*)skel_fwd, NTHR, LDS_BYTES) != hipSuccess || per_cu < 1) { fprintf(stderr, "kernel_launch: the occupancy query reports %d workgroups per CU; nothing launched\n", per_cu); (void)hipGetLastError(); grid = -1; return; }
        (void)hipGetLastError();
        if (cus * per_cu < 256) { fprintf(stderr, "kernel_launch: needs 256 co-resident workgroups (one per 64-token chunk), device admits %d\n", cus * per_cu); grid = -1; return; }
        grid = 256;
    }
    if (grid < 0) return;
    (void)hipMemsetAsync((char*)d_ws + WS_CTL, 0, CTL_ZERO_BYTES, stream);
    Args a{};
    for (int i = 0; i < 27; ++i) a.in[i] = (const float*)d_in[i];
    a.out = (float*)d_out; a.ws = (unsigned char*)d_ws; a.ph_lo = 0; a.ph_hi = 11;
    hipLaunchKernelGGL(skel_fwd, dim3(grid), dim3(NTHR), LDS_BYTES, stream, a);
}
```
